# Optimizing an MI355X kernel written in HIP

```python
import math
import jax, jax.numpy as jnp
from jax import lax
import numpy as np

D_MODEL = 1024
BATCH = 2
SEQ = 8192
DEPTH = 1

N_META = 16
GROUP_SIZE = 16
SSM_WIDTH = D_MODEL
N_GROUPS = SSM_WIDTH // GROUP_SIZE
STATE = 64
DT_MIN = 0.001
DT_MAX = 0.1
HEAD_DIM = 64
N_Q_HEADS = D_MODEL // HEAD_DIM
N_KV_HEADS = 2
GQA = N_Q_HEADS // N_KV_HEADS
Q_WIDTH = N_Q_HEADS * HEAD_DIM
KV_WIDTH = N_KV_HEADS * HEAD_DIM
WINDOW = 128
ATTN_BLOCK = 128
ROT_DIM = HEAD_DIM // 4
ROPE_THETA = 500000.0
IN_WIDTH = SSM_WIDTH + Q_WIDTH + 2 * KV_WIDTH + 2 * D_MODEL
N_EXPERTS = 32
TOP_K = 4
D_FF = D_MODEL
SWIGLU_LIMIT = 7.0
SWIGLU_ALPHA = 1.702
EXPERT_BLOCK = 128
RMS_EPS = 1e-5
NEG_INF = -1e30

kernel_name = "hybrid_s5_swa_moe_block"


def rmsnorm(x, g):
    x32 = x.astype(jnp.float32)
    y = x32 * lax.rsqrt(jnp.mean(x32 * x32, axis=-1, keepdims=True) + RMS_EPS)
    return (y * g.astype(jnp.float32)).astype(x.dtype)


def partial_rotary(x, cos, sin):
    half = ROT_DIM // 2
    x1, x2, xp = x[..., :half], x[..., half:ROT_DIM], x[..., ROT_DIM:]
    c = cos[None, :, None, :].astype(x.dtype)
    s = sin[None, :, None, :].astype(x.dtype)
    return jnp.concatenate([x1 * c - x2 * s, x2 * c + x1 * s, xp], axis=-1)


def _ssm_combine(e1, e2):
    a1r, a1i, b1r, b1i = e1
    a2r, a2i, b2r, b2i = e2
    return (a2r * a1r - a2i * a1i,
            a2r * a1i + a2i * a1r,
            a2r * b1r - a2i * b1i + b2r,
            a2r * b1i + a2i * b1r + b2i)


def s5_ssm(u, lam_re, lam_im, log_dt, b_re, b_im, c_re, c_im, d):
    bsz, L, _ = u.shape
    ug = u.reshape(bsz, L, N_GROUPS, GROUP_SIZE).astype(jnp.float32)
    lr = lam_re.astype(jnp.float32)
    li = lam_im.astype(jnp.float32)
    dt = jnp.exp(log_dt.astype(jnp.float32))[:, None]
    mag = jnp.exp(dt * lr)
    a_re = mag * jnp.cos(dt * li)
    a_im = mag * jnp.sin(dt * li)
    den = lr * lr + li * li
    nr, ni = a_re - 1.0, a_im
    f_re = (nr * lr + ni * li) / den
    f_im = (ni * lr - nr * li) / den
    br, bi = b_re.astype(jnp.float32), b_im.astype(jnp.float32)
    bb_re = f_re[..., None] * br - f_im[..., None] * bi
    bb_im = f_re[..., None] * bi + f_im[..., None] * br
    bu_re = jnp.einsum('blgh,gph->blgp', ug, bb_re)
    bu_im = jnp.einsum('blgh,gph->blgp', ug, bb_im)
    a_re_t = jnp.broadcast_to(a_re[None, None], (1, L, N_GROUPS, STATE))
    a_im_t = jnp.broadcast_to(a_im[None, None], (1, L, N_GROUPS, STATE))
    _, _, x_re, x_im = lax.associative_scan(_ssm_combine, (a_re_t, a_im_t, bu_re, bu_im), axis=1)
    y = (jnp.einsum('blgp,ghp->blgh', x_re, c_re.astype(jnp.float32))
         - jnp.einsum('blgp,ghp->blgh', x_im, c_im.astype(jnp.float32))
         + d.astype(jnp.float32)[None, None] * ug)
    return y.reshape(bsz, L, SSM_WIDTH).astype(u.dtype)


def sliding_window_attention(q, k, v, sinks):
    bsz, L = q.shape[:2]
    pad = ATTN_BLOCK - N_META
    Lp = L + pad
    nb = Lp // ATTN_BLOCK
    padcfg = ((0, 0), (pad, 0), (0, 0), (0, 0))
    qb = jnp.pad(q, padcfg).reshape(bsz, nb, ATTN_BLOCK, N_KV_HEADS, GQA, HEAD_DIM)
    kb = jnp.pad(k, padcfg).reshape(bsz, nb, ATTN_BLOCK, N_KV_HEADS, HEAD_DIM)
    vb = jnp.pad(v, padcfg).reshape(bsz, nb, ATTN_BLOCK, N_KV_HEADS, HEAD_DIM)
    blkpad = ((0, 0), (1, 0), (0, 0), (0, 0), (0, 0))
    k_band = jnp.concatenate([jnp.pad(kb, blkpad)[:, :-1], kb], axis=2)
    v_band = jnp.concatenate([jnp.pad(vb, blkpad)[:, :-1], vb], axis=2)
    k_meta, v_meta = k[:, :N_META], v[:, :N_META]

    q_idx = jnp.arange(nb)[:, None] * ATTN_BLOCK + jnp.arange(ATTN_BLOCK)[None, :]
    k_idx = jnp.arange(nb)[:, None] * ATTN_BLOCK - ATTN_BLOCK + jnp.arange(2 * ATTN_BLOCK)[None, :]
    qi, ki = q_idx[:, :, None], k_idx[:, None, :]
    band_ok = (ki <= qi) & (qi - ki < WINDOW) & (ki >= pad + N_META)
    meta_ok = jnp.arange(N_META)[None, None, :] <= (q_idx - pad)[:, :, None]
    mask = jnp.concatenate([band_ok, meta_ok], axis=-1)

    scale = 1.0 / math.sqrt(HEAD_DIM)
    s = jnp.concatenate([jnp.einsum('bnqhgd,bnkhd->bnhgqk', qb, k_band),
                         jnp.einsum('bnqhgd,bmhd->bnhgqm', qb, k_meta)], axis=-1)
    s = jnp.where(mask[None, :, None, None], s.astype(jnp.float32) * scale, NEG_INF)
    sink = jnp.broadcast_to(sinks.astype(jnp.float32).reshape(N_KV_HEADS, GQA)[None, None, :, :, None, None],
                            s.shape[:-1] + (1,))
    p = jax.nn.softmax(jnp.concatenate([s, sink], axis=-1), axis=-1)[..., :-1].astype(v.dtype)
    nbk = 2 * ATTN_BLOCK
    o = (jnp.einsum('bnhgqk,bnkhd->bnqhgd', p[..., :nbk], v_band)
         + jnp.einsum('bnhgqm,bmhd->bnqhgd', p[..., nbk:], v_meta))
    return o.reshape(bsz, Lp, Q_WIDTH)[:, pad:]


def moe_ffn(h, w_router, b_router, w_gate_up, b_gate_up, w_down, b_down):
    bsz, L, dm = h.shape
    xt = h.reshape(-1, dm)
    n_tok = xt.shape[0]
    logits = (xt @ w_router + b_router).astype(jnp.float32)
    top_val, top_idx = lax.top_k(logits, TOP_K)
    gates = jax.nn.softmax(top_val, axis=-1)
    n_asg = n_tok * TOP_K
    e_flat = top_idx.reshape(-1).astype(jnp.int32)
    tok_flat = jnp.arange(n_asg, dtype=jnp.int32) // TOP_K
    g_flat = gates.reshape(-1)
    order = jnp.argsort(e_flat)
    e_sorted = e_flat[order]
    counts = jnp.bincount(e_flat, length=N_EXPERTS)
    starts = jnp.cumsum(counts) - counts
    padded = (counts + EXPERT_BLOCK - 1) // EXPERT_BLOCK * EXPERT_BLOCK
    pends = jnp.cumsum(padded)
    pstarts = pends - padded
    dest = pstarts[e_sorted] + (jnp.arange(n_asg, dtype=jnp.int32) - starts[e_sorted])
    n_blocks = -(-n_asg // EXPERT_BLOCK) + N_EXPERTS
    n_slots = n_blocks * EXPERT_BLOCK
    slot_tok = jnp.full((n_slots,), n_tok, jnp.int32).at[dest].set(tok_flat[order])
    slot_gate = jnp.zeros((n_slots,), jnp.float32).at[dest].set(g_flat[order])
    block_expert = jnp.clip(jnp.searchsorted(pends, jnp.arange(n_blocks) * EXPERT_BLOCK, side='right'),
                            0, N_EXPERTS - 1).astype(jnp.int32)
    x_ext = jnp.concatenate([xt, jnp.zeros((1, dm), xt.dtype)], axis=0)

    def run_block(args):
        toks, e = args
        xb = x_ext[toks]
        gu = xb @ w_gate_up[e] + b_gate_up[e]
        g, up = gu[:, :D_FF], gu[:, D_FF:]
        g = jnp.minimum(g, SWIGLU_LIMIT)
        up = jnp.clip(up, -SWIGLU_LIMIT, SWIGLU_LIMIT)
        hid = g * jax.nn.sigmoid(SWIGLU_ALPHA * g) * (up + 1.0)
        return hid @ w_down[e] + b_down[e]

    y_slots = lax.map(run_block, (slot_tok.reshape(n_blocks, EXPERT_BLOCK), block_expert))
    y_slots = y_slots.reshape(n_slots, dm)
    y = jnp.zeros((n_tok + 1, dm), h.dtype).at[slot_tok].add(
        y_slots * slot_gate[:, None].astype(y_slots.dtype))
    return y[:n_tok].reshape(bsz, L, dm)


def setup_inputs(seed: int = 0) -> dict:
    key = jax.random.key(seed)
    ks = jax.random.split(key, 26)
    f32 = jnp.float32
    nrm = lambda k, shape, s: jax.random.normal(k, shape, f32) * s
    lam_im = jnp.broadcast_to(jnp.pi * jnp.arange(STATE, dtype=f32), (DEPTH, N_GROUPS, STATE))
    return {
        "x": nrm(ks[0], (BATCH, SEQ, D_MODEL), 1.0),
        "meta_tokens": nrm(ks[1], (N_META, D_MODEL), 1.0),
        "norm_mix": 1.0 + nrm(ks[2], (DEPTH, D_MODEL), 0.02),
        "w_in": nrm(ks[3], (DEPTH, D_MODEL, IN_WIDTH), D_MODEL ** -0.5),
        "ssm_lam_re": -0.5 * jnp.exp(nrm(ks[4], (DEPTH, N_GROUPS, STATE), 0.01)),
        "ssm_lam_im": lam_im + nrm(ks[5], (DEPTH, N_GROUPS, STATE), 0.01),
        "ssm_log_dt": jax.random.uniform(ks[6], (DEPTH, N_GROUPS), f32, math.log(DT_MIN), math.log(DT_MAX)),
        "ssm_b_re": nrm(ks[7], (DEPTH, N_GROUPS, STATE, GROUP_SIZE), (2 * GROUP_SIZE) ** -0.5),
        "ssm_b_im": nrm(ks[8], (DEPTH, N_GROUPS, STATE, GROUP_SIZE), (2 * GROUP_SIZE) ** -0.5),
        "ssm_c_re": nrm(ks[9], (DEPTH, N_GROUPS, GROUP_SIZE, STATE), STATE ** -0.5),
        "ssm_c_im": nrm(ks[10], (DEPTH, N_GROUPS, GROUP_SIZE, STATE), STATE ** -0.5),
        "ssm_d": nrm(ks[11], (DEPTH, N_GROUPS, GROUP_SIZE), 1.0),
        "w_glu": nrm(ks[12], (DEPTH, SSM_WIDTH, SSM_WIDTH), SSM_WIDTH ** -0.5),
        "b_glu": nrm(ks[13], (DEPTH, SSM_WIDTH), 0.02),
        "attn_sinks": nrm(ks[14], (DEPTH, N_Q_HEADS), 0.5),
        "w_br_ssm": nrm(ks[15], (DEPTH, SSM_WIDTH, D_MODEL), SSM_WIDTH ** -0.5),
        "w_br_attn": nrm(ks[16], (DEPTH, Q_WIDTH, D_MODEL), Q_WIDTH ** -0.5),
        "w_out": nrm(ks[17], (DEPTH, D_MODEL, D_MODEL), D_MODEL ** -0.5),
        "norm_ffn": 1.0 + nrm(ks[18], (DEPTH, D_MODEL), 0.02),
        "w_router": nrm(ks[19], (DEPTH, D_MODEL, N_EXPERTS), D_MODEL ** -0.5),
        "b_router": nrm(ks[20], (DEPTH, N_EXPERTS), 0.01),
        "w_gate_up": nrm(ks[21], (DEPTH, N_EXPERTS, D_MODEL, 2 * D_FF), D_MODEL ** -0.5),
        "b_gate_up": nrm(ks[22], (DEPTH, N_EXPERTS, 2 * D_FF), 0.02),
        "w_down": nrm(ks[23], (DEPTH, N_EXPERTS, D_FF, D_MODEL), D_FF ** -0.5),
        "b_down": nrm(ks[24], (DEPTH, N_EXPERTS, D_MODEL), 0.02),
        "norm_final": 1.0 + nrm(ks[25], (D_MODEL,), 0.02),
    }


def reference(x, meta_tokens, norm_mix, w_in, ssm_lam_re, ssm_lam_im, ssm_log_dt, ssm_b_re, ssm_b_im,
              ssm_c_re, ssm_c_im, ssm_d, w_glu, b_glu, attn_sinks, w_br_ssm, w_br_attn, w_out,
              norm_ffn, w_router, b_router, w_gate_up, b_gate_up, w_down, b_down, norm_final):
    bsz = x.shape[0]
    meta = jnp.broadcast_to(meta_tokens[None].astype(x.dtype), (bsz, N_META, D_MODEL))
    h = jnp.concatenate([meta, x], axis=1)
    L = h.shape[1]
    pos = jnp.arange(L, dtype=jnp.float32)
    inv_freq = ROPE_THETA ** (-jnp.arange(0, ROT_DIM, 2, dtype=jnp.float32) / ROT_DIM)
    ang = pos[:, None] * inv_freq[None, :]
    cos, sin = jnp.cos(ang), jnp.sin(ang)
    splits = np.cumsum([SSM_WIDTH, Q_WIDTH, KV_WIDTH, KV_WIDTH, D_MODEL]).tolist()

    for layer in range(DEPTH):
        hn = rmsnorm(h, norm_mix[layer])
        proj = hn @ w_in[layer]
        u, q, k, v, g_ssm, g_attn = jnp.split(proj, splits, axis=-1)
        y = s5_ssm(u, ssm_lam_re[layer], ssm_lam_im[layer], ssm_log_dt[layer], ssm_b_re[layer],
                   ssm_b_im[layer], ssm_c_re[layer], ssm_c_im[layer], ssm_d[layer])
        z = jax.nn.gelu(y)
        ssm_out = z * jax.nn.sigmoid(z @ w_glu[layer] + b_glu[layer])
        q = partial_rotary(q.reshape(bsz, L, N_Q_HEADS, HEAD_DIM), cos, sin)
        k = partial_rotary(k.reshape(bsz, L, N_KV_HEADS, HEAD_DIM), cos, sin)
        v = v.reshape(bsz, L, N_KV_HEADS, HEAD_DIM)
        attn_out = sliding_window_attention(q, k, v, attn_sinks[layer])
        mix = (jax.nn.sigmoid(g_ssm) * (ssm_out @ w_br_ssm[layer])
               + jax.nn.sigmoid(g_attn) * (attn_out @ w_br_attn[layer]))
        h = h + mix @ w_out[layer]
        h = h + moe_ffn(rmsnorm(h, norm_ffn[layer]), w_router[layer], b_router[layer], w_gate_up[layer],
                        b_gate_up[layer], w_down[layer], b_down[layer])

    return rmsnorm(h, norm_final)[:, N_META:]
```

```cpp
#include <hip/hip_runtime.h>
#include <cstdio>
#include <cstdint>
namespace pg8 {
#define PG8_LAS __attribute__((address_space(3)))
typedef unsigned short bf16_t;
typedef short bf16x8 __attribute__((ext_vector_type(8)));
typedef float f32x4 __attribute__((ext_vector_type(4)));
typedef unsigned u32x4 __attribute__((ext_vector_type(4)));
constexpr int BM = 256, BK = 64, HALF = 128, HTB = HALF * BK * 2  , STAGE_BYTES = 8 * HTB, NXCD = 8, WGM = 8;

__host__ __device__ __forceinline__ int lds_byte(int r, int c) { const int st = (r >> 4) * 2 + (c >> 5), rr = r & 15, cc = c & 31, ob = rr * 64 + cc * 2; return st * 1024 + (ob ^ (((ob >> 9) & 1) << 5)); }
__host__ __device__ __forceinline__ void stage_rc(int b, int& R, int& C) { const int st = b / 1024, sb = b % 1024, swz = sb ^ (((sb >> 9) & 1) << 5); R = (st >> 1) * 16 + swz / 64; C = (st & 1) * 32 + (swz % 64) / 2; }
__host__ __device__ __forceinline__ int perm32(int rho) { const int n = rho >> 4, i = rho & 15; return 8 * (i >> 2) + 4 * n + (i & 3); }

struct Unit { int pm, pn; };
struct Gemm { const bf16_t* A; const bf16_t* Bt; int M, N, K; };

struct StaticOrder {
    int nM, nN, nwg, G, c;
    __host__ __device__ void init(int M, int N, int G_, int c_) { nM = M / BM; nN = N / BM; nwg = nM * nN; G = G_; c = c_; }
    __host__ __device__ bool next(int i, Unit& u) const {
        const long L = (long)i * G + c; if (L >= nwg) return false;
        int wgid = (int)L; { const int q = nwg / NXCD, r = nwg % NXCD, xcd = wgid % NXCD, off = wgid / NXCD; wgid = (xcd < r ? xcd * (q + 1) : r * (q + 1) + (xcd - r) * q) + off; }
        const int nig = WGM * nN, gid = wgid / nig, fm = gid * WGM, gsz = (nM - fm) < WGM ? (nM - fm) : WGM;
        u.pm = fm + ((wgid % nig) % gsz); u.pn = (wgid % nig) / gsz; return true;
    }
    __device__ __forceinline__ void a_ready(const Unit&) const {}
    __device__ __forceinline__ void done(const Unit&) const {}
};
__device__ __forceinline__ unsigned cvt_pk_bf16(float lo, float hi) { unsigned r; asm volatile("v_cvt_pk_bf16_f32 %0, %1, %2" : "=v"(r) : "v"(lo), "v"(hi)); return r; }
template <class Epi, class Sched, bool ALIGN_EPI = false, bool SP2 = false>
__device__ __forceinline__ void gemm_phase(PG8_LAS unsigned char* lds, const Gemm g, const Sched& S, const Epi& E) {
    const int tid = threadIdx.x, wid = __builtin_amdgcn_readfirstlane(tid >> 6), lane = tid & 63, wr = wid >> 2, wc = wid & 3, fr = lane & 15, fq = lane >> 4;
    const int K = g.K, nt = K / BK;
    unsigned voffA[2], voffB[2];
#pragma unroll
    for (int i = 0; i < 2; ++i) { int R, C; stage_rc(tid * 16 + i * 8192, R, C); const int Rb = Epi::PERM ? ((R & ~31) + perm32(R & 31)) : R;
        voffA[i] = (unsigned)(R * K + C) * 2u; voffB[i] = (unsigned)(Rb * K + C) * 2u; }
    const size_t kstep = (size_t)(BK * 2);
    const size_t hstep = (size_t)HALF * K * 2;
    const size_t tstep = 2 * hstep;
    const unsigned ldsw = (unsigned)wid * 1024u;
    const int aoff = lds_byte(wr * 64 + fr, fq * 8), boff = lds_byte(wc * 32 + fr, fq * 8);
#define PG8_SA(b, h) (((b) * 2 + (h)) * HTB)
#define PG8_SB(b, h) ((4 + (b) * 2 + (h)) * HTB)
#define PG8_STAGE(bufoff, gbase, voff) do { _Pragma("unroll") for (int _i = 0; _i < 2; ++_i) \
        __builtin_amdgcn_global_load_lds((const unsigned*)((const char*)(gbase) + (voff)[_i]), (PG8_LAS unsigned*)(lds + (bufoff) + ldsw + _i * 8192), 16, 0, 0); } while (0)
#define PG8_LDA(dst, b, h) do { _Pragma("unroll") for (int m = 0; m < 4; ++m) _Pragma("unroll") for (int k = 0; k < 2; ++k) dst[m][k] = *(const PG8_LAS bf16x8*)(lds + PG8_SA(b, h) + aoff + m * 2048 + k * 1024); } while (0)
#define PG8_LDB(dst, b, h) do { _Pragma("unroll") for (int n = 0; n < 2; ++n) _Pragma("unroll") for (int k = 0; k < 2; ++k) dst[n][k] = *(const PG8_LAS bf16x8*)(lds + PG8_SB(b, h) + boff + n * 2048 + k * 1024); } while (0)
#define PG8_MMA(ai, bj, At, Bt) do { __builtin_amdgcn_s_setprio(1); _Pragma("unroll") for (int m = 0; m < 4; ++m) _Pragma("unroll") for (int n = 0; n < 2; ++n) _Pragma("unroll") for (int k = 0; k < 2; ++k) \
        acc[ai][bj][m][n] = __builtin_amdgcn_mfma_f32_16x16x32_bf16(Bt[n][k], At[m][k], acc[ai][bj][m][n], 0, 0, 0); __builtin_amdgcn_s_setprio(0); } while (0)
#define PG8_WAIT_V(n) asm volatile("s_waitcnt vmcnt(" #n ")" ::: "memory")
#define PG8_WAIT_L(n) asm volatile("s_waitcnt lgkmcnt(" #n ")" ::: "memory")
#define PG8_BAR __builtin_amdgcn_s_barrier()
#define PG8_SCHED __builtin_amdgcn_sched_barrier(0)
    Unit cur, nxt; int ui = 0;
    if (!S.next(0, cur)) return;
    f32x4 acc[2][2][4][2];
#pragma unroll
    for (int a = 0; a < 2; ++a)
#pragma unroll
        for (int b = 0; b < 2; ++b)
#pragma unroll
            for (int m = 0; m < 4; ++m)
#pragma unroll
                for (int n = 0; n < 2; ++n) acc[a][b][m][n] = (f32x4){0.f, 0.f, 0.f, 0.f};
    bf16x8 At[4][2], B0[2][2], B1[2][2];
    const char* cA = (const char*)g.A + (size_t)cur.pm * tstep; const char* cB = (const char*)g.Bt + (size_t)cur.pn * tstep;
    S.a_ready(cur);
    if constexpr (SP2) {
        PG8_STAGE(PG8_SB(0, 0), cB, voffB); PG8_STAGE(PG8_SB(0, 1), cB + hstep, voffB); PG8_STAGE(PG8_SA(0, 0), cA, voffA); PG8_STAGE(PG8_SA(0, 1), cA + hstep, voffA);
        if (wr == 1) PG8_BAR;
        PG8_WAIT_V(2); PG8_BAR;
        PG8_STAGE(PG8_SB(1, 0), cB + kstep, voffB); PG8_STAGE(PG8_SA(1, 0), cA + kstep, voffA); PG8_STAGE(PG8_SB(1, 1), cB + hstep + kstep, voffB);
        PG8_WAIT_V(6); PG8_BAR;
    } else {
        PG8_STAGE(PG8_SB(0, 0), cB, voffB); PG8_STAGE(PG8_SA(0, 0), cA, voffA); PG8_STAGE(PG8_SB(0, 1), cB + hstep, voffB); PG8_STAGE(PG8_SA(0, 1), cA + hstep, voffA);
        if (wr == 1) PG8_BAR;
        PG8_WAIT_V(4); PG8_BAR;
        PG8_STAGE(PG8_SB(1, 0), cB + kstep, voffB); PG8_STAGE(PG8_SA(1, 0), cA + kstep, voffA); PG8_STAGE(PG8_SB(1, 1), cB + hstep + kstep, voffB);
        PG8_WAIT_V(6); PG8_BAR;
    }
    for (;;) {
        const bool has_next = S.next(ui + 1, nxt);
        const char* nA = has_next ? (const char*)g.A + (size_t)nxt.pm * tstep : cA; const char* nB = has_next ? (const char*)g.Bt + (size_t)nxt.pn * tstep : cB;
        for (int t = 0; t < nt; t += 2) {
            if constexpr (Epi::HAS_MID) { if (t == (nt >> 1)) E.mid(acc, cur, wr, wc, fr, fq); }
            const bool last = (t == nt - 2);
            const char* a1 = cA + (size_t)(t + 1) * kstep;
            const char* a2 = last ? nA : cA + (size_t)(t + 2) * kstep; const char* b2 = last ? nB : cB + (size_t)(t + 2) * kstep;
            const char* a3 = a2 + kstep; const char* b3 = b2 + kstep;
            if (last && has_next) S.a_ready(nxt);
            if constexpr (SP2) {
            PG8_LDB(B0, 0, 0); PG8_LDB(B1, 0, 1); PG8_SCHED; PG8_LDA(At, 0, 0); PG8_STAGE(PG8_SA(1, 1), a1 + hstep, voffA);
            PG8_WAIT_V(8); PG8_WAIT_L(0); PG8_BAR; PG8_MMA(0, 0, At, B0); PG8_MMA(0, 1, At, B1); PG8_BAR; PG8_SCHED;
            PG8_LDA(At, 0, 1); PG8_STAGE(PG8_SB(0, 0), b2, voffB); PG8_STAGE(PG8_SB(0, 1), b2 + hstep, voffB); PG8_STAGE(PG8_SA(0, 0), a2, voffA);
            PG8_WAIT_V(8); PG8_WAIT_L(0); PG8_BAR; PG8_MMA(1, 0, At, B0); PG8_MMA(1, 1, At, B1); PG8_BAR; PG8_SCHED;
            PG8_LDB(B0, 1, 0); PG8_LDB(B1, 1, 1); PG8_SCHED; PG8_LDA(At, 1, 0); PG8_STAGE(PG8_SA(0, 1), a2 + hstep, voffA);
            PG8_WAIT_V(8); PG8_WAIT_L(0); PG8_BAR; PG8_MMA(0, 0, At, B0); PG8_MMA(0, 1, At, B1); PG8_BAR; PG8_SCHED;
            PG8_LDA(At, 1, 1); PG8_STAGE(PG8_SB(1, 0), b3, voffB); PG8_STAGE(PG8_SB(1, 1), b3 + hstep, voffB); PG8_STAGE(PG8_SA(1, 0), a3, voffA);
            PG8_WAIT_V(8); PG8_WAIT_L(0); PG8_BAR; PG8_MMA(1, 0, At, B0); PG8_MMA(1, 1, At, B1); PG8_BAR; PG8_SCHED;
            } else {
            PG8_LDB(B0, 0, 0); PG8_SCHED; PG8_LDA(At, 0, 0); PG8_STAGE(PG8_SA(1, 1), a1 + hstep, voffA);
            PG8_WAIT_L(8); PG8_BAR; PG8_WAIT_L(0); PG8_MMA(0, 0, At, B0); PG8_BAR; PG8_SCHED;
            PG8_LDB(B1, 0, 1); PG8_STAGE(PG8_SB(0, 0), b2, voffB);
            PG8_BAR; PG8_WAIT_L(0); PG8_MMA(0, 1, At, B1); PG8_BAR;
            PG8_LDA(At, 0, 1); PG8_STAGE(PG8_SA(0, 0), a2, voffA);
            PG8_BAR; PG8_WAIT_L(0); PG8_MMA(1, 0, At, B0); PG8_BAR; PG8_SCHED;
            PG8_STAGE(PG8_SB(0, 1), b2 + hstep, voffB);
            PG8_WAIT_V(6); PG8_BAR; PG8_MMA(1, 1, At, B1); PG8_BAR;
            PG8_LDB(B0, 1, 0); PG8_SCHED; PG8_LDA(At, 1, 0); PG8_STAGE(PG8_SA(0, 1), a2 + hstep, voffA);
            PG8_WAIT_L(8); PG8_BAR; PG8_WAIT_L(0); PG8_MMA(0, 0, At, B0); PG8_BAR; PG8_SCHED;
            PG8_LDB(B1, 1, 1); PG8_STAGE(PG8_SB(1, 0), b3, voffB);
            PG8_BAR; PG8_WAIT_L(0); PG8_MMA(0, 1, At, B1); PG8_BAR;
            PG8_LDA(At, 1, 1); PG8_STAGE(PG8_SA(1, 0), a3, voffA);
            PG8_BAR; PG8_WAIT_L(0); PG8_MMA(1, 0, At, B0); PG8_BAR; PG8_SCHED;
            PG8_STAGE(PG8_SB(1, 1), b3 + hstep, voffB);
            PG8_WAIT_V(6); PG8_BAR; PG8_MMA(1, 1, At, B1); PG8_BAR;
            }
        }
        if constexpr (ALIGN_EPI) { if (wr == 0) PG8_BAR; }
        if constexpr (!Epi::AFTER_DRAIN) { E(acc, cur, wr, wc, fr, fq); S.done(cur); }
        if (!has_next) break;
#pragma unroll
        for (int a = 0; a < 2; ++a)
#pragma unroll
            for (int b = 0; b < 2; ++b)
#pragma unroll
                for (int m = 0; m < 4; ++m)
#pragma unroll
                    for (int n = 0; n < 2; ++n) acc[a][b][m][n] = (f32x4){0.f, 0.f, 0.f, 0.f};
        cur = nxt; cA = nA; cB = nB; ++ui;
        if constexpr (ALIGN_EPI) { if (wr == 1) PG8_BAR; }
    }
    PG8_WAIT_V(0);
    if constexpr (!ALIGN_EPI) { if (wr == 0) PG8_BAR; }
    PG8_BAR;
    if constexpr (Epi::AFTER_DRAIN) { E.fused(acc, cur, wr, wc, fr, fq, lds, wid, lane); S.done(cur); }
#undef PG8_SA
#undef PG8_SB
#undef PG8_STAGE
#undef PG8_LDA
#undef PG8_LDB
#undef PG8_MMA
#undef PG8_WAIT_V
#undef PG8_WAIT_L
#undef PG8_BAR
#undef PG8_SCHED
}
}

#define GAS __attribute__((address_space(1)))
#define LAS __attribute__((address_space(3)))
typedef unsigned short bf16;
typedef float f32x4 __attribute__((ext_vector_type(4)));
typedef short bf16x8 __attribute__((ext_vector_type(8)));
typedef unsigned u32x4 __attribute__((ext_vector_type(4)));
typedef unsigned u32x2 __attribute__((ext_vector_type(2)));
typedef GAS unsigned gu32;

constexpr int NWAVES = 8;
constexpr int D = 1024, SEQ = 8192, NBATCH = 2, NMETA = 16, LTOT = SEQ + NMETA;
constexpr int M = NBATCH * SEQ;
constexpr int MP = M + 256;
constexpr int INW = 4352;
constexpr int NCH = LTOT / 16;
constexpr int NE = 32, TOPK = 4;
constexpr int MAXT = M * TOPK / 256 + NE;
constexpr int NSLOT = MAXT * 256;
constexpr int VP = 8320;
constexpr float RMS_EPS = 1e-5f;

constexpr size_t MiB = 1ull << 20;
constexpr size_t WS_CTL = 0, CTL_ZERO_BYTES = 65536;
constexpr size_t WS_ROT = 1 * MiB;
constexpr size_t WS_TOK = 2 * MiB;
constexpr size_t WS_SSMP = 4 * MiB;
constexpr size_t WS_WIN = 32 * MiB;
constexpr size_t WS_WGLU = 41 * MiB;
constexpr size_t WS_WBR = 43 * MiB;
constexpr size_t WS_WOUT = 47 * MiB;
constexpr size_t WS_WGU = 49 * MiB;
constexpr size_t WS_WDN = 177 * MiB;
constexpr size_t WS_XN = 241 * MiB;
constexpr size_t WS_U = 274 * MiB;
constexpr size_t WS_Q = 307 * MiB;
constexpr size_t WS_K = 339 * MiB;
constexpr size_t WS_VT = 344 * MiB;
constexpr size_t WS_GS = 349 * MiB;
constexpr size_t WS_GA = 381 * MiB;
constexpr size_t WS_Z = 413 * MiB;
constexpr size_t WS_BRA = 445 * MiB;
constexpr size_t WS_MIX = 509 * MiB;
constexpr size_t WS_H1 = 541 * MiB;
constexpr size_t WS_HN2 = 605 * MiB;
constexpr size_t WS_S16 = 637 * MiB;
constexpr size_t WS_XC = 671 * MiB;
constexpr size_t WS_XS = 241 * MiB;
constexpr size_t WS_HID = 385 * MiB;
constexpr size_t WS_YS = 688 * MiB;
constexpr size_t WS_END = 832 * MiB;
static_assert((size_t)NSLOT * 2048 <= 144 * MiB, "slot buffers");
constexpr int CW_TMO = 0, CW_CNT = 1024, CW_BAR = 4096;

constexpr int RING_BYTES = 131072;
constexpr int LDSCTL_OFF = RING_BYTES;
constexpr int LDS_BYTES = 147456;

#define LDS_WAIT() asm volatile("s_waitcnt lgkmcnt(0)" ::: "memory")
#define VM_WAIT() asm volatile("s_waitcnt vmcnt(0)" ::: "memory")
#define RLX_AGENT __ATOMIC_RELAXED, __HIP_MEMORY_SCOPE_AGENT

__device__ __forceinline__ unsigned f2bf(float f) { unsigned u = __builtin_bit_cast(unsigned, f); return (u + 0x7fffu + ((u >> 16) & 1u)) >> 16; }
__device__ __forceinline__ unsigned pk2(float lo, float hi) { return f2bf(lo) | (f2bf(hi) << 16); }
__device__ __forceinline__ float bflo(unsigned w) { return __uint_as_float(w << 16); }
__device__ __forceinline__ float bfhi(unsigned w) { return __uint_as_float(w & 0xffff0000u); }
__device__ __forceinline__ float bf2f(bf16 b) { return __uint_as_float((unsigned)b << 16); }
__device__ __forceinline__ float wave_sum(float v) {
#pragma unroll
    for (int o = 1; o < 64; o <<= 1) v += __shfl_xor(v, o);
    return v;
}
__device__ __forceinline__ float wave_max(float v) {
#pragma unroll
    for (int o = 1; o < 64; o <<= 1) v = fmaxf(v, __shfl_xor(v, o));
    return v;
}
__device__ __forceinline__ float sigmoidf_(float x) { return 1.0f / (1.0f + __expf(-x)); }
__device__ __forceinline__ float gelu_tanh(float x) { const float u = 0.7978845608028654f * (x + 0.044715f * x * x * x); return x / (1.0f + __expf(-2.0f * u)); }
__device__ __forceinline__ void unpack8(u32x4 w, float (&v)[8]) { v[0] = bflo(w.x); v[1] = bfhi(w.x); v[2] = bflo(w.y); v[3] = bfhi(w.y); v[4] = bflo(w.z); v[5] = bfhi(w.z); v[6] = bflo(w.w); v[7] = bfhi(w.w); }
__device__ __forceinline__ u32x4 pack8(const float (&v)[8]) { u32x4 w; w.x = pk2(v[0], v[1]); w.y = pk2(v[2], v[3]); w.z = pk2(v[4], v[5]); w.w = pk2(v[6], v[7]); return w; }

struct Args { const float* in[26]; float* out; unsigned char* ws; int ph_lo, ph_hi; };
struct Ctx { LAS unsigned char* lds; unsigned char* ws; int tid, lane, wave, G, bid, gw, ngw; };
using pg8::Unit;

template <class E>
__device__ __forceinline__ void naive_gemm_unit(const bf16* __restrict__ A, int lda, const bf16* __restrict__ Bt, int ldb, int K, int pm, int pn, const E& e, int wave, int lane) {
    const int fr = lane & 15, fq = lane >> 4;
    const int row0 = pm * 256 + wave * 32;
#pragma unroll 1
    for (int cg = 0; cg < 4; ++cg) {
        f32x4 acc[2][2][2];
#pragma unroll
        for (int i = 0; i < 2; ++i)
#pragma unroll
            for (int j = 0; j < 2; ++j)
#pragma unroll
                for (int n = 0; n < 2; ++n) acc[i][j][n] = (f32x4){0.f, 0.f, 0.f, 0.f};
        const bf16* ap[2]; const bf16* bp[2][2];
#pragma unroll
        for (int mi = 0; mi < 2; ++mi) ap[mi] = A + (size_t)(row0 + 16 * mi + fr) * lda + 8 * fq;
#pragma unroll
        for (int bj = 0; bj < 2; ++bj)
#pragma unroll
            for (int n = 0; n < 2; ++n) bp[bj][n] = Bt + (size_t)(pn * 256 + 128 * bj + 32 * cg + pg8::perm32(16 * n + fr)) * ldb + 8 * fq;
#pragma unroll 1
        for (int k0 = 0; k0 < K; k0 += 32) {
            if constexpr (E::HAS_MID) {
                if (k0 == (K >> 1)) {
#pragma unroll
                    for (int mi = 0; mi < 2; ++mi) e.mid(row0 + 16 * mi + fr, pn * 256 + 32 * cg + 8 * fq, acc[mi][0][0], acc[mi][0][1], acc[mi][1][0], acc[mi][1][1]);
                }
            }
            bf16x8 av[2], bv[2][2];
#pragma unroll
            for (int mi = 0; mi < 2; ++mi) av[mi] = *(const bf16x8*)(ap[mi] + k0);
#pragma unroll
            for (int bj = 0; bj < 2; ++bj)
#pragma unroll
                for (int n = 0; n < 2; ++n) bv[bj][n] = *(const bf16x8*)(bp[bj][n] + k0);
#pragma unroll
            for (int mi = 0; mi < 2; ++mi)
#pragma unroll
                for (int bj = 0; bj < 2; ++bj)
#pragma unroll
                    for (int n = 0; n < 2; ++n) acc[mi][bj][n] = __builtin_amdgcn_mfma_f32_16x16x32_bf16(bv[bj][n], av[mi], acc[mi][bj][n], 0, 0, 0);
        }
#pragma unroll
        for (int mi = 0; mi < 2; ++mi) e.row8(row0 + 16 * mi + fr, pn * 256 + 32 * cg + 8 * fq, acc[mi][0][0], acc[mi][0][1], acc[mi][1][0], acc[mi][1][1], pm, pn);
    }
}
template <class E> struct FastEpi {
    static constexpr bool PERM = true, AFTER_DRAIN = false, HAS_MID = E::HAS_MID;
    E e;
    __device__ __forceinline__ void operator()(const f32x4 (&acc)[2][2][4][2], const Unit& u, int wr, int wc, int fr, int fq) const {
#pragma unroll
        for (int ai = 0; ai < 2; ++ai)
#pragma unroll
            for (int m = 0; m < 4; ++m)
                e.row8(u.pm * 256 + ai * 128 + wr * 64 + m * 16 + fr, u.pn * 256 + wc * 32 + 8 * fq, acc[ai][0][m][0], acc[ai][0][m][1], acc[ai][1][m][0], acc[ai][1][m][1], u.pm, u.pn);
    }
    __device__ __forceinline__ void mid(f32x4 (&acc)[2][2][4][2], const Unit& u, int wr, int wc, int fr, int fq) const {
        if constexpr (E::HAS_MID) {
#pragma unroll
            for (int ai = 0; ai < 2; ++ai)
#pragma unroll
                for (int m = 0; m < 4; ++m)
                    e.mid(u.pm * 256 + ai * 128 + wr * 64 + m * 16 + fr, u.pn * 256 + wc * 32 + 8 * fq, acc[ai][0][m][0], acc[ai][0][m][1], acc[ai][1][m][0], acc[ai][1][m][1]);
        }
    }
};
struct RowMajorOrder {
    int nN, nwg, G, c;
    __device__ __forceinline__ bool next(int i, Unit& u) const { const long L = (long)i * G + c; if (L >= nwg) return false; u.pm = (int)L / nN; u.pn = (int)L % nN; return true; }
    __device__ __forceinline__ void a_ready(const Unit&) const {}
    __device__ __forceinline__ void done(const Unit&) const {}
};
struct MoeOrder {
    const LAS int* tile_e; int ntiles, nct, G, c;
    __device__ __forceinline__ bool next(int i, Unit& u) const { const long L = (long)i * G + c; if (L >= (long)ntiles * nct) return false; const int rt = (int)L / nct, ct = (int)L % nct; u.pm = rt; u.pn = tile_e[rt] * nct + ct; return true; }
    __device__ __forceinline__ void a_ready(const Unit&) const {}
    __device__ __forceinline__ void done(const Unit&) const {}
};

__device__ __forceinline__ void f4to8(f32x4 a0, f32x4 a1, float (&v)[8]) { v[0] = a0[0]; v[1] = a0[1]; v[2] = a0[2]; v[3] = a0[3]; v[4] = a1[0]; v[5] = a1[1]; v[6] = a1[2]; v[7] = a1[3]; }

struct EpiInProj {
    static constexpr bool HAS_MID = false;
    bf16 *U, *Q, *Kb, *Vt, *GSp, *GAp; const float* rot;
    __device__ __forceinline__ void one(int row, int col, f32x4 v0, f32x4 v1) const {
        const bool meta = row >= M;
        if (meta) { if (row >= M + NMETA) return; if (!(col < 1024 || (col >= 2048 && col < 2304))) return; }
        const int pos = meta ? row - M : NMETA + (row & (SEQ - 1));
        const int b0 = meta ? 0 : (row >> 13), nb = meta ? 2 : 1;
        float v[8]; f4to8(v0, v1, v);
        if (col < 1024) {
            const int g = col >> 4, h0 = col & 15; const u32x4 w = pack8(v);
            for (int bi = 0; bi < nb; ++bi) { const int b = b0 + bi; *(u32x4*)(U + ((size_t)((g * 2 + b) * NCH + (pos >> 4)) * 256 + (pos & 15) * 16 + h0)) = w; }
        } else if (col < 2176) {
            if ((col & 63) < 16) {
                const int i0 = (col & 8) ? 4 : 0; const float* cs = rot + pos * 16;
#pragma unroll
                for (int j = 0; j < 4; ++j) { const float c = cs[i0 + j], s = cs[8 + i0 + j], x1 = v[j], x2 = v[4 + j]; v[j] = x1 * c - x2 * s; v[4 + j] = x2 * c + x1 * s; }
            }
            if (col < 2048) {
#pragma unroll
                for (int j = 0; j < 8; ++j) v[j] *= 0.125f;
                *(u32x4*)(Q + (size_t)row * 1024 + (col - 1024)) = pack8(v);
            } else {
                const u32x4 w = pack8(v);
                for (int bi = 0; bi < nb; ++bi) { const int b = b0 + bi; *(u32x4*)(Kb + ((size_t)(b * LTOT + pos)) * 128 + (col - 2048)) = w; }
            }
        } else if (col < 2304) {
            const int cc = col - 2176, kvh = cc >> 6, d0 = cc & 63;
            for (int bi = 0; bi < nb; ++bi) { const int b = b0 + bi;
#pragma unroll
                for (int j = 0; j < 8; ++j) Vt[((size_t)((b * 2 + kvh) * 64 + d0 + j)) * VP + pos] = (bf16)f2bf(v[j]); }
        } else {
#pragma unroll
            for (int j = 0; j < 8; ++j) v[j] = sigmoidf_(v[j]);
            if (col < 3328) *(u32x4*)(GSp + (size_t)row * 1024 + (col - 2304)) = pack8(v);
            else *(u32x4*)(GAp + (size_t)row * 1024 + (col - 3328)) = pack8(v);
        }
    }
    __device__ __forceinline__ void row8(int row, int col, f32x4 a0, f32x4 a1, f32x4 b0, f32x4 b1, int, int) const { one(row, col, a0, a1); one(row, col + 128, b0, b1); }
};
struct EpiGlu {
    static constexpr bool HAS_MID = false;
    const bf16* Z; const float* bias; bf16* O;
    __device__ __forceinline__ void one(int row, int col, f32x4 v0, f32x4 v1) const {
        float v[8], z[8]; f4to8(v0, v1, v); unpack8(*(const u32x4*)(Z + (size_t)row * 1024 + col), z);
        const f32x4 c0 = *(const f32x4*)(bias + col), c1 = *(const f32x4*)(bias + col + 4); float bb[8]; f4to8(c0, c1, bb);
#pragma unroll
        for (int j = 0; j < 8; ++j) v[j] = z[j] * sigmoidf_(v[j] + bb[j]);
        *(u32x4*)(O + (size_t)row * 2048 + col) = pack8(v);
    }
    __device__ __forceinline__ void row8(int row, int col, f32x4 a0, f32x4 a1, f32x4 b0, f32x4 b1, int, int) const { one(row, col, a0, a1); one(row, col + 128, b0, b1); }
};
struct EpiBr {
    static constexpr bool HAS_MID = true;
    const bf16* GSp; const bf16* GAp; bf16* MIX;
    __device__ __forceinline__ void mid1(int row, int col, f32x4& v0, f32x4& v1) const {
        float gs[8], ga[8]; unpack8(*(const u32x4*)(GSp + (size_t)row * 1024 + col), gs); unpack8(*(const u32x4*)(GAp + (size_t)row * 1024 + col), ga);
#pragma unroll
        for (int j = 0; j < 4; ++j) { v0[j] *= gs[j] / fmaxf(ga[j], 1e-20f); v1[j] *= gs[4 + j] / fmaxf(ga[4 + j], 1e-20f); }
    }
    __device__ __forceinline__ void mid(int row, int col, f32x4& a0, f32x4& a1, f32x4& b0, f32x4& b1) const { mid1(row, col, a0, a1); mid1(row, col + 128, b0, b1); }
    __device__ __forceinline__ void one(int row, int col, f32x4 v0, f32x4 v1) const {
        float v[8], ga[8]; f4to8(v0, v1, v); unpack8(*(const u32x4*)(GAp + (size_t)row * 1024 + col), ga);
#pragma unroll
        for (int j = 0; j < 8; ++j) v[j] *= ga[j];
        *(u32x4*)(MIX + (size_t)row * 1024 + col) = pack8(v);
    }
    __device__ __forceinline__ void row8(int row, int col, f32x4 a0, f32x4 a1, f32x4 b0, f32x4 b1, int, int) const { one(row, col, a0, a1); one(row, col + 128, b0, b1); }
};
struct EpiOut {
    static constexpr bool HAS_MID = false;
    const float* X; float* H1;
    __device__ __forceinline__ void one(int row, int col, f32x4 v0, f32x4 v1) const {
        const size_t o = (size_t)row * 1024 + col;
        *(f32x4*)(H1 + o) = *(const f32x4*)(X + o) + v0; *(f32x4*)(H1 + o + 4) = *(const f32x4*)(X + o + 4) + v1;
    }
    __device__ __forceinline__ void row8(int row, int col, f32x4 a0, f32x4 a1, f32x4 b0, f32x4 b1, int, int) const { one(row, col, a0, a1); one(row, col + 128, b0, b1); }
};
struct EpiMoe1 {
    static constexpr bool HAS_MID = false;
    const float* bgu; bf16* HID;
    __device__ __forceinline__ void row8(int row, int col, f32x4 a0, f32x4 a1, f32x4 b0, f32x4 b1, int, int pn) const {
        const int e = pn >> 3, ct = pn & 7, j0 = 128 * ct + (col - pn * 256);
        float g[8], up[8], bg[8], bu[8]; f4to8(a0, a1, g); f4to8(b0, b1, up);
        const float* bp = bgu + (size_t)e * 2048 + j0;
        f4to8(*(const f32x4*)bp, *(const f32x4*)(bp + 4), bg); f4to8(*(const f32x4*)(bp + 1024), *(const f32x4*)(bp + 1028), bu);
#pragma unroll
        for (int j = 0; j < 8; ++j) { const float gg = fminf(g[j] + bg[j], 7.0f), uu = fminf(fmaxf(up[j] + bu[j], -7.0f), 7.0f); g[j] = gg * sigmoidf_(1.702f * gg) * (uu + 1.0f); }
        *(u32x4*)(HID + (size_t)row * 1024 + j0) = pack8(g);
    }
};
struct EpiMoe2 {
    static constexpr bool HAS_MID = false;
    const float* bd; const float* SG; bf16* YS;
    __device__ __forceinline__ void one(int row, int e, int c0, f32x4 v0, f32x4 v1, float gt) const {
        float v[8], bb[8]; f4to8(v0, v1, v); const float* bp = bd + (size_t)e * 1024 + c0; f4to8(*(const f32x4*)bp, *(const f32x4*)(bp + 4), bb);
#pragma unroll
        for (int j = 0; j < 8; ++j) v[j] = (v[j] + bb[j]) * gt;
        *(u32x4*)(YS + (size_t)row * 1024 + c0) = pack8(v);
    }
    __device__ __forceinline__ void row8(int row, int col, f32x4 a0, f32x4 a1, f32x4 b0, f32x4 b1, int, int pn) const {
        const int e = pn >> 2, ct = pn & 3, c0 = 256 * ct + (col - pn * 256); const float gt = SG[row];
        one(row, e, c0, a0, a1, gt); one(row, e, c0 + 128, b0, b1, gt);
    }
};
#define XB_TMO      128
#define XB_XCNT(j)  (256  + 64 * (j))
#define XB_XSUB(j)  (1280 + 64 * (j))
#define XB_XGEN(j)  (2304 + 64 * (j))
#define XB_TOP      3328
#define XB_TOPGEN   3392
#define XCD_BAR_WORDS 3456
#define XB_SPIN_CAP (1u << 18)

__device__ __forceinline__ unsigned xb_ld(unsigned* p)              { return __hip_atomic_load(p, __ATOMIC_RELAXED, __HIP_MEMORY_SCOPE_AGENT); }
__device__ __forceinline__ unsigned xb_add(unsigned* p, unsigned v) { return __hip_atomic_fetch_add(p, v, __ATOMIC_RELAXED, __HIP_MEMORY_SCOPE_AGENT); }
__device__ __forceinline__ unsigned xb_xcc_id() { return (unsigned)__builtin_amdgcn_s_getreg((3 << 11) | 20) & 0xFu; }
#define XB_SPIN(cond, bar) do { unsigned _sp = 0; while (cond) { __builtin_amdgcn_s_sleep(1); \
    if ((++_sp & 255u) == 0u) { if (xb_ld(&(bar)[XB_TMO])) break; if (_sp > XB_SPIN_CAP) { atomicAdd(&(bar)[XB_TMO], 1u); break; } } } } while (0)

struct XcdBarrier {
    unsigned* bar; unsigned x;
    volatile LAS unsigned* st;
};

__device__ __forceinline__ XcdBarrier xcd_barrier_post(unsigned* bar, volatile LAS unsigned* st) {
    XcdBarrier b; b.bar = bar; b.x = xb_xcc_id(); b.st = st;
    if (threadIdx.x == 0) (void)xb_add(&bar[XB_XCNT(b.x)], 1u);
    return b;
}
__device__ __forceinline__ void xcd_barrier_complete(unsigned* bar, unsigned x, unsigned& nloc, unsigned& nx) {
    const unsigned G = gridDim.x * gridDim.y * gridDim.z;
    unsigned sum, cnt, mine, sp = 0u;
    for (;;) {
        sum = 0u; cnt = 0u; mine = 0u;
#pragma unroll
        for (unsigned j = 0; j < 16; ++j) { const unsigned c = xb_ld(&bar[XB_XCNT(j)]); sum += c; cnt += (c > 0u) ? 1u : 0u; mine = (j == x) ? c : mine; }
        if (sum == G) break;
        __builtin_amdgcn_s_sleep(1);
        if ((++sp & 255u) == 0u) { if (xb_ld(&bar[XB_TMO])) break; if (sp > XB_SPIN_CAP) { atomicAdd(&bar[XB_TMO], 1u); break; } }
    }
    nloc = mine > 0u ? mine : 1u; nx = cnt > 0u ? cnt : 1u;
}

__device__ __forceinline__ void xcd_barrier(const XcdBarrier& b) {
    asm volatile("s_waitcnt vmcnt(0)" ::: "memory");
    __syncthreads();
    if (threadIdx.x == 0) {
        unsigned* bar = b.bar;
        __builtin_amdgcn_s_waitcnt(0);
        unsigned nloc = b.st[0], nx = b.st[1];
        if (nloc == 0u) { xcd_barrier_complete(bar, b.x, nloc, nx); b.st[0] = nloc; b.st[1] = nx; }
        const unsigned old = xb_add(&bar[XB_XSUB(b.x)], 1u);
        const unsigned gen = old / nloc;
        if (old + 1u == (gen + 1u) * nloc) {
            __builtin_amdgcn_fence(__ATOMIC_RELEASE, "agent");
            asm volatile("s_waitcnt vmcnt(0)" ::: "memory");
            const unsigned og = xb_add(&bar[XB_TOP], 1u);
            const unsigned tg = og / nx;
            if (og + 1u == (tg + 1u) * nx) xb_add(&bar[XB_TOPGEN], 1u);
            else XB_SPIN(xb_ld(&bar[XB_TOPGEN]) == tg, bar);
            __builtin_amdgcn_fence(__ATOMIC_ACQUIRE, "agent");
            xb_add(&bar[XB_XGEN(b.x)], 1u);
            asm volatile("s_waitcnt vmcnt(0)" ::: "memory");
        } else {
            XB_SPIN(xb_ld(&bar[XB_XGEN(b.x)]) == gen, bar);
            __builtin_amdgcn_fence(__ATOMIC_ACQUIRE, "agent");
            asm volatile("s_waitcnt vmcnt(0)" ::: "memory");
        }
    }
    __syncthreads();
}

__device__ __forceinline__ int swap23(int p) { return (p & 3) | ((p & 4) << 1) | ((p & 8) >> 1); }
__device__ __forceinline__ void tr_item(const float* __restrict__ W, int ldw, int k0, int n0src, bool perm, bf16* WT, int ldt, int rowdst0, int kdst, LAS float* scr, int lane) {
#pragma unroll 8
    for (int i = 0; i < 32; ++i) { const int kk = 2 * i + (lane >> 5); scr[kk * 33 + (lane & 31)] = W[(size_t)(k0 + kk) * ldw + n0src + (lane & 31)]; }
    LDS_WAIT(); asm volatile("" ::: "memory");
    const int c = lane & 7;
#pragma unroll
    for (int j = 0; j < 4; ++j) { const int n = (lane >> 3) + 8 * j; const int ns = (perm && n < 16) ? swap23(n) : n; const LAS float* s = scr + (8 * c) * 33 + ns;
        u32x4 o; o.x = pk2(s[0 * 33], s[1 * 33]); o.y = pk2(s[2 * 33], s[3 * 33]); o.z = pk2(s[4 * 33], s[5 * 33]); o.w = pk2(s[6 * 33], s[7 * 33]);
        *(u32x4*)(WT + (size_t)(rowdst0 + n) * ldt + kdst + k0 + 8 * c) = o; }
    LDS_WAIT(); asm volatile("" ::: "memory");
}
__device__ __forceinline__ void rms_row_to_bf16(const float* xrow, const float* gain, bf16* orow, int lane) {
    f32x4 v[4]; float s = 0.f;
#pragma unroll
    for (int j = 0; j < 4; ++j) { v[j] = *(const f32x4*)(xrow + 4 * lane + 256 * j); s += (v[j].x * v[j].x + v[j].y * v[j].y) + (v[j].z * v[j].z + v[j].w * v[j].w); }
    const float rstd = 1.0f / sqrtf(wave_sum(s) * (1.0f / D) + RMS_EPS);
#pragma unroll
    for (int j = 0; j < 4; ++j) { const f32x4 g = *(const f32x4*)(gain + 4 * lane + 256 * j); u32x2 w; w.x = pk2(v[j].x * rstd * g.x, v[j].y * rstd * g.y); w.y = pk2(v[j].z * rstd * g.z, v[j].w * rstd * g.w);
        *(u32x2*)(orow + 4 * lane + 256 * j) = w; }
}
__device__ __forceinline__ void p0_prologue(const Args& a, const Ctx& c) {
    LAS float* scr = (LAS float*)(c.lds + c.wave * 16384);
    bf16* WinT = (bf16*)(c.ws + WS_WIN); bf16* WgluT = (bf16*)(c.ws + WS_WGLU); bf16* WbrT = (bf16*)(c.ws + WS_WBR); bf16* WoutT = (bf16*)(c.ws + WS_WOUT);
    bf16* WguT = (bf16*)(c.ws + WS_WGU); bf16* WdnT = (bf16*)(c.ws + WS_WDN);
    constexpr int NI_IN = 16 * 136, NI_SQ = 512, NI_GU = 32 * 1024, NI_DN = 32 * 512, NI_ALL = NI_IN + 4 * NI_SQ + NI_GU + NI_DN;
    for (int it = c.gw; it < NI_ALL; it += c.ngw) {
        int r = it;
        if (r < NI_IN) { const int kb = r / 136, nb = r % 136, n0 = 32 * nb; const bool perm = (n0 >= 1024 && n0 < 2176 && (n0 & 63) == 0);
            tr_item(a.in[3], INW, 64 * kb, n0, perm, WinT, 1024, n0, 0, scr, c.lane); continue; } r -= NI_IN;
        if (r < NI_SQ) { tr_item(a.in[12], 1024, 64 * (r >> 5), 32 * (r & 31), false, WgluT, 1024, 32 * (r & 31), 0, scr, c.lane); continue; } r -= NI_SQ;
        if (r < NI_SQ) { tr_item(a.in[15], 1024, 64 * (r >> 5), 32 * (r & 31), false, WbrT, 2048, 32 * (r & 31), 0, scr, c.lane); continue; } r -= NI_SQ;
        if (r < NI_SQ) { tr_item(a.in[16], 1024, 64 * (r >> 5), 32 * (r & 31), false, WbrT, 2048, 32 * (r & 31), 1024, scr, c.lane); continue; } r -= NI_SQ;
        if (r < NI_SQ) { tr_item(a.in[17], 1024, 64 * (r >> 5), 32 * (r & 31), false, WoutT, 1024, 32 * (r & 31), 0, scr, c.lane); continue; } r -= NI_SQ;
        if (r < NI_GU) { const int e = r >> 10, rr = r & 1023, kb = rr >> 6, r0 = 32 * (rr & 63), jt = r0 >> 8, w = r0 & 255; const int src = w < 128 ? 128 * jt + w : 1024 + 128 * jt + (w - 128);
            tr_item(a.in[21] + (size_t)e * 1024 * 2048, 2048, 64 * kb, src, false, WguT + (size_t)e * 2048 * 1024, 1024, r0, 0, scr, c.lane); continue; } r -= NI_GU;
        { const int e = r >> 9, rr = r & 511, kb = rr >> 5, nb = rr & 31;
            tr_item(a.in[23] + (size_t)e * 1024 * 1024, 1024, 64 * kb, 32 * nb, false, WdnT + (size_t)e * 1024 * 1024, 1024, 32 * nb, 0, scr, c.lane); }
    }
    bf16* XN = (bf16*)(c.ws + WS_XN);
    for (int m = c.gw; m < MP; m += c.ngw) {
        if (m < M + NMETA) rms_row_to_bf16(m < M ? a.in[0] + (size_t)m * D : a.in[1] + (size_t)(m - M) * D, a.in[2], XN + (size_t)m * D, c.lane);
        else { u32x4 z = {0u, 0u, 0u, 0u}; *(u32x4*)(XN + (size_t)m * D + 8 * c.lane) = z; *(u32x4*)(XN + (size_t)m * D + 512 + 8 * c.lane) = z; }
    }
    const int gt = c.bid * (NWAVES * 64) + c.tid, ngt = c.G * NWAVES * 64;
    float* rot = (float*)(c.ws + WS_ROT);
    for (int i = gt; i < LTOT * 8; i += ngt) { const int pos = i >> 3, j = i & 7; const float inv = powf(500000.0f, -(float)(2 * j) / 16.0f); const float ang = (float)pos * inv;
        rot[pos * 16 + j] = cosf(ang); rot[pos * 16 + 8 + j] = sinf(ang); }
    float* Ab = (float*)(c.ws + WS_SSMP); float* BB = Ab + 16384;
    for (int i = gt; i < 4096; i += ngt) { const int g = i >> 6;
        const float lr = a.in[4][i], li = a.in[5][i], dt = expf(a.in[6][g]), mag = expf(dt * lr), ar = mag * cosf(dt * li), ai = mag * sinf(dt * li);
        const float den = lr * lr + li * li, nr = ar - 1.0f, ni = ai, fr = (nr * lr + ni * li) / den, fi = (ni * lr - nr * li) / den;
        Ab[2 * i] = ar; Ab[2 * i + 1] = ai;
        for (int h = 0; h < 16; ++h) { const float br = a.in[7][i * 16 + h], bi = a.in[8][i * 16 + h]; BB[(i * 16 + h) * 2] = fr * br - fi * bi; BB[(i * 16 + h) * 2 + 1] = fr * bi + fi * br; }
    }
}

__device__ __forceinline__ void p2_ssm_naive(const Args& a, const Ctx& c) {
    const float* Ab = (const float*)(c.ws + WS_SSMP); const float* BB = Ab + 16384;
    const bf16* U = (const bf16*)(c.ws + WS_U); bf16* Z = (bf16*)(c.ws + WS_Z);
    for (int it = c.gw; it < 128; it += c.ngw) {
        const int g = it >> 1, b = it & 1, p = c.lane, gp = g * 64 + p;
        const float ar = Ab[2 * gp], ai = Ab[2 * gp + 1];
        float bbr[16], bbi[16], cr[16], ci[16], dd[16];
#pragma unroll
        for (int h = 0; h < 16; ++h) { bbr[h] = BB[(gp * 16 + h) * 2]; bbi[h] = BB[(gp * 16 + h) * 2 + 1]; cr[h] = a.in[9][(g * 16 + h) * 64 + p]; ci[h] = a.in[10][(g * 16 + h) * 64 + p]; dd[h] = a.in[11][g * 16 + h]; }
        float xr = 0.f, xi = 0.f;
        const bf16* up = U + (size_t)((g * 2 + b) * NCH) * 256;
        for (int t = 0; t < LTOT; ++t) {
            float u[16]; { float t0[8], t1[8]; unpack8(*(const u32x4*)(up + t * 16), t0); unpack8(*(const u32x4*)(up + t * 16 + 8), t1);
#pragma unroll
                for (int h = 0; h < 8; ++h) { u[h] = t0[h]; u[8 + h] = t1[h]; } }
            float br_ = 0.f, bi_ = 0.f;
#pragma unroll
            for (int h = 0; h < 16; ++h) { br_ += bbr[h] * u[h]; bi_ += bbi[h] * u[h]; }
            const float nxr = ar * xr - ai * xi + br_, nxi = ar * xi + ai * xr + bi_; xr = nxr; xi = nxi;
            if (t >= NMETA) {
                float mine = 0.f;
#pragma unroll
                for (int h = 0; h < 16; ++h) { float v = wave_sum(cr[h] * xr - ci[h] * xi); if (c.lane == h) mine = v + dd[h] * u[h]; }
                if (c.lane < 16) Z[(size_t)(b * SEQ + t - NMETA) * 1024 + g * 16 + c.lane] = (bf16)f2bf(gelu_tanh(mine));
            }
        }
    }
}
__device__ __forceinline__ float dot8(u32x4 q, u32x4 k) {
    return (bflo(q.x) * bflo(k.x) + bfhi(q.x) * bfhi(k.x)) + (bflo(q.y) * bflo(k.y) + bfhi(q.y) * bfhi(k.y)) + (bflo(q.z) * bflo(k.z) + bfhi(q.z) * bfhi(k.z)) + (bflo(q.w) * bflo(k.w) + bfhi(q.w) * bfhi(k.w));
}
__device__ __forceinline__ void p2_attn_naive(const Args& a, const Ctx& c) {
    const bf16* Q = (const bf16*)(c.ws + WS_Q); const bf16* Kb = (const bf16*)(c.ws + WS_K); const bf16* Vt = (const bf16*)(c.ws + WS_VT); bf16* BRA = (bf16*)(c.ws + WS_BRA);
    const int lane = c.lane;
    for (int it = c.gw; it < M * 16; it += c.ngw) {
        const int r = it >> 4, h = it & 15, kvh = h >> 3, b = r >> 13, t = r & (SEQ - 1);
        u32x4 qv[8];
#pragma unroll
        for (int i = 0; i < 8; ++i) qv[i] = *(const u32x4*)(Q + (size_t)r * 1024 + h * 64 + 8 * i);
        float s[3];
#pragma unroll
        for (int sl = 0; sl < 3; ++sl) {
            int pos; bool ok;
            if (sl < 2) { const int tok = t - 127 + lane + 64 * sl; ok = tok >= 0; pos = NMETA + (ok ? tok : 0); } else { ok = lane < NMETA; pos = ok ? lane : 0; }
            const bf16* kp = Kb + ((size_t)(b * LTOT + pos)) * 128 + kvh * 64; float acc = 0.f;
#pragma unroll
            for (int i = 0; i < 8; ++i) acc += dot8(qv[i], *(const u32x4*)(kp + 8 * i));
            s[sl] = ok ? acc : -1e30f;
        }
        const float sink = a.in[14][h];
        const float mx = wave_max(fmaxf(fmaxf(s[0], s[1]), fmaxf(s[2], sink)));
        const float p0 = __expf(s[0] - mx), p1 = __expf(s[1] - mx), p2 = __expf(s[2] - mx);
        const float l = wave_sum(p0 + p1 + p2) + __expf(sink - mx);
        const bf16* vrow = Vt + ((size_t)((b * 2 + kvh) * 64 + lane)) * VP;
        float o = 0.f;
        for (int j = 0; j < 128; ++j) { const int tok = t - 127 + j; const float pj = __shfl(j < 64 ? p0 : p1, j & 63); if (tok >= 0) o += pj * bf2f(vrow[NMETA + tok]); }
        for (int j = 0; j < NMETA; ++j) { const float pj = __shfl(p2, j); o += pj * bf2f(vrow[j]); }
        BRA[(size_t)r * 2048 + 1024 + h * 64 + lane] = (bf16)f2bf(o / l);
    }
}

__device__ __forceinline__ void p6_router(const Args& a, const Ctx& c) {
    const float* H1 = (const float*)(c.ws + WS_H1); bf16* HN2 = (bf16*)(c.ws + WS_HN2);
    int* TE = (int*)(c.ws + WS_TOK); int* TP = TE + M * 4; float* TG = (float*)(TP + M * 4);
    unsigned* cnt = (unsigned*)(c.ws + WS_CTL) + CW_CNT;
    const float* wr = a.in[19]; const float* brt = a.in[20]; const float* gain = a.in[18];
    const int lane = c.lane;
    for (int row = c.gw; row < M; row += c.ngw) {
        f32x4 v[4]; float s = 0.f;
#pragma unroll
        for (int j = 0; j < 4; ++j) { v[j] = *(const f32x4*)(H1 + (size_t)row * D + 4 * lane + 256 * j); s += (v[j].x * v[j].x + v[j].y * v[j].y) + (v[j].z * v[j].z + v[j].w * v[j].w); }
        const float rstd = 1.0f / sqrtf(wave_sum(s) * (1.0f / D) + RMS_EPS);
        float lg[32];
#pragma unroll
        for (int e = 0; e < 32; ++e) lg[e] = 0.f;
#pragma unroll
        for (int j = 0; j < 4; ++j) { const f32x4 g = *(const f32x4*)(gain + 4 * lane + 256 * j); v[j] = v[j] * rstd * g;
            u32x2 w; w.x = pk2(v[j].x, v[j].y); w.y = pk2(v[j].z, v[j].w); *(u32x2*)(HN2 + (size_t)row * D + 4 * lane + 256 * j) = w;
#pragma unroll
            for (int i = 0; i < 4; ++i) { const float xv = v[j][i]; const float* wp = wr + (size_t)(4 * lane + 256 * j + i) * 32;
#pragma unroll
                for (int q = 0; q < 8; ++q) { const f32x4 w4 = *(const f32x4*)(wp + 4 * q); lg[4 * q] += xv * w4.x; lg[4 * q + 1] += xv * w4.y; lg[4 * q + 2] += xv * w4.z; lg[4 * q + 3] += xv * w4.w; } } }
#pragma unroll
        for (int e = 0; e < 32; ++e) lg[e] = wave_sum(lg[e]) + brt[e];
        int te[4]; float tv[4];
#pragma unroll
        for (int k = 0; k < 4; ++k) { float best = -3.0e38f; int bi = 0;
#pragma unroll
            for (int e = 0; e < 32; ++e) if (lg[e] > best) { best = lg[e]; bi = e; }
            te[k] = bi; tv[k] = best;
#pragma unroll
            for (int e = 0; e < 32; ++e) if (e == bi) lg[e] = -3.0e38f; }
        const float e1 = __expf(tv[1] - tv[0]), e2 = __expf(tv[2] - tv[0]), e3 = __expf(tv[3] - tv[0]), inv = 1.0f / (1.0f + e1 + e2 + e3);
        if (lane == 0) {
            const float gts[4] = {inv, e1 * inv, e2 * inv, e3 * inv};
#pragma unroll
            for (int k = 0; k < 4; ++k) { const unsigned p = __hip_atomic_fetch_add(cnt + te[k], 1u, RLX_AGENT); TE[row * 4 + k] = te[k]; TP[row * 4 + k] = (int)p; TG[row * 4 + k] = gts[k]; }
        }
    }
}
__device__ __forceinline__ int moe_tables(const Ctx& c, LAS int* tb, LAS int* tile_e) {
    __syncthreads();
    if (c.tid == 0) { const gu32* cnt = (const gu32*)(c.ws + WS_CTL) + CW_CNT; int acc = 0;
        for (int e = 0; e < NE; ++e) { tb[e] = acc; const int n = ((int)__hip_atomic_load(cnt + e, RLX_AGENT) + 255) >> 8; for (int i = 0; i < n && acc + i < MAXT; ++i) tile_e[acc + i] = e; acc += n; if (acc > MAXT) acc = MAXT; }
        tb[NE] = acc; }
    __syncthreads();
    return tb[NE];
}
__device__ __forceinline__ void p7_gather(const Args& a, const Ctx& c, LAS int* tb) {
    const bf16* HN2 = (const bf16*)(c.ws + WS_HN2); bf16* XS = (bf16*)(c.ws + WS_XS);
    const int* TE = (const int*)(c.ws + WS_TOK); const int* TP = TE + M * 4; const float* TG = (const float*)(TP + M * 4); int* TS = (int*)(TG + M * 4); float* SG = (float*)(TS + M * 4);
    for (int row = c.gw; row < M; row += c.ngw) {
        const u32x4 w0 = *(const u32x4*)(HN2 + (size_t)row * D + 8 * c.lane), w1 = *(const u32x4*)(HN2 + (size_t)row * D + 512 + 8 * c.lane);
#pragma unroll
        for (int k = 0; k < 4; ++k) { const int e = TE[row * 4 + k], slot = tb[e] * 256 + TP[row * 4 + k];
            *(u32x4*)(XS + (size_t)slot * D + 8 * c.lane) = w0; *(u32x4*)(XS + (size_t)slot * D + 512 + 8 * c.lane) = w1;
            if (c.lane == 0) { TS[row * 4 + k] = slot; SG[slot] = TG[row * 4 + k]; } }
    }
}
__device__ __forceinline__ void p10_final(const Args& a, const Ctx& c) {
    const float* H1 = (const float*)(c.ws + WS_H1); const bf16* YS = (const bf16*)(c.ws + WS_YS);
    const int* TS = (const int*)(c.ws + WS_TOK) + M * 12; const float* gain = a.in[25];
    for (int row = c.gw; row < M; row += c.ngw) {
        f32x4 v[4];
#pragma unroll
        for (int j = 0; j < 4; ++j) v[j] = *(const f32x4*)(H1 + (size_t)row * D + 4 * c.lane + 256 * j);
#pragma unroll
        for (int k = 0; k < 4; ++k) { const bf16* ys = YS + (size_t)TS[row * 4 + k] * D;
#pragma unroll
            for (int j = 0; j < 4; ++j) { const u32x2 w = *(const u32x2*)(ys + 4 * c.lane + 256 * j); v[j].x += bflo(w.x); v[j].y += bfhi(w.x); v[j].z += bflo(w.y); v[j].w += bfhi(w.y); } }
        float s = 0.f;
#pragma unroll
        for (int j = 0; j < 4; ++j) s += (v[j].x * v[j].x + v[j].y * v[j].y) + (v[j].z * v[j].z + v[j].w * v[j].w);
        const float rstd = 1.0f / sqrtf(wave_sum(s) * (1.0f / D) + RMS_EPS);
#pragma unroll
        for (int j = 0; j < 4; ++j) { const f32x4 g = *(const f32x4*)(gain + 4 * c.lane + 256 * j); *(f32x4*)(a.out + (size_t)row * D + 4 * c.lane + 256 * j) = v[j] * rstd * g; }
    }
}

#ifndef ONE_LAUNCH
#define ONE_LAUNCH 0
#endif
#ifndef FAST_GEMM
#define FAST_GEMM 0
#endif
constexpr int NPH = 11;

template <bool FAST, class E, class S>
__device__ __forceinline__ void run_gemm(const Ctx& c, const bf16* A, const bf16* Bt, int K, const S& s, const E& e) {
    if constexpr (FAST) { pg8::Gemm g{A, Bt, 0, 0, K}; FastEpi<E> fe{e}; pg8::gemm_phase<FastEpi<E>, S, true, true>(c.lds, g, s, fe); }
    else { Unit u; for (int i = 0; s.next(i, u); ++i) naive_gemm_unit(A, K, Bt, K, K, u.pm, u.pn, e, c.wave, c.lane); }
}

__global__ void __launch_bounds__(NWAVES * 64, 2) fwd(Args args) {
    extern __shared__ __attribute__((aligned(16))) unsigned char lds_raw[];
    Ctx c; c.lds = (LAS unsigned char*)lds_raw; c.ws = args.ws; c.tid = threadIdx.x; c.lane = c.tid & 63; c.wave = __builtin_amdgcn_readfirstlane(c.tid >> 6);
    c.G = gridDim.x; c.bid = blockIdx.x; c.gw = c.bid * NWAVES + c.wave; c.ngw = c.G * NWAVES;
    volatile LAS unsigned* MISC = (volatile LAS unsigned*)(c.lds + LDSCTL_OFF);
    LAS int* tb = (LAS int*)(c.lds + LDSCTL_OFF + 512); LAS int* tile_e = (LAS int*)(c.lds + LDSCTL_OFF + 1024);
    for (int u = c.tid; u < (LDS_BYTES - LDSCTL_OFF) / 4; u += NWAVES * 64) ((LAS unsigned*)(c.lds + LDSCTL_OFF))[u] = 0u;
    __syncthreads();
    const int lo = args.ph_lo, hi = args.ph_hi;
    XcdBarrier bar; bar.bar = (unsigned*)(c.ws + WS_CTL) + CW_BAR; bar.x = 0; bar.st = nullptr;
    if (hi - lo > 1) bar = xcd_barrier_post((unsigned*)(c.ws + WS_CTL) + CW_BAR, MISC + 8);
#ifndef DISMASK
#define DISMASK 0
#endif
#define IN(k) (lo <= (k) && (k) < hi && !((DISMASK >> (k)) & 1))
#define SEAM(k) do { if (IN(k) && IN((k) + 1)) xcd_barrier(bar); } while (0)
    unsigned char* ws = c.ws;
    bf16* XN = (bf16*)(ws + WS_XN); bf16* U = (bf16*)(ws + WS_U); bf16* Q = (bf16*)(ws + WS_Q); bf16* Kb = (bf16*)(ws + WS_K); bf16* Vt = (bf16*)(ws + WS_VT);
    bf16* GSp = (bf16*)(ws + WS_GS); bf16* GAp = (bf16*)(ws + WS_GA); bf16* Z = (bf16*)(ws + WS_Z); bf16* BRA = (bf16*)(ws + WS_BRA); bf16* MIX = (bf16*)(ws + WS_MIX);
    float* H1 = (float*)(ws + WS_H1); bf16* XS = (bf16*)(ws + WS_XS); bf16* HID = (bf16*)(ws + WS_HID); bf16* YS = (bf16*)(ws + WS_YS);

    if (IN(0)) { p0_prologue(args, c); } SEAM(0);
    if (IN(1)) {
        pg8::StaticOrder S; S.init(MP, INW, c.G, c.bid);
        EpiInProj E{U, Q, Kb, Vt, GSp, GAp, (const float*)(ws + WS_ROT)};
        run_gemm<FAST_GEMM>(c, XN, (const bf16*)(ws + WS_WIN), 1024, S, E);
    } SEAM(1);
    if (IN(2)) { p2_ssm_naive(args, c); p2_attn_naive(args, c); } SEAM(2);
    if (IN(3)) {
        pg8::StaticOrder S; S.init(M, 1024, c.G, c.bid);
        EpiGlu E{Z, args.in[13], BRA};
        run_gemm<FAST_GEMM>(c, Z, (const bf16*)(ws + WS_WGLU), 1024, S, E);
    } SEAM(3);
    if (IN(4)) {
        pg8::StaticOrder S; S.init(M, 1024, c.G, c.bid);
        EpiBr E{GSp, GAp, MIX};
        run_gemm<FAST_GEMM>(c, BRA, (const bf16*)(ws + WS_WBR), 2048, S, E);
    } SEAM(4);
    if (IN(5)) {
        pg8::StaticOrder S; S.init(M, 1024, c.G, c.bid);
        EpiOut E{args.in[0], H1};
        run_gemm<FAST_GEMM>(c, MIX, (const bf16*)(ws + WS_WOUT), 1024, S, E);
    } SEAM(5);
    if (IN(6)) { p6_router(args, c); } SEAM(6);
    if (IN(7)) { moe_tables(c, tb, tile_e); p7_gather(args, c, tb); } SEAM(7);
    if (IN(8)) {
        const int nt = moe_tables(c, tb, tile_e);
        MoeOrder S{tile_e, nt, 8, c.G, c.bid};
        EpiMoe1 E{args.in[22], HID};
        run_gemm<FAST_GEMM>(c, XS, (const bf16*)(ws + WS_WGU), 1024, S, E);
    } SEAM(8);
    if (IN(9)) {
        const int nt = moe_tables(c, tb, tile_e);
        MoeOrder S{tile_e, nt, 4, c.G, c.bid};
        EpiMoe2 E{args.in[24], (const float*)(ws + WS_TOK) + M * 16, YS};
        run_gemm<FAST_GEMM>(c, HID, (const bf16*)(ws + WS_WDN), 1024, S, E);
    } SEAM(9);
    if (IN(10)) { p10_final(args, c); }
#undef IN
#undef SEAM
}

extern "C" void kernel_launch(void* const* d_in, const int* in_sizes, int n_in, void* d_out, int out_size, void* d_ws, size_t ws_size, hipStream_t stream) {
    static int grid = 0;
    if (grid == 0) {
        if (n_in != 26 || in_sizes[0] != M * D || out_size != M * D || ws_size < WS_END) { fprintf(stderr, "kernel_launch: unexpected shapes (n_in %d, in0 %d, out %d, ws %zu)\n", n_in, n_in > 0 ? in_sizes[0] : -1, out_size, ws_size); grid = -1; return; }
        int dev = 0, cus = 0, per_cu = 0;
        if (hipGetDevice(&dev) != hipSuccess || hipDeviceGetAttribute(&cus, hipDeviceAttributeMultiprocessorCount, dev) != hipSuccess) { grid = -1; return; }
        if (hipFuncSetAttribute((const void*)fwd, hipFuncAttributeMaxDynamicSharedMemorySize, LDS_BYTES) != hipSuccess) { fprintf(stderr, "kernel_launch: hipFuncSetAttribute failed\n"); grid = -1; return; }
        if (hipOccupancyMaxActiveBlocksPerMultiprocessor(&per_cu, (const void*)fwd, NWAVES * 64, LDS_BYTES) != hipSuccess || per_cu < 1) fprintf(stderr, "kernel_launch: occupancy query says %d\n", per_cu);
        (void)hipGetLastError();
        grid = cus;
    }
    if (grid < 0) return;
    if (hipMemsetAsync((char*)d_ws + WS_CTL, 0, CTL_ZERO_BYTES, stream) != hipSuccess) return;
    Args a{};
    for (int i = 0; i < 26; ++i) a.in[i] = (const float*)d_in[i];
    a.out = (float*)d_out; a.ws = (unsigned char*)d_ws;
#if ONE_LAUNCH
    a.ph_lo = 0; a.ph_hi = NPH;
    hipLaunchKernelGGL(fwd, dim3(grid), dim3(NWAVES * 64), LDS_BYTES, stream, a);
#else
    for (int p = 0; p < NPH; ++p) { a.ph_lo = p; a.ph_hi = p + 1; hipLaunchKernelGGL(fwd, dim3(grid), dim3(NWAVES * 64), LDS_BYTES, stream, a); }
#endif
}
```

```cpp
#include <hip/hip_runtime.h>
#include <cstdio>
#include <cstdint>
#define ONE_LAUNCH 1
#define FAST_GEMM 1
#define FAST_MIX 1
namespace pg8 {
#define PG8_LAS __attribute__((address_space(3)))
typedef unsigned short bf16_t;
typedef short bf16x8 __attribute__((ext_vector_type(8)));
typedef float f32x4 __attribute__((ext_vector_type(4)));
typedef unsigned u32x4 __attribute__((ext_vector_type(4)));
constexpr int BM = 256, BK = 64, HALF = 128, HTB = HALF * BK * 2  , STAGE_BYTES = 8 * HTB, NXCD = 8, WGM = 8;

__host__ __device__ __forceinline__ int lds_byte(int r, int c) { const int st = (r >> 4) * 2 + (c >> 5), rr = r & 15, cc = c & 31, ob = rr * 64 + cc * 2; return st * 1024 + (ob ^ (((ob >> 9) & 1) << 5)); }
__host__ __device__ __forceinline__ void stage_rc(int b, int& R, int& C) { const int st = b / 1024, sb = b % 1024, swz = sb ^ (((sb >> 9) & 1) << 5); R = (st >> 1) * 16 + swz / 64; C = (st & 1) * 32 + (swz % 64) / 2; }
__host__ __device__ __forceinline__ int perm32(int rho) { const int n = rho >> 4, i = rho & 15; return 8 * (i >> 2) + 4 * n + (i & 3); }

struct Unit { int pm, pn; };
struct Gemm { const bf16_t* A; const bf16_t* Bt; int M, N, K; };

struct StaticOrder {
    int nM, nN, nwg, G, c;
    __host__ __device__ void init(int M, int N, int G_, int c_) { nM = M / BM; nN = N / BM; nwg = nM * nN; G = G_; c = c_; }
    __host__ __device__ bool next(int i, Unit& u) const {
        const long L = (long)i * G + c; if (L >= nwg) return false;
        int wgid = (int)L; { const int q = nwg / NXCD, r = nwg % NXCD, xcd = wgid % NXCD, off = wgid / NXCD; wgid = (xcd < r ? xcd * (q + 1) : r * (q + 1) + (xcd - r) * q) + off; }
        const int nig = WGM * nN, gid = wgid / nig, fm = gid * WGM, gsz = (nM - fm) < WGM ? (nM - fm) : WGM;
        u.pm = fm + ((wgid % nig) % gsz); u.pn = (wgid % nig) / gsz; return true;
    }
    __device__ __forceinline__ void a_ready(const Unit&) const {}
    __device__ __forceinline__ void done(const Unit&) const {}
};
__device__ __forceinline__ unsigned cvt_pk_bf16(float lo, float hi) { unsigned r; asm volatile("v_cvt_pk_bf16_f32 %0, %1, %2" : "=v"(r) : "v"(lo), "v"(hi)); return r; }
template <class Epi, class Sched, bool ALIGN_EPI = false, bool SP2 = false>
__device__ __forceinline__ void gemm_phase(PG8_LAS unsigned char* lds, const Gemm g, const Sched& S, const Epi& E) {
    const int tid = threadIdx.x, wid = __builtin_amdgcn_readfirstlane(tid >> 6), lane = tid & 63, wr = wid >> 2, wc = wid & 3, fr = lane & 15, fq = lane >> 4;
    const int K = g.K, nt = K / BK;
    unsigned voffA[2], voffB[2];
#pragma unroll
    for (int i = 0; i < 2; ++i) { int R, C; stage_rc(tid * 16 + i * 8192, R, C); const int Rb = Epi::PERM ? ((R & ~31) + perm32(R & 31)) : R;
        voffA[i] = (unsigned)(R * K + C) * 2u; voffB[i] = (unsigned)(Rb * K + C) * 2u; }
    const size_t kstep = (size_t)(BK * 2);
    const size_t hstep = (size_t)HALF * K * 2;
    const size_t tstep = 2 * hstep;
    const unsigned ldsw = (unsigned)wid * 1024u;
    const int aoff = lds_byte(wr * 64 + fr, fq * 8), boff = lds_byte(wc * 32 + fr, fq * 8);
#define PG8_SA(b, h) (((b) * 2 + (h)) * HTB)
#define PG8_SB(b, h) ((4 + (b) * 2 + (h)) * HTB)
#define PG8_STAGE(bufoff, gbase, voff) do { _Pragma("unroll") for (int _i = 0; _i < 2; ++_i) \
        __builtin_amdgcn_global_load_lds((const unsigned*)((const char*)(gbase) + (voff)[_i]), (PG8_LAS unsigned*)(lds + (bufoff) + ldsw + _i * 8192), 16, 0, 0); } while (0)
#define PG8_LDA(dst, b, h) do { _Pragma("unroll") for (int m = 0; m < 4; ++m) _Pragma("unroll") for (int k = 0; k < 2; ++k) dst[m][k] = *(const PG8_LAS bf16x8*)(lds + PG8_SA(b, h) + aoff + m * 2048 + k * 1024); } while (0)
#define PG8_LDB(dst, b, h) do { _Pragma("unroll") for (int n = 0; n < 2; ++n) _Pragma("unroll") for (int k = 0; k < 2; ++k) dst[n][k] = *(const PG8_LAS bf16x8*)(lds + PG8_SB(b, h) + boff + n * 2048 + k * 1024); } while (0)
#define PG8_MMA(ai, bj, At, Bt) do { __builtin_amdgcn_s_setprio(1); _Pragma("unroll") for (int m = 0; m < 4; ++m) _Pragma("unroll") for (int n = 0; n < 2; ++n) _Pragma("unroll") for (int k = 0; k < 2; ++k) \
        acc[ai][bj][m][n] = __builtin_amdgcn_mfma_f32_16x16x32_bf16(Bt[n][k], At[m][k], acc[ai][bj][m][n], 0, 0, 0); __builtin_amdgcn_s_setprio(0); } while (0)
#define PG8_WAIT_V(n) asm volatile("s_waitcnt vmcnt(" #n ")" ::: "memory")
#define PG8_WAIT_L(n) asm volatile("s_waitcnt lgkmcnt(" #n ")" ::: "memory")
#define PG8_BAR __builtin_amdgcn_s_barrier()
#define PG8_SCHED __builtin_amdgcn_sched_barrier(0)
    Unit cur, nxt; int ui = 0;
    if (!S.next(0, cur)) return;
    f32x4 acc[2][2][4][2];
#pragma unroll
    for (int a = 0; a < 2; ++a)
#pragma unroll
        for (int b = 0; b < 2; ++b)
#pragma unroll
            for (int m = 0; m < 4; ++m)
#pragma unroll
                for (int n = 0; n < 2; ++n) acc[a][b][m][n] = (f32x4){0.f, 0.f, 0.f, 0.f};
    bf16x8 At[4][2], B0[2][2], B1[2][2];
    const char* cA = (const char*)g.A + (size_t)cur.pm * tstep; const char* cB = (const char*)g.Bt + (size_t)cur.pn * tstep;
    S.a_ready(cur);
    if constexpr (SP2) {
        PG8_STAGE(PG8_SB(0, 0), cB, voffB); PG8_STAGE(PG8_SB(0, 1), cB + hstep, voffB); PG8_STAGE(PG8_SA(0, 0), cA, voffA); PG8_STAGE(PG8_SA(0, 1), cA + hstep, voffA);
        if (wr == 1) PG8_BAR;
        PG8_WAIT_V(2); PG8_BAR;
        PG8_STAGE(PG8_SB(1, 0), cB + kstep, voffB); PG8_STAGE(PG8_SA(1, 0), cA + kstep, voffA); PG8_STAGE(PG8_SB(1, 1), cB + hstep + kstep, voffB);
        PG8_WAIT_V(6); PG8_BAR;
    } else {
        PG8_STAGE(PG8_SB(0, 0), cB, voffB); PG8_STAGE(PG8_SA(0, 0), cA, voffA); PG8_STAGE(PG8_SB(0, 1), cB + hstep, voffB); PG8_STAGE(PG8_SA(0, 1), cA + hstep, voffA);
        if (wr == 1) PG8_BAR;
        PG8_WAIT_V(4); PG8_BAR;
        PG8_STAGE(PG8_SB(1, 0), cB + kstep, voffB); PG8_STAGE(PG8_SA(1, 0), cA + kstep, voffA); PG8_STAGE(PG8_SB(1, 1), cB + hstep + kstep, voffB);
        PG8_WAIT_V(6); PG8_BAR;
    }
    for (;;) {
        const bool has_next = S.next(ui + 1, nxt);
        const char* nA = has_next ? (const char*)g.A + (size_t)nxt.pm * tstep : cA; const char* nB = has_next ? (const char*)g.Bt + (size_t)nxt.pn * tstep : cB;
        for (int t = 0; t < nt; t += 2) {
            const bool last = (t == nt - 2);
            const char* a1 = cA + (size_t)(t + 1) * kstep;
            const char* a2 = last ? nA : cA + (size_t)(t + 2) * kstep; const char* b2 = last ? nB : cB + (size_t)(t + 2) * kstep;
            const char* a3 = a2 + kstep; const char* b3 = b2 + kstep;
            if (last && has_next) S.a_ready(nxt);
            if constexpr (SP2) {
            PG8_LDB(B0, 0, 0); PG8_LDB(B1, 0, 1); PG8_SCHED; PG8_LDA(At, 0, 0); PG8_STAGE(PG8_SA(1, 1), a1 + hstep, voffA);
            PG8_WAIT_V(8); PG8_WAIT_L(0); PG8_BAR; PG8_MMA(0, 0, At, B0); PG8_MMA(0, 1, At, B1); PG8_BAR; PG8_SCHED;
            PG8_LDA(At, 0, 1); PG8_STAGE(PG8_SB(0, 0), b2, voffB); PG8_STAGE(PG8_SB(0, 1), b2 + hstep, voffB); PG8_STAGE(PG8_SA(0, 0), a2, voffA);
            PG8_WAIT_V(8); PG8_WAIT_L(0); PG8_BAR; PG8_MMA(1, 0, At, B0); PG8_MMA(1, 1, At, B1); PG8_BAR; PG8_SCHED;
            PG8_LDB(B0, 1, 0); PG8_LDB(B1, 1, 1); PG8_SCHED; PG8_LDA(At, 1, 0); PG8_STAGE(PG8_SA(0, 1), a2 + hstep, voffA);
            PG8_WAIT_V(8); PG8_WAIT_L(0); PG8_BAR; PG8_MMA(0, 0, At, B0); PG8_MMA(0, 1, At, B1); PG8_BAR; PG8_SCHED;
            PG8_LDA(At, 1, 1); PG8_STAGE(PG8_SB(1, 0), b3, voffB); PG8_STAGE(PG8_SB(1, 1), b3 + hstep, voffB); PG8_STAGE(PG8_SA(1, 0), a3, voffA);
            PG8_WAIT_V(8); PG8_WAIT_L(0); PG8_BAR; PG8_MMA(1, 0, At, B0); PG8_MMA(1, 1, At, B1); PG8_BAR; PG8_SCHED;
            } else {
            PG8_LDB(B0, 0, 0); PG8_SCHED; PG8_LDA(At, 0, 0); PG8_STAGE(PG8_SA(1, 1), a1 + hstep, voffA);
            PG8_WAIT_L(8); PG8_BAR; PG8_WAIT_L(0); PG8_MMA(0, 0, At, B0); PG8_BAR; PG8_SCHED;
            PG8_LDB(B1, 0, 1); PG8_STAGE(PG8_SB(0, 0), b2, voffB);
            PG8_BAR; PG8_WAIT_L(0); PG8_MMA(0, 1, At, B1); PG8_BAR;
            PG8_LDA(At, 0, 1); PG8_STAGE(PG8_SA(0, 0), a2, voffA);
            PG8_BAR; PG8_WAIT_L(0); PG8_MMA(1, 0, At, B0); PG8_BAR; PG8_SCHED;
            PG8_STAGE(PG8_SB(0, 1), b2 + hstep, voffB);
            PG8_WAIT_V(6); PG8_BAR; PG8_MMA(1, 1, At, B1); PG8_BAR;
            PG8_LDB(B0, 1, 0); PG8_SCHED; PG8_LDA(At, 1, 0); PG8_STAGE(PG8_SA(0, 1), a2 + hstep, voffA);
            PG8_WAIT_L(8); PG8_BAR; PG8_WAIT_L(0); PG8_MMA(0, 0, At, B0); PG8_BAR; PG8_SCHED;
            PG8_LDB(B1, 1, 1); PG8_STAGE(PG8_SB(1, 0), b3, voffB);
            PG8_BAR; PG8_WAIT_L(0); PG8_MMA(0, 1, At, B1); PG8_BAR;
            PG8_LDA(At, 1, 1); PG8_STAGE(PG8_SA(1, 0), a3, voffA);
            PG8_BAR; PG8_WAIT_L(0); PG8_MMA(1, 0, At, B0); PG8_BAR; PG8_SCHED;
            PG8_STAGE(PG8_SB(1, 1), b3 + hstep, voffB);
            PG8_WAIT_V(6); PG8_BAR; PG8_MMA(1, 1, At, B1); PG8_BAR;
            }
        }
        if constexpr (ALIGN_EPI) { if (wr == 0) PG8_BAR; }
        bool keep = false;
        if constexpr (Epi::HAS_MID) keep = E.first_half(cur);
        if constexpr (!Epi::AFTER_DRAIN) { if (keep) E.mid(acc, cur, wr, wc, fr, fq); else E(acc, cur, wr, wc, fr, fq); S.done(cur); }
        if (!has_next) break;
        if (!keep) {
#pragma unroll
        for (int a = 0; a < 2; ++a)
#pragma unroll
            for (int b = 0; b < 2; ++b)
#pragma unroll
                for (int m = 0; m < 4; ++m)
#pragma unroll
                    for (int n = 0; n < 2; ++n) acc[a][b][m][n] = (f32x4){0.f, 0.f, 0.f, 0.f};
        }
        cur = nxt; cA = nA; cB = nB; ++ui;
        if constexpr (ALIGN_EPI) { if (wr == 1) PG8_BAR; }
    }
    PG8_WAIT_V(0);
    if constexpr (!ALIGN_EPI) { if (wr == 0) PG8_BAR; }
    PG8_BAR;
    if constexpr (Epi::AFTER_DRAIN) { E.fused(acc, cur, wr, wc, fr, fq, lds, wid, lane); S.done(cur); }
#undef PG8_SA
#undef PG8_SB
#undef PG8_STAGE
#undef PG8_LDA
#undef PG8_LDB
#undef PG8_MMA
#undef PG8_WAIT_V
#undef PG8_WAIT_L
#undef PG8_BAR
#undef PG8_SCHED
}
}

#define GAS __attribute__((address_space(1)))
#define LAS __attribute__((address_space(3)))
typedef unsigned short bf16;
typedef float f32x4 __attribute__((ext_vector_type(4)));
typedef short bf16x8 __attribute__((ext_vector_type(8)));
typedef unsigned u32x4 __attribute__((ext_vector_type(4)));
typedef unsigned u32x2 __attribute__((ext_vector_type(2)));
typedef GAS unsigned gu32;

constexpr int NWAVES = 8;
constexpr int D = 1024, SEQ = 8192, NBATCH = 2, NMETA = 16, LTOT = SEQ + NMETA;
constexpr int M = NBATCH * SEQ;
constexpr int MP = M + 256;
constexpr int INW = 4352;
constexpr int NCH = LTOT / 16;
constexpr int NE = 32, TOPK = 4;
constexpr int MAXT = M * TOPK / 256 + NE;
constexpr int NSLOT = MAXT * 256;
constexpr int VP = 8320;
constexpr float RMS_EPS = 1e-5f;

constexpr size_t MiB = 1ull << 20;
constexpr size_t WS_CTL = 0, CTL_ZERO_BYTES = 65536;
constexpr size_t WS_ROT = 1 * MiB;
constexpr size_t WS_TOK = 2 * MiB;
constexpr size_t WS_SSMP = 4 * MiB;
constexpr size_t WS_WIN = 32 * MiB;
constexpr size_t WS_WGLU = 41 * MiB;
constexpr size_t WS_WBR = 43 * MiB;
constexpr size_t WS_WOUT = 47 * MiB;
constexpr size_t WS_WGU = 49 * MiB;
constexpr size_t WS_WDN = 177 * MiB;
constexpr size_t WS_XN = 241 * MiB;
constexpr size_t WS_U = 274 * MiB;
constexpr size_t WS_Q = 307 * MiB;
constexpr size_t WS_K = 339 * MiB;
constexpr size_t WS_VT = 344 * MiB;
constexpr size_t WS_GS = 349 * MiB;
constexpr size_t WS_GA = 381 * MiB;
constexpr size_t WS_Z = 413 * MiB;
constexpr size_t WS_BRA = 445 * MiB;
constexpr size_t WS_MIX = 509 * MiB;
constexpr size_t WS_H1 = 541 * MiB;
constexpr size_t WS_HN2 = 605 * MiB;
constexpr size_t WS_S16 = 637 * MiB;
constexpr size_t WS_XC = 671 * MiB;
constexpr size_t WS_XS = 241 * MiB;
constexpr size_t WS_HID = 385 * MiB;
constexpr size_t WS_YS = 688 * MiB;
constexpr size_t WS_END = 832 * MiB;
static_assert((size_t)NSLOT * 2048 <= 144 * MiB, "slot buffers");
constexpr int CW_TMO = 0, CW_CNT = 1024, CW_BAR = 4096;

constexpr int RING_BYTES = 131072;
constexpr int LDSCTL_OFF = RING_BYTES;
constexpr int LDS_BYTES = 147456;

#define LDS_WAIT() asm volatile("s_waitcnt lgkmcnt(0)" ::: "memory")
#define VM_WAIT() asm volatile("s_waitcnt vmcnt(0)" ::: "memory")
#define RLX_AGENT __ATOMIC_RELAXED, __HIP_MEMORY_SCOPE_AGENT

__device__ __forceinline__ unsigned f2bf(float f) { unsigned u = __builtin_bit_cast(unsigned, f); return (u + 0x7fffu + ((u >> 16) & 1u)) >> 16; }
typedef float f32x2_t __attribute__((ext_vector_type(2))); typedef __bf16 bf16x2_t __attribute__((ext_vector_type(2)));
__device__ __forceinline__ unsigned pk2(float lo, float hi) { f32x2_t v = {lo, hi}; bf16x2_t b = __builtin_convertvector(v, bf16x2_t); return __builtin_bit_cast(unsigned, b); }
__device__ __forceinline__ float bflo(unsigned w) { return __uint_as_float(w << 16); }
__device__ __forceinline__ float bfhi(unsigned w) { return __uint_as_float(w & 0xffff0000u); }
__device__ __forceinline__ float bf2f(bf16 b) { return __uint_as_float((unsigned)b << 16); }
__device__ __forceinline__ float wave_sum(float v) {
#pragma unroll
    for (int o = 1; o < 64; o <<= 1) v += __shfl_xor(v, o);
    return v;
}
__device__ __forceinline__ float wave_max(float v) {
#pragma unroll
    for (int o = 1; o < 64; o <<= 1) v = fmaxf(v, __shfl_xor(v, o));
    return v;
}
__device__ __forceinline__ float sigmoidf_(float x) { return 1.0f / (1.0f + __expf(-x)); }
__device__ __forceinline__ float gelu_tanh(float x) { const float u = 0.7978845608028654f * (x + 0.044715f * x * x * x); return x / (1.0f + __expf(-2.0f * u)); }
__device__ __forceinline__ void unpack8(u32x4 w, float (&v)[8]) { v[0] = bflo(w.x); v[1] = bfhi(w.x); v[2] = bflo(w.y); v[3] = bfhi(w.y); v[4] = bflo(w.z); v[5] = bfhi(w.z); v[6] = bflo(w.w); v[7] = bfhi(w.w); }
__device__ __forceinline__ u32x4 pack8(const float (&v)[8]) { u32x4 w; w.x = pk2(v[0], v[1]); w.y = pk2(v[2], v[3]); w.z = pk2(v[4], v[5]); w.w = pk2(v[6], v[7]); return w; }

struct Args { const float* in[26]; float* out; unsigned char* ws; int ph_lo, ph_hi; };
struct Ctx { LAS unsigned char* lds; unsigned char* ws; int tid, lane, wave, G, bid, gw, ngw; };
using pg8::Unit;

template <class E>
__device__ __forceinline__ void naive_gemm_unit(const bf16* __restrict__ A, int lda, const bf16* __restrict__ Bt, int ldb, int K, int pm, int pn, const E& e, int wave, int lane) {
    const int fr = lane & 15, fq = lane >> 4;
    const int row0 = pm * 256 + wave * 32;
#pragma unroll 1
    for (int cg = 0; cg < 4; ++cg) {
        f32x4 acc[2][2][2];
#pragma unroll
        for (int i = 0; i < 2; ++i)
#pragma unroll
            for (int j = 0; j < 2; ++j)
#pragma unroll
                for (int n = 0; n < 2; ++n) acc[i][j][n] = (f32x4){0.f, 0.f, 0.f, 0.f};
#pragma unroll 1
        for (int half = 0; half < (E::HAS_MID ? 2 : 1); ++half) {
            const bf16* ap[2]; const bf16* bp[2][2];
#pragma unroll
            for (int mi = 0; mi < 2; ++mi) ap[mi] = A + (size_t)(half * M + row0 + 16 * mi + fr) * lda + 8 * fq;
#pragma unroll
            for (int bj = 0; bj < 2; ++bj)
#pragma unroll
                for (int n = 0; n < 2; ++n) bp[bj][n] = Bt + (size_t)(half * 1024 + pn * 256 + 128 * bj + 32 * cg + pg8::perm32(16 * n + fr)) * ldb + 8 * fq;
#pragma unroll 1
            for (int k0 = 0; k0 < K; k0 += 32) {
                bf16x8 av[2], bv[2][2];
#pragma unroll
                for (int mi = 0; mi < 2; ++mi) av[mi] = *(const bf16x8*)(ap[mi] + k0);
#pragma unroll
                for (int bj = 0; bj < 2; ++bj)
#pragma unroll
                    for (int n = 0; n < 2; ++n) bv[bj][n] = *(const bf16x8*)(bp[bj][n] + k0);
#pragma unroll
                for (int mi = 0; mi < 2; ++mi)
#pragma unroll
                    for (int bj = 0; bj < 2; ++bj)
#pragma unroll
                        for (int n = 0; n < 2; ++n) acc[mi][bj][n] = __builtin_amdgcn_mfma_f32_16x16x32_bf16(bv[bj][n], av[mi], acc[mi][bj][n], 0, 0, 0);
            }
            if constexpr (E::HAS_MID) {
                if (half == 0) {
#pragma unroll
                    for (int mi = 0; mi < 2; ++mi) e.mid(row0 + 16 * mi + fr, pn * 256 + 32 * cg + 8 * fq, acc[mi][0][0], acc[mi][0][1], acc[mi][1][0], acc[mi][1][1]);
                }
            }
        }
#pragma unroll
        for (int mi = 0; mi < 2; ++mi) e.row8(row0 + 16 * mi + fr, pn * 256 + 32 * cg + 8 * fq, acc[mi][0][0], acc[mi][0][1], acc[mi][1][0], acc[mi][1][1], pm, pn);
    }
}
template <class E> struct FastEpi {
    static constexpr bool PERM = true, AFTER_DRAIN = false, HAS_MID = E::HAS_MID;
    E e;
    __device__ __forceinline__ void operator()(const f32x4 (&acc)[2][2][4][2], const Unit& u, int wr, int wc, int fr, int fq) const {
#pragma unroll
        for (int ai = 0; ai < 2; ++ai)
#pragma unroll
            for (int m = 0; m < 4; ++m)
                e.row8(u.pm * 256 + ai * 128 + wr * 64 + m * 16 + fr, u.pn * 256 + wc * 32 + 8 * fq, acc[ai][0][m][0], acc[ai][0][m][1], acc[ai][1][m][0], acc[ai][1][m][1], u.pm, u.pn);
    }
    __device__ __forceinline__ bool first_half(const Unit& u) const { if constexpr (E::HAS_MID) return u.pm < M / 256; else return false; }
    __device__ __forceinline__ void mid(f32x4 (&acc)[2][2][4][2], const Unit& u, int wr, int wc, int fr, int fq) const {
        if constexpr (E::HAS_MID) {
#pragma unroll
            for (int ai = 0; ai < 2; ++ai)
#pragma unroll
                for (int m = 0; m < 4; ++m)
                    e.mid(u.pm * 256 + ai * 128 + wr * 64 + m * 16 + fr, u.pn * 256 + wc * 32 + 8 * fq, acc[ai][0][m][0], acc[ai][0][m][1], acc[ai][1][m][0], acc[ai][1][m][1]);
        }
    }
};
struct PairOrder {
    pg8::StaticOrder so;
    __device__ __forceinline__ bool next(int i, Unit& u) const { Unit t; if (!so.next(i >> 1, t)) return false; const int h = i & 1; u.pm = t.pm + h * (M / 256); u.pn = t.pn + h * 4; return true; }
    __device__ __forceinline__ void a_ready(const Unit&) const {}
    __device__ __forceinline__ void done(const Unit&) const {}
};
struct RowMajorOrder {
    int nN, nwg, G, c;
    __device__ __forceinline__ bool next(int i, Unit& u) const { const long L = (long)i * G + c; if (L >= nwg) return false; u.pm = (int)L / nN; u.pn = (int)L % nN; return true; }
    __device__ __forceinline__ void a_ready(const Unit&) const {}
    __device__ __forceinline__ void done(const Unit&) const {}
};
struct MoeOrder {
    const LAS int* tile_e; int ntiles, nct, G, c;
    __device__ __forceinline__ bool next(int i, Unit& u) const { const long L = (long)i * G + c; if (L >= (long)ntiles * nct) return false; const int rt = (int)L / nct, ct = (int)L % nct; u.pm = rt; u.pn = tile_e[rt] * nct + ct; return true; }
    __device__ __forceinline__ void a_ready(const Unit&) const {}
    __device__ __forceinline__ void done(const Unit&) const {}
};

__device__ __forceinline__ void f4to8(f32x4 a0, f32x4 a1, float (&v)[8]) { v[0] = a0[0]; v[1] = a0[1]; v[2] = a0[2]; v[3] = a0[3]; v[4] = a1[0]; v[5] = a1[1]; v[6] = a1[2]; v[7] = a1[3]; }

struct EpiInProj {
    static constexpr bool HAS_MID = false;
    bf16 *U, *Q, *Kb, *Vt, *GSp, *GAp; const float* rot;
    __device__ __forceinline__ void one(int row, int col, f32x4 v0, f32x4 v1) const {
        const bool meta = row >= M;
        if (meta) { if (row >= M + NMETA) return; if (!(col < 1024 || (col >= 2048 && col < 2304))) return; }
        const int pos = meta ? row - M : NMETA + (row & (SEQ - 1));
        const int b0 = meta ? 0 : (row >> 13), nb = meta ? 2 : 1;
        float v[8]; f4to8(v0, v1, v);
        if (col < 1024) {
            const int g = col >> 4, h0 = col & 15; const u32x4 w = pack8(v);
            for (int bi = 0; bi < nb; ++bi) { const int b = b0 + bi; *(u32x4*)(U + ((size_t)((g * 2 + b) * NCH + (pos >> 4)) * 256 + (pos & 15) * 16 + h0)) = w; }
        } else if (col < 2176) {
            if ((col & 63) < 16) {
                const int i0 = (col & 8) ? 4 : 0; const float* cs = rot + pos * 16;
#pragma unroll
                for (int j = 0; j < 4; ++j) { const float c = cs[i0 + j], s = cs[8 + i0 + j], x1 = v[j], x2 = v[4 + j]; v[j] = x1 * c - x2 * s; v[4 + j] = x2 * c + x1 * s; }
            }
            if (col < 2048) {
#pragma unroll
                for (int j = 0; j < 8; ++j) v[j] *= 0.125f;
                *(u32x4*)(Q + (size_t)row * 1024 + (col - 1024)) = pack8(v);
            } else {
                const u32x4 w = pack8(v);
                for (int bi = 0; bi < nb; ++bi) { const int b = b0 + bi; *(u32x4*)(Kb + ((size_t)(b * LTOT + pos)) * 128 + (col - 2048)) = w; }
            }
        } else if (col < 2304) {
            const int cc = col - 2176, kvh = cc >> 6, d0 = cc & 63;
            for (int bi = 0; bi < nb; ++bi) { const int b = b0 + bi;
#pragma unroll
                for (int j = 0; j < 8; ++j) Vt[((size_t)((b * 2 + kvh) * 64 + d0 + j)) * VP + pos] = (bf16)f2bf(v[j]); }
        } else {
#pragma unroll
            for (int j = 0; j < 8; ++j) v[j] = sigmoidf_(v[j]);
            if (col < 3328) *(u32x4*)(GSp + (size_t)row * 1024 + (col - 2304)) = pack8(v);
            else *(u32x4*)(GAp + (size_t)row * 1024 + (col - 3328)) = pack8(v);
        }
    }
    __device__ __forceinline__ void row8(int row, int col, f32x4 a0, f32x4 a1, f32x4 b0, f32x4 b1, int, int) const { one(row, col, a0, a1); one(row, col + 128, b0, b1); }
};
struct EpiGlu {
    static constexpr bool HAS_MID = false;
    const bf16* Z; const float* bias; bf16* O;
    __device__ __forceinline__ void one(int row, int col, f32x4 v0, f32x4 v1) const {
        float v[8], z[8]; f4to8(v0, v1, v); unpack8(*(const u32x4*)(Z + (size_t)row * 1024 + col), z);
        const f32x4 c0 = *(const f32x4*)(bias + col), c1 = *(const f32x4*)(bias + col + 4); float bb[8]; f4to8(c0, c1, bb);
#pragma unroll
        for (int j = 0; j < 8; ++j) v[j] = z[j] * sigmoidf_(v[j] + bb[j]);
        *(u32x4*)(O + (size_t)row * 1024 + col) = pack8(v);
    }
    __device__ __forceinline__ void row8(int row, int col, f32x4 a0, f32x4 a1, f32x4 b0, f32x4 b1, int, int) const { one(row, col, a0, a1); one(row, col + 128, b0, b1); }
};
struct EpiBr {
    static constexpr bool HAS_MID = true;
    const bf16* GSp; const bf16* GAp; bf16* MIX;
    __device__ __forceinline__ void mid1(int row, int col, f32x4& v0, f32x4& v1) const {
        float gs[8], ga[8]; unpack8(*(const u32x4*)(GSp + (size_t)row * 1024 + col), gs); unpack8(*(const u32x4*)(GAp + (size_t)row * 1024 + col), ga);
#pragma unroll
        for (int j = 0; j < 4; ++j) { v0[j] *= gs[j] / fmaxf(ga[j], 1e-20f); v1[j] *= gs[4 + j] / fmaxf(ga[4 + j], 1e-20f); }
    }
    __device__ __forceinline__ void mid(int row, int col, f32x4& a0, f32x4& a1, f32x4& b0, f32x4& b1) const { mid1(row, col, a0, a1); mid1(row, col + 128, b0, b1); }
    __device__ __forceinline__ void one(int row, int col, f32x4 v0, f32x4 v1) const {
        float v[8], ga[8]; f4to8(v0, v1, v); unpack8(*(const u32x4*)(GAp + (size_t)row * 1024 + col), ga);
#pragma unroll
        for (int j = 0; j < 8; ++j) v[j] *= ga[j];
        *(u32x4*)(MIX + (size_t)row * 1024 + col) = pack8(v);
    }
    __device__ __forceinline__ void row8(int row, int col, f32x4 a0, f32x4 a1, f32x4 b0, f32x4 b1, int, int) const {
        if (row >= M) { row -= M; col -= 1024; }
        one(row, col, a0, a1); one(row, col + 128, b0, b1); }
};
struct EpiOut {
    static constexpr bool HAS_MID = false;
    const float* X; float* H1;
    __device__ __forceinline__ void one(int row, int col, f32x4 v0, f32x4 v1) const {
        const size_t o = (size_t)row * 1024 + col;
        *(f32x4*)(H1 + o) = *(const f32x4*)(X + o) + v0; *(f32x4*)(H1 + o + 4) = *(const f32x4*)(X + o + 4) + v1;
    }
    __device__ __forceinline__ void row8(int row, int col, f32x4 a0, f32x4 a1, f32x4 b0, f32x4 b1, int, int) const { one(row, col, a0, a1); one(row, col + 128, b0, b1); }
};
struct EpiMoe1 {
    static constexpr bool HAS_MID = false;
    const float* bgu; const float* SR; bf16* HID;
    __device__ __forceinline__ void row8(int row, int col, f32x4 a0, f32x4 a1, f32x4 b0, f32x4 b1, int, int pn) const {
        const int e = pn >> 3, ct = pn & 7, j0 = 128 * ct + (col - pn * 256); const float rs = SR[row];
        float g[8], up[8], bg[8], bu[8]; f4to8(a0 * rs, a1 * rs, g); f4to8(b0 * rs, b1 * rs, up);
        const float* bp = bgu + (size_t)e * 2048 + j0;
        f4to8(*(const f32x4*)bp, *(const f32x4*)(bp + 4), bg); f4to8(*(const f32x4*)(bp + 1024), *(const f32x4*)(bp + 1028), bu);
#pragma unroll
        for (int j = 0; j < 8; ++j) { const float gg = fminf(g[j] + bg[j], 7.0f), uu = fminf(fmaxf(up[j] + bu[j], -7.0f), 7.0f); g[j] = gg * sigmoidf_(1.702f * gg) * (uu + 1.0f); }
        *(u32x4*)(HID + (size_t)row * 1024 + j0) = pack8(g);
    }
};
struct EpiMoe2 {
    static constexpr bool HAS_MID = false;
    const float* bd; const float* SG; bf16* YS;
    __device__ __forceinline__ void one(int row, int e, int c0, f32x4 v0, f32x4 v1, float gt) const {
        float v[8], bb[8]; f4to8(v0, v1, v); const float* bp = bd + (size_t)e * 1024 + c0; f4to8(*(const f32x4*)bp, *(const f32x4*)(bp + 4), bb);
#pragma unroll
        for (int j = 0; j < 8; ++j) v[j] = (v[j] + bb[j]) * gt;
        *(u32x4*)(YS + (size_t)row * 1024 + c0) = pack8(v);
    }
    __device__ __forceinline__ void row8(int row, int col, f32x4 a0, f32x4 a1, f32x4 b0, f32x4 b1, int, int pn) const {
        const int e = pn >> 2, ct = pn & 3, c0 = 256 * ct + (col - pn * 256); const float gt = SG[row];
        one(row, e, c0, a0, a1, gt); one(row, e, c0 + 128, b0, b1, gt);
    }
};
#define XB_TMO      128
#define XB_XCNT(j)  (256  + 64 * (j))
#define XB_XSUB(j)  (1280 + 64 * (j))
#define XB_XGEN(j)  (2304 + 64 * (j))
#define XB_TOP      3328
#define XB_TOPGEN   3392
#define XCD_BAR_WORDS 3456
#define XB_SPIN_CAP (1u << 18)

__device__ __forceinline__ unsigned xb_ld(unsigned* p)              { return __hip_atomic_load(p, __ATOMIC_RELAXED, __HIP_MEMORY_SCOPE_AGENT); }
__device__ __forceinline__ unsigned xb_add(unsigned* p, unsigned v) { return __hip_atomic_fetch_add(p, v, __ATOMIC_RELAXED, __HIP_MEMORY_SCOPE_AGENT); }
__device__ __forceinline__ unsigned xb_xcc_id() { return (unsigned)__builtin_amdgcn_s_getreg((3 << 11) | 20) & 0xFu; }
#define XB_SPIN(cond, bar) do { unsigned _sp = 0; while (cond) { __builtin_amdgcn_s_sleep(1); \
    if ((++_sp & 255u) == 0u) { if (xb_ld(&(bar)[XB_TMO])) break; if (_sp > XB_SPIN_CAP) { atomicAdd(&(bar)[XB_TMO], 1u); break; } } } } while (0)

struct XcdBarrier {
    unsigned* bar; unsigned x;
    volatile LAS unsigned* st;
};

__device__ __forceinline__ XcdBarrier xcd_barrier_post(unsigned* bar, volatile LAS unsigned* st) {
    XcdBarrier b; b.bar = bar; b.x = xb_xcc_id(); b.st = st;
    if (threadIdx.x == 0) (void)xb_add(&bar[XB_XCNT(b.x)], 1u);
    return b;
}
__device__ __forceinline__ void xcd_barrier_complete(unsigned* bar, unsigned x, unsigned& nloc, unsigned& nx) {
    const unsigned G = gridDim.x * gridDim.y * gridDim.z;
    unsigned sum, cnt, mine, sp = 0u;
    for (;;) {
        sum = 0u; cnt = 0u; mine = 0u;
#pragma unroll
        for (unsigned j = 0; j < 16; ++j) { const unsigned c = xb_ld(&bar[XB_XCNT(j)]); sum += c; cnt += (c > 0u) ? 1u : 0u; mine = (j == x) ? c : mine; }
        if (sum == G) break;
        __builtin_amdgcn_s_sleep(1);
        if ((++sp & 255u) == 0u) { if (xb_ld(&bar[XB_TMO])) break; if (sp > XB_SPIN_CAP) { atomicAdd(&bar[XB_TMO], 1u); break; } }
    }
    nloc = mine > 0u ? mine : 1u; nx = cnt > 0u ? cnt : 1u;
}

__device__ __forceinline__ void xcd_barrier(const XcdBarrier& b) {
    asm volatile("s_waitcnt vmcnt(0)" ::: "memory");
    __syncthreads();
    if (threadIdx.x == 0) {
        unsigned* bar = b.bar;
        __builtin_amdgcn_s_waitcnt(0);
        unsigned nloc = b.st[0], nx = b.st[1];
        if (nloc == 0u) { xcd_barrier_complete(bar, b.x, nloc, nx); b.st[0] = nloc; b.st[1] = nx; }
        const unsigned old = xb_add(&bar[XB_XSUB(b.x)], 1u);
        const unsigned gen = old / nloc;
        if (old + 1u == (gen + 1u) * nloc) {
            __builtin_amdgcn_fence(__ATOMIC_RELEASE, "agent");
            asm volatile("s_waitcnt vmcnt(0)" ::: "memory");
            const unsigned og = xb_add(&bar[XB_TOP], 1u);
            const unsigned tg = og / nx;
            if (og + 1u == (tg + 1u) * nx) xb_add(&bar[XB_TOPGEN], 1u);
            else XB_SPIN(xb_ld(&bar[XB_TOPGEN]) == tg, bar);
            __builtin_amdgcn_fence(__ATOMIC_ACQUIRE, "agent");
            xb_add(&bar[XB_XGEN(b.x)], 1u);
            asm volatile("s_waitcnt vmcnt(0)" ::: "memory");
        } else {
            XB_SPIN(xb_ld(&bar[XB_XGEN(b.x)]) == gen, bar);
            __builtin_amdgcn_fence(__ATOMIC_ACQUIRE, "agent");
            asm volatile("s_waitcnt vmcnt(0)" ::: "memory");
        }
    }
    __syncthreads();
}

constexpr size_t SSM_A16 = 1 * MiB, SSM_TF = 2 * MiB, SSM_VF = 4 * MiB, SSM_WF = 8 * MiB;
constexpr int NCI = 2 * NCH;
constexpr int NCB = (NCI + 15) / 16;
constexpr int CW_Q = 2048;

__device__ __forceinline__ void p0_ssm_prep(const Args& a, const Ctx& c, int g) {
    LAS float* AP = (LAS float*)(c.lds);
    LAS float* BBl = AP + 64 * 17 * 2;
    LAS float* Cc = BBl + 64 * 16 * 2;
    LAS float* Kt = Cc + 16 * 64 * 2;
    unsigned char* sp = c.ws + WS_SSMP;
    const int tid = c.tid;
    if (tid < 64) { const int p = tid, i = g * 64 + p;
        const float lr = a.in[4][i], li = a.in[5][i], dt = expf(a.in[6][g]);
        for (int tau = 0; tau <= 16; ++tau) { const float mag = expf((float)tau * dt * lr), ang = (float)tau * dt * li; AP[(p * 17 + tau) * 2] = mag * cosf(ang); AP[(p * 17 + tau) * 2 + 1] = mag * sinf(ang); }
        const float mag = expf(dt * lr), ar = mag * cosf(dt * li), ai = mag * sinf(dt * li);
        const float den = lr * lr + li * li, nr = ar - 1.0f, ni = ai, fr_ = (nr * lr + ni * li) / den, fi_ = (ni * lr - nr * li) / den;
        for (int h = 0; h < 16; ++h) { const float br = a.in[7][i * 16 + h], bi = a.in[8][i * 16 + h]; BBl[(p * 16 + h) * 2] = fr_ * br - fi_ * bi; BBl[(p * 16 + h) * 2 + 1] = fr_ * bi + fi_ * br; }
        float* A16 = (float*)(sp + SSM_A16); const float m16 = expf(16.0f * dt * lr), a16 = 16.0f * dt * li; A16[i * 2] = m16 * cosf(a16); A16[i * 2 + 1] = m16 * sinf(a16);
    }
    for (int idx = tid; idx < 1024; idx += NWAVES * 64) { const int h = idx >> 6, p = idx & 63; Cc[idx * 2] = a.in[9][(g * 16 + h) * 64 + p]; Cc[idx * 2 + 1] = a.in[10][(g * 16 + h) * 64 + p]; }
    __syncthreads();
    for (int idx = tid; idx < 4096; idx += NWAVES * 64) { const int tau = idx >> 8, h = (idx >> 4) & 15, hp = idx & 15; float s = 0.f;
        for (int p = 0; p < 64; ++p) { const float ar = AP[(p * 17 + tau) * 2], ai = AP[(p * 17 + tau) * 2 + 1], br = BBl[(p * 16 + hp) * 2], bi = BBl[(p * 16 + hp) * 2 + 1];
            const float gr = ar * br - ai * bi, gi = ar * bi + ai * br; s += Cc[(h * 64 + p) * 2] * gr - Cc[(h * 64 + p) * 2 + 1] * gi; }
        if (tau == 0 && h == hp) s += a.in[11][g * 16 + h];
        Kt[idx] = s; }
    __syncthreads();
    bf16* TF = (bf16*)(sp + SSM_TF); bf16* VF = (bf16*)(sp + SSM_VF); bf16* WF = (bf16*)(sp + SSM_WF);
    for (int idx = tid; idx < 1024; idx += NWAVES * 64) { const int dl = idx >> 6, ln = idx & 63, fr = ln & 15, fq = ln >> 4; float v[8];
#pragma unroll
        for (int e = 0; e < 8; ++e) { const int j = 8 * fq + e, tau = dl - (j >> 4), hp = j & 15; v[e] = tau >= 0 ? Kt[(tau * 16 + fr) * 16 + hp] : 0.f; }
        *(u32x4*)(TF + ((size_t)(g * 16 + dl) * 64 + ln) * 8) = pack8(v); }
    for (int idx = tid; idx < 4096; idx += NWAVES * 64) { const int t = idx >> 8, kx = (idx >> 6) & 3, ln = idx & 63, fr = ln & 15, fq = ln >> 4; float v[8];
#pragma unroll
        for (int e = 0; e < 8; ++e) { const int pp = 32 * kx + 8 * fq + e, p = pp & 63; const float cr = Cc[(fr * 64 + p) * 2], ci = Cc[(fr * 64 + p) * 2 + 1], ar = AP[(p * 17 + t + 1) * 2], ai = AP[(p * 17 + t + 1) * 2 + 1];
            v[e] = pp < 64 ? (cr * ar - ci * ai) : -(cr * ai + ci * ar); }
        *(u32x4*)(VF + ((size_t)((g * 16 + t) * 4 + kx) * 64 + ln) * 8) = pack8(v); }
    for (int idx = tid; idx < 4096; idx += NWAVES * 64) { const int pb = idx >> 9, ks = (idx >> 6) & 7, ln = idx & 63, fr = ln & 15, fq = ln >> 4, pp = 16 * pb + fr, p = pp & 63; float v[8];
#pragma unroll
        for (int e = 0; e < 8; ++e) { const int k = 32 * ks + 8 * fq + e, s = k >> 4, h = k & 15; const float ar = AP[(p * 17 + 15 - s) * 2], ai = AP[(p * 17 + 15 - s) * 2 + 1], br = BBl[(p * 16 + h) * 2], bi = BBl[(p * 16 + h) * 2 + 1];
            v[e] = pp < 64 ? (ar * br - ai * bi) : (ar * bi + ai * br); }
        *(u32x4*)(WF + ((size_t)((g * 8 + pb) * 8 + ks) * 64 + ln) * 8) = pack8(v); }
    __syncthreads();
}
__device__ __forceinline__ void ssm_phase_a(const Ctx& c) {
    const bf16* U = (const bf16*)(c.ws + WS_U); const bf16* WF = (const bf16*)(c.ws + WS_SSMP + SSM_WF); float* S16 = (float*)(c.ws + WS_S16);
    const int fr = c.lane & 15, fq = c.lane >> 4;
    for (int it = c.gw; it < 64 * NCB; it += c.ngw) {
        const int g = it / NCB, cb = it % NCB, cidx = 16 * cb + fr, cl = cidx < NCI ? cidx : NCI - 1;
        bf16x8 uf[8];
#pragma unroll
        for (int ks = 0; ks < 8; ++ks) uf[ks] = *(const bf16x8*)(U + ((size_t)(g * NCI + cl)) * 256 + 32 * ks + 8 * fq);
#pragma unroll 2
        for (int pb = 0; pb < 8; ++pb) { f32x4 acc = {0.f, 0.f, 0.f, 0.f};
#pragma unroll
            for (int ks = 0; ks < 8; ++ks) { const bf16x8 wf = *(const bf16x8*)(WF + ((size_t)((g * 8 + pb) * 8 + ks) * 64 + c.lane) * 8); acc = __builtin_amdgcn_mfma_f32_16x16x32_bf16(wf, uf[ks], acc, 0, 0, 0); }
            if (cidx < NCI) *(f32x4*)(S16 + ((size_t)(g * NCI + cidx)) * 128 + 16 * pb + 4 * fq) = acc; }
    }
}
__device__ __forceinline__ void ssm_carry(const Ctx& c) {
    LAS float* E = (LAS float*)(c.lds + LDSCTL_OFF + 4096);
    for (int it = c.bid; it < 128; it += c.G) {
        const int g = it >> 1, b = it & 1, p = c.lane, seg = c.wave, c0 = 64 * seg;
        const float* A16 = (const float*)(c.ws + WS_SSMP + SSM_A16); const float ar = A16[(g * 64 + p) * 2], ai = A16[(g * 64 + p) * 2 + 1];
        const float* sp = (const float*)(c.ws + WS_S16) + ((size_t)(g * NCI + b * NCH + c0)) * 128; bf16* xp = (bf16*)(c.ws + WS_XC) + ((size_t)(g * NCI + b * NCH + c0)) * 128;
        float lr[64], li[64];
#pragma unroll
        for (int j = 0; j < 64; ++j) { lr[j] = sp[j * 128 + p]; li[j] = sp[j * 128 + 64 + p]; }
        float xr = 0.f, xi = 0.f;
#pragma unroll
        for (int j = 0; j < 64; ++j) { const float tr = ar * xr - ai * xi + lr[j], ti = ar * xi + ai * xr + li[j]; xr = tr; xi = ti; lr[j] = xr; li[j] = xi; }
        __syncthreads();
        E[(seg * 64 + p) * 2] = xr; E[(seg * 64 + p) * 2 + 1] = xi;
        float a64r = ar, a64i = ai;
#pragma unroll
        for (int k = 0; k < 6; ++k) { const float tr = a64r * a64r - a64i * a64i, ti = 2.0f * a64r * a64i; a64r = tr; a64i = ti; }
        __syncthreads();
        float cr = 0.f, ci = 0.f;
        for (int s2 = 0; s2 < seg; ++s2) { const float er = E[(s2 * 64 + p) * 2], ei = E[(s2 * 64 + p) * 2 + 1]; const float tr = a64r * cr - a64i * ci + er, ti = a64r * ci + a64i * cr + ei; cr = tr; ci = ti; }
        float pr = ar, pi = ai; bf16* xq = xp + 128 + p;
#pragma unroll
        for (int j = 0; j < 64; ++j) { const float vr = lr[j] + pr * cr - pi * ci, vi = li[j] + pr * ci + pi * cr;
            xq[0] = (bf16)f2bf(vr); xq[64] = (bf16)f2bf(vi); xq += 128; asm volatile("" : "+v"(xq));
            const float tr = pr * ar - pi * ai, ti = pr * ai + pi * ar; pr = tr; pi = ti; }
    }
}
__device__ __forceinline__ void ssm_phase_c(const Ctx& c) {
    const bf16* U = (const bf16*)(c.ws + WS_U); const bf16* XC = (const bf16*)(c.ws + WS_XC); bf16* Z = (bf16*)(c.ws + WS_Z);
    const bf16* TF = (const bf16*)(c.ws + WS_SSMP + SSM_TF); const bf16* VF = (const bf16*)(c.ws + WS_SSMP + SSM_VF);
    const int fr = c.lane & 15, fq = c.lane >> 4;
    for (int it = c.bid; it < 256; it += c.G) {
        const int g = it >> 2, q = it & 3;
        __syncthreads();
        for (int idx = c.tid; idx < 4096; idx += NWAVES * 64) *(LAS u32x4*)(c.lds + idx * 16) = *(const u32x4*)(VF + (size_t)g * 32768 + idx * 8);
        bf16x8 tf[16];
#pragma unroll
        for (int dl = 0; dl < 16; ++dl) tf[dl] = *(const bf16x8*)(TF + ((size_t)(g * 16 + dl) * 64 + c.lane) * 8);
        __syncthreads();
        for (int cb = q + 4 * c.wave; cb < NCB; cb += 32) {
            const int cidx = 16 * cb + fr, cl = cidx < NCI ? cidx : NCI - 1;
            bf16x8 uf[8], xf[4];
#pragma unroll
            for (int ks = 0; ks < 8; ++ks) uf[ks] = *(const bf16x8*)(U + ((size_t)(g * NCI + cl)) * 256 + 32 * ks + 8 * fq);
#pragma unroll
            for (int kx = 0; kx < 4; ++kx) xf[kx] = *(const bf16x8*)(XC + ((size_t)(g * NCI + cl)) * 128 + 32 * kx + 8 * fq);
            const int b = cidx >= NCH ? 1 : 0, cc = cidx - b * NCH; const bool ok = cidx < NCI && cc >= 1;
            bf16* zp = Z + (size_t)(b * SEQ + 16 * (cc - 1)) * 1024 + g * 16 + 4 * fq;
#pragma unroll
            for (int t = 0; t < 16; ++t) { f32x4 acc = {0.f, 0.f, 0.f, 0.f};
#pragma unroll
                for (int ks = 0; ks <= t / 2; ++ks) acc = __builtin_amdgcn_mfma_f32_16x16x32_bf16(tf[t - 2 * ks], uf[ks], acc, 0, 0, 0);
#pragma unroll
                for (int kx = 0; kx < 4; ++kx) { const bf16x8 vf = *(const LAS bf16x8*)(c.lds + ((t * 4 + kx) * 64 + c.lane) * 16); acc = __builtin_amdgcn_mfma_f32_16x16x32_bf16(vf, xf[kx], acc, 0, 0, 0); }
                if (ok) { u32x2 w; w.x = pk2(gelu_tanh(acc[0]), gelu_tanh(acc[1])); w.y = pk2(gelu_tanh(acc[2]), gelu_tanh(acc[3])); *(u32x2*)(zp + (size_t)t * 1024) = w; }
                asm volatile("" ::: "memory"); }
        }
    }
}

__device__ __forceinline__ void attn_fast(const Args& a, const Ctx& c) {
    const bf16* Q = (const bf16*)(c.ws + WS_Q); const bf16* Kb = (const bf16*)(c.ws + WS_K); const bf16* Vt = (const bf16*)(c.ws + WS_VT); bf16* AO = (bf16*)(c.ws + WS_BRA) + (size_t)M * 1024;
    unsigned* qctr = (unsigned*)(c.ws + WS_CTL) + CW_Q;
    LAS unsigned char* Ks = c.lds; LAS unsigned char* Vs = c.lds + 30720; volatile LAS int* uslot = (volatile LAS int*)(c.lds + LDSCTL_OFF + 64);
    constexpr int KST = 144, VST = 432;
    const int fr = c.lane & 15, fq = c.lane >> 4;
    volatile LAS int* ncall = (volatile LAS int*)(c.lds + LDSCTL_OFF + 68);
    __syncthreads(); if (c.tid == 0) *ncall = *ncall + 1; __syncthreads();
    const int qbase = (*ncall - 1) * (512 + c.G);
    for (;;) {
        __syncthreads();
        if (c.tid == 0) *uslot = (int)__hip_atomic_fetch_add(qctr, 1u, RLX_AGENT) - qbase;
        __syncthreads();
        const int unit = *uslot; if (unit >= 512) break;
        const int b = unit >> 8, kvh = (unit >> 7) & 1, t0 = 64 * (unit & 127);
        for (int idx = c.tid; idx < 1664; idx += NWAVES * 64) { const int row = idx >> 3, pc = idx & 7; int pos; bool ok = true;
            if (row < 192) { const int tok = t0 - 128 + row; ok = tok >= 0; pos = NMETA + tok; } else pos = row - 192;
            u32x4 v = {0u, 0u, 0u, 0u}; if (ok) v = *(const u32x4*)(Kb + ((size_t)(b * LTOT + pos)) * 128 + kvh * 64 + pc * 8);
            *(LAS u32x4*)(Ks + row * KST + pc * 16) = v; }
        for (int idx = c.tid; idx < 1664; idx += NWAVES * 64) { const int d = idx / 26, pc = idx % 26; const bf16* vrow = Vt + ((size_t)((b * 2 + kvh) * 64 + d)) * VP; u32x4 v = {0u, 0u, 0u, 0u}; int kk0;
            if (pc < 24) { const int tok0 = t0 - 128 + 8 * pc; kk0 = 8 * pc; if (tok0 >= 0) v = *(const u32x4*)(vrow + NMETA + tok0); } else { kk0 = 192 + 8 * (pc - 24); v = *(const u32x4*)(vrow + 8 * (pc - 24)); }
            *(LAS u32x4*)(Vs + d * VST + kk0 * 2) = v; }
        __syncthreads();
        const int head = kvh * 8 + c.wave; const float sink = a.in[14][head];
#pragma unroll 1
        for (int qa = 0; qa < 4; ++qa) {
            const int r = b * SEQ + t0 + 16 * qa + fr;
            bf16x8 qf[2];
#pragma unroll
            for (int ks = 0; ks < 2; ++ks) qf[ks] = *(const bf16x8*)(Q + (size_t)r * 1024 + head * 64 + 32 * ks + 8 * fq);
            f32x4 s[10];
#pragma unroll
            for (int jb = 0; jb < 10; ++jb) { const int j = jb < 9 ? qa + jb : 12; f32x4 acc = {0.f, 0.f, 0.f, 0.f};
#pragma unroll
                for (int ks = 0; ks < 2; ++ks) { const bf16x8 kf = *(const LAS bf16x8*)(Ks + (16 * j + fr) * KST + (32 * ks + 8 * fq) * 2); acc = __builtin_amdgcn_mfma_f32_16x16x32_bf16(kf, qf[ks], acc, 0, 0, 0); }
                s[jb] = acc; }
            float mx = sink;
#pragma unroll
            for (int jb = 0; jb < 9; ++jb)
#pragma unroll
                for (int i = 0; i < 4; ++i) { const int rel = 16 * jb + 4 * fq + i - fr, tok = t0 - 128 + 16 * (qa + jb) + 4 * fq + i; const bool okk = rel >= 1 && rel <= 128 && tok >= 0; s[jb][i] = okk ? s[jb][i] : -1e30f; mx = fmaxf(mx, s[jb][i]); }
#pragma unroll
            for (int i = 0; i < 4; ++i) mx = fmaxf(mx, s[9][i]);
            mx = fmaxf(mx, __shfl_xor(mx, 16)); mx = fmaxf(mx, __shfl_xor(mx, 32));
            float l = 0.f;
#pragma unroll
            for (int jb = 0; jb < 10; ++jb)
#pragma unroll
                for (int i = 0; i < 4; ++i) { s[jb][i] = __expf(s[jb][i] - mx); l += s[jb][i]; }
            l += __shfl_xor(l, 16); l += __shfl_xor(l, 32); l += __expf(sink - mx);
            f32x4 o[4];
#pragma unroll
            for (int db = 0; db < 4; ++db) o[db] = (f32x4){0.f, 0.f, 0.f, 0.f};
#pragma unroll
            for (int pr = 0; pr < 5; ++pr) { const int ja = qa + 2 * pr, jbk = pr < 4 ? qa + 2 * pr + 1 : 12;
                u32x4 pw; pw.x = pk2(s[2 * pr][0], s[2 * pr][1]); pw.y = pk2(s[2 * pr][2], s[2 * pr][3]); pw.z = pk2(s[2 * pr + 1][0], s[2 * pr + 1][1]); pw.w = pk2(s[2 * pr + 1][2], s[2 * pr + 1][3]);
                const bf16x8 pf = __builtin_bit_cast(bf16x8, pw);
#pragma unroll
                for (int db = 0; db < 4; ++db) { const u32x2 lo = *(const LAS u32x2*)(Vs + (16 * db + fr) * VST + (16 * ja + 4 * fq) * 2), hi = *(const LAS u32x2*)(Vs + (16 * db + fr) * VST + (16 * jbk + 4 * fq) * 2);
                    u32x4 vw; vw.x = lo.x; vw.y = lo.y; vw.z = hi.x; vw.w = hi.y; o[db] = __builtin_amdgcn_mfma_f32_16x16x32_bf16(__builtin_bit_cast(bf16x8, vw), pf, o[db], 0, 0, 0); } }
            const float inv = 1.0f / l;
#pragma unroll
            for (int db = 0; db < 4; ++db) { u32x2 w; w.x = pk2(o[db][0] * inv, o[db][1] * inv); w.y = pk2(o[db][2] * inv, o[db][3] * inv); *(u32x2*)(AO + (size_t)r * 1024 + head * 64 + 16 * db + 4 * fq) = w; }
        }
    }
}

constexpr size_t SSM_WRF = 16 * MiB;
__device__ __forceinline__ void p0_router_frags(const Args& a, const Ctx& c) {
    bf16* WRF = (bf16*)(c.ws + WS_SSMP + SSM_WRF); const float* wr = a.in[19];
    const int gt = c.bid * (NWAVES * 64) + c.tid, ngt = c.G * NWAVES * 64;
    for (int idx = gt; idx < 4096; idx += ngt) { const int ks = idx >> 7, eb = (idx >> 6) & 1, ln = idx & 63, fr = ln & 15, fq = ln >> 4; float hi[8], lo[8];
#pragma unroll
        for (int e = 0; e < 8; ++e) { const float w = wr[(size_t)(32 * ks + 8 * fq + e) * 32 + 16 * eb + fr]; const float h = bf2f((bf16)f2bf(w)); hi[e] = h; lo[e] = w - h; }
        *(u32x4*)(WRF + (size_t)idx * 8) = pack8(hi); *(u32x4*)(WRF + 32768 + (size_t)idx * 8) = pack8(lo); }
}

__device__ __forceinline__ int swap23(int p) { return (p & 3) | ((p & 4) << 1) | ((p & 8) >> 1); }
__device__ __forceinline__ void tr_item(const float* __restrict__ W, int ldw, int k0, int n0src, bool perm, bf16* WT, int ldt, int rowdst0, int kdst, LAS float* scr, int lane) {
#pragma unroll 8
    for (int i = 0; i < 32; ++i) { const int kk = 2 * i + (lane >> 5); scr[kk * 33 + (lane & 31)] = W[(size_t)(k0 + kk) * ldw + n0src + (lane & 31)]; }
    LDS_WAIT(); asm volatile("" ::: "memory");
    const int c = lane & 7;
#pragma unroll
    for (int j = 0; j < 4; ++j) { const int n = (lane >> 3) + 8 * j; const int ns = (perm && n < 16) ? swap23(n) : n; const LAS float* s = scr + (8 * c) * 33 + ns;
        u32x4 o; o.x = pk2(s[0 * 33], s[1 * 33]); o.y = pk2(s[2 * 33], s[3 * 33]); o.z = pk2(s[4 * 33], s[5 * 33]); o.w = pk2(s[6 * 33], s[7 * 33]);
        *(u32x4*)(WT + (size_t)(rowdst0 + n) * ldt + kdst + k0 + 8 * c) = o; }
    LDS_WAIT(); asm volatile("" ::: "memory");
}
__device__ __forceinline__ void rms_row_to_bf16(const float* xrow, const float* gain, bf16* orow, int lane) {
    f32x4 v[4]; float s = 0.f;
#pragma unroll
    for (int j = 0; j < 4; ++j) { v[j] = *(const f32x4*)(xrow + 4 * lane + 256 * j); s += (v[j].x * v[j].x + v[j].y * v[j].y) + (v[j].z * v[j].z + v[j].w * v[j].w); }
    const float rstd = 1.0f / sqrtf(wave_sum(s) * (1.0f / D) + RMS_EPS);
#pragma unroll
    for (int j = 0; j < 4; ++j) { const f32x4 g = *(const f32x4*)(gain + 4 * lane + 256 * j); u32x2 w; w.x = pk2(v[j].x * rstd * g.x, v[j].y * rstd * g.y); w.y = pk2(v[j].z * rstd * g.z, v[j].w * rstd * g.w);
        *(u32x2*)(orow + 4 * lane + 256 * j) = w; }
}
__device__ __forceinline__ void p0_prologue(const Args& a, const Ctx& c) {
    for (int g = c.bid; g < 64; g += c.G) p0_ssm_prep(a, c, g);
    LAS float* scr = (LAS float*)(c.lds + c.wave * 16384);
    bf16* WinT = (bf16*)(c.ws + WS_WIN); bf16* WgluT = (bf16*)(c.ws + WS_WGLU); bf16* WbrT = (bf16*)(c.ws + WS_WBR); bf16* WoutT = (bf16*)(c.ws + WS_WOUT);
    bf16* WguT = (bf16*)(c.ws + WS_WGU); bf16* WdnT = (bf16*)(c.ws + WS_WDN);
    constexpr int NI_IN = 16 * 136, NI_SQ = 512, NI_GU = 32 * 1024, NI_DN = 32 * 512, NI_ALL = NI_IN + 4 * NI_SQ + NI_GU + NI_DN;
    for (int it = c.gw; it < NI_ALL; it += c.ngw) {
        int r = it;
        if (r < NI_IN) { const int kb = r / 136, nb = r % 136, n0 = 32 * nb; const bool perm = (n0 >= 1024 && n0 < 2176 && (n0 & 63) == 0);
            tr_item(a.in[3], INW, 64 * kb, n0, perm, WinT, 1024, n0, 0, scr, c.lane); continue; } r -= NI_IN;
        if (r < NI_SQ) { tr_item(a.in[12], 1024, 64 * (r >> 5), 32 * (r & 31), false, WgluT, 1024, 32 * (r & 31), 0, scr, c.lane); continue; } r -= NI_SQ;
        if (r < NI_SQ) { tr_item(a.in[15], 1024, 64 * (r >> 5), 32 * (r & 31), false, WbrT, 1024, 32 * (r & 31), 0, scr, c.lane); continue; } r -= NI_SQ;
        if (r < NI_SQ) { tr_item(a.in[16], 1024, 64 * (r >> 5), 32 * (r & 31), false, WbrT, 1024, 1024 + 32 * (r & 31), 0, scr, c.lane); continue; } r -= NI_SQ;
        if (r < NI_SQ) { tr_item(a.in[17], 1024, 64 * (r >> 5), 32 * (r & 31), false, WoutT, 1024, 32 * (r & 31), 0, scr, c.lane); continue; } r -= NI_SQ;
        if (r < NI_GU) { const int e = r >> 10, rr = r & 1023, kb = rr >> 6, r0 = 32 * (rr & 63), jt = r0 >> 8, w = r0 & 255; const int src = w < 128 ? 128 * jt + w : 1024 + 128 * jt + (w - 128);
            tr_item(a.in[21] + (size_t)e * 1024 * 2048, 2048, 64 * kb, src, false, WguT + (size_t)e * 2048 * 1024, 1024, r0, 0, scr, c.lane); continue; } r -= NI_GU;
        { const int e = r >> 9, rr = r & 511, kb = rr >> 5, nb = rr & 31;
            tr_item(a.in[23] + (size_t)e * 1024 * 1024, 1024, 64 * kb, 32 * nb, false, WdnT + (size_t)e * 1024 * 1024, 1024, 32 * nb, 0, scr, c.lane); }
    }
    bf16* XN = (bf16*)(c.ws + WS_XN);
    for (int m = c.gw; m < MP; m += c.ngw) {
        if (m < M + NMETA) rms_row_to_bf16(m < M ? a.in[0] + (size_t)m * D : a.in[1] + (size_t)(m - M) * D, a.in[2], XN + (size_t)m * D, c.lane);
        else { u32x4 z = {0u, 0u, 0u, 0u}; *(u32x4*)(XN + (size_t)m * D + 8 * c.lane) = z; *(u32x4*)(XN + (size_t)m * D + 512 + 8 * c.lane) = z; }
    }
    p0_router_frags(a, c);
    const int gt = c.bid * (NWAVES * 64) + c.tid, ngt = c.G * NWAVES * 64;
    float* rot = (float*)(c.ws + WS_ROT);
    for (int i = gt; i < LTOT * 8; i += ngt) { const int pos = i >> 3, j = i & 7; const float inv = powf(500000.0f, -(float)(2 * j) / 16.0f); const float ang = (float)pos * inv;
        rot[pos * 16 + j] = cosf(ang); rot[pos * 16 + 8 + j] = sinf(ang); }
    float* Ab = (float*)(c.ws + WS_SSMP); float* BB = Ab + 16384;
    for (int i = gt; i < 4096; i += ngt) { const int g = i >> 6;
        const float lr = a.in[4][i], li = a.in[5][i], dt = expf(a.in[6][g]), mag = expf(dt * lr), ar = mag * cosf(dt * li), ai = mag * sinf(dt * li);
        const float den = lr * lr + li * li, nr = ar - 1.0f, ni = ai, fr = (nr * lr + ni * li) / den, fi = (ni * lr - nr * li) / den;
        Ab[2 * i] = ar; Ab[2 * i + 1] = ai;
        for (int h = 0; h < 16; ++h) { const float br = a.in[7][i * 16 + h], bi = a.in[8][i * 16 + h]; BB[(i * 16 + h) * 2] = fr * br - fi * bi; BB[(i * 16 + h) * 2 + 1] = fr * bi + fi * br; }
    }
}

__device__ __forceinline__ void p2_ssm_naive(const Args& a, const Ctx& c) {
    const float* Ab = (const float*)(c.ws + WS_SSMP); const float* BB = Ab + 16384;
    const bf16* U = (const bf16*)(c.ws + WS_U); bf16* Z = (bf16*)(c.ws + WS_Z);
    for (int it = c.gw; it < 128; it += c.ngw) {
        const int g = it >> 1, b = it & 1, p = c.lane, gp = g * 64 + p;
        const float ar = Ab[2 * gp], ai = Ab[2 * gp + 1];
        float bbr[16], bbi[16], cr[16], ci[16], dd[16];
#pragma unroll
        for (int h = 0; h < 16; ++h) { bbr[h] = BB[(gp * 16 + h) * 2]; bbi[h] = BB[(gp * 16 + h) * 2 + 1]; cr[h] = a.in[9][(g * 16 + h) * 64 + p]; ci[h] = a.in[10][(g * 16 + h) * 64 + p]; dd[h] = a.in[11][g * 16 + h]; }
        float xr = 0.f, xi = 0.f;
        const bf16* up = U + (size_t)((g * 2 + b) * NCH) * 256;
        for (int t = 0; t < LTOT; ++t) {
            float u[16]; { float t0[8], t1[8]; unpack8(*(const u32x4*)(up + t * 16), t0); unpack8(*(const u32x4*)(up + t * 16 + 8), t1);
#pragma unroll
                for (int h = 0; h < 8; ++h) { u[h] = t0[h]; u[8 + h] = t1[h]; } }
            float br_ = 0.f, bi_ = 0.f;
#pragma unroll
            for (int h = 0; h < 16; ++h) { br_ += bbr[h] * u[h]; bi_ += bbi[h] * u[h]; }
            const float nxr = ar * xr - ai * xi + br_, nxi = ar * xi + ai * xr + bi_; xr = nxr; xi = nxi;
            if (t >= NMETA) {
                float mine = 0.f;
#pragma unroll
                for (int h = 0; h < 16; ++h) { float v = wave_sum(cr[h] * xr - ci[h] * xi); if (c.lane == h) mine = v + dd[h] * u[h]; }
                if (c.lane < 16) Z[(size_t)(b * SEQ + t - NMETA) * 1024 + g * 16 + c.lane] = (bf16)f2bf(gelu_tanh(mine));
            }
        }
    }
}
__device__ __forceinline__ float dot8(u32x4 q, u32x4 k) {
    return (bflo(q.x) * bflo(k.x) + bfhi(q.x) * bfhi(k.x)) + (bflo(q.y) * bflo(k.y) + bfhi(q.y) * bfhi(k.y)) + (bflo(q.z) * bflo(k.z) + bfhi(q.z) * bfhi(k.z)) + (bflo(q.w) * bflo(k.w) + bfhi(q.w) * bfhi(k.w));
}
__device__ __forceinline__ void p2_attn_naive(const Args& a, const Ctx& c) {
    const bf16* Q = (const bf16*)(c.ws + WS_Q); const bf16* Kb = (const bf16*)(c.ws + WS_K); const bf16* Vt = (const bf16*)(c.ws + WS_VT); bf16* BRA = (bf16*)(c.ws + WS_BRA);
    const int lane = c.lane;
    for (int it = c.gw; it < M * 16; it += c.ngw) {
        const int r = it >> 4, h = it & 15, kvh = h >> 3, b = r >> 13, t = r & (SEQ - 1);
        u32x4 qv[8];
#pragma unroll
        for (int i = 0; i < 8; ++i) qv[i] = *(const u32x4*)(Q + (size_t)r * 1024 + h * 64 + 8 * i);
        float s[3];
#pragma unroll
        for (int sl = 0; sl < 3; ++sl) {
            int pos; bool ok;
            if (sl < 2) { const int tok = t - 127 + lane + 64 * sl; ok = tok >= 0; pos = NMETA + (ok ? tok : 0); } else { ok = lane < NMETA; pos = ok ? lane : 0; }
            const bf16* kp = Kb + ((size_t)(b * LTOT + pos)) * 128 + kvh * 64; float acc = 0.f;
#pragma unroll
            for (int i = 0; i < 8; ++i) acc += dot8(qv[i], *(const u32x4*)(kp + 8 * i));
            s[sl] = ok ? acc : -1e30f;
        }
        const float sink = a.in[14][h];
        const float mx = wave_max(fmaxf(fmaxf(s[0], s[1]), fmaxf(s[2], sink)));
        const float p0 = __expf(s[0] - mx), p1 = __expf(s[1] - mx), p2 = __expf(s[2] - mx);
        const float l = wave_sum(p0 + p1 + p2) + __expf(sink - mx);
        const bf16* vrow = Vt + ((size_t)((b * 2 + kvh) * 64 + lane)) * VP;
        float o = 0.f;
        for (int j = 0; j < 128; ++j) { const int tok = t - 127 + j; const float pj = __shfl(j < 64 ? p0 : p1, j & 63); if (tok >= 0) o += pj * bf2f(vrow[NMETA + tok]); }
        for (int j = 0; j < NMETA; ++j) { const float pj = __shfl(p2, j); o += pj * bf2f(vrow[j]); }
        BRA[(size_t)(M + r) * 1024 + h * 64 + lane] = (bf16)f2bf(o / l);
    }
}

__device__ __forceinline__ void p6_router(const Args& a, const Ctx& c) {
    const float* H1 = (const float*)(c.ws + WS_H1); bf16* XG = (bf16*)(c.ws + WS_HN2);
    int* TE = (int*)(c.ws + WS_TOK); int* TP = TE + M * 4; float* TG = (float*)(TP + M * 4); float* RS = (float*)(c.ws + WS_TOK) + M * 16 + NSLOT * 2;
    unsigned* cnt = (unsigned*)(c.ws + WS_CTL) + CW_CNT;
    const float* brt = a.in[20];
    LAS float* gl = (LAS float*)(c.lds + LDSCTL_OFF + 8192);
    LAS unsigned* hist = (LAS unsigned*)(c.lds + LDSCTL_OFF + 12288); LAS unsigned* ebase = hist + 32;
    const int lane = c.lane, fr = lane & 15, fq = lane >> 4;
    __syncthreads();
    for (int idx = c.tid; idx < 8192; idx += NWAVES * 64) *(LAS u32x4*)(c.lds + idx * 16) = *(const u32x4*)(c.ws + WS_SSMP + SSM_WRF + (size_t)idx * 16);
    for (int idx = c.tid; idx < 1024; idx += NWAVES * 64) gl[idx] = a.in[18][idx];
    for (int t0 = 0; t0 < M / 16; t0 += 4 * c.G) {
        if (c.tid < 32) hist[c.tid] = 0u;
        __syncthreads();
        const int tile = t0 + c.wave * c.G + c.bid; const bool work = c.wave < 4 && tile < M / 16;
        int te[4]; unsigned rk[4]; const int row = 16 * tile + fr;
        if (work) {
            const float* xr = H1 + (size_t)row * D + 8 * fq;
            f32x4 acc0 = {0.f, 0.f, 0.f, 0.f}, acc1 = {0.f, 0.f, 0.f, 0.f}; float ss = 0.f;
#pragma unroll 2
            for (int ks = 0; ks < 32; ++ks) {
                const f32x4 x0 = *(const f32x4*)(xr + 32 * ks), x1 = *(const f32x4*)(xr + 32 * ks + 4);
                const f32x4 g0 = *(const LAS f32x4*)(gl + 32 * ks + 8 * fq), g1 = *(const LAS f32x4*)(gl + 32 * ks + 8 * fq + 4);
                ss += (x0.x * x0.x + x0.y * x0.y) + (x0.z * x0.z + x0.w * x0.w) + (x1.x * x1.x + x1.y * x1.y) + (x1.z * x1.z + x1.w * x1.w);
                const f32x4 v0 = x0 * g0, v1 = x1 * g1;
                u32x4 hw; hw.x = pk2(v0.x, v0.y); hw.y = pk2(v0.z, v0.w); hw.z = pk2(v1.x, v1.y); hw.w = pk2(v1.z, v1.w);
                *(u32x4*)(XG + (size_t)row * D + 32 * ks + 8 * fq) = hw;
                u32x4 lw; lw.x = pk2(v0.x - bflo(hw.x), v0.y - bfhi(hw.x)); lw.y = pk2(v0.z - bflo(hw.y), v0.w - bfhi(hw.y)); lw.z = pk2(v1.x - bflo(hw.z), v1.y - bfhi(hw.z)); lw.w = pk2(v1.z - bflo(hw.w), v1.w - bfhi(hw.w));
                const bf16x8 hi = __builtin_bit_cast(bf16x8, hw), lo = __builtin_bit_cast(bf16x8, lw);
                const bf16x8 wh0 = *(const LAS bf16x8*)(c.lds + ((ks * 2 + 0) * 64 + lane) * 16), wh1 = *(const LAS bf16x8*)(c.lds + ((ks * 2 + 1) * 64 + lane) * 16);
                const bf16x8 wl0 = *(const LAS bf16x8*)(c.lds + 65536 + ((ks * 2 + 0) * 64 + lane) * 16), wl1 = *(const LAS bf16x8*)(c.lds + 65536 + ((ks * 2 + 1) * 64 + lane) * 16);
                acc0 = __builtin_amdgcn_mfma_f32_16x16x32_bf16(wh0, hi, acc0, 0, 0, 0); acc1 = __builtin_amdgcn_mfma_f32_16x16x32_bf16(wh1, hi, acc1, 0, 0, 0);
                acc0 = __builtin_amdgcn_mfma_f32_16x16x32_bf16(wl0, hi, acc0, 0, 0, 0); acc1 = __builtin_amdgcn_mfma_f32_16x16x32_bf16(wl1, hi, acc1, 0, 0, 0);
                acc0 = __builtin_amdgcn_mfma_f32_16x16x32_bf16(wh0, lo, acc0, 0, 0, 0); acc1 = __builtin_amdgcn_mfma_f32_16x16x32_bf16(wh1, lo, acc1, 0, 0, 0);
            }
            ss += __shfl_xor(ss, 16); ss += __shfl_xor(ss, 32);
            const float rstd = 1.0f / sqrtf(ss * (1.0f / D) + RMS_EPS);
            float lg[32];
#pragma unroll
            for (int q = 0; q < 4; ++q)
#pragma unroll
                for (int r = 0; r < 4; ++r) { lg[4 * q + r] = __shfl(acc0[r], fr + 16 * q) * rstd + brt[4 * q + r]; lg[16 + 4 * q + r] = __shfl(acc1[r], fr + 16 * q) * rstd + brt[16 + 4 * q + r]; }
            float tv[4];
#pragma unroll
            for (int k = 0; k < 4; ++k) { float best = -3.0e38f; int bi = 0;
#pragma unroll
                for (int e = 0; e < 32; ++e) if (lg[e] > best) { best = lg[e]; bi = e; }
                te[k] = bi; tv[k] = best;
#pragma unroll
                for (int e = 0; e < 32; ++e) if (e == bi) lg[e] = -3.0e38f; }
            if (fq == 0) {
                const float e1 = __expf(tv[1] - tv[0]), e2 = __expf(tv[2] - tv[0]), e3 = __expf(tv[3] - tv[0]), inv = 1.0f / (1.0f + e1 + e2 + e3);
                *(f32x4*)(TG + row * 4) = (f32x4){inv, e1 * inv, e2 * inv, e3 * inv};
                TE[row * 4 + 0] = te[0]; TE[row * 4 + 1] = te[1]; TE[row * 4 + 2] = te[2]; TE[row * 4 + 3] = te[3];
                RS[row] = rstd;
#pragma unroll
                for (int k = 0; k < 4; ++k) rk[k] = __hip_atomic_fetch_add(hist + te[k], 1u, __ATOMIC_RELAXED, __HIP_MEMORY_SCOPE_WORKGROUP);
            }
        }
        __syncthreads();
        if (c.tid < 32) ebase[c.tid] = __hip_atomic_fetch_add(cnt + c.tid, hist[c.tid], RLX_AGENT);
        __syncthreads();
        if (work && fq == 0) {
#pragma unroll
            for (int k = 0; k < 4; ++k) TP[row * 4 + k] = (int)(ebase[te[k]] + rk[k]); }
        __syncthreads();
    }
}
__device__ __forceinline__ int moe_tables(const Ctx& c, LAS int* tb, LAS int* tile_e) {
    __syncthreads();
    if (c.tid == 0) { const gu32* cnt = (const gu32*)(c.ws + WS_CTL) + CW_CNT; int acc = 0;
        for (int e = 0; e < NE; ++e) { tb[e] = acc; const int n = ((int)__hip_atomic_load(cnt + e, RLX_AGENT) + 255) >> 8; for (int i = 0; i < n && acc + i < MAXT; ++i) tile_e[acc + i] = e; acc += n; if (acc > MAXT) acc = MAXT; }
        tb[NE] = acc; }
    __syncthreads();
    return tb[NE];
}
__device__ __forceinline__ void p7_gather(const Args& a, const Ctx& c, LAS int* tb) {
    const bf16* HN2 = (const bf16*)(c.ws + WS_HN2); bf16* XS = (bf16*)(c.ws + WS_XS);
    const int* TE = (const int*)(c.ws + WS_TOK); const int* TP = TE + M * 4; const float* TG = (const float*)(TP + M * 4); int* TS = (int*)(TG + M * 4); float* SG = (float*)(TS + M * 4);
    float* SR = SG + NSLOT; const float* RS = SG + 2 * NSLOT;
    for (int row = c.gw; row < M; row += c.ngw) {
        const u32x4 w0 = *(const u32x4*)(HN2 + (size_t)row * D + 8 * c.lane), w1 = *(const u32x4*)(HN2 + (size_t)row * D + 512 + 8 * c.lane);
#pragma unroll
        for (int k = 0; k < 4; ++k) { const int e = TE[row * 4 + k], slot = tb[e] * 256 + TP[row * 4 + k];
            *(u32x4*)(XS + (size_t)slot * D + 8 * c.lane) = w0; *(u32x4*)(XS + (size_t)slot * D + 512 + 8 * c.lane) = w1;
            if (c.lane == 0) { TS[row * 4 + k] = slot; SG[slot] = TG[row * 4 + k]; SR[slot] = RS[row]; } }
    }
}
__device__ __forceinline__ void p10_final(const Args& a, const Ctx& c) {
    const float* H1 = (const float*)(c.ws + WS_H1); const bf16* YS = (const bf16*)(c.ws + WS_YS);
    const int* TS = (const int*)(c.ws + WS_TOK) + M * 12; const float* gain = a.in[25];
    for (int row = c.gw; row < M; row += c.ngw) {
        f32x4 v[4];
#pragma unroll
        for (int j = 0; j < 4; ++j) v[j] = *(const f32x4*)(H1 + (size_t)row * D + 4 * c.lane + 256 * j);
#pragma unroll
        for (int k = 0; k < 4; ++k) { const bf16* ys = YS + (size_t)TS[row * 4 + k] * D;
#pragma unroll
            for (int j = 0; j < 4; ++j) { const u32x2 w = *(const u32x2*)(ys + 4 * c.lane + 256 * j); v[j].x += bflo(w.x); v[j].y += bfhi(w.x); v[j].z += bflo(w.y); v[j].w += bfhi(w.y); } }
        float s = 0.f;
#pragma unroll
        for (int j = 0; j < 4; ++j) s += (v[j].x * v[j].x + v[j].y * v[j].y) + (v[j].z * v[j].z + v[j].w * v[j].w);
        const float rstd = 1.0f / sqrtf(wave_sum(s) * (1.0f / D) + RMS_EPS);
#pragma unroll
        for (int j = 0; j < 4; ++j) { const f32x4 g = *(const f32x4*)(gain + 4 * c.lane + 256 * j); *(f32x4*)(a.out + (size_t)row * D + 4 * c.lane + 256 * j) = v[j] * rstd * g; }
    }
}

#ifndef ONE_LAUNCH
#define ONE_LAUNCH 0
#endif
#ifndef FAST_GEMM
#define FAST_GEMM 0
#endif
#ifndef FAST_MIX
#define FAST_MIX 0
#endif
constexpr int NPH = 13;

template <bool FAST, class E, class S>
__device__ __forceinline__ void run_gemm(const Ctx& c, const bf16* A, const bf16* Bt, int K, const S& s, const E& e) {
    if constexpr (FAST) { pg8::Gemm g{A, Bt, 0, 0, K}; FastEpi<E> fe{e}; pg8::gemm_phase<FastEpi<E>, S, true, true>(c.lds, g, s, fe); }
    else { Unit u; for (int i = 0; s.next(i, u); ++i) naive_gemm_unit(A, K, Bt, K, K, u.pm, u.pn, e, c.wave, c.lane); }
}

__global__ void __launch_bounds__(NWAVES * 64, 2) fwd(Args args) {
    extern __shared__ __attribute__((aligned(16))) unsigned char lds_raw[];
    Ctx c; c.lds = (LAS unsigned char*)lds_raw; c.ws = args.ws; c.tid = threadIdx.x; c.lane = c.tid & 63; c.wave = __builtin_amdgcn_readfirstlane(c.tid >> 6);
    c.G = gridDim.x; c.bid = blockIdx.x; c.gw = c.bid * NWAVES + c.wave; c.ngw = c.G * NWAVES;
    volatile LAS unsigned* MISC = (volatile LAS unsigned*)(c.lds + LDSCTL_OFF);
    LAS int* tb = (LAS int*)(c.lds + LDSCTL_OFF + 512); LAS int* tile_e = (LAS int*)(c.lds + LDSCTL_OFF + 1024);
    for (int u = c.tid; u < (LDS_BYTES - LDSCTL_OFF) / 4; u += NWAVES * 64) ((LAS unsigned*)(c.lds + LDSCTL_OFF))[u] = 0u;
    __syncthreads();
    const int lo = args.ph_lo, hi = args.ph_hi;
    XcdBarrier bar; bar.bar = (unsigned*)(c.ws + WS_CTL) + CW_BAR; bar.x = 0; bar.st = nullptr;
    if (hi - lo > 1) bar = xcd_barrier_post((unsigned*)(c.ws + WS_CTL) + CW_BAR, MISC + 8);
#ifndef DISMASK
#define DISMASK 0
#endif
#define IN(k) (lo <= (k) && (k) < hi && !((DISMASK >> (k)) & 1))
#define SEAM(k) do { if (IN(k) && IN((k) + 1)) xcd_barrier(bar); } while (0)
    unsigned char* ws = c.ws;
    bf16* XN = (bf16*)(ws + WS_XN); bf16* U = (bf16*)(ws + WS_U); bf16* Q = (bf16*)(ws + WS_Q); bf16* Kb = (bf16*)(ws + WS_K); bf16* Vt = (bf16*)(ws + WS_VT);
    bf16* GSp = (bf16*)(ws + WS_GS); bf16* GAp = (bf16*)(ws + WS_GA); bf16* Z = (bf16*)(ws + WS_Z); bf16* BRA = (bf16*)(ws + WS_BRA); bf16* MIX = (bf16*)(ws + WS_MIX);
    float* H1 = (float*)(ws + WS_H1); bf16* XS = (bf16*)(ws + WS_XS); bf16* HID = (bf16*)(ws + WS_HID); bf16* YS = (bf16*)(ws + WS_YS);

#ifndef REPMASK
#define REPMASK 0
#endif
#define PHASE(k, ...) if (IN(k)) { __VA_ARGS__ if constexpr ((REPMASK >> (k)) & 1) { xcd_barrier(bar); __VA_ARGS__ } } SEAM(k);
    PHASE(0, p0_prologue(args, c);)
    PHASE(1, {
        pg8::StaticOrder S; S.init(MP, INW, c.G, c.bid);
        EpiInProj E{U, Q, Kb, Vt, GSp, GAp, (const float*)(ws + WS_ROT)};
        run_gemm<FAST_GEMM>(c, XN, (const bf16*)(ws + WS_WIN), 1024, S, E); })
    PHASE(2, if constexpr (FAST_MIX) ssm_phase_a(c); else { p2_ssm_naive(args, c); p2_attn_naive(args, c); })
    PHASE(3, if constexpr (FAST_MIX) { ssm_carry(c); attn_fast(args, c); })
    PHASE(4, if constexpr (FAST_MIX) ssm_phase_c(c);)
    PHASE(5, {
        pg8::StaticOrder S; S.init(M, 1024, c.G, c.bid);
        EpiGlu E{Z, args.in[13], BRA};
        run_gemm<FAST_GEMM>(c, Z, (const bf16*)(ws + WS_WGLU), 1024, S, E); })
    PHASE(6, {
        EpiBr E{GSp, GAp, MIX};
        if constexpr (FAST_GEMM) { PairOrder S; S.so.init(M, 1024, c.G, c.bid); run_gemm<true>(c, BRA, (const bf16*)(ws + WS_WBR), 1024, S, E); }
        else { pg8::StaticOrder S; S.init(M, 1024, c.G, c.bid); run_gemm<false>(c, BRA, (const bf16*)(ws + WS_WBR), 1024, S, E); } })
    PHASE(7, {
        pg8::StaticOrder S; S.init(M, 1024, c.G, c.bid);
        EpiOut E{args.in[0], H1};
        run_gemm<FAST_GEMM>(c, MIX, (const bf16*)(ws + WS_WOUT), 1024, S, E); })
    PHASE(8, p6_router(args, c);)
    PHASE(9, { moe_tables(c, tb, tile_e); p7_gather(args, c, tb); })
    PHASE(10, {
        const int nt = moe_tables(c, tb, tile_e);
        MoeOrder S{tile_e, nt, 8, c.G, c.bid};
        EpiMoe1 E{args.in[22], (const float*)(ws + WS_TOK) + M * 16 + NSLOT, HID};
        run_gemm<FAST_GEMM>(c, XS, (const bf16*)(ws + WS_WGU), 1024, S, E); })
    PHASE(11, {
        const int nt = moe_tables(c, tb, tile_e);
        MoeOrder S{tile_e, nt, 4, c.G, c.bid};
        EpiMoe2 E{args.in[24], (const float*)(ws + WS_TOK) + M * 16, YS};
        run_gemm<FAST_GEMM>(c, HID, (const bf16*)(ws + WS_WDN), 1024, S, E); })
    PHASE(12, p10_final(args, c);)
#undef PHASE
#undef IN
#undef SEAM
}

extern "C" void kernel_launch(void* const* d_in, const int* in_sizes, int n_in, void* d_out, int out_size, void* d_ws, size_t ws_size, hipStream_t stream) {
    static int grid = 0;
    if (grid == 0) {
        if (n_in != 26 || in_sizes[0] != M * D || out_size != M * D || ws_size < WS_END) { fprintf(stderr, "kernel_launch: unexpected shapes (n_in %d, in0 %d, out %d, ws %zu)\n", n_in, n_in > 0 ? in_sizes[0] : -1, out_size, ws_size); grid = -1; return; }
        int dev = 0, cus = 0, per_cu = 0;
        if (hipGetDevice(&dev) != hipSuccess || hipDeviceGetAttribute(&cus, hipDeviceAttributeMultiprocessorCount, dev) != hipSuccess) { grid = -1; return; }
        if (hipFuncSetAttribute((const void*)fwd, hipFuncAttributeMaxDynamicSharedMemorySize, LDS_BYTES) != hipSuccess) { fprintf(stderr, "kernel_launch: hipFuncSetAttribute failed\n"); grid = -1; return; }
        if (hipOccupancyMaxActiveBlocksPerMultiprocessor(&per_cu, (const void*)fwd, NWAVES * 64, LDS_BYTES) != hipSuccess || per_cu < 1) fprintf(stderr, "kernel_launch: occupancy query says %d\n", per_cu);
        (void)hipGetLastError();
        grid = cus;
    }
    if (grid < 0) return;
    if (hipMemsetAsync((char*)d_ws + WS_CTL, 0, CTL_ZERO_BYTES, stream) != hipSuccess) return;
    Args a{};
    for (int i = 0; i < 26; ++i) a.in[i] = (const float*)d_in[i];
    a.out = (float*)d_out; a.ws = (unsigned char*)d_ws;
#if ONE_LAUNCH
    a.ph_lo = 0; a.ph_hi = NPH;
    hipLaunchKernelGGL(fwd, dim3(grid), dim3(NWAVES * 64), LDS_BYTES, stream, a);
#else
    for (int p = 0; p < NPH; ++p) { a.ph_lo = p; a.ph_hi = p + 1; hipLaunchKernelGGL(fwd, dim3(grid), dim3(NWAVES * 64), LDS_BYTES, stream, a); }
#endif
}
```

```cpp
#include <hip/hip_runtime.h>
#include <cstdio>
#include <cstdint>
#define ONE_LAUNCH 1
#define FAST_GEMM 1
#define FAST_MIX 1
#define EPI_FENCE 0
namespace pg8 {
#define PG8_LAS __attribute__((address_space(3)))
typedef unsigned short bf16_t;
typedef short bf16x8 __attribute__((ext_vector_type(8)));
typedef float f32x4 __attribute__((ext_vector_type(4)));
typedef unsigned u32x4 __attribute__((ext_vector_type(4)));
constexpr int BM = 256, BK = 64, HALF = 128, HTB = HALF * BK * 2  , STAGE_BYTES = 8 * HTB, NXCD = 8, WGM = 8;

__host__ __device__ __forceinline__ int lds_byte(int r, int c) { const int st = (r >> 4) * 2 + (c >> 5), rr = r & 15, cc = c & 31, ob = rr * 64 + cc * 2; return st * 1024 + (ob ^ (((ob >> 9) & 1) << 5)); }
__host__ __device__ __forceinline__ void stage_rc(int b, int& R, int& C) { const int st = b / 1024, sb = b % 1024, swz = sb ^ (((sb >> 9) & 1) << 5); R = (st >> 1) * 16 + swz / 64; C = (st & 1) * 32 + (swz % 64) / 2; }
__host__ __device__ __forceinline__ int perm32(int rho) { const int n = rho >> 4, i = rho & 15; return 8 * (i >> 2) + 4 * n + (i & 3); }

struct Unit { int pm, pn; };
struct Gemm { const bf16_t* A; const bf16_t* Bt; int M, N, K; int wid; };
__device__ __forceinline__ int fresh_lane() { int l; asm volatile("v_mbcnt_lo_u32_b32 %0, -1, 0\n\tv_mbcnt_hi_u32_b32 %0, -1, %0" : "=v"(l)); return l; }

struct StaticOrder {
    int nM, nN, nwg, G, c;
    __host__ __device__ void init(int M, int N, int G_, int c_) { nM = M / BM; nN = N / BM; nwg = nM * nN; G = G_; c = c_; }
    __host__ __device__ bool next(int i, Unit& u) const {
        const long L = (long)i * G + c; if (L >= nwg) return false;
        int wgid = (int)L; { const int q = nwg / NXCD, r = nwg % NXCD, xcd = wgid % NXCD, off = wgid / NXCD; wgid = (xcd < r ? xcd * (q + 1) : r * (q + 1) + (xcd - r) * q) + off; }
        const int nig = WGM * nN, gid = wgid / nig, fm = gid * WGM, gsz = (nM - fm) < WGM ? (nM - fm) : WGM;
        u.pm = fm + ((wgid % nig) % gsz); u.pn = (wgid % nig) / gsz; return true;
    }
    __device__ __forceinline__ void a_ready(const Unit&) const {}
    __device__ __forceinline__ void done(const Unit&) const {}
};
__device__ __forceinline__ unsigned cvt_pk_bf16(float lo, float hi) { unsigned r; asm volatile("v_cvt_pk_bf16_f32 %0, %1, %2" : "=v"(r) : "v"(lo), "v"(hi)); return r; }
typedef int pg8_v8i __attribute__((ext_vector_type(8))); typedef int pg8_v4i __attribute__((ext_vector_type(4)));
__device__ __forceinline__ pg8_v8i pg8_cat(bf16x8 lo, bf16x8 hi) { return __builtin_shufflevector(__builtin_bit_cast(pg8_v4i, lo), __builtin_bit_cast(pg8_v4i, hi), 0, 1, 2, 3, 4, 5, 6, 7); }
template <class Epi, class Sched, bool ALIGN_EPI = false, bool SP2 = false, bool F8 = false>
__device__ __forceinline__ void gemm_phase(PG8_LAS unsigned char* lds, const Gemm g, const Sched& S, const Epi& E) {
    const int lane = fresh_lane(), wid = g.wid, tid = wid * 64 + lane, wr = wid >> 2, wc = wid & 3, fr = lane & 15, fq = lane >> 4;
    const int K = g.K, nt = K / BK;
    unsigned voffA[2], voffB[2];
#pragma unroll
    for (int i = 0; i < 2; ++i) { int R, C; stage_rc(tid * 16 + i * 8192, R, C); const int Rb = Epi::PERM ? ((R & ~31) + perm32(R & 31)) : R;
        voffA[i] = (unsigned)(R * K + C) * 2u; voffB[i] = (unsigned)(Rb * K + C) * 2u; }
    const unsigned kstep = (unsigned)(BK * 2);
    const unsigned hstep = (unsigned)HALF * K * 2;
    const unsigned tstep = 2 * hstep;
    const __amdgpu_buffer_rsrc_t rsA = __builtin_amdgcn_make_buffer_rsrc((void*)g.A, (short)0, -1, 0x00020000), rsB = __builtin_amdgcn_make_buffer_rsrc((void*)g.Bt, (short)0, -1, 0x00020000);
    const unsigned ldsw = (unsigned)wid * 1024u;
    const int aoff = lds_byte(wr * 64 + fr, fq * 8), boff = lds_byte(wc * 32 + fr, fq * 8);
#define PG8_SA(b, h) (((b) * 2 + (h)) * HTB)
#define PG8_SB(b, h) ((4 + (b) * 2 + (h)) * HTB)
#define PG8_STAGE(bufoff, gbase, voff) do { _Pragma("unroll") for (int _i = 0; _i < 2; ++_i) \
        __builtin_amdgcn_raw_ptr_buffer_load_lds(PG8_RS_##voff, (PG8_LAS unsigned*)(lds + (bufoff) + ldsw + _i * 8192), 16, (int)(voff)[_i], (int)(gbase), 0, 0); } while (0)
#define PG8_RS_voffA rsA
#define PG8_RS_voffB rsB
#define PG8_LDA(dst, b, h) do { _Pragma("unroll") for (int m = 0; m < 4; ++m) _Pragma("unroll") for (int k = 0; k < 2; ++k) dst[m][k] = *(const PG8_LAS bf16x8*)(lds + PG8_SA(b, h) + aoff + m * 2048 + k * 1024); } while (0)
#define PG8_LDB(dst, b, h) do { _Pragma("unroll") for (int n = 0; n < 2; ++n) _Pragma("unroll") for (int k = 0; k < 2; ++k) dst[n][k] = *(const PG8_LAS bf16x8*)(lds + PG8_SB(b, h) + boff + n * 2048 + k * 1024); } while (0)
#define PG8_MMA(ai, bj, At, Bt) do { __builtin_amdgcn_s_setprio(1); if constexpr (F8) { _Pragma("unroll") for (int m = 0; m < 4; ++m) _Pragma("unroll") for (int n = 0; n < 2; ++n) \
        acc[ai][bj][m][n] = __builtin_amdgcn_mfma_scale_f32_16x16x128_f8f6f4(pg8_cat(Bt[n][0], Bt[n][1]), pg8_cat(At[m][0], At[m][1]), acc[ai][bj][m][n], 0, 0, 0, 0, 0, 0); } else { \
        _Pragma("unroll") for (int m = 0; m < 4; ++m) _Pragma("unroll") for (int n = 0; n < 2; ++n) _Pragma("unroll") for (int k = 0; k < 2; ++k) \
        acc[ai][bj][m][n] = __builtin_amdgcn_mfma_f32_16x16x32_bf16(Bt[n][k], At[m][k], acc[ai][bj][m][n], 0, 0, 0); } __builtin_amdgcn_s_setprio(0); } while (0)
#define PG8_WAIT_V(n) asm volatile("s_waitcnt vmcnt(" #n ")" ::: "memory")
#define PG8_WAIT_L(n) asm volatile("s_waitcnt lgkmcnt(" #n ")" ::: "memory")
#define PG8_BAR __builtin_amdgcn_s_barrier()
#define PG8_SCHED __builtin_amdgcn_sched_barrier(0)
    Unit cur, nxt; int ui = 0;
    if (!S.next(0, cur)) return;
    f32x4 acc[2][2][4][2];
#pragma unroll
    for (int a = 0; a < 2; ++a)
#pragma unroll
        for (int b = 0; b < 2; ++b)
#pragma unroll
            for (int m = 0; m < 4; ++m)
#pragma unroll
                for (int n = 0; n < 2; ++n) acc[a][b][m][n] = (f32x4){0.f, 0.f, 0.f, 0.f};
    bf16x8 At[4][2], B0[2][2], B1[2][2];
    unsigned cA = (unsigned)cur.pm * tstep, cB = (unsigned)cur.pn * tstep;
    S.a_ready(cur);
    if constexpr (SP2) {
        PG8_STAGE(PG8_SB(0, 0), cB, voffB); PG8_STAGE(PG8_SB(0, 1), cB + hstep, voffB); PG8_STAGE(PG8_SA(0, 0), cA, voffA); PG8_STAGE(PG8_SA(0, 1), cA + hstep, voffA);
        if (wr == 1) PG8_BAR;
        PG8_WAIT_V(2); PG8_BAR;
        PG8_STAGE(PG8_SB(1, 0), cB + kstep, voffB); PG8_STAGE(PG8_SA(1, 0), cA + kstep, voffA); PG8_STAGE(PG8_SB(1, 1), cB + hstep + kstep, voffB);
        PG8_WAIT_V(6); PG8_BAR;
    } else {
        PG8_STAGE(PG8_SB(0, 0), cB, voffB); PG8_STAGE(PG8_SA(0, 0), cA, voffA); PG8_STAGE(PG8_SB(0, 1), cB + hstep, voffB); PG8_STAGE(PG8_SA(0, 1), cA + hstep, voffA);
        if (wr == 1) PG8_BAR;
        PG8_WAIT_V(4); PG8_BAR;
        PG8_STAGE(PG8_SB(1, 0), cB + kstep, voffB); PG8_STAGE(PG8_SA(1, 0), cA + kstep, voffA); PG8_STAGE(PG8_SB(1, 1), cB + hstep + kstep, voffB);
        PG8_WAIT_V(6); PG8_BAR;
    }
    for (;;) {
        const bool has_next = S.next(ui + 1, nxt);
        const unsigned nA = has_next ? (unsigned)nxt.pm * tstep : cA, nB = has_next ? (unsigned)nxt.pn * tstep : cB;
#pragma unroll 1
        for (int t = 0; t < nt; t += 2) {
            const bool last = (t == nt - 2);
            const unsigned a1 = cA + (unsigned)(t + 1) * kstep;
            const unsigned a2 = last ? nA : cA + (unsigned)(t + 2) * kstep, b2 = last ? nB : cB + (unsigned)(t + 2) * kstep;
            const unsigned a3 = a2 + kstep, b3 = b2 + kstep;
            if (last && has_next) S.a_ready(nxt);
            if constexpr (SP2) {
            PG8_LDB(B0, 0, 0); PG8_LDB(B1, 0, 1); PG8_SCHED; PG8_LDA(At, 0, 0); PG8_STAGE(PG8_SA(1, 1), a1 + hstep, voffA);
            PG8_WAIT_V(8); PG8_WAIT_L(0); PG8_BAR; PG8_MMA(0, 0, At, B0); PG8_MMA(0, 1, At, B1); PG8_BAR; PG8_SCHED;
            PG8_LDA(At, 0, 1); PG8_STAGE(PG8_SB(0, 0), b2, voffB); PG8_STAGE(PG8_SB(0, 1), b2 + hstep, voffB); PG8_STAGE(PG8_SA(0, 0), a2, voffA);
            PG8_WAIT_V(8); PG8_WAIT_L(0); PG8_BAR; PG8_MMA(1, 0, At, B0); PG8_MMA(1, 1, At, B1); PG8_BAR; PG8_SCHED;
            PG8_LDB(B0, 1, 0); PG8_LDB(B1, 1, 1); PG8_SCHED; PG8_LDA(At, 1, 0); PG8_STAGE(PG8_SA(0, 1), a2 + hstep, voffA);
            PG8_WAIT_V(8); PG8_WAIT_L(0); PG8_BAR; PG8_MMA(0, 0, At, B0); PG8_MMA(0, 1, At, B1); PG8_BAR; PG8_SCHED;
            PG8_LDA(At, 1, 1); PG8_STAGE(PG8_SB(1, 0), b3, voffB); PG8_STAGE(PG8_SB(1, 1), b3 + hstep, voffB); PG8_STAGE(PG8_SA(1, 0), a3, voffA);
            PG8_WAIT_V(8); PG8_WAIT_L(0); PG8_BAR; PG8_MMA(1, 0, At, B0); PG8_MMA(1, 1, At, B1); PG8_BAR; PG8_SCHED;
            } else {
            PG8_LDB(B0, 0, 0); PG8_SCHED; PG8_LDA(At, 0, 0); PG8_STAGE(PG8_SA(1, 1), a1 + hstep, voffA);
            PG8_WAIT_L(8); PG8_BAR; PG8_WAIT_L(0); PG8_MMA(0, 0, At, B0); PG8_BAR; PG8_SCHED;
            PG8_LDB(B1, 0, 1); PG8_STAGE(PG8_SB(0, 0), b2, voffB);
            PG8_BAR; PG8_WAIT_L(0); PG8_MMA(0, 1, At, B1); PG8_BAR;
            PG8_LDA(At, 0, 1); PG8_STAGE(PG8_SA(0, 0), a2, voffA);
            PG8_BAR; PG8_WAIT_L(0); PG8_MMA(1, 0, At, B0); PG8_BAR; PG8_SCHED;
            PG8_STAGE(PG8_SB(0, 1), b2 + hstep, voffB);
            PG8_WAIT_V(6); PG8_BAR; PG8_MMA(1, 1, At, B1); PG8_BAR;
            PG8_LDB(B0, 1, 0); PG8_SCHED; PG8_LDA(At, 1, 0); PG8_STAGE(PG8_SA(0, 1), a2 + hstep, voffA);
            PG8_WAIT_L(8); PG8_BAR; PG8_WAIT_L(0); PG8_MMA(0, 0, At, B0); PG8_BAR; PG8_SCHED;
            PG8_LDB(B1, 1, 1); PG8_STAGE(PG8_SB(1, 0), b3, voffB);
            PG8_BAR; PG8_WAIT_L(0); PG8_MMA(0, 1, At, B1); PG8_BAR;
            PG8_LDA(At, 1, 1); PG8_STAGE(PG8_SA(1, 0), a3, voffA);
            PG8_BAR; PG8_WAIT_L(0); PG8_MMA(1, 0, At, B0); PG8_BAR; PG8_SCHED;
            PG8_STAGE(PG8_SB(1, 1), b3 + hstep, voffB);
            PG8_WAIT_V(6); PG8_BAR; PG8_MMA(1, 1, At, B1); PG8_BAR;
            }
        }
        if constexpr (ALIGN_EPI) { if (wr == 0) PG8_BAR; }
        bool keep = false;
        if constexpr (Epi::HAS_MID) keep = E.first_half(cur);
        if constexpr (!Epi::AFTER_DRAIN) { if (keep) E.mid(acc, cur, wr, wc, fr, fq); else E(acc, cur, wr, wc, fr, fq); S.done(cur); }
        if (!has_next) break;
        if (!keep) {
#pragma unroll
        for (int a = 0; a < 2; ++a)
#pragma unroll
            for (int b = 0; b < 2; ++b)
#pragma unroll
                for (int m = 0; m < 4; ++m)
#pragma unroll
                    for (int n = 0; n < 2; ++n) acc[a][b][m][n] = (f32x4){0.f, 0.f, 0.f, 0.f};
        }
        cur = nxt; cA = nA; cB = nB; ++ui;
        if constexpr (ALIGN_EPI) { if (wr == 1) PG8_BAR; }
    }
    PG8_WAIT_V(0);
    if constexpr (!ALIGN_EPI) { if (wr == 0) PG8_BAR; }
    PG8_BAR;
    if constexpr (Epi::AFTER_DRAIN) { E.fused(acc, cur, wr, wc, fr, fq, lds, wid, lane); S.done(cur); }
#undef PG8_SA
#undef PG8_SB
#undef PG8_STAGE
#undef PG8_RS_voffA
#undef PG8_RS_voffB
#undef PG8_LDA
#undef PG8_LDB
#undef PG8_MMA
#undef PG8_WAIT_V
#undef PG8_WAIT_L
#undef PG8_BAR
#undef PG8_SCHED
}
}

#define GAS __attribute__((address_space(1)))
#define LAS __attribute__((address_space(3)))
typedef unsigned short bf16;
typedef float f32x4 __attribute__((ext_vector_type(4)));
typedef short bf16x8 __attribute__((ext_vector_type(8)));
typedef unsigned u32x4 __attribute__((ext_vector_type(4)));
typedef unsigned u32x2 __attribute__((ext_vector_type(2)));
typedef GAS unsigned gu32;

constexpr int NWAVES = 8;
constexpr int D = 1024, SEQ = 8192, NBATCH = 2, NMETA = 16, LTOT = SEQ + NMETA;
constexpr int M = NBATCH * SEQ;
constexpr int MP = M + 256;
constexpr int INW = 4352;
constexpr int NCH = LTOT / 16;
constexpr int NE = 32, TOPK = 4;
constexpr int MAXT = M * TOPK / 256 + NE;
constexpr int NSLOT = MAXT * 256;
constexpr int VP = 8320;
constexpr float RMS_EPS = 1e-5f;

constexpr size_t MiB = 1ull << 20;
constexpr size_t WS_CTL = 0, CTL_ZERO_BYTES = 65536;
constexpr size_t WS_ROT = 1 * MiB;
constexpr size_t WS_TOK = 2 * MiB;
constexpr size_t WS_SSMP = 4 * MiB;
constexpr size_t WS_WIN = 32 * MiB;
constexpr size_t WS_WGLU = 41 * MiB;
constexpr size_t WS_WBR = 43 * MiB;
constexpr size_t WS_WOUT = 47 * MiB;
constexpr size_t WS_WGU = 49 * MiB;
constexpr size_t WS_WDN = 177 * MiB;
constexpr size_t WS_XN = 241 * MiB;
constexpr size_t WS_U = 274 * MiB;
constexpr size_t WS_Q = 307 * MiB;
constexpr size_t WS_K = 339 * MiB;
constexpr size_t WS_VT = 344 * MiB;
constexpr size_t WS_GS = 349 * MiB;
constexpr size_t WS_GA = 381 * MiB;
constexpr size_t WS_Z = 413 * MiB;
constexpr size_t WS_BRA = 445 * MiB;
constexpr size_t WS_MIX = 509 * MiB;
constexpr size_t WS_H1 = 541 * MiB;
constexpr size_t WS_HN2 = 605 * MiB;
constexpr size_t WS_S16 = 637 * MiB;
constexpr size_t WS_XC = 671 * MiB;
constexpr size_t WS_XS = 241 * MiB;
constexpr size_t WS_HID = 385 * MiB;
constexpr size_t WS_YS = 688 * MiB;
constexpr size_t WS_END = 832 * MiB;
static_assert((size_t)NSLOT * 2048 <= 144 * MiB, "slot buffers");
constexpr int CW_TMO = 0, CW_CNT = 1024, CW_BAR = 4096;

constexpr int RING_BYTES = 131072;
constexpr int LDSCTL_OFF = RING_BYTES;
constexpr int LDS_BYTES = 147456;

#define LDS_WAIT() asm volatile("s_waitcnt lgkmcnt(0)" ::: "memory")
#define VM_WAIT() asm volatile("s_waitcnt vmcnt(0)" ::: "memory")
#define RLX_AGENT __ATOMIC_RELAXED, __HIP_MEMORY_SCOPE_AGENT

__device__ __forceinline__ unsigned f2bf(float f) { unsigned u = __builtin_bit_cast(unsigned, f); return (u + 0x7fffu + ((u >> 16) & 1u)) >> 16; }
typedef float f32x2_t __attribute__((ext_vector_type(2))); typedef __bf16 bf16x2_t __attribute__((ext_vector_type(2)));
__device__ __forceinline__ unsigned pk2(float lo, float hi) { f32x2_t v = {lo, hi}; bf16x2_t b = __builtin_convertvector(v, bf16x2_t); return __builtin_bit_cast(unsigned, b); }
__device__ __forceinline__ float bflo(unsigned w) { return __uint_as_float(w << 16); }
__device__ __forceinline__ float bfhi(unsigned w) { return __uint_as_float(w & 0xffff0000u); }
__device__ __forceinline__ float bf2f(bf16 b) { return __uint_as_float((unsigned)b << 16); }
__device__ __forceinline__ float wave_sum(float v) {
#pragma unroll
    for (int o = 1; o < 64; o <<= 1) v += __shfl_xor(v, o);
    return v;
}
__device__ __forceinline__ float wave_max(float v) {
#pragma unroll
    for (int o = 1; o < 64; o <<= 1) v = fmaxf(v, __shfl_xor(v, o));
    return v;
}
__device__ __forceinline__ float sigmoidf_(float x) { return __builtin_amdgcn_rcpf(1.0f + __builtin_amdgcn_exp2f(-1.4426950408889634f * x)); }
__device__ __forceinline__ float gelu_tanh(float x) { const float e = __builtin_amdgcn_exp2f(x * (-2.3022082f + -0.1029432f * (x * x))); return x * __builtin_amdgcn_rcpf(1.0f + e); }
__device__ __forceinline__ void unpack8(u32x4 w, float (&v)[8]) { v[0] = bflo(w.x); v[1] = bfhi(w.x); v[2] = bflo(w.y); v[3] = bfhi(w.y); v[4] = bflo(w.z); v[5] = bfhi(w.z); v[6] = bflo(w.w); v[7] = bfhi(w.w); }
__device__ __forceinline__ u32x4 pack8(const float (&v)[8]) { u32x4 w; w.x = pk2(v[0], v[1]); w.y = pk2(v[2], v[3]); w.z = pk2(v[4], v[5]); w.w = pk2(v[6], v[7]); return w; }

__device__ __forceinline__ unsigned pk4_fp8(float a, float b, float c, float d) { unsigned w = 0u; w = __builtin_amdgcn_cvt_pk_fp8_f32(a, b, w, false); w = __builtin_amdgcn_cvt_pk_fp8_f32(c, d, w, true); return w; }
struct Args { const float* in[26]; float* out; unsigned char* ws; int ph_lo, ph_hi; };
struct Ctx { LAS unsigned char* lds; unsigned char* ws; int tid, lane, wave, G, bid, gw, ngw; };
using pg8::Unit;

template <class E>
__device__ __forceinline__ void naive_gemm_unit(const bf16* __restrict__ A, int lda, const bf16* __restrict__ Bt, int ldb, int K, int pm, int pn, const E& e, int wave, int lane) {
    const int fr = lane & 15, fq = lane >> 4;
    const int row0 = pm * 256 + wave * 32;
#pragma unroll 1
    for (int cg = 0; cg < 4; ++cg) {
        f32x4 acc[2][2][2];
#pragma unroll
        for (int i = 0; i < 2; ++i)
#pragma unroll
            for (int j = 0; j < 2; ++j)
#pragma unroll
                for (int n = 0; n < 2; ++n) acc[i][j][n] = (f32x4){0.f, 0.f, 0.f, 0.f};
#pragma unroll 1
        for (int half = 0; half < (E::HAS_MID ? 2 : 1); ++half) {
            const bf16* ap[2]; const bf16* bp[2][2];
#pragma unroll
            for (int mi = 0; mi < 2; ++mi) ap[mi] = A + (size_t)(half * M + row0 + 16 * mi + fr) * lda + 8 * fq;
#pragma unroll
            for (int bj = 0; bj < 2; ++bj)
#pragma unroll
                for (int n = 0; n < 2; ++n) bp[bj][n] = Bt + (size_t)(half * 1024 + pn * 256 + 128 * bj + 32 * cg + pg8::perm32(16 * n + fr)) * ldb + 8 * fq;
#pragma unroll 1
            for (int k0 = 0; k0 < K; k0 += 32) {
                bf16x8 av[2], bv[2][2];
#pragma unroll
                for (int mi = 0; mi < 2; ++mi) av[mi] = *(const bf16x8*)(ap[mi] + k0);
#pragma unroll
                for (int bj = 0; bj < 2; ++bj)
#pragma unroll
                    for (int n = 0; n < 2; ++n) bv[bj][n] = *(const bf16x8*)(bp[bj][n] + k0);
#pragma unroll
                for (int mi = 0; mi < 2; ++mi)
#pragma unroll
                    for (int bj = 0; bj < 2; ++bj)
#pragma unroll
                        for (int n = 0; n < 2; ++n) acc[mi][bj][n] = __builtin_amdgcn_mfma_f32_16x16x32_bf16(bv[bj][n], av[mi], acc[mi][bj][n], 0, 0, 0);
            }
            if constexpr (E::HAS_MID) {
                if (half == 0) {
#pragma unroll
                    for (int mi = 0; mi < 2; ++mi) e.mid(row0 + 16 * mi + fr, pn * 256 + 32 * cg + 8 * fq, acc[mi][0][0], acc[mi][0][1], acc[mi][1][0], acc[mi][1][1]);
                }
            }
        }
#pragma unroll
        for (int mi = 0; mi < 2; ++mi) e.row8(row0 + 16 * mi + fr, pn * 256 + 32 * cg + 8 * fq, acc[mi][0][0], acc[mi][0][1], acc[mi][1][0], acc[mi][1][1], pm, pn);
    }
}
#ifndef EPI_FENCE
#define EPI_FENCE 0
#endif
template <class E> struct FastEpi {
    static constexpr bool PERM = true, AFTER_DRAIN = false, HAS_MID = E::HAS_MID;
    E e;
    __device__ __forceinline__ void operator()(const f32x4 (&acc)[2][2][4][2], const Unit& u, int wr, int wc, int fr, int fq) const {
#pragma unroll
        for (int ai = 0; ai < 2; ++ai)
#pragma unroll
            for (int m = 0; m < 4; ++m) {
                e.row8(u.pm * 256 + ai * 128 + wr * 64 + m * 16 + fr, u.pn * 256 + wc * 32 + 8 * fq, acc[ai][0][m][0], acc[ai][0][m][1], acc[ai][1][m][0], acc[ai][1][m][1], u.pm, u.pn);
                if constexpr (EPI_FENCE > 0) { if ((m % EPI_FENCE) == EPI_FENCE - 1) asm volatile("" ::: "memory"); } }
    }
    __device__ __forceinline__ bool first_half(const Unit& u) const { if constexpr (E::HAS_MID) return u.pm < M / 256; else return false; }
    __device__ __forceinline__ void mid(f32x4 (&acc)[2][2][4][2], const Unit& u, int wr, int wc, int fr, int fq) const {
        if constexpr (E::HAS_MID) {
#pragma unroll
            for (int ai = 0; ai < 2; ++ai)
#pragma unroll
                for (int m = 0; m < 4; ++m)
                    e.mid(u.pm * 256 + ai * 128 + wr * 64 + m * 16 + fr, u.pn * 256 + wc * 32 + 8 * fq, acc[ai][0][m][0], acc[ai][0][m][1], acc[ai][1][m][0], acc[ai][1][m][1]);
        }
    }
};
struct PairOrder {
    pg8::StaticOrder so;
    __device__ __forceinline__ bool next(int i, Unit& u) const { Unit t; if (!so.next(i >> 1, t)) return false; const int h = i & 1; u.pm = t.pm + h * (M / 256); u.pn = t.pn + h * 4; return true; }
    __device__ __forceinline__ void a_ready(const Unit&) const {}
    __device__ __forceinline__ void done(const Unit&) const {}
};
struct RowMajorOrder {
    int nN, nwg, G, c;
    __device__ __forceinline__ bool next(int i, Unit& u) const { const long L = (long)i * G + c; if (L >= nwg) return false; u.pm = (int)L / nN; u.pn = (int)L % nN; return true; }
    __device__ __forceinline__ void a_ready(const Unit&) const {}
    __device__ __forceinline__ void done(const Unit&) const {}
};
struct InProjOrder {
    pg8::StaticOrder so;
    __device__ __forceinline__ bool next(int i, Unit& u) const { if (!so.next(i, u)) return false; if (u.pn == 15 && u.pm < 5) { u.pn = u.pm < 4 ? u.pm : 8; u.pm = M / 256; } return true; }
    __device__ __forceinline__ void a_ready(const Unit&) const {}
    __device__ __forceinline__ void done(const Unit&) const {}
};
struct DeferredOrder {
    int j;
    __device__ __forceinline__ bool next(int i, Unit& u) const { if (i != 0 || j < 0 || j >= 69) return false; if (j < 64) { u.pm = j; u.pn = 16; } else { u.pm = j - 64; u.pn = 15; } return true; }
    __device__ __forceinline__ void a_ready(const Unit&) const {}
    __device__ __forceinline__ void done(const Unit&) const {}
};
struct MoeOrder {
    const LAS int* tile_e; int ntiles, nct, G, c;
    __device__ __forceinline__ bool next(int i, Unit& u) const {
        if ((G & 7) != 0) { const long L = (long)i * G + c; if (L >= (long)ntiles * nct) return false; u.pm = (int)L / nct; u.pn = __builtin_amdgcn_readfirstlane(tile_e[u.pm]) * nct + (int)L % nct; return true; }
        const int per = G >> 3, x = c & 7, j = c >> 3, rpb = 32 / nct;
        const long slot = (long)i * per + j;
        const long blk = (slot >> 5) * 8 + x; const int w = (int)(slot & 31);
        const long rt = blk * rpb + w / nct;
        if (rt >= ntiles) return false;
        u.pm = (int)rt; u.pn = __builtin_amdgcn_readfirstlane(tile_e[rt]) * nct + w % nct; return true; }
    __device__ __forceinline__ void a_ready(const Unit&) const {}
    __device__ __forceinline__ void done(const Unit&) const {}
};

__device__ __forceinline__ void f4to8(f32x4 a0, f32x4 a1, float (&v)[8]) { v[0] = a0[0]; v[1] = a0[1]; v[2] = a0[2]; v[3] = a0[3]; v[4] = a1[0]; v[5] = a1[1]; v[6] = a1[2]; v[7] = a1[3]; }

struct EpiInProj {
    static constexpr bool HAS_MID = false;
    bf16 *U, *Q, *Kb, *Vt, *GSp, *GAp; const float* rot;
    __device__ __forceinline__ void one(int row, int col, f32x4 v0, f32x4 v1) const {
        const bool meta = row >= M;
        if (meta) { if (row >= M + NMETA) return; if (!(col < 1024 || (col >= 2048 && col < 2304))) return; }
        const int pos = meta ? row - M : NMETA + (row & (SEQ - 1));
        const int b0 = meta ? 0 : (row >> 13), nb = meta ? 2 : 1;
        float v[8]; f4to8(v0, v1, v);
        if (col < 1024) {
            const int g = col >> 4, h0 = col & 15; const u32x4 w = pack8(v);
            for (int bi = 0; bi < nb; ++bi) { const int b = b0 + bi; *(u32x4*)(U + ((size_t)((g * 2 + b) * NCH + (pos >> 4)) * 256 + (pos & 15) * 16 + h0)) = w; }
        } else if (col < 2176) {
            if ((col & 63) < 16) {
                const int i0 = (col & 8) ? 4 : 0; const float* cs = rot + pos * 16;
#pragma unroll
                for (int j = 0; j < 4; ++j) { const float c = cs[i0 + j], s = cs[8 + i0 + j], x1 = v[j], x2 = v[4 + j]; v[j] = x1 * c - x2 * s; v[4 + j] = x2 * c + x1 * s; }
            }
            if (col < 2048) {
#pragma unroll
                for (int j = 0; j < 8; ++j) v[j] *= 0.18033688011112042f;
                *(u32x4*)(Q + (size_t)row * 1024 + (col - 1024)) = pack8(v);
            } else {
                const u32x4 w = pack8(v);
                for (int bi = 0; bi < nb; ++bi) { const int b = b0 + bi; *(u32x4*)(Kb + ((size_t)(b * LTOT + pos)) * 128 + (col - 2048)) = w; }
            }
        } else if (col < 2304) {
            const u32x4 w = pack8(v);
            for (int bi = 0; bi < nb; ++bi) { const int b = b0 + bi; *(u32x4*)(Vt + ((size_t)(b * LTOT + pos)) * 128 + (col - 2176)) = w; }
        } else {
#pragma unroll
            for (int j = 0; j < 8; ++j) v[j] = sigmoidf_(v[j]);
            if (col < 3328) *(u32x4*)(GSp + (size_t)row * 1024 + (col - 2304)) = pack8(v);
            else *(u32x4*)(GAp + (size_t)row * 1024 + (col - 3328)) = pack8(v);
        }
    }
    __device__ __forceinline__ void row8(int row, int col, f32x4 a0, f32x4 a1, f32x4 b0, f32x4 b1, int, int) const { one(row, col, a0, a1); one(row, col + 128, b0, b1); }
};
struct EpiGlu {
    static constexpr bool HAS_MID = false;
    const bf16* Z; const float* bias; bf16* O;
    __device__ __forceinline__ void one(int row, int col, f32x4 v0, f32x4 v1) const {
        float v[8], z[8]; f4to8(v0, v1, v); unpack8(*(const u32x4*)(Z + (size_t)row * 1024 + col), z);
        const f32x4 c0 = *(const f32x4*)(bias + col), c1 = *(const f32x4*)(bias + col + 4); float bb[8]; f4to8(c0, c1, bb);
#pragma unroll
        for (int j = 0; j < 8; ++j) v[j] = z[j] * sigmoidf_(v[j] + bb[j]);
        *(u32x4*)(O + (size_t)row * 1024 + col) = pack8(v);
    }
    __device__ __forceinline__ void row8(int row, int col, f32x4 a0, f32x4 a1, f32x4 b0, f32x4 b1, int, int) const { one(row, col, a0, a1); one(row, col + 128, b0, b1); }
};
struct EpiBr {
    static constexpr bool HAS_MID = true;
    const bf16* GSp; const bf16* GAp; bf16* MIX;
    __device__ __forceinline__ void mid1(int row, int col, f32x4& v0, f32x4& v1) const {
        float gs[8], ga[8]; unpack8(*(const u32x4*)(GSp + (size_t)row * 1024 + col), gs); unpack8(*(const u32x4*)(GAp + (size_t)row * 1024 + col), ga);
#pragma unroll
        for (int j = 0; j < 4; ++j) { v0[j] *= gs[j] * __builtin_amdgcn_rcpf(fmaxf(ga[j], 1e-20f)); v1[j] *= gs[4 + j] * __builtin_amdgcn_rcpf(fmaxf(ga[4 + j], 1e-20f)); }
    }
    __device__ __forceinline__ void mid(int row, int col, f32x4& a0, f32x4& a1, f32x4& b0, f32x4& b1) const { mid1(row, col, a0, a1); mid1(row, col + 128, b0, b1); }
    __device__ __forceinline__ void one(int row, int col, f32x4 v0, f32x4 v1) const {
        float v[8], ga[8]; f4to8(v0, v1, v); unpack8(*(const u32x4*)(GAp + (size_t)row * 1024 + col), ga);
#pragma unroll
        for (int j = 0; j < 8; ++j) v[j] *= ga[j];
        *(u32x4*)(MIX + (size_t)row * 1024 + col) = pack8(v);
    }
    __device__ __forceinline__ void row8(int row, int col, f32x4 a0, f32x4 a1, f32x4 b0, f32x4 b1, int, int) const {
        if (row >= M) { row -= M; col -= 1024; }
        one(row, col, a0, a1); one(row, col + 128, b0, b1); }
};
struct EpiOut {
    static constexpr bool HAS_MID = false;
    const float* X; float* H1;
    __device__ __forceinline__ void one(int row, int col, f32x4 v0, f32x4 v1) const {
        const size_t o = (size_t)row * 1024 + col;
        *(f32x4*)(H1 + o) = *(const f32x4*)(X + o) + v0; *(f32x4*)(H1 + o + 4) = *(const f32x4*)(X + o + 4) + v1;
    }
    __device__ __forceinline__ void row8(int row, int col, f32x4 a0, f32x4 a1, f32x4 b0, f32x4 b1, int, int) const { one(row, col, a0, a1); one(row, col + 128, b0, b1); }
};
struct EpiMoe1 {
    static constexpr bool HAS_MID = false;
    const float* bgu; const float* SR; unsigned char* HID;
    __device__ __forceinline__ void row8(int row, int col, f32x4 a0, f32x4 a1, f32x4 b0, f32x4 b1, int, int pn) const {
        const int e = pn >> 3, ct = pn & 7, j0 = 128 * ct + (col - pn * 256); const float rs = SR[row] * 0.0625f;
        float g[8], up[8], bg[8], bu[8]; f4to8(a0 * rs, a1 * rs, g); f4to8(b0 * rs, b1 * rs, up);
        const float* bp = bgu + (size_t)e * 2048 + j0;
        f4to8(*(const f32x4*)bp, *(const f32x4*)(bp + 4), bg); f4to8(*(const f32x4*)(bp + 1024), *(const f32x4*)(bp + 1028), bu);
#pragma unroll
        for (int j = 0; j < 8; ++j) { const float gg = fminf(g[j] + bg[j], 7.0f), uu = fminf(fmaxf(up[j] + bu[j], -7.0f), 7.0f); g[j] = gg * sigmoidf_(1.702f * gg) * (uu + 1.0f); }
        u32x2 w; w.x = pk4_fp8(g[0], g[1], g[2], g[3]); w.y = pk4_fp8(g[4], g[5], g[6], g[7]); *(u32x2*)(HID + (size_t)row * 1024 + j0) = w;
    }
};
struct EpiMoe2 {
    static constexpr bool HAS_MID = false;
    const float* bd; const float* SG; bf16* YS;
    __device__ __forceinline__ void one(int row, int e, int c0, f32x4 v0, f32x4 v1, float gt) const {
        float v[8], bb[8]; f4to8(v0, v1, v); const float* bp = bd + (size_t)e * 1024 + c0; f4to8(*(const f32x4*)bp, *(const f32x4*)(bp + 4), bb);
#pragma unroll
        for (int j = 0; j < 8; ++j) v[j] = (v[j] * 0.0625f + bb[j]) * gt;
        *(u32x4*)(YS + (size_t)row * 1024 + c0) = pack8(v);
    }
    __device__ __forceinline__ void row8(int row, int col, f32x4 a0, f32x4 a1, f32x4 b0, f32x4 b1, int, int pn) const {
        const int e = pn >> 2, ct = pn & 3, c0 = 256 * ct + (col - pn * 256); const float gt = SG[row];
        one(row, e, c0, a0, a1, gt); one(row, e, c0 + 128, b0, b1, gt);
    }
};
#define XB_TMO      128
#define XB_XCNT(j)  (256  + 64 * (j))
#define XB_XSUB(j)  (1280 + 64 * (j))
#define XB_XGEN(j)  (2304 + 64 * (j))
#define XB_TOP      3328
#define XB_TOPGEN   3392
#define XCD_BAR_WORDS 3456
#define XB_SPIN_CAP (1u << 18)

__device__ __forceinline__ unsigned xb_ld(unsigned* p)              { return __hip_atomic_load(p, __ATOMIC_RELAXED, __HIP_MEMORY_SCOPE_AGENT); }
__device__ __forceinline__ unsigned xb_add(unsigned* p, unsigned v) { return __hip_atomic_fetch_add(p, v, __ATOMIC_RELAXED, __HIP_MEMORY_SCOPE_AGENT); }
__device__ __forceinline__ unsigned xb_xcc_id() { return (unsigned)__builtin_amdgcn_s_getreg((3 << 11) | 20) & 0xFu; }
#define XB_SPIN(cond, bar) do { unsigned _sp = 0; while (cond) { __builtin_amdgcn_s_sleep(1); \
    if ((++_sp & 255u) == 0u) { if (xb_ld(&(bar)[XB_TMO])) break; if (_sp > XB_SPIN_CAP) { atomicAdd(&(bar)[XB_TMO], 1u); break; } } } } while (0)

struct XcdBarrier {
    unsigned* bar; unsigned x;
    volatile LAS unsigned* st;
};

__device__ __forceinline__ XcdBarrier xcd_barrier_post(unsigned* bar, volatile LAS unsigned* st) {
    XcdBarrier b; b.bar = bar; b.x = xb_xcc_id(); b.st = st;
    if (threadIdx.x == 0) (void)xb_add(&bar[XB_XCNT(b.x)], 1u);
    return b;
}
__device__ __forceinline__ void xcd_barrier_complete(unsigned* bar, unsigned x, unsigned& nloc, unsigned& nx) {
    const unsigned G = gridDim.x * gridDim.y * gridDim.z;
    unsigned sum, cnt, mine, sp = 0u;
    for (;;) {
        sum = 0u; cnt = 0u; mine = 0u;
#pragma unroll
        for (unsigned j = 0; j < 16; ++j) { const unsigned c = xb_ld(&bar[XB_XCNT(j)]); sum += c; cnt += (c > 0u) ? 1u : 0u; mine = (j == x) ? c : mine; }
        if (sum == G) break;
        __builtin_amdgcn_s_sleep(1);
        if ((++sp & 255u) == 0u) { if (xb_ld(&bar[XB_TMO])) break; if (sp > XB_SPIN_CAP) { atomicAdd(&bar[XB_TMO], 1u); break; } }
    }
    nloc = mine > 0u ? mine : 1u; nx = cnt > 0u ? cnt : 1u;
}

__device__ __forceinline__ void xcd_barrier(const XcdBarrier& b, const bool thread0) {
    asm volatile("s_waitcnt vmcnt(0)" ::: "memory");
    __syncthreads();
    if (thread0) {
        unsigned* bar = b.bar;
        __builtin_amdgcn_s_waitcnt(0);
        unsigned nloc = b.st[0], nx = b.st[1];
        if (nloc == 0u) { xcd_barrier_complete(bar, b.x, nloc, nx); b.st[0] = nloc; b.st[1] = nx; }
        const unsigned old = xb_add(&bar[XB_XSUB(b.x)], 1u);
        const unsigned gen = old / nloc;
        if (old + 1u == (gen + 1u) * nloc) {
            __builtin_amdgcn_fence(__ATOMIC_RELEASE, "agent");
            asm volatile("s_waitcnt vmcnt(0)" ::: "memory");
            const unsigned og = xb_add(&bar[XB_TOP], 1u);
            const unsigned tg = og / nx;
            if (og + 1u == (tg + 1u) * nx) xb_add(&bar[XB_TOPGEN], 1u);
            else XB_SPIN(xb_ld(&bar[XB_TOPGEN]) == tg, bar);
            __builtin_amdgcn_fence(__ATOMIC_ACQUIRE, "agent");
            xb_add(&bar[XB_XGEN(b.x)], 1u);
            asm volatile("s_waitcnt vmcnt(0)" ::: "memory");
        } else {
            XB_SPIN(xb_ld(&bar[XB_XGEN(b.x)]) == gen, bar);
            __builtin_amdgcn_fence(__ATOMIC_ACQUIRE, "agent");
            asm volatile("s_waitcnt vmcnt(0)" ::: "memory");
        }
    }
    __syncthreads();
}

constexpr size_t SSM_A16 = 1 * MiB, SSM_TF = 2 * MiB, SSM_VF = 4 * MiB, SSM_WF = 8 * MiB;
constexpr int NCI = 2 * NCH;
constexpr int NCB = (NCI + 15) / 16;
constexpr int CW_Q = 2048;

__device__ __forceinline__ void p0_ssm_prep(const Args& a, const Ctx& c, int g) {
    LAS float* AP = (LAS float*)(c.lds);
    LAS float* BBl = AP + 64 * 17 * 2;
    LAS float* Cc = BBl + 64 * 16 * 2;
    LAS float* Kt = Cc + 16 * 64 * 2;
    unsigned char* sp = c.ws + WS_SSMP;
    const int tid = c.tid;
    if (tid < 64) { const int p = tid, i = g * 64 + p;
        const float lr = a.in[4][i], li = a.in[5][i], dt = expf(a.in[6][g]);
        for (int tau = 0; tau <= 16; ++tau) { const float mag = expf((float)tau * dt * lr), ang = (float)tau * dt * li; AP[(p * 17 + tau) * 2] = mag * cosf(ang); AP[(p * 17 + tau) * 2 + 1] = mag * sinf(ang); }
        const float mag = expf(dt * lr), ar = mag * cosf(dt * li), ai = mag * sinf(dt * li);
        const float den = lr * lr + li * li, nr = ar - 1.0f, ni = ai, fr_ = (nr * lr + ni * li) / den, fi_ = (ni * lr - nr * li) / den;
        for (int h = 0; h < 16; ++h) { const float br = a.in[7][i * 16 + h], bi = a.in[8][i * 16 + h]; BBl[(p * 16 + h) * 2] = fr_ * br - fi_ * bi; BBl[(p * 16 + h) * 2 + 1] = fr_ * bi + fi_ * br; }
        float* A16 = (float*)(sp + SSM_A16); const float m16 = expf(16.0f * dt * lr), a16 = 16.0f * dt * li; A16[i * 2] = m16 * cosf(a16); A16[i * 2 + 1] = m16 * sinf(a16);
    }
    for (int idx = tid; idx < 1024; idx += NWAVES * 64) { const int h = idx >> 6, p = idx & 63; Cc[idx * 2] = a.in[9][(g * 16 + h) * 64 + p]; Cc[idx * 2 + 1] = a.in[10][(g * 16 + h) * 64 + p]; }
    __syncthreads();
    for (int idx = tid; idx < 4096; idx += NWAVES * 64) { const int tau = idx >> 8, h = (idx >> 4) & 15, hp = idx & 15; float s = 0.f;
        for (int p = 0; p < 64; ++p) { const float ar = AP[(p * 17 + tau) * 2], ai = AP[(p * 17 + tau) * 2 + 1], br = BBl[(p * 16 + hp) * 2], bi = BBl[(p * 16 + hp) * 2 + 1];
            const float gr = ar * br - ai * bi, gi = ar * bi + ai * br; s += Cc[(h * 64 + p) * 2] * gr - Cc[(h * 64 + p) * 2 + 1] * gi; }
        if (tau == 0 && h == hp) s += a.in[11][g * 16 + h];
        Kt[idx] = s; }
    __syncthreads();
    bf16* TF = (bf16*)(sp + SSM_TF); bf16* VF = (bf16*)(sp + SSM_VF); bf16* WF = (bf16*)(sp + SSM_WF);
    for (int idx = tid; idx < 1024; idx += NWAVES * 64) { const int dl = idx >> 6, ln = idx & 63, fr = ln & 15, fq = ln >> 4; float v[8];
#pragma unroll
        for (int e = 0; e < 8; ++e) { const int j = 8 * fq + e, tau = dl - (j >> 4), hp = j & 15; v[e] = tau >= 0 ? Kt[(tau * 16 + fr) * 16 + hp] : 0.f; }
        *(u32x4*)(TF + ((size_t)(g * 16 + dl) * 64 + ln) * 8) = pack8(v); }
    for (int idx = tid; idx < 4096; idx += NWAVES * 64) { const int t = idx >> 8, kx = (idx >> 6) & 3, ln = idx & 63, fr = ln & 15, fq = ln >> 4; float v[8];
#pragma unroll
        for (int e = 0; e < 8; ++e) { const int pp = 32 * kx + 8 * fq + e, p = pp & 63; const float cr = Cc[(fr * 64 + p) * 2], ci = Cc[(fr * 64 + p) * 2 + 1], ar = AP[(p * 17 + t + 1) * 2], ai = AP[(p * 17 + t + 1) * 2 + 1];
            v[e] = pp < 64 ? (cr * ar - ci * ai) : -(cr * ai + ci * ar); }
        *(u32x4*)(VF + ((size_t)((g * 16 + t) * 4 + kx) * 64 + ln) * 8) = pack8(v); }
    for (int idx = tid; idx < 4096; idx += NWAVES * 64) { const int pb = idx >> 9, ks = (idx >> 6) & 7, ln = idx & 63, fr = ln & 15, fq = ln >> 4, pp = 16 * pb + fr, p = pp & 63; float v[8];
#pragma unroll
        for (int e = 0; e < 8; ++e) { const int k = 32 * ks + 8 * fq + e, s = k >> 4, h = k & 15; const float ar = AP[(p * 17 + 15 - s) * 2], ai = AP[(p * 17 + 15 - s) * 2 + 1], br = BBl[(p * 16 + h) * 2], bi = BBl[(p * 16 + h) * 2 + 1];
            v[e] = pp < 64 ? (ar * br - ai * bi) : (ar * bi + ai * br); }
        *(u32x4*)(WF + ((size_t)((g * 8 + pb) * 8 + ks) * 64 + ln) * 8) = pack8(v); }
    __syncthreads();
}
__device__ __forceinline__ void ssm_phase_a(const Ctx& c) {
    const bf16* U = (const bf16*)(c.ws + WS_U); const bf16* WF = (const bf16*)(c.ws + WS_SSMP + SSM_WF); float* S16 = (float*)(c.ws + WS_S16);
    const int fr = c.lane & 15, fq = c.lane >> 4;
    for (int it = c.gw; it < 64 * NCB; it += c.ngw) {
        const int g = it / NCB, cb = it % NCB, cidx = 16 * cb + fr, cl = cidx < NCI ? cidx : NCI - 1;
        bf16x8 uf[8];
#pragma unroll
        for (int ks = 0; ks < 8; ++ks) uf[ks] = *(const bf16x8*)(U + ((size_t)(g * NCI + cl)) * 256 + 32 * ks + 8 * fq);
#pragma unroll 2
        for (int pb = 0; pb < 8; ++pb) { f32x4 acc = {0.f, 0.f, 0.f, 0.f};
#pragma unroll
            for (int ks = 0; ks < 8; ++ks) { const bf16x8 wf = *(const bf16x8*)(WF + ((size_t)((g * 8 + pb) * 8 + ks) * 64 + c.lane) * 8); acc = __builtin_amdgcn_mfma_f32_16x16x32_bf16(wf, uf[ks], acc, 0, 0, 0); }
            if (cidx < NCI) *(f32x4*)(S16 + ((size_t)(g * NCI + cidx)) * 128 + 16 * pb + 4 * fq) = acc; }
    }
}
__device__ __forceinline__ void ssm_carry(const Ctx& c) {
    LAS float* E = (LAS float*)(c.lds + LDSCTL_OFF + 4096);
    for (int it = c.bid; it < 128; it += c.G) {
        const int g = it >> 1, b = it & 1, p = c.lane, seg = c.wave, c0 = 64 * seg;
        const float* A16 = (const float*)(c.ws + WS_SSMP + SSM_A16); const float ar = A16[(g * 64 + p) * 2], ai = A16[(g * 64 + p) * 2 + 1];
        const float* sp = (const float*)(c.ws + WS_S16) + ((size_t)(g * NCI + b * NCH + c0)) * 128; bf16* xp = (bf16*)(c.ws + WS_XC) + ((size_t)(g * NCI + b * NCH + c0)) * 128;
        float lr[64], li[64];
#pragma unroll
        for (int j = 0; j < 64; ++j) { lr[j] = sp[j * 128 + p]; li[j] = sp[j * 128 + 64 + p]; }
        float xr = 0.f, xi = 0.f;
#pragma unroll
        for (int j = 0; j < 64; ++j) { const float tr = ar * xr - ai * xi + lr[j], ti = ar * xi + ai * xr + li[j]; xr = tr; xi = ti; lr[j] = xr; li[j] = xi; }
        __syncthreads();
        E[(seg * 64 + p) * 2] = xr; E[(seg * 64 + p) * 2 + 1] = xi;
        float a64r = ar, a64i = ai;
#pragma unroll
        for (int k = 0; k < 6; ++k) { const float tr = a64r * a64r - a64i * a64i, ti = 2.0f * a64r * a64i; a64r = tr; a64i = ti; }
        __syncthreads();
        float cr = 0.f, ci = 0.f;
        for (int s2 = 0; s2 < seg; ++s2) { const float er = E[(s2 * 64 + p) * 2], ei = E[(s2 * 64 + p) * 2 + 1]; const float tr = a64r * cr - a64i * ci + er, ti = a64r * ci + a64i * cr + ei; cr = tr; ci = ti; }
        float pr = ar, pi = ai; bf16* xq = xp + 128 + p;
#pragma unroll
        for (int j = 0; j < 64; ++j) { const float vr = lr[j] + pr * cr - pi * ci, vi = li[j] + pr * ci + pi * cr;
            xq[0] = (bf16)f2bf(vr); xq[64] = (bf16)f2bf(vi); xq += 128; asm volatile("" : "+v"(xq));
            const float tr = pr * ar - pi * ai, ti = pr * ai + pi * ar; pr = tr; pi = ti; }
    }
}
__device__ __forceinline__ void ssm_phase_c(const Ctx& c) {
    const bf16* U = (const bf16*)(c.ws + WS_U); const bf16* XC = (const bf16*)(c.ws + WS_XC); bf16* Z = (bf16*)(c.ws + WS_Z);
    const bf16* TF = (const bf16*)(c.ws + WS_SSMP + SSM_TF); const bf16* VF = (const bf16*)(c.ws + WS_SSMP + SSM_VF);
    const int fr = c.lane & 15, fq = c.lane >> 4;
    for (int it = c.bid; it < 256; it += c.G) {
        const int g = it >> 2, q = it & 3;
        __syncthreads();
        for (int idx = c.tid; idx < 4096; idx += NWAVES * 64) *(LAS u32x4*)(c.lds + idx * 16) = *(const u32x4*)(VF + (size_t)g * 32768 + idx * 8);
        bf16x8 tf[16];
#pragma unroll
        for (int dl = 0; dl < 16; ++dl) tf[dl] = *(const bf16x8*)(TF + ((size_t)(g * 16 + dl) * 64 + c.lane) * 8);
        __syncthreads();
        for (int cb = q + 4 * c.wave; cb < NCB; cb += 32) {
            const int cidx = 16 * cb + fr, cl = cidx < NCI ? cidx : NCI - 1;
            bf16x8 uf[8], xf[4];
#pragma unroll
            for (int ks = 0; ks < 8; ++ks) uf[ks] = *(const bf16x8*)(U + ((size_t)(g * NCI + cl)) * 256 + 32 * ks + 8 * fq);
#pragma unroll
            for (int kx = 0; kx < 4; ++kx) xf[kx] = *(const bf16x8*)(XC + ((size_t)(g * NCI + cl)) * 128 + 32 * kx + 8 * fq);
            const int b = cidx >= NCH ? 1 : 0, cc = cidx - b * NCH; const bool ok = cidx < NCI && cc >= 1;
            bf16* zp = Z + (size_t)(b * SEQ + 16 * (cc - 1)) * 1024 + g * 16 + 4 * fq;
#pragma unroll
            for (int t = 0; t < 16; ++t) { f32x4 acc = {0.f, 0.f, 0.f, 0.f};
#pragma unroll
                for (int ks = 0; ks <= t / 2; ++ks) acc = __builtin_amdgcn_mfma_f32_16x16x32_bf16(tf[t - 2 * ks], uf[ks], acc, 0, 0, 0);
#pragma unroll
                for (int kx = 0; kx < 4; ++kx) { const bf16x8 vf = *(const LAS bf16x8*)(c.lds + ((t * 4 + kx) * 64 + c.lane) * 16); acc = __builtin_amdgcn_mfma_f32_16x16x32_bf16(vf, xf[kx], acc, 0, 0, 0); }
                if (ok) { u32x2 w; w.x = pk2(gelu_tanh(acc[0]), gelu_tanh(acc[1])); w.y = pk2(gelu_tanh(acc[2]), gelu_tanh(acc[3])); *(u32x2*)(zp + (size_t)t * 1024) = w; }
                asm volatile("" ::: "memory"); }
        }
    }
}

__device__ __forceinline__ float ld_sc1_f32(const float* p) { return __uint_as_float(__hip_atomic_load((const unsigned*)p, RLX_AGENT)); }
__device__ __forceinline__ void ssm_chain(const Ctx& c, int g, int b) {
    const int fr = c.lane & 15, fq = c.lane >> 4, w = c.wave, p = c.lane;
    const bf16* Ub = (const bf16*)(c.ws + WS_U) + ((size_t)(g * NCI + b * NCH)) * 256;
    float* Sb = (float*)(c.ws + WS_S16) + ((size_t)(g * NCI + b * NCH)) * 128;
    bf16* Xb = (bf16*)(c.ws + WS_XC) + ((size_t)(g * NCI + b * NCH)) * 128;
    bf16* Z = (bf16*)(c.ws + WS_Z);
    const bf16* TF = (const bf16*)(c.ws + WS_SSMP + SSM_TF); const bf16* VF = (const bf16*)(c.ws + WS_SSMP + SSM_VF); const bf16* WF = (const bf16*)(c.ws + WS_SSMP + SSM_WF);
    LAS float* E = (LAS float*)(c.lds + LDSCTL_OFF + 4096);
    __syncthreads();
    for (int idx = c.tid; idx < 4096; idx += NWAVES * 64) { *(LAS u32x4*)(c.lds + idx * 16) = *(const u32x4*)(VF + (size_t)g * 32768 + idx * 8); *(LAS u32x4*)(c.lds + 65536 + idx * 16) = *(const u32x4*)(WF + (size_t)g * 32768 + idx * 8); }
    {
        __syncthreads();
#pragma unroll 1
        for (int h2 = 0; h2 < 2; ++h2) {
            bf16x8 uf[2][8];
#pragma unroll
            for (int i = 0; i < 2; ++i)
#pragma unroll
                for (int ks = 0; ks < 8; ++ks) uf[i][ks] = *(const bf16x8*)(Ub + (size_t)(16 * (w + 8 * (2 * h2 + i)) + fr) * 256 + 32 * ks + 8 * fq);
#pragma unroll
            for (int i = 0; i < 2; ++i) {
#pragma unroll 2
                for (int pb = 0; pb < 8; ++pb) { f32x4 acc = {0.f, 0.f, 0.f, 0.f};
#pragma unroll
                    for (int ks = 0; ks < 8; ++ks) acc = __builtin_amdgcn_mfma_f32_16x16x32_bf16(*(const LAS bf16x8*)(c.lds + 65536 + ((pb * 8 + ks) * 64 + c.lane) * 16), uf[i][ks], acc, 0, 0, 0);
                    *(f32x4*)(Sb + (size_t)(16 * (w + 8 * (2 * h2 + i)) + fr) * 128 + 16 * pb + 4 * fq) = acc; }
            }
        }
    }
    VM_WAIT(); __syncthreads();
    {
        const float* A16 = (const float*)(c.ws + WS_SSMP + SSM_A16); const float ar = A16[(g * 64 + p) * 2], ai = A16[(g * 64 + p) * 2 + 1];
        const float* sp = Sb + (size_t)(64 * w) * 128;
        float xr = 0.f, xi = 0.f;
#pragma unroll 1
        for (int h2 = 0; h2 < 2; ++h2) { float lr[32], li[32];
#pragma unroll
            for (int j = 0; j < 32; ++j) { lr[j] = ld_sc1_f32(sp + (32 * h2 + j) * 128 + p); li[j] = ld_sc1_f32(sp + (32 * h2 + j) * 128 + 64 + p); }
#pragma unroll
            for (int j = 0; j < 32; ++j) { const float tr = ar * xr - ai * xi + lr[j], ti = ar * xi + ai * xr + li[j]; xr = tr; xi = ti; } }
        E[(w * 64 + p) * 2] = xr; E[(w * 64 + p) * 2 + 1] = xi;
        float a64r = ar, a64i = ai;
#pragma unroll
        for (int k = 0; k < 6; ++k) { const float tr = a64r * a64r - a64i * a64i, ti = 2.0f * a64r * a64i; a64r = tr; a64i = ti; }
        __syncthreads();
        xr = 0.f; xi = 0.f;
        for (int s2 = 0; s2 < w; ++s2) { const float er = E[(s2 * 64 + p) * 2], ei = E[(s2 * 64 + p) * 2 + 1]; const float tr = a64r * xr - a64i * xi + er, ti = a64r * xi + a64i * xr + ei; xr = tr; xi = ti; }
        bf16* xq = Xb + (size_t)(64 * w + 1) * 128 + p;
#pragma unroll 1
        for (int h2 = 0; h2 < 2; ++h2) { float lr[32], li[32];
#pragma unroll
            for (int j = 0; j < 32; ++j) { lr[j] = ld_sc1_f32(sp + (32 * h2 + j) * 128 + p); li[j] = ld_sc1_f32(sp + (32 * h2 + j) * 128 + 64 + p); }
#pragma unroll
            for (int j = 0; j < 32; ++j) { const float tr = ar * xr - ai * xi + lr[j], ti = ar * xi + ai * xr + li[j]; xr = tr; xi = ti;
                xq[0] = (bf16)f2bf(xr); xq[64] = (bf16)f2bf(xi); xq += 128; asm volatile("" : "+v"(xq)); } }
    }
    VM_WAIT(); __syncthreads();
    {
        bf16x8 tf[16];
#pragma unroll
        for (int dl = 0; dl < 16; ++dl) tf[dl] = *(const bf16x8*)(TF + ((size_t)(g * 16 + dl) * 64 + c.lane) * 8);
        bf16x8 uf[8], xf[4], un[8], xn[4];
        { const int cl = 16 * w + fr;
#pragma unroll
            for (int ks = 0; ks < 8; ++ks) uf[ks] = *(const bf16x8*)(Ub + (size_t)cl * 256 + 32 * ks + 8 * fq);
#pragma unroll
            for (int kx = 0; kx < 4; ++kx) xf[kx] = *(const bf16x8*)(Xb + (size_t)cl * 128 + 32 * kx + 8 * fq); }
#pragma unroll 1
        for (int cb = w; cb < 33; cb += 8) {
            const int ci_ = 16 * cb + fr;
            if (cb + 8 < 33) { const int cn = 16 * (cb + 8) + fr, cl = cn < NCH ? cn : NCH - 1;
#pragma unroll
                for (int ks = 0; ks < 8; ++ks) un[ks] = *(const bf16x8*)(Ub + (size_t)cl * 256 + 32 * ks + 8 * fq);
#pragma unroll
                for (int kx = 0; kx < 4; ++kx) xn[kx] = *(const bf16x8*)(Xb + (size_t)cl * 128 + 32 * kx + 8 * fq); }
            const bool ok = ci_ >= 1 && ci_ < NCH;
            bf16* zp = Z + (size_t)(b * SEQ + 16 * (ci_ - 1)) * 1024 + g * 16 + 4 * fq;
#pragma unroll
            for (int t = 0; t < 16; ++t) { f32x4 acc = {0.f, 0.f, 0.f, 0.f};
#pragma unroll
                for (int ks = 0; ks <= t / 2; ++ks) acc = __builtin_amdgcn_mfma_f32_16x16x32_bf16(tf[t - 2 * ks], uf[ks], acc, 0, 0, 0);
#pragma unroll
                for (int kx = 0; kx < 4; ++kx) { const bf16x8 vf = *(const LAS bf16x8*)(c.lds + ((t * 4 + kx) * 64 + c.lane) * 16); acc = __builtin_amdgcn_mfma_f32_16x16x32_bf16(vf, xf[kx], acc, 0, 0, 0); }
                if (ok) { u32x2 wv; wv.x = pk2(gelu_tanh(acc[0]), gelu_tanh(acc[1])); wv.y = pk2(gelu_tanh(acc[2]), gelu_tanh(acc[3])); *(u32x2*)(zp + (size_t)t * 1024) = wv; }
                asm volatile("" ::: "memory"); }
#pragma unroll
            for (int ks = 0; ks < 8; ++ks) uf[ks] = un[ks];
#pragma unroll
            for (int kx = 0; kx < 4; ++kx) xf[kx] = xn[kx];
        }
    }
}

__device__ __forceinline__ void attn_fast(const Args& a, const Ctx& c) {
    const bf16* Q = (const bf16*)(c.ws + WS_Q); const bf16* Kb = (const bf16*)(c.ws + WS_K); const bf16* Vt = (const bf16*)(c.ws + WS_VT); bf16* AO = (bf16*)(c.ws + WS_BRA) + (size_t)M * 1024;
    unsigned* qctr = (unsigned*)(c.ws + WS_CTL) + CW_Q;
    LAS unsigned char* Ks = c.lds; LAS unsigned char* Vs = c.lds + 30720; volatile LAS int* uslot = (volatile LAS int*)(c.lds + LDSCTL_OFF + 64);
    constexpr int KST = 144, VST = 432;
    const int fr = c.lane & 15, fq = c.lane >> 4;
    volatile LAS int* ncall = (volatile LAS int*)(c.lds + LDSCTL_OFF + 68);
    __syncthreads(); if (c.tid == 0) *ncall = *ncall + 1; __syncthreads();
    const int qbase = (*ncall - 1) * (512 + c.G);
    int nxt = 0; if (c.tid == 0) nxt = (int)__hip_atomic_fetch_add(qctr, 1u, RLX_AGENT) - qbase;
    for (;;) {
        __syncthreads();
        if (c.tid == 0) *uslot = nxt;
        __syncthreads();
        const int unit = *uslot; if (unit >= 512) break;
        if (c.tid == 0) nxt = (int)__hip_atomic_fetch_add(qctr, 1u, RLX_AGENT) - qbase;
        const int b = unit >> 8, kvh = (unit >> 7) & 1, t0 = 64 * (unit & 127);
        const int head = kvh * 8 + c.wave;
        const bf16* qp = Q + (size_t)(b * SEQ + t0 + fr) * 1024 + head * 64 + 8 * fq;
        bf16x8 qc[2]; qc[0] = *(const bf16x8*)qp; qc[1] = *(const bf16x8*)(qp + 32);
        for (int idx = c.tid; idx < 1664; idx += NWAVES * 64) { const int row = idx >> 3, pc = idx & 7; int pos; bool ok = true;
            if (row < 192) { const int tok = t0 - 128 + row; ok = tok >= 0; pos = NMETA + tok; } else pos = row - 192;
            u32x4 v = {0u, 0u, 0u, 0u}; if (ok) v = *(const u32x4*)(Kb + ((size_t)(b * LTOT + pos)) * 128 + kvh * 64 + pc * 8);
            *(LAS u32x4*)(Ks + row * KST + pc * 16) = v; }
        for (int idx = c.tid; idx < 1664; idx += NWAVES * 64) { const int row = idx >> 3, pc = idx & 7; int pos; bool ok = true;
            if (row < 192) { const int tok = t0 - 128 + row; ok = tok >= 0; pos = NMETA + tok; } else pos = row - 192;
            u32x4 v = {0u, 0u, 0u, 0u}; if (ok) v = *(const u32x4*)(Vt + ((size_t)(b * LTOT + pos)) * 128 + kvh * 64 + pc * 8);
            LAS bf16* vd = (LAS bf16*)(Vs + (8 * pc) * VST + row * 2);
            vd[0 * (VST / 2)] = (bf16)(v.x & 0xffffu); vd[1 * (VST / 2)] = (bf16)(v.x >> 16); vd[2 * (VST / 2)] = (bf16)(v.y & 0xffffu); vd[3 * (VST / 2)] = (bf16)(v.y >> 16);
            vd[4 * (VST / 2)] = (bf16)(v.z & 0xffffu); vd[5 * (VST / 2)] = (bf16)(v.z >> 16); vd[6 * (VST / 2)] = (bf16)(v.w & 0xffffu); vd[7 * (VST / 2)] = (bf16)(v.w >> 16); }
        __syncthreads();
        const float sink = a.in[14][head] * 1.4426950408889634f;
#pragma unroll 1
        for (int qa = 0; qa < 4; ++qa) {
            const int r = b * SEQ + t0 + 16 * qa + fr;
            bf16x8 qf[2]; qf[0] = qc[0]; qf[1] = qc[1];
            if (qa < 3) { qc[0] = *(const bf16x8*)(qp + (size_t)(16 * (qa + 1)) * 1024); qc[1] = *(const bf16x8*)(qp + (size_t)(16 * (qa + 1)) * 1024 + 32); }
            f32x4 s[10];
#pragma unroll
            for (int jb = 0; jb < 10; ++jb) { const int j = jb < 9 ? qa + jb : 12; f32x4 acc = {0.f, 0.f, 0.f, 0.f};
#pragma unroll
                for (int ks = 0; ks < 2; ++ks) { const bf16x8 kf = *(const LAS bf16x8*)(Ks + (16 * j + fr) * KST + (32 * ks + 8 * fq) * 2); acc = __builtin_amdgcn_mfma_f32_16x16x32_bf16(kf, qf[ks], acc, 0, 0, 0); }
                s[jb] = acc; }
#pragma unroll
            for (int i = 0; i < 4; ++i) { if (4 * fq + i - fr < 1) s[0][i] = -1e30f; if (4 * fq + i - fr > 0) s[8][i] = -1e30f; }
            if (t0 < 128) {
#pragma unroll
                for (int jb = 0; jb < 9; ++jb)
#pragma unroll
                    for (int i = 0; i < 4; ++i) if (t0 - 128 + 16 * (qa + jb) + 4 * fq + i < 0) s[jb][i] = -1e30f; }
            float mx = sink;
#pragma unroll
            for (int jb = 0; jb < 10; ++jb) mx = fmaxf(fmaxf(mx, fmaxf(s[jb][0], s[jb][1])), fmaxf(s[jb][2], s[jb][3]));
            mx = fmaxf(mx, __shfl_xor(mx, 16)); mx = fmaxf(mx, __shfl_xor(mx, 32));
            float l = 0.f;
#pragma unroll
            for (int jb = 0; jb < 10; ++jb)
#pragma unroll
                for (int i = 0; i < 4; ++i) { s[jb][i] = __builtin_amdgcn_exp2f(s[jb][i] - mx); l += s[jb][i]; }
            l += __shfl_xor(l, 16); l += __shfl_xor(l, 32); l += __builtin_amdgcn_exp2f(sink - mx);
            f32x4 o[4];
#pragma unroll
            for (int db = 0; db < 4; ++db) o[db] = (f32x4){0.f, 0.f, 0.f, 0.f};
#pragma unroll
            for (int pr = 0; pr < 5; ++pr) { const int ja = qa + 2 * pr, jbk = pr < 4 ? qa + 2 * pr + 1 : 12;
                u32x4 pw; pw.x = pk2(s[2 * pr][0], s[2 * pr][1]); pw.y = pk2(s[2 * pr][2], s[2 * pr][3]); pw.z = pk2(s[2 * pr + 1][0], s[2 * pr + 1][1]); pw.w = pk2(s[2 * pr + 1][2], s[2 * pr + 1][3]);
                const bf16x8 pf = __builtin_bit_cast(bf16x8, pw);
#pragma unroll
                for (int db = 0; db < 4; ++db) { const u32x2 lo = *(const LAS u32x2*)(Vs + (16 * db + fr) * VST + (16 * ja + 4 * fq) * 2), hi = *(const LAS u32x2*)(Vs + (16 * db + fr) * VST + (16 * jbk + 4 * fq) * 2);
                    u32x4 vw; vw.x = lo.x; vw.y = lo.y; vw.z = hi.x; vw.w = hi.y; o[db] = __builtin_amdgcn_mfma_f32_16x16x32_bf16(__builtin_bit_cast(bf16x8, vw), pf, o[db], 0, 0, 0); } }
            const float inv = 1.0f / l;
#pragma unroll
            for (int db = 0; db < 4; ++db) { u32x2 w; w.x = pk2(o[db][0] * inv, o[db][1] * inv); w.y = pk2(o[db][2] * inv, o[db][3] * inv); *(u32x2*)(AO + (size_t)r * 1024 + head * 64 + 16 * db + 4 * fq) = w; }
        }
    }
}

constexpr size_t SSM_WRF = 16 * MiB;
__device__ __forceinline__ void p0_router_frags(const Args& a, const Ctx& c) {
    bf16* WRF = (bf16*)(c.ws + WS_SSMP + SSM_WRF); const float* wr = a.in[19];
    const int gt = c.bid * (NWAVES * 64) + c.tid, ngt = c.G * NWAVES * 64;
    for (int idx = gt; idx < 4096; idx += ngt) { const int ks = idx >> 7, eb = (idx >> 6) & 1, ln = idx & 63, fr = ln & 15, fq = ln >> 4; float hi[8], lo[8];
#pragma unroll
        for (int e = 0; e < 8; ++e) { const float w = wr[(size_t)(32 * ks + 8 * fq + e) * 32 + 16 * eb + fr]; const float h = bf2f((bf16)f2bf(w)); hi[e] = h; lo[e] = w - h; }
        *(u32x4*)(WRF + (size_t)idx * 8) = pack8(hi); *(u32x4*)(WRF + 32768 + (size_t)idx * 8) = pack8(lo); }
}

__device__ __forceinline__ int swap23(int p) { return (p & 3) | ((p & 4) << 1) | ((p & 8) >> 1); }
__device__ __forceinline__ void tr_item(const float* __restrict__ W, int ldw, int k0, int n0src, bool perm, bf16* WT, int ldt, int rowdst0, int kdst, LAS float* scr, int lane) {
    float tv[32];
#pragma unroll
    for (int i = 0; i < 32; ++i) tv[i] = W[(size_t)(k0 + 2 * i + (lane >> 5)) * ldw + n0src + (lane & 31)];
#pragma unroll
    for (int i = 0; i < 32; ++i) scr[(2 * i + (lane >> 5)) * 33 + (lane & 31)] = tv[i];
    LDS_WAIT(); asm volatile("" ::: "memory");
    const int c = lane & 7;
#pragma unroll
    for (int j = 0; j < 4; ++j) { const int n = (lane >> 3) + 8 * j; const int ns = (perm && n < 16) ? swap23(n) : n; const LAS float* s = scr + (8 * c) * 33 + ns;
        u32x4 o; o.x = pk2(s[0 * 33], s[1 * 33]); o.y = pk2(s[2 * 33], s[3 * 33]); o.z = pk2(s[4 * 33], s[5 * 33]); o.w = pk2(s[6 * 33], s[7 * 33]);
        *(u32x4*)(WT + (size_t)(rowdst0 + n) * ldt + kdst + k0 + 8 * c) = o; }
    LDS_WAIT(); asm volatile("" ::: "memory");
}
struct Tr8Item { const float* src; unsigned char* dst; int ldw; };
__device__ __forceinline__ Tr8Item tr8_item_of(const Args& a, unsigned char* Wgu8, unsigned char* Wdn8, int id, int wave, int lane) {
    Tr8Item t;
    if (id < 2048) { const int e = id >> 6, kb = (id >> 3) & 7, jt = id & 7; const int col = lane < 32 ? 128 * jt + 4 * lane : 1024 + 128 * jt + 4 * (lane - 32);
        t.src = a.in[21] + (size_t)e * 1024 * 2048 + (size_t)(128 * kb + 16 * wave) * 2048 + col; t.ldw = 2048; t.dst = Wgu8 + (size_t)e * 2048 * 1024 + (size_t)(256 * jt) * 1024 + 128 * kb; }
    else { const int r = id - 2048, e = r >> 5, kb = (r >> 2) & 7, nb = r & 3;
        t.src = a.in[23] + (size_t)e * 1024 * 1024 + (size_t)(128 * kb + 16 * wave) * 1024 + 256 * nb + 4 * lane; t.ldw = 1024; t.dst = Wdn8 + (size_t)e * 1024 * 1024 + (size_t)(256 * nb) * 1024 + 128 * kb; }
    return t;
}
__device__ __forceinline__ void tr8_load(const Tr8Item& t, f32x4 (&v)[16]) {
#pragma unroll
    for (int j = 0; j < 16; ++j) v[j] = *(const f32x4*)(t.src + (size_t)j * t.ldw);
}
__device__ __forceinline__ void tr8_finish(const Tr8Item& t, const f32x4 (&v)[16], LAS unsigned char* tile, int tid, int wave, int lane) {
    __syncthreads();
#pragma unroll
    for (int cc = 0; cc < 4; ++cc) { u32x4 o;
        o.x = pk4_fp8(v[0][cc] * 16.0f, v[1][cc] * 16.0f, v[2][cc] * 16.0f, v[3][cc] * 16.0f);    o.y = pk4_fp8(v[4][cc] * 16.0f, v[5][cc] * 16.0f, v[6][cc] * 16.0f, v[7][cc] * 16.0f);
        o.z = pk4_fp8(v[8][cc] * 16.0f, v[9][cc] * 16.0f, v[10][cc] * 16.0f, v[11][cc] * 16.0f); o.w = pk4_fp8(v[12][cc] * 16.0f, v[13][cc] * 16.0f, v[14][cc] * 16.0f, v[15][cc] * 16.0f);
        *(LAS u32x4*)(tile + (4 * lane + cc) * 144 + 16 * wave) = o; }
    __syncthreads();
#pragma unroll
    for (int i = 0; i < 4; ++i) { const int p = tid + 512 * i, n = p >> 3, q = p & 7;
        *(u32x4*)(t.dst + (size_t)n * 1024 + 16 * q) = *(const LAS u32x4*)(tile + n * 144 + 16 * q); }
}
__device__ __forceinline__ void rms_row_to_bf16(const float* xrow, const float* gain, bf16* orow, int lane) {
    f32x4 v[4]; float s = 0.f;
#pragma unroll
    for (int j = 0; j < 4; ++j) { v[j] = *(const f32x4*)(xrow + 4 * lane + 256 * j); s += (v[j].x * v[j].x + v[j].y * v[j].y) + (v[j].z * v[j].z + v[j].w * v[j].w); }
    const float rstd = 1.0f / sqrtf(wave_sum(s) * (1.0f / D) + RMS_EPS);
#pragma unroll
    for (int j = 0; j < 4; ++j) { const f32x4 g = *(const f32x4*)(gain + 4 * lane + 256 * j); u32x2 w; w.x = pk2(v[j].x * rstd * g.x, v[j].y * rstd * g.y); w.y = pk2(v[j].z * rstd * g.z, v[j].w * rstd * g.w);
        *(u32x2*)(orow + 4 * lane + 256 * j) = w; }
}
#ifndef P0REP
#define P0REP 0
#endif
#ifdef FAST_MIX
constexpr bool FAST_MIX_P0 = FAST_MIX != 0;
#else
constexpr bool FAST_MIX_P0 = false;
#endif
__device__ __forceinline__ void p0_prologue(const Args& a, const Ctx& c) {
    for (int rp = 0; rp < 1 + (P0REP & 1); ++rp)
    for (int g = c.bid; g < 64; g += c.G) p0_ssm_prep(a, c, g);
    LAS float* scr = (LAS float*)(c.lds + c.wave * 16384);
    bf16* WinT = (bf16*)(c.ws + WS_WIN); bf16* WgluT = (bf16*)(c.ws + WS_WGLU); bf16* WbrT = (bf16*)(c.ws + WS_WBR); bf16* WoutT = (bf16*)(c.ws + WS_WOUT);
    unsigned char* Wgu8 = c.ws + WS_WGU; unsigned char* Wdn8 = c.ws + WS_WDN;
    constexpr int NI_IN = 16 * 136, NI_SQ = 512, NI_ALL = NI_IN + 4 * NI_SQ;
    for (int rp = 0; rp < 1 + ((P0REP >> 1) & 1); ++rp)
    for (int it = c.gw; it < NI_ALL; it += c.ngw) {
        int r = it;
        if (r < NI_IN) { const int kb = r / 136, nb = r % 136, n0 = 32 * nb; const bool perm = (n0 >= 1024 && n0 < 2176 && (n0 & 63) == 0);
            tr_item(a.in[3], INW, 64 * kb, n0, perm, WinT, 1024, n0, 0, scr, c.lane); continue; } r -= NI_IN;
        if (r < NI_SQ) { tr_item(a.in[12], 1024, 64 * (r >> 5), 32 * (r & 31), false, WgluT, 1024, 32 * (r & 31), 0, scr, c.lane); continue; } r -= NI_SQ;
        if (r < NI_SQ) { tr_item(a.in[15], 1024, 64 * (r >> 5), 32 * (r & 31), false, WbrT, 1024, 32 * (r & 31), 0, scr, c.lane); continue; } r -= NI_SQ;
        if (r < NI_SQ) { tr_item(a.in[16], 1024, 64 * (r >> 5), 32 * (r & 31), false, WbrT, 1024, 1024 + 32 * (r & 31), 0, scr, c.lane); continue; } r -= NI_SQ;
        tr_item(a.in[17], 1024, 64 * (r >> 5), 32 * (r & 31), false, WoutT, 1024, 32 * (r & 31), 0, scr, c.lane);
    }
    for (int rp = 0; rp < 1 + ((P0REP >> 2) & 1); ++rp)
    {
        f32x4 va[16], vb[16];
        int id = c.bid;
        Tr8Item ta = tr8_item_of(a, Wgu8, Wdn8, id < 3072 ? id : 0, c.wave, c.lane), tb = ta;
        if (id < 3072) tr8_load(ta, va);
        while (id < 3072) {
            const int id1 = id + c.G;
            if (id1 < 3072) { tb = tr8_item_of(a, Wgu8, Wdn8, id1, c.wave, c.lane); tr8_load(tb, vb); }
            tr8_finish(ta, va, c.lds, c.tid, c.wave, c.lane);
            if (id1 >= 3072) break;
            const int id2 = id1 + c.G;
            if (id2 < 3072) { ta = tr8_item_of(a, Wgu8, Wdn8, id2, c.wave, c.lane); tr8_load(ta, va); }
            tr8_finish(tb, vb, c.lds, c.tid, c.wave, c.lane);
            id = id2;
        }
        __syncthreads();
    }
    bf16* XN = (bf16*)(c.ws + WS_XN);
    for (int rp = 0; rp < 1 + ((P0REP >> 3) & 1); ++rp)
    for (int m = c.gw; m < MP; m += c.ngw) {
        if (m < M + NMETA) rms_row_to_bf16(m < M ? a.in[0] + (size_t)m * D : a.in[1] + (size_t)(m - M) * D, a.in[2], XN + (size_t)m * D, c.lane);
        else { u32x4 z = {0u, 0u, 0u, 0u}; *(u32x4*)(XN + (size_t)m * D + 8 * c.lane) = z; *(u32x4*)(XN + (size_t)m * D + 512 + 8 * c.lane) = z; }
    }
    p0_router_frags(a, c);
    const int gt = c.bid * (NWAVES * 64) + c.tid, ngt = c.G * NWAVES * 64;
    float* rot = (float*)(c.ws + WS_ROT);
    for (int i = gt; i < LTOT * 8; i += ngt) { const int pos = i >> 3, j = i & 7;
        const float invs[8] = {1.0f, 0.1939227432012558f, 0.03760603070259094f, 0.007292664609849453f, 0.0014142135623842478f, 0.00027424818836152554f, 5.318296098266728e-05f, 1.0313386155758053e-05f};
        float inv = invs[0];
#pragma unroll
        for (int q = 1; q < 8; ++q) inv = (j == q) ? invs[q] : inv;
        const float ang = (float)pos * inv; const double rev = (double)ang * 0.15915494309189535; const float fr_ = (float)(rev - floor(rev));
        rot[pos * 16 + j] = __builtin_amdgcn_cosf(fr_); rot[pos * 16 + 8 + j] = __builtin_amdgcn_sinf(fr_); }
    if constexpr (!FAST_MIX_P0) {
    float* Ab = (float*)(c.ws + WS_SSMP); float* BB = Ab + 16384;
    for (int i = gt; i < 4096; i += ngt) { const int g = i >> 6;
        const float lr = a.in[4][i], li = a.in[5][i], dt = expf(a.in[6][g]), mag = expf(dt * lr), ar = mag * cosf(dt * li), ai = mag * sinf(dt * li);
        const float den = lr * lr + li * li, nr = ar - 1.0f, ni = ai, fr = (nr * lr + ni * li) / den, fi = (ni * lr - nr * li) / den;
        Ab[2 * i] = ar; Ab[2 * i + 1] = ai;
        for (int h = 0; h < 16; ++h) { const float br = a.in[7][i * 16 + h], bi = a.in[8][i * 16 + h]; BB[(i * 16 + h) * 2] = fr * br - fi * bi; BB[(i * 16 + h) * 2 + 1] = fr * bi + fi * br; }
    }
    }
}

__device__ __forceinline__ void p2_ssm_naive(const Args& a, const Ctx& c) {
    const float* Ab = (const float*)(c.ws + WS_SSMP); const float* BB = Ab + 16384;
    const bf16* U = (const bf16*)(c.ws + WS_U); bf16* Z = (bf16*)(c.ws + WS_Z);
    for (int it = c.gw; it < 128; it += c.ngw) {
        const int g = it >> 1, b = it & 1, p = c.lane, gp = g * 64 + p;
        const float ar = Ab[2 * gp], ai = Ab[2 * gp + 1];
        float bbr[16], bbi[16], cr[16], ci[16], dd[16];
#pragma unroll
        for (int h = 0; h < 16; ++h) { bbr[h] = BB[(gp * 16 + h) * 2]; bbi[h] = BB[(gp * 16 + h) * 2 + 1]; cr[h] = a.in[9][(g * 16 + h) * 64 + p]; ci[h] = a.in[10][(g * 16 + h) * 64 + p]; dd[h] = a.in[11][g * 16 + h]; }
        float xr = 0.f, xi = 0.f;
        const bf16* up = U + (size_t)((g * 2 + b) * NCH) * 256;
        for (int t = 0; t < LTOT; ++t) {
            float u[16]; { float t0[8], t1[8]; unpack8(*(const u32x4*)(up + t * 16), t0); unpack8(*(const u32x4*)(up + t * 16 + 8), t1);
#pragma unroll
                for (int h = 0; h < 8; ++h) { u[h] = t0[h]; u[8 + h] = t1[h]; } }
            float br_ = 0.f, bi_ = 0.f;
#pragma unroll
            for (int h = 0; h < 16; ++h) { br_ += bbr[h] * u[h]; bi_ += bbi[h] * u[h]; }
            const float nxr = ar * xr - ai * xi + br_, nxi = ar * xi + ai * xr + bi_; xr = nxr; xi = nxi;
            if (t >= NMETA) {
                float mine = 0.f;
#pragma unroll
                for (int h = 0; h < 16; ++h) { float v = wave_sum(cr[h] * xr - ci[h] * xi); if (c.lane == h) mine = v + dd[h] * u[h]; }
                if (c.lane < 16) Z[(size_t)(b * SEQ + t - NMETA) * 1024 + g * 16 + c.lane] = (bf16)f2bf(gelu_tanh(mine));
            }
        }
    }
}
__device__ __forceinline__ float dot8(u32x4 q, u32x4 k) {
    return (bflo(q.x) * bflo(k.x) + bfhi(q.x) * bfhi(k.x)) + (bflo(q.y) * bflo(k.y) + bfhi(q.y) * bfhi(k.y)) + (bflo(q.z) * bflo(k.z) + bfhi(q.z) * bfhi(k.z)) + (bflo(q.w) * bflo(k.w) + bfhi(q.w) * bfhi(k.w));
}
__device__ __forceinline__ void p2_attn_naive(const Args& a, const Ctx& c) {
    const bf16* Q = (const bf16*)(c.ws + WS_Q); const bf16* Kb = (const bf16*)(c.ws + WS_K); const bf16* Vt = (const bf16*)(c.ws + WS_VT); bf16* BRA = (bf16*)(c.ws + WS_BRA);
    const int lane = c.lane;
    for (int it = c.gw; it < M * 16; it += c.ngw) {
        const int r = it >> 4, h = it & 15, kvh = h >> 3, b = r >> 13, t = r & (SEQ - 1);
        u32x4 qv[8];
#pragma unroll
        for (int i = 0; i < 8; ++i) qv[i] = *(const u32x4*)(Q + (size_t)r * 1024 + h * 64 + 8 * i);
        float s[3];
#pragma unroll
        for (int sl = 0; sl < 3; ++sl) {
            int pos; bool ok;
            if (sl < 2) { const int tok = t - 127 + lane + 64 * sl; ok = tok >= 0; pos = NMETA + (ok ? tok : 0); } else { ok = lane < NMETA; pos = ok ? lane : 0; }
            const bf16* kp = Kb + ((size_t)(b * LTOT + pos)) * 128 + kvh * 64; float acc = 0.f;
#pragma unroll
            for (int i = 0; i < 8; ++i) acc += dot8(qv[i], *(const u32x4*)(kp + 8 * i));
            s[sl] = ok ? acc : -1e30f;
        }
        const float sink = a.in[14][h] * 1.4426950408889634f;
        const float mx = wave_max(fmaxf(fmaxf(s[0], s[1]), fmaxf(s[2], sink)));
        const float p0 = exp2f(s[0] - mx), p1 = exp2f(s[1] - mx), p2 = exp2f(s[2] - mx);
        const float l = wave_sum(p0 + p1 + p2) + exp2f(sink - mx);
        const bf16* vrow = Vt + (size_t)(b * LTOT) * 128 + kvh * 64 + lane;
        float o = 0.f;
        for (int j = 0; j < 128; ++j) { const int tok = t - 127 + j; const float pj = __shfl(j < 64 ? p0 : p1, j & 63); if (tok >= 0) o += pj * bf2f(vrow[(size_t)(NMETA + tok) * 128]); }
        for (int j = 0; j < NMETA; ++j) { const float pj = __shfl(p2, j); o += pj * bf2f(vrow[(size_t)j * 128]); }
        BRA[(size_t)(M + r) * 1024 + h * 64 + lane] = (bf16)f2bf(o / l);
    }
}

__device__ __forceinline__ void p6_router(const Args& a, const Ctx& c) {
    const float* H1 = (const float*)(c.ws + WS_H1); unsigned char* XG = c.ws + WS_HN2;
    int* TE = (int*)(c.ws + WS_TOK); int* TP = TE + M * 4; float* TG = (float*)(TP + M * 4); float* RS = (float*)(c.ws + WS_TOK) + M * 16 + NSLOT * 2;
    unsigned* cnt = (unsigned*)(c.ws + WS_CTL) + CW_CNT;
    const float* brt = a.in[20];
    LAS float* gl = (LAS float*)(c.lds + LDSCTL_OFF + 8192);
    LAS unsigned* hist = (LAS unsigned*)(c.lds + LDSCTL_OFF + 12288); LAS unsigned* ebase = hist + 32;
    const int lane = c.lane, fr = lane & 15, fq = lane >> 4;
    __syncthreads();
    for (int idx = c.tid; idx < 8192; idx += NWAVES * 64) *(LAS u32x4*)(c.lds + idx * 16) = *(const u32x4*)(c.ws + WS_SSMP + SSM_WRF + (size_t)idx * 16);
    for (int idx = c.tid; idx < 1024; idx += NWAVES * 64) gl[idx] = a.in[18][idx];
    for (int t0 = 0; t0 < M / 16; t0 += 4 * c.G) {
        if (c.tid < 32) hist[c.tid] = 0u;
        __syncthreads();
        const int tile = t0 + c.wave * c.G + c.bid; const bool work = c.wave < 4 && tile < M / 16;
        int te[4]; unsigned rk[4]; const int row = 16 * tile + fr;
        if (work) {
            const float* xr = H1 + (size_t)row * D + 8 * fq;
            f32x4 acc0 = {0.f, 0.f, 0.f, 0.f}, acc1 = {0.f, 0.f, 0.f, 0.f}; float ss = 0.f;
#pragma unroll 2
            for (int ks = 0; ks < 32; ++ks) {
                const f32x4 x0 = *(const f32x4*)(xr + 32 * ks), x1 = *(const f32x4*)(xr + 32 * ks + 4);
                const f32x4 g0 = *(const LAS f32x4*)(gl + 32 * ks + 8 * fq), g1 = *(const LAS f32x4*)(gl + 32 * ks + 8 * fq + 4);
                ss += (x0.x * x0.x + x0.y * x0.y) + (x0.z * x0.z + x0.w * x0.w) + (x1.x * x1.x + x1.y * x1.y) + (x1.z * x1.z + x1.w * x1.w);
                const f32x4 v0 = x0 * g0, v1 = x1 * g1;
                u32x4 hw; hw.x = pk2(v0.x, v0.y); hw.y = pk2(v0.z, v0.w); hw.z = pk2(v1.x, v1.y); hw.w = pk2(v1.z, v1.w);
                { u32x2 w8; w8.x = pk4_fp8(v0.x, v0.y, v0.z, v0.w); w8.y = pk4_fp8(v1.x, v1.y, v1.z, v1.w); *(u32x2*)(XG + (size_t)row * D + 32 * ks + 8 * fq) = w8; }
                u32x4 lw; lw.x = pk2(v0.x - bflo(hw.x), v0.y - bfhi(hw.x)); lw.y = pk2(v0.z - bflo(hw.y), v0.w - bfhi(hw.y)); lw.z = pk2(v1.x - bflo(hw.z), v1.y - bfhi(hw.z)); lw.w = pk2(v1.z - bflo(hw.w), v1.w - bfhi(hw.w));
                const bf16x8 hi = __builtin_bit_cast(bf16x8, hw), lo = __builtin_bit_cast(bf16x8, lw);
                const bf16x8 wh0 = *(const LAS bf16x8*)(c.lds + ((ks * 2 + 0) * 64 + lane) * 16), wh1 = *(const LAS bf16x8*)(c.lds + ((ks * 2 + 1) * 64 + lane) * 16);
                const bf16x8 wl0 = *(const LAS bf16x8*)(c.lds + 65536 + ((ks * 2 + 0) * 64 + lane) * 16), wl1 = *(const LAS bf16x8*)(c.lds + 65536 + ((ks * 2 + 1) * 64 + lane) * 16);
                acc0 = __builtin_amdgcn_mfma_f32_16x16x32_bf16(wh0, hi, acc0, 0, 0, 0); acc1 = __builtin_amdgcn_mfma_f32_16x16x32_bf16(wh1, hi, acc1, 0, 0, 0);
                acc0 = __builtin_amdgcn_mfma_f32_16x16x32_bf16(wl0, hi, acc0, 0, 0, 0); acc1 = __builtin_amdgcn_mfma_f32_16x16x32_bf16(wl1, hi, acc1, 0, 0, 0);
                acc0 = __builtin_amdgcn_mfma_f32_16x16x32_bf16(wh0, lo, acc0, 0, 0, 0); acc1 = __builtin_amdgcn_mfma_f32_16x16x32_bf16(wh1, lo, acc1, 0, 0, 0);
            }
            ss += __shfl_xor(ss, 16); ss += __shfl_xor(ss, 32);
            const float rstd = 1.0f / sqrtf(ss * (1.0f / D) + RMS_EPS);
            float lg[32];
#pragma unroll
            for (int q = 0; q < 4; ++q)
#pragma unroll
                for (int r = 0; r < 4; ++r) { lg[4 * q + r] = __shfl(acc0[r], fr + 16 * q) * rstd + brt[4 * q + r]; lg[16 + 4 * q + r] = __shfl(acc1[r], fr + 16 * q) * rstd + brt[16 + 4 * q + r]; }
            float tv[4];
#pragma unroll
            for (int k = 0; k < 4; ++k) { float best = -3.0e38f; int bi = 0;
#pragma unroll
                for (int e = 0; e < 32; ++e) if (lg[e] > best) { best = lg[e]; bi = e; }
                te[k] = bi; tv[k] = best;
#pragma unroll
                for (int e = 0; e < 32; ++e) if (e == bi) lg[e] = -3.0e38f; }
            if (fq == 0) {
                const float e1 = __expf(tv[1] - tv[0]), e2 = __expf(tv[2] - tv[0]), e3 = __expf(tv[3] - tv[0]), inv = 1.0f / (1.0f + e1 + e2 + e3);
                *(f32x4*)(TG + row * 4) = (f32x4){inv, e1 * inv, e2 * inv, e3 * inv};
                TE[row * 4 + 0] = te[0]; TE[row * 4 + 1] = te[1]; TE[row * 4 + 2] = te[2]; TE[row * 4 + 3] = te[3];
                RS[row] = rstd;
#pragma unroll
                for (int k = 0; k < 4; ++k) rk[k] = __hip_atomic_fetch_add(hist + te[k], 1u, __ATOMIC_RELAXED, __HIP_MEMORY_SCOPE_WORKGROUP);
            }
        }
        __syncthreads();
        if (c.tid < 32) ebase[c.tid] = __hip_atomic_fetch_add(cnt + c.tid, hist[c.tid], RLX_AGENT);
        __syncthreads();
        if (work && fq == 0) {
#pragma unroll
            for (int k = 0; k < 4; ++k) TP[row * 4 + k] = (int)(ebase[te[k]] + rk[k]); }
        __syncthreads();
    }
}
__device__ __forceinline__ int moe_tables(const Ctx& c, LAS int* tb, LAS int* tile_e) {
    __syncthreads();
    if (c.tid == 0) { const gu32* cnt = (const gu32*)(c.ws + WS_CTL) + CW_CNT; int acc = 0;
        for (int e = 0; e < NE; ++e) { tb[e] = acc; const int n = ((int)__hip_atomic_load(cnt + e, RLX_AGENT) + 255) >> 8; for (int i = 0; i < n && acc + i < MAXT; ++i) tile_e[acc + i] = e; acc += n; if (acc > MAXT) acc = MAXT; }
        tb[NE] = acc; }
    __syncthreads();
    return __builtin_amdgcn_readfirstlane(tb[NE]);
}
__device__ __forceinline__ void p7_gather(const Args& a, const Ctx& c, LAS int* tb) {
    const unsigned char* HN2 = c.ws + WS_HN2; unsigned char* XS = c.ws + WS_XS;
    const int* TE = (const int*)(c.ws + WS_TOK); const int* TP = TE + M * 4; const float* TG = (const float*)(TP + M * 4); int* TS = (int*)(TG + M * 4); float* SG = (float*)(TS + M * 4);
    float* SR = SG + NSLOT; const float* RS = SG + 2 * NSLOT;
    for (int row = c.gw; row < M; row += c.ngw) {
        const u32x4 w0 = *(const u32x4*)(HN2 + (size_t)row * D + 16 * c.lane);
#pragma unroll
        for (int k = 0; k < 4; ++k) { const int e = TE[row * 4 + k], slot = tb[e] * 256 + TP[row * 4 + k];
            *(u32x4*)(XS + (size_t)slot * D + 16 * c.lane) = w0;
            if (c.lane == 0) { TS[row * 4 + k] = slot; SG[slot] = TG[row * 4 + k]; SR[slot] = RS[row]; } }
    }
}
__device__ __forceinline__ void p10_final(const Args& a, const Ctx& c) {
    const float* H1 = (const float*)(c.ws + WS_H1); const bf16* YS = (const bf16*)(c.ws + WS_YS);
    const int* TS = (const int*)(c.ws + WS_TOK) + M * 12; const float* gain = a.in[25];
    for (int row = c.gw; row < M; row += c.ngw) {
        f32x4 v[4];
#pragma unroll
        for (int j = 0; j < 4; ++j) v[j] = *(const f32x4*)(H1 + (size_t)row * D + 4 * c.lane + 256 * j);
#pragma unroll
        for (int k = 0; k < 4; ++k) { const bf16* ys = YS + (size_t)TS[row * 4 + k] * D;
#pragma unroll
            for (int j = 0; j < 4; ++j) { const u32x2 w = *(const u32x2*)(ys + 4 * c.lane + 256 * j); v[j].x += bflo(w.x); v[j].y += bfhi(w.x); v[j].z += bflo(w.y); v[j].w += bfhi(w.y); } }
        float s = 0.f;
#pragma unroll
        for (int j = 0; j < 4; ++j) s += (v[j].x * v[j].x + v[j].y * v[j].y) + (v[j].z * v[j].z + v[j].w * v[j].w);
        const float rstd = 1.0f / sqrtf(wave_sum(s) * (1.0f / D) + RMS_EPS);
#pragma unroll
        for (int j = 0; j < 4; ++j) { const f32x4 g = *(const f32x4*)(gain + 4 * c.lane + 256 * j); *(f32x4*)(a.out + (size_t)row * D + 4 * c.lane + 256 * j) = v[j] * rstd * g; }
    }
}

#ifndef ONE_LAUNCH
#define ONE_LAUNCH 0
#endif
#ifndef FAST_GEMM
#define FAST_GEMM 0
#endif
#ifndef FAST_MIX
#define FAST_MIX 0
#endif
constexpr int NPH = 11;

template <bool FAST, class E, class S, bool F8 = false>
__device__ __forceinline__ void run_gemm(const Ctx& c, const bf16* A, const bf16* Bt, int K, const S& s, const E& e) {
    if constexpr (FAST) { pg8::Gemm g{A, Bt, 0, 0, K, c.wave}; FastEpi<E> fe{e}; pg8::gemm_phase<FastEpi<E>, S, true, true, F8>(c.lds, g, s, fe); }
    else { Unit u; for (int i = 0; s.next(i, u); ++i) naive_gemm_unit(A, K, Bt, K, K, u.pm, u.pn, e, c.wave, c.lane); }
}

__global__ void __launch_bounds__(NWAVES * 64, 2) fwd(Args args) {
    extern __shared__ __attribute__((aligned(16))) unsigned char lds_raw[];
    Ctx c0; c0.lds = (LAS unsigned char*)lds_raw; c0.ws = args.ws; c0.tid = threadIdx.x; c0.lane = c0.tid & 63; c0.wave = __builtin_amdgcn_readfirstlane(c0.tid >> 6);
    c0.G = gridDim.x; c0.bid = blockIdx.x; c0.gw = c0.bid * NWAVES + c0.wave; c0.ngw = c0.G * NWAVES;
    const Ctx& c = c0;
    volatile LAS unsigned* MISC = (volatile LAS unsigned*)(c.lds + LDSCTL_OFF);
    LAS int* tb = (LAS int*)(c.lds + LDSCTL_OFF + 512); LAS int* tile_e = (LAS int*)(c.lds + LDSCTL_OFF + 1024);
    for (int u = c.tid; u < (LDS_BYTES - LDSCTL_OFF) / 4; u += NWAVES * 64) ((LAS unsigned*)(c.lds + LDSCTL_OFF))[u] = 0u;
    __syncthreads();
    const int lo = args.ph_lo, hi = args.ph_hi;
    XcdBarrier bar; bar.bar = (unsigned*)(c.ws + WS_CTL) + CW_BAR; bar.x = 0; bar.st = nullptr;
    if (hi - lo > 1) bar = xcd_barrier_post((unsigned*)(c.ws + WS_CTL) + CW_BAR, MISC + 8);
#ifndef DISMASK
#define DISMASK 0
#endif
#define IN(k) (lo <= (k) && (k) < hi && !((DISMASK >> (k)) & 1))
#define GRID_BAR() xcd_barrier(bar, c0.wave == 0 && pg8::fresh_lane() == 0)
#define SEAM(k) do { if (IN(k) && IN((k) + 1)) GRID_BAR(); } while (0)
    unsigned char* ws = c.ws;
    bf16* XN = (bf16*)(ws + WS_XN); bf16* U = (bf16*)(ws + WS_U); bf16* Q = (bf16*)(ws + WS_Q); bf16* Kb = (bf16*)(ws + WS_K); bf16* Vt = (bf16*)(ws + WS_VT);
    bf16* GSp = (bf16*)(ws + WS_GS); bf16* GAp = (bf16*)(ws + WS_GA); bf16* Z = (bf16*)(ws + WS_Z); bf16* BRA = (bf16*)(ws + WS_BRA); bf16* MIX = (bf16*)(ws + WS_MIX);
    float* H1 = (float*)(ws + WS_H1); bf16* XS = (bf16*)(ws + WS_XS); bf16* HID = (bf16*)(ws + WS_HID); bf16* YS = (bf16*)(ws + WS_YS);

#ifndef REPMASK
#define REPMASK 0
#endif
    int mixpass = 0, glupass = 0;
#ifndef GLU_NOSTORE
#define GLU_NOSTORE 0
#endif
#define PHASE(k, ...) if (IN(k)) { Ctx c = c0; c.lane = pg8::fresh_lane(); c.tid = c.wave * 64 + c.lane; __VA_ARGS__ if constexpr ((REPMASK >> (k)) & 1) { GRID_BAR(); __VA_ARGS__ } } SEAM(k);
    PHASE(0, p0_prologue(args, c);)
    PHASE(1, {
        EpiInProj E{U, Q, Kb, Vt, GSp, GAp, (const float*)(ws + WS_ROT)};
        if constexpr (FAST_GEMM && FAST_MIX) { InProjOrder S; S.so.init(M, 4096, c.G, c.bid); run_gemm<true>(c, XN, (const bf16*)(ws + WS_WIN), 1024, S, E); }
        else { pg8::StaticOrder S; S.init(MP, INW, c.G, c.bid); run_gemm<FAST_GEMM>(c, XN, (const bf16*)(ws + WS_WIN), 1024, S, E); } })
    PHASE(2, if constexpr (FAST_MIX) {
#ifndef DEFER_REP
#define DEFER_REP 0
#endif
#ifndef MIXSKIP
#define MIXSKIP 0
#endif
 if (!(MIXSKIP & 1) || mixpass == 0) { for (int it = c.bid; it < 128; it += c.G) ssm_chain(c, it >> 1, it & 1); }
 if constexpr (FAST_GEMM) { if (mixpass == 0 || DEFER_REP) { EpiInProj E{U, Q, Kb, Vt, GSp, GAp, (const float*)(ws + WS_ROT)}; DeferredOrder S{c.G >= 197 ? c.bid - 128 : (c.bid == 0 ? 0 : -1)};
     if (c.G >= 197) { run_gemm<true>(c, XN, (const bf16*)(ws + WS_WIN), 1024, S, E); } else { for (int j = c.bid; j < 69; j += c.G) { DeferredOrder S1{j}; run_gemm<true>(c, XN, (const bf16*)(ws + WS_WIN), 1024, S1, E); } } __syncthreads(); } }
 if (!(MIXSKIP & 2) || mixpass == 0) attn_fast(args, c);
 ++mixpass;
 } else { p2_ssm_naive(args, c); p2_attn_naive(args, c); })
    PHASE(3, {
        pg8::StaticOrder S; S.init(M, 1024, c.G, c.bid);
        EpiGlu E{Z, args.in[13], BRA};
        run_gemm<FAST_GEMM>(c, Z, (const bf16*)(ws + WS_WGLU), 1024, S, E); })
    PHASE(4, {
        EpiBr E{GSp, GAp, MIX};
        if constexpr (FAST_GEMM) { PairOrder S; S.so.init(M, 1024, c.G, c.bid); run_gemm<true>(c, BRA, (const bf16*)(ws + WS_WBR), 1024, S, E); }
        else { pg8::StaticOrder S; S.init(M, 1024, c.G, c.bid); run_gemm<false>(c, BRA, (const bf16*)(ws + WS_WBR), 1024, S, E); } })
    PHASE(5, {
        pg8::StaticOrder S; S.init(M, 1024, c.G, c.bid);
        EpiOut E{args.in[0], H1};
        run_gemm<FAST_GEMM>(c, MIX, (const bf16*)(ws + WS_WOUT), 1024, S, E); })
    PHASE(6, p6_router(args, c);)
    PHASE(7, { moe_tables(c, tb, tile_e); p7_gather(args, c, tb); })
    PHASE(8, {
        const int nt = moe_tables(c, tb, tile_e);
        MoeOrder S{tile_e, nt, 8, c.G, c.bid};
        EpiMoe1 E{args.in[22], (const float*)(ws + WS_TOK) + M * 16 + NSLOT, (unsigned char*)HID};
        run_gemm<true, EpiMoe1, MoeOrder, true>(c, XS, (const bf16*)(ws + WS_WGU), 512, S, E); })
    PHASE(9, {
        const int nt = moe_tables(c, tb, tile_e);
        MoeOrder S{tile_e, nt, 4, c.G, c.bid};
        EpiMoe2 E{args.in[24], (const float*)(ws + WS_TOK) + M * 16, YS};
        run_gemm<true, EpiMoe2, MoeOrder, true>(c, HID, (const bf16*)(ws + WS_WDN), 512, S, E); })
    PHASE(10, p10_final(args, c);)
#undef PHASE
#undef IN
#undef SEAM
}

extern "C" void kernel_launch(void* const* d_in, const int* in_sizes, int n_in, void* d_out, int out_size, void* d_ws, size_t ws_size, hipStream_t stream) {
    static int grid = 0;
    if (grid == 0) {
        if (n_in != 26 || in_sizes[0] != M * D || out_size != M * D || ws_size < WS_END) { fprintf(stderr, "kernel_launch: unexpected shapes (n_in %d, in0 %d, out %d, ws %zu)\n", n_in, n_in > 0 ? in_sizes[0] : -1, out_size, ws_size); grid = -1; return; }
        int dev = 0, cus = 0, per_cu = 0;
        if (hipGetDevice(&dev) != hipSuccess || hipDeviceGetAttribute(&cus, hipDeviceAttributeMultiprocessorCount, dev) != hipSuccess) { grid = -1; return; }
        if (hipFuncSetAttribute((const void*)fwd, hipFuncAttributeMaxDynamicSharedMemorySize, LDS_BYTES) != hipSuccess) { fprintf(stderr, "kernel_launch: hipFuncSetAttribute failed\n"); grid = -1; return; }
        if (hipOccupancyMaxActiveBlocksPerMultiprocessor(&per_cu, (const void*)fwd, NWAVES * 64, LDS_BYTES) != hipSuccess || per_cu < 1) fprintf(stderr, "kernel_launch: occupancy query says %d\n", per_cu);
        (void)hipGetLastError();
        grid = cus;
    }
    if (grid < 0) return;
    if (hipMemsetAsync((char*)d_ws + WS_CTL, 0, CTL_ZERO_BYTES, stream) != hipSuccess) return;
    Args a{};
    for (int i = 0; i < 26; ++i) a.in[i] = (const float*)d_in[i];
    a.out = (float*)d_out; a.ws = (unsigned char*)d_ws;
#if ONE_LAUNCH
    a.ph_lo = 0; a.ph_hi = NPH;
    hipLaunchKernelGGL(fwd, dim3(grid), dim3(NWAVES * 64), LDS_BYTES, stream, a);
#else
    for (int p = 0; p < NPH; ++p) { a.ph_lo = p; a.ph_hi = p + 1; hipLaunchKernelGGL(fwd, dim3(grid), dim3(NWAVES * 64), LDS_BYTES, stream, a); }
#endif
}
```

```cpp
#include <hip/hip_runtime.h>
#include <cstdio>
#include <cstdint>
#define ONE_LAUNCH 1
#define FAST_GEMM 1
#define FAST_MIX 1
#define EPI_FENCE 0
namespace pg8 {
#define PG8_LAS __attribute__((address_space(3)))
typedef unsigned short bf16_t;
typedef short bf16x8 __attribute__((ext_vector_type(8)));
typedef float f32x4 __attribute__((ext_vector_type(4)));
typedef unsigned u32x4 __attribute__((ext_vector_type(4)));
constexpr int BM = 256, BK = 64, HALF = 128, HTB = HALF * BK * 2  , STAGE_BYTES = 8 * HTB, NXCD = 8, WGM = 8;

__host__ __device__ __forceinline__ int lds_byte(int r, int c) { const int st = (r >> 4) * 2 + (c >> 5), rr = r & 15, cc = c & 31, ob = rr * 64 + cc * 2; return st * 1024 + (ob ^ (((ob >> 9) & 1) << 5)); }
__host__ __device__ __forceinline__ void stage_rc(int b, int& R, int& C) { const int st = b / 1024, sb = b % 1024, swz = sb ^ (((sb >> 9) & 1) << 5); R = (st >> 1) * 16 + swz / 64; C = (st & 1) * 32 + (swz % 64) / 2; }
__host__ __device__ __forceinline__ int perm32(int rho) { const int n = rho >> 4, i = rho & 15; return 8 * (i >> 2) + 4 * n + (i & 3); }

struct Unit { int pm, pn; };
struct Gemm { const bf16_t* A; const bf16_t* Bt; int M, N, K; int wid; };
__device__ __forceinline__ int fresh_lane() { int l; asm volatile("v_mbcnt_lo_u32_b32 %0, -1, 0\n\tv_mbcnt_hi_u32_b32 %0, -1, %0" : "=v"(l)); return l; }

struct StaticOrder {
    int nM, nN, nwg, G, c;
    __host__ __device__ void init(int M, int N, int G_, int c_) { nM = M / BM; nN = N / BM; nwg = nM * nN; G = G_; c = c_; }
    __host__ __device__ bool next(int i, Unit& u) const {
        const long L = (long)i * G + c; if (L >= nwg) return false;
        int wgid = (int)L; { const int q = nwg / NXCD, r = nwg % NXCD, xcd = wgid % NXCD, off = wgid / NXCD; wgid = (xcd < r ? xcd * (q + 1) : r * (q + 1) + (xcd - r) * q) + off; }
        const int nig = WGM * nN, gid = wgid / nig, fm = gid * WGM, gsz = (nM - fm) < WGM ? (nM - fm) : WGM;
        u.pm = fm + ((wgid % nig) % gsz); u.pn = (wgid % nig) / gsz; return true;
    }
    __device__ __forceinline__ void a_ready(const Unit&) const {}
    __device__ __forceinline__ void done(const Unit&) const {}
};
__device__ __forceinline__ unsigned cvt_pk_bf16(float lo, float hi) { unsigned r; asm volatile("v_cvt_pk_bf16_f32 %0, %1, %2" : "=v"(r) : "v"(lo), "v"(hi)); return r; }
typedef int pg8_v8i __attribute__((ext_vector_type(8))); typedef int pg8_v4i __attribute__((ext_vector_type(4)));
__device__ __forceinline__ pg8_v8i pg8_cat(bf16x8 lo, bf16x8 hi) { return __builtin_shufflevector(__builtin_bit_cast(pg8_v4i, lo), __builtin_bit_cast(pg8_v4i, hi), 0, 1, 2, 3, 4, 5, 6, 7); }
template <class Epi, class Sched, bool ALIGN_EPI = false, bool SP2 = false, bool F8 = false>
__device__ __forceinline__ void gemm_phase(PG8_LAS unsigned char* lds, const Gemm g, const Sched& S, const Epi& E) {
    const int lane = fresh_lane(), wid = g.wid, tid = wid * 64 + lane, wr = wid >> 2, wc = wid & 3, fr = lane & 15, fq = lane >> 4;
    const int K = g.K, nt = K / BK;
    unsigned voffA[2], voffB[2];
#pragma unroll
    for (int i = 0; i < 2; ++i) { int R, C; stage_rc(tid * 16 + i * 8192, R, C); const int Rb = Epi::PERM ? ((R & ~31) + perm32(R & 31)) : R;
        voffA[i] = (unsigned)(R * K + C) * 2u; voffB[i] = (unsigned)(Rb * K + C) * 2u; }
    const unsigned kstep = (unsigned)(BK * 2);
    const unsigned hstep = (unsigned)HALF * K * 2;
    const unsigned tstep = 2 * hstep;
    const __amdgpu_buffer_rsrc_t rsA = __builtin_amdgcn_make_buffer_rsrc((void*)g.A, (short)0, -1, 0x00020000), rsB = __builtin_amdgcn_make_buffer_rsrc((void*)g.Bt, (short)0, -1, 0x00020000);
    const unsigned ldsw = (unsigned)wid * 1024u;
    const int aoff = lds_byte(wr * 64 + fr, fq * 8), boff = lds_byte(wc * 32 + fr, fq * 8);
#define PG8_SA(b, h) (((b) * 2 + (h)) * HTB)
#define PG8_SB(b, h) ((4 + (b) * 2 + (h)) * HTB)
#define PG8_STAGE(bufoff, gbase, voff) do { _Pragma("unroll") for (int _i = 0; _i < 2; ++_i) \
        __builtin_amdgcn_raw_ptr_buffer_load_lds(PG8_RS_##voff, (PG8_LAS unsigned*)(lds + (bufoff) + ldsw + _i * 8192), 16, (int)(voff)[_i], (int)(gbase), 0, 0); } while (0)
#define PG8_RS_voffA rsA
#define PG8_RS_voffB rsB
#define PG8_LDA(dst, b, h) do { _Pragma("unroll") for (int m = 0; m < 4; ++m) _Pragma("unroll") for (int k = 0; k < 2; ++k) dst[m][k] = *(const PG8_LAS bf16x8*)(lds + PG8_SA(b, h) + aoff + m * 2048 + k * 1024); } while (0)
#define PG8_LDB(dst, b, h) do { _Pragma("unroll") for (int n = 0; n < 2; ++n) _Pragma("unroll") for (int k = 0; k < 2; ++k) dst[n][k] = *(const PG8_LAS bf16x8*)(lds + PG8_SB(b, h) + boff + n * 2048 + k * 1024); } while (0)
#define PG8_MMA(ai, bj, At, Bt) do { __builtin_amdgcn_s_setprio(1); if constexpr (F8) { _Pragma("unroll") for (int m = 0; m < 4; ++m) _Pragma("unroll") for (int n = 0; n < 2; ++n) \
        acc[ai][bj][m][n] = __builtin_amdgcn_mfma_scale_f32_16x16x128_f8f6f4(pg8_cat(Bt[n][0], Bt[n][1]), pg8_cat(At[m][0], At[m][1]), acc[ai][bj][m][n], 0, 0, 0, 0, 0, 0); } else { \
        _Pragma("unroll") for (int m = 0; m < 4; ++m) _Pragma("unroll") for (int n = 0; n < 2; ++n) _Pragma("unroll") for (int k = 0; k < 2; ++k) \
        acc[ai][bj][m][n] = __builtin_amdgcn_mfma_f32_16x16x32_bf16(Bt[n][k], At[m][k], acc[ai][bj][m][n], 0, 0, 0); } __builtin_amdgcn_s_setprio(0); } while (0)
#define PG8_WAIT_V(n) asm volatile("s_waitcnt vmcnt(" #n ")" ::: "memory")
#define PG8_WAIT_L(n) asm volatile("s_waitcnt lgkmcnt(" #n ")" ::: "memory")
#define PG8_BAR __builtin_amdgcn_s_barrier()
#define PG8_SCHED __builtin_amdgcn_sched_barrier(0)
    Unit cur, nxt; int ui = 0;
    if (!S.next(0, cur)) return;
    f32x4 acc[2][2][4][2];
#pragma unroll
    for (int a = 0; a < 2; ++a)
#pragma unroll
        for (int b = 0; b < 2; ++b)
#pragma unroll
            for (int m = 0; m < 4; ++m)
#pragma unroll
                for (int n = 0; n < 2; ++n) acc[a][b][m][n] = (f32x4){0.f, 0.f, 0.f, 0.f};
    bf16x8 At[4][2], B0[2][2], B1[2][2];
    unsigned cA = (unsigned)cur.pm * tstep, cB = (unsigned)cur.pn * tstep;
    S.a_ready(cur);
    if constexpr (SP2) {
        PG8_STAGE(PG8_SB(0, 0), cB, voffB); PG8_STAGE(PG8_SB(0, 1), cB + hstep, voffB); PG8_STAGE(PG8_SA(0, 0), cA, voffA); PG8_STAGE(PG8_SA(0, 1), cA + hstep, voffA);
        if (wr == 1) PG8_BAR;
        PG8_WAIT_V(2); PG8_BAR;
        PG8_STAGE(PG8_SB(1, 0), cB + kstep, voffB); PG8_STAGE(PG8_SA(1, 0), cA + kstep, voffA); PG8_STAGE(PG8_SB(1, 1), cB + hstep + kstep, voffB);
        PG8_WAIT_V(6); PG8_BAR;
    } else {
        PG8_STAGE(PG8_SB(0, 0), cB, voffB); PG8_STAGE(PG8_SA(0, 0), cA, voffA); PG8_STAGE(PG8_SB(0, 1), cB + hstep, voffB); PG8_STAGE(PG8_SA(0, 1), cA + hstep, voffA);
        if (wr == 1) PG8_BAR;
        PG8_WAIT_V(4); PG8_BAR;
        PG8_STAGE(PG8_SB(1, 0), cB + kstep, voffB); PG8_STAGE(PG8_SA(1, 0), cA + kstep, voffA); PG8_STAGE(PG8_SB(1, 1), cB + hstep + kstep, voffB);
        PG8_WAIT_V(6); PG8_BAR;
    }
    for (;;) {
        const bool has_next = S.next(ui + 1, nxt);
        const unsigned nA = has_next ? (unsigned)nxt.pm * tstep : cA, nB = has_next ? (unsigned)nxt.pn * tstep : cB;
#pragma unroll 1
        for (int t = 0; t < nt; t += 2) {
            const bool last = (t == nt - 2);
            const unsigned a1 = cA + (unsigned)(t + 1) * kstep;
            const unsigned a2 = last ? nA : cA + (unsigned)(t + 2) * kstep, b2 = last ? nB : cB + (unsigned)(t + 2) * kstep;
            const unsigned a3 = a2 + kstep, b3 = b2 + kstep;
            if (last && has_next) S.a_ready(nxt);
            if constexpr (SP2) {
            PG8_LDB(B0, 0, 0); PG8_LDB(B1, 0, 1); PG8_SCHED; PG8_LDA(At, 0, 0); PG8_STAGE(PG8_SA(1, 1), a1 + hstep, voffA);
            PG8_WAIT_V(8); PG8_WAIT_L(0); PG8_BAR; PG8_MMA(0, 0, At, B0); PG8_MMA(0, 1, At, B1); PG8_BAR; PG8_SCHED;
            PG8_LDA(At, 0, 1); PG8_STAGE(PG8_SB(0, 0), b2, voffB); PG8_STAGE(PG8_SB(0, 1), b2 + hstep, voffB); PG8_STAGE(PG8_SA(0, 0), a2, voffA);
            PG8_WAIT_V(8); PG8_WAIT_L(0); PG8_BAR; PG8_MMA(1, 0, At, B0); PG8_MMA(1, 1, At, B1); PG8_BAR; PG8_SCHED;
            PG8_LDB(B0, 1, 0); PG8_LDB(B1, 1, 1); PG8_SCHED; PG8_LDA(At, 1, 0); PG8_STAGE(PG8_SA(0, 1), a2 + hstep, voffA);
            PG8_WAIT_V(8); PG8_WAIT_L(0); PG8_BAR; PG8_MMA(0, 0, At, B0); PG8_MMA(0, 1, At, B1); PG8_BAR; PG8_SCHED;
            PG8_LDA(At, 1, 1); PG8_STAGE(PG8_SB(1, 0), b3, voffB); PG8_STAGE(PG8_SB(1, 1), b3 + hstep, voffB); PG8_STAGE(PG8_SA(1, 0), a3, voffA);
            PG8_WAIT_V(8); PG8_WAIT_L(0); PG8_BAR; PG8_MMA(1, 0, At, B0); PG8_MMA(1, 1, At, B1); PG8_BAR; PG8_SCHED;
            } else {
            PG8_LDB(B0, 0, 0); PG8_SCHED; PG8_LDA(At, 0, 0); PG8_STAGE(PG8_SA(1, 1), a1 + hstep, voffA);
            PG8_WAIT_L(8); PG8_BAR; PG8_WAIT_L(0); PG8_MMA(0, 0, At, B0); PG8_BAR; PG8_SCHED;
            PG8_LDB(B1, 0, 1); PG8_STAGE(PG8_SB(0, 0), b2, voffB);
            PG8_BAR; PG8_WAIT_L(0); PG8_MMA(0, 1, At, B1); PG8_BAR;
            PG8_LDA(At, 0, 1); PG8_STAGE(PG8_SA(0, 0), a2, voffA);
            PG8_BAR; PG8_WAIT_L(0); PG8_MMA(1, 0, At, B0); PG8_BAR; PG8_SCHED;
            PG8_STAGE(PG8_SB(0, 1), b2 + hstep, voffB);
            PG8_WAIT_V(6); PG8_BAR; PG8_MMA(1, 1, At, B1); PG8_BAR;
            PG8_LDB(B0, 1, 0); PG8_SCHED; PG8_LDA(At, 1, 0); PG8_STAGE(PG8_SA(0, 1), a2 + hstep, voffA);
            PG8_WAIT_L(8); PG8_BAR; PG8_WAIT_L(0); PG8_MMA(0, 0, At, B0); PG8_BAR; PG8_SCHED;
            PG8_LDB(B1, 1, 1); PG8_STAGE(PG8_SB(1, 0), b3, voffB);
            PG8_BAR; PG8_WAIT_L(0); PG8_MMA(0, 1, At, B1); PG8_BAR;
            PG8_LDA(At, 1, 1); PG8_STAGE(PG8_SA(1, 0), a3, voffA);
            PG8_BAR; PG8_WAIT_L(0); PG8_MMA(1, 0, At, B0); PG8_BAR; PG8_SCHED;
            PG8_STAGE(PG8_SB(1, 1), b3 + hstep, voffB);
            PG8_WAIT_V(6); PG8_BAR; PG8_MMA(1, 1, At, B1); PG8_BAR;
            }
        }
        if constexpr (ALIGN_EPI) { if (wr == 0) PG8_BAR; }
        bool keep = false;
        if constexpr (Epi::HAS_MID) keep = E.first_half(cur);
        if constexpr (!Epi::AFTER_DRAIN) { if (keep) E.mid(acc, cur, wr, wc, fr, fq); else E(acc, cur, wr, wc, fr, fq); S.done(cur); }
        if (!has_next) break;
        if (!keep) {
#pragma unroll
        for (int a = 0; a < 2; ++a)
#pragma unroll
            for (int b = 0; b < 2; ++b)
#pragma unroll
                for (int m = 0; m < 4; ++m)
#pragma unroll
                    for (int n = 0; n < 2; ++n) acc[a][b][m][n] = (f32x4){0.f, 0.f, 0.f, 0.f};
        }
        cur = nxt; cA = nA; cB = nB; ++ui;
        if constexpr (ALIGN_EPI) { if (wr == 1) PG8_BAR; }
    }
    PG8_WAIT_V(0);
    if constexpr (!ALIGN_EPI) { if (wr == 0) PG8_BAR; }
    PG8_BAR;
    if constexpr (Epi::AFTER_DRAIN) { E.fused(acc, cur, wr, wc, fr, fq, lds, wid, lane); S.done(cur); }
#undef PG8_SA
#undef PG8_SB
#undef PG8_STAGE
#undef PG8_RS_voffA
#undef PG8_RS_voffB
#undef PG8_LDA
#undef PG8_LDB
#undef PG8_MMA
#undef PG8_WAIT_V
#undef PG8_WAIT_L
#undef PG8_BAR
#undef PG8_SCHED
}
}

#define GAS __attribute__((address_space(1)))
#define LAS __attribute__((address_space(3)))
typedef unsigned short bf16;
typedef float f32x4 __attribute__((ext_vector_type(4)));
typedef short bf16x8 __attribute__((ext_vector_type(8)));
typedef unsigned u32x4 __attribute__((ext_vector_type(4)));
typedef unsigned u32x2 __attribute__((ext_vector_type(2)));
typedef GAS unsigned gu32;

constexpr int NWAVES = 8;
constexpr int D = 1024, SEQ = 8192, NBATCH = 2, NMETA = 16, LTOT = SEQ + NMETA;
constexpr int M = NBATCH * SEQ;
constexpr int MP = M + 256;
constexpr int INW = 4352;
constexpr int NCH = LTOT / 16;
constexpr int NE = 32, TOPK = 4;
constexpr int MAXT = M * TOPK / 256 + NE;
constexpr int NSLOT = MAXT * 256;
constexpr int VP = 8320;
constexpr float RMS_EPS = 1e-5f;

constexpr size_t MiB = 1ull << 20;
constexpr size_t WS_CTL = 0, CTL_ZERO_BYTES = 65536;
constexpr size_t WS_ROT = 1 * MiB;
constexpr size_t WS_TOK = 2 * MiB;
constexpr size_t WS_SSMP = 4 * MiB;
constexpr size_t WS_WIN = 32 * MiB;
constexpr size_t WS_WGLU = 41 * MiB;
constexpr size_t WS_WBR = 43 * MiB;
constexpr size_t WS_WOUT = 47 * MiB;
constexpr size_t WS_WGU = 49 * MiB;
constexpr size_t WS_WDN = 177 * MiB;
constexpr size_t WS_XN = 241 * MiB;
constexpr size_t WS_U = 274 * MiB;
constexpr size_t WS_Q = 307 * MiB;
constexpr size_t WS_K = 339 * MiB;
constexpr size_t WS_VT = 344 * MiB;
constexpr size_t WS_GS = 349 * MiB;
constexpr size_t WS_GA = 381 * MiB;
constexpr size_t WS_Z = 413 * MiB;
constexpr size_t WS_BRA = 445 * MiB;
constexpr size_t WS_MIX = 509 * MiB;
constexpr size_t WS_H1 = 541 * MiB;
constexpr size_t WS_HN2 = 605 * MiB;
constexpr size_t WS_S16 = 637 * MiB;
constexpr size_t WS_XC = 671 * MiB;
constexpr size_t WS_XS = 241 * MiB;
constexpr size_t WS_HID = 385 * MiB;
constexpr size_t WS_YS = 688 * MiB;
constexpr size_t WS_END = 832 * MiB;
static_assert((size_t)NSLOT * 2048 <= 144 * MiB, "slot buffers");
constexpr int CW_TMO = 0, CW_CNT = 1024, CW_BAR = 4096;

constexpr int RING_BYTES = 131072;
constexpr int LDSCTL_OFF = RING_BYTES;
constexpr int LDS_BYTES = 163840;

#define LDS_WAIT() asm volatile("s_waitcnt lgkmcnt(0)" ::: "memory")
#define VM_WAIT() asm volatile("s_waitcnt vmcnt(0)" ::: "memory")
#define RLX_AGENT __ATOMIC_RELAXED, __HIP_MEMORY_SCOPE_AGENT

__device__ __forceinline__ unsigned f2bf(float f) { unsigned u = __builtin_bit_cast(unsigned, f); return (u + 0x7fffu + ((u >> 16) & 1u)) >> 16; }
typedef float f32x2_t __attribute__((ext_vector_type(2))); typedef __bf16 bf16x2_t __attribute__((ext_vector_type(2)));
__device__ __forceinline__ unsigned pk2(float lo, float hi) { f32x2_t v = {lo, hi}; bf16x2_t b = __builtin_convertvector(v, bf16x2_t); return __builtin_bit_cast(unsigned, b); }
__device__ __forceinline__ float bflo(unsigned w) { return __uint_as_float(w << 16); }
__device__ __forceinline__ float bfhi(unsigned w) { return __uint_as_float(w & 0xffff0000u); }
__device__ __forceinline__ float bf2f(bf16 b) { return __uint_as_float((unsigned)b << 16); }
__device__ __forceinline__ float wave_sum(float v) {
#pragma unroll
    for (int o = 1; o < 64; o <<= 1) v += __shfl_xor(v, o);
    return v;
}
__device__ __forceinline__ float wave_max(float v) {
#pragma unroll
    for (int o = 1; o < 64; o <<= 1) v = fmaxf(v, __shfl_xor(v, o));
    return v;
}
__device__ __forceinline__ float sigmoidf_(float x) { return __builtin_amdgcn_rcpf(1.0f + __builtin_amdgcn_exp2f(-1.4426950408889634f * x)); }
__device__ __forceinline__ float gelu_tanh(float x) { const float e = __builtin_amdgcn_exp2f(x * (-2.3022082f + -0.1029432f * (x * x))); return x * __builtin_amdgcn_rcpf(1.0f + e); }
__device__ __forceinline__ void unpack8(u32x4 w, float (&v)[8]) { v[0] = bflo(w.x); v[1] = bfhi(w.x); v[2] = bflo(w.y); v[3] = bfhi(w.y); v[4] = bflo(w.z); v[5] = bfhi(w.z); v[6] = bflo(w.w); v[7] = bfhi(w.w); }
__device__ __forceinline__ u32x4 pack8(const float (&v)[8]) { u32x4 w; w.x = pk2(v[0], v[1]); w.y = pk2(v[2], v[3]); w.z = pk2(v[4], v[5]); w.w = pk2(v[6], v[7]); return w; }

__device__ __forceinline__ unsigned pk4_fp8(float a, float b, float c, float d) { unsigned w = 0u; w = __builtin_amdgcn_cvt_pk_fp8_f32(a, b, w, false); w = __builtin_amdgcn_cvt_pk_fp8_f32(c, d, w, true); return w; }
struct Args { const float* in[26]; float* out; unsigned char* ws; int ph_lo, ph_hi; };
struct Ctx { LAS unsigned char* lds; unsigned char* ws; int tid, lane, wave, G, bid, gw, ngw; };
using pg8::Unit;

template <class E>
__device__ __forceinline__ void naive_gemm_unit(const bf16* __restrict__ A, int lda, const bf16* __restrict__ Bt, int ldb, int K, int pm, int pn, const E& e, int wave, int lane) {
    const int fr = lane & 15, fq = lane >> 4;
    const int row0 = pm * 256 + wave * 32;
#pragma unroll 1
    for (int cg = 0; cg < 4; ++cg) {
        f32x4 acc[2][2][2];
#pragma unroll
        for (int i = 0; i < 2; ++i)
#pragma unroll
            for (int j = 0; j < 2; ++j)
#pragma unroll
                for (int n = 0; n < 2; ++n) acc[i][j][n] = (f32x4){0.f, 0.f, 0.f, 0.f};
#pragma unroll 1
        for (int half = 0; half < (E::HAS_MID ? 2 : 1); ++half) {
            const bf16* ap[2]; const bf16* bp[2][2];
#pragma unroll
            for (int mi = 0; mi < 2; ++mi) ap[mi] = A + (size_t)(half * M + row0 + 16 * mi + fr) * lda + 8 * fq;
#pragma unroll
            for (int bj = 0; bj < 2; ++bj)
#pragma unroll
                for (int n = 0; n < 2; ++n) bp[bj][n] = Bt + (size_t)(half * 1024 + pn * 256 + 128 * bj + 32 * cg + pg8::perm32(16 * n + fr)) * ldb + 8 * fq;
#pragma unroll 1
            for (int k0 = 0; k0 < K; k0 += 32) {
                bf16x8 av[2], bv[2][2];
#pragma unroll
                for (int mi = 0; mi < 2; ++mi) av[mi] = *(const bf16x8*)(ap[mi] + k0);
#pragma unroll
                for (int bj = 0; bj < 2; ++bj)
#pragma unroll
                    for (int n = 0; n < 2; ++n) bv[bj][n] = *(const bf16x8*)(bp[bj][n] + k0);
#pragma unroll
                for (int mi = 0; mi < 2; ++mi)
#pragma unroll
                    for (int bj = 0; bj < 2; ++bj)
#pragma unroll
                        for (int n = 0; n < 2; ++n) acc[mi][bj][n] = __builtin_amdgcn_mfma_f32_16x16x32_bf16(bv[bj][n], av[mi], acc[mi][bj][n], 0, 0, 0);
            }
            if constexpr (E::HAS_MID) {
                if (half == 0) {
#pragma unroll
                    for (int mi = 0; mi < 2; ++mi) e.mid(row0 + 16 * mi + fr, pn * 256 + 32 * cg + 8 * fq, acc[mi][0][0], acc[mi][0][1], acc[mi][1][0], acc[mi][1][1]);
                }
            }
        }
#pragma unroll
        for (int mi = 0; mi < 2; ++mi) e.row8(row0 + 16 * mi + fr, pn * 256 + 32 * cg + 8 * fq, acc[mi][0][0], acc[mi][0][1], acc[mi][1][0], acc[mi][1][1], pm, pn);
    }
}
#ifndef EPI_FENCE
#define EPI_FENCE 0
#endif
template <class E> struct FastEpi {
    static constexpr bool PERM = true, AFTER_DRAIN = false, HAS_MID = E::HAS_MID;
    E e;
    __device__ __forceinline__ void operator()(const f32x4 (&acc)[2][2][4][2], const Unit& u, int wr, int wc, int fr, int fq) const {
#pragma unroll
        for (int ai = 0; ai < 2; ++ai)
#pragma unroll
            for (int m = 0; m < 4; ++m) {
                e.row8(u.pm * 256 + ai * 128 + wr * 64 + m * 16 + fr, u.pn * 256 + wc * 32 + 8 * fq, acc[ai][0][m][0], acc[ai][0][m][1], acc[ai][1][m][0], acc[ai][1][m][1], u.pm, u.pn);
                if constexpr (EPI_FENCE > 0) { if ((m % EPI_FENCE) == EPI_FENCE - 1) asm volatile("" ::: "memory"); } }
    }
    __device__ __forceinline__ bool first_half(const Unit& u) const { if constexpr (E::HAS_MID) return u.pm < M / 256; else return false; }
    __device__ __forceinline__ void mid(f32x4 (&acc)[2][2][4][2], const Unit& u, int wr, int wc, int fr, int fq) const {
        if constexpr (E::HAS_MID) {
#pragma unroll
            for (int ai = 0; ai < 2; ++ai)
#pragma unroll
                for (int m = 0; m < 4; ++m)
                    e.mid(u.pm * 256 + ai * 128 + wr * 64 + m * 16 + fr, u.pn * 256 + wc * 32 + 8 * fq, acc[ai][0][m][0], acc[ai][0][m][1], acc[ai][1][m][0], acc[ai][1][m][1]);
        }
    }
};
struct PairOrder {
    pg8::StaticOrder so;
    __device__ __forceinline__ bool next(int i, Unit& u) const { Unit t; if (!so.next(i >> 1, t)) return false; const int h = i & 1; u.pm = t.pm + h * (M / 256); u.pn = t.pn + h * 4; return true; }
    __device__ __forceinline__ void a_ready(const Unit&) const {}
    __device__ __forceinline__ void done(const Unit&) const {}
};
struct RowMajorOrder {
    int nN, nwg, G, c;
    __device__ __forceinline__ bool next(int i, Unit& u) const { const long L = (long)i * G + c; if (L >= nwg) return false; u.pm = (int)L / nN; u.pn = (int)L % nN; return true; }
    __device__ __forceinline__ void a_ready(const Unit&) const {}
    __device__ __forceinline__ void done(const Unit&) const {}
};
struct InProjOrder {
    pg8::StaticOrder so;
    __device__ __forceinline__ bool next(int i, Unit& u) const { if (!so.next(i, u)) return false; if (u.pn == 15 && u.pm < 5) { u.pn = u.pm < 4 ? u.pm : 8; u.pm = M / 256; } return true; }
    __device__ __forceinline__ void a_ready(const Unit&) const {}
    __device__ __forceinline__ void done(const Unit&) const {}
};
struct DeferredOrder {
    int j;
    __device__ __forceinline__ bool next(int i, Unit& u) const { if (i != 0 || j < 0 || j >= 69) return false; if (j < 64) { u.pm = j; u.pn = 16; } else { u.pm = j - 64; u.pn = 15; } return true; }
    __device__ __forceinline__ void a_ready(const Unit&) const {}
    __device__ __forceinline__ void done(const Unit&) const {}
};
struct MoeOrder {
    const LAS int* tile_e; int ntiles, nct, G, c;
    __device__ __forceinline__ bool next(int i, Unit& u) const {
        if ((G & 7) != 0) { const long L = (long)i * G + c; if (L >= (long)ntiles * nct) return false; u.pm = (int)L / nct; u.pn = __builtin_amdgcn_readfirstlane(tile_e[u.pm]) * nct + (int)L % nct; return true; }
        const int per = G >> 3, x = c & 7, j = c >> 3, rpb = 32 / nct;
        const long slot = (long)i * per + j;
        const long blk = (slot >> 5) * 8 + x; const int w = (int)(slot & 31);
        const long rt = blk * rpb + w / nct;
        if (rt >= ntiles) return false;
        u.pm = (int)rt; u.pn = __builtin_amdgcn_readfirstlane(tile_e[rt]) * nct + w % nct; return true; }
    __device__ __forceinline__ void a_ready(const Unit&) const {}
    __device__ __forceinline__ void done(const Unit&) const {}
};

__device__ __forceinline__ void f4to8(f32x4 a0, f32x4 a1, float (&v)[8]) { v[0] = a0[0]; v[1] = a0[1]; v[2] = a0[2]; v[3] = a0[3]; v[4] = a1[0]; v[5] = a1[1]; v[6] = a1[2]; v[7] = a1[3]; }

struct EpiInProj {
    static constexpr bool HAS_MID = false;
    bf16 *U, *Q, *Kb, *Vt, *GSp, *GAp; const float* rot;
    __device__ __forceinline__ void one(int row, int col, f32x4 v0, f32x4 v1) const {
        const bool meta = row >= M;
        if (meta) { if (row >= M + NMETA) return; if (!(col < 1024 || (col >= 2048 && col < 2304))) return; }
        const int pos = meta ? row - M : NMETA + (row & (SEQ - 1));
        const int b0 = meta ? 0 : (row >> 13), nb = meta ? 2 : 1;
        float v[8]; f4to8(v0, v1, v);
        if (col < 1024) {
            const int g = col >> 4, h0 = col & 15; const u32x4 w = pack8(v);
            for (int bi = 0; bi < nb; ++bi) { const int b = b0 + bi; *(u32x4*)(U + ((size_t)((g * 2 + b) * NCH + (pos >> 4)) * 256 + (pos & 15) * 16 + h0)) = w; }
        } else if (col < 2176) {
            if ((col & 63) < 16) {
                const int i0 = (col & 8) ? 4 : 0; const float* cs = rot + pos * 16;
#pragma unroll
                for (int j = 0; j < 4; ++j) { const float c = cs[i0 + j], s = cs[8 + i0 + j], x1 = v[j], x2 = v[4 + j]; v[j] = x1 * c - x2 * s; v[4 + j] = x2 * c + x1 * s; }
            }
            if (col < 2048) {
#pragma unroll
                for (int j = 0; j < 8; ++j) v[j] *= 0.18033688011112042f;
                *(u32x4*)(Q + (size_t)row * 1024 + (col - 1024)) = pack8(v);
            } else {
                const u32x4 w = pack8(v);
                for (int bi = 0; bi < nb; ++bi) { const int b = b0 + bi; *(u32x4*)(Kb + ((size_t)(b * LTOT + pos)) * 128 + (col - 2048)) = w; }
            }
        } else if (col < 2304) {
            const u32x4 w = pack8(v);
            for (int bi = 0; bi < nb; ++bi) { const int b = b0 + bi; *(u32x4*)(Vt + ((size_t)(b * LTOT + pos)) * 128 + (col - 2176)) = w; }
        } else {
#pragma unroll
            for (int j = 0; j < 8; ++j) v[j] = sigmoidf_(v[j]);
            if (col < 3328) *(u32x4*)(GSp + (size_t)row * 1024 + (col - 2304)) = pack8(v);
            else *(u32x4*)(GAp + (size_t)row * 1024 + (col - 3328)) = pack8(v);
        }
    }
    __device__ __forceinline__ void row8(int row, int col, f32x4 a0, f32x4 a1, f32x4 b0, f32x4 b1, int, int) const { one(row, col, a0, a1); one(row, col + 128, b0, b1); }
};
struct EpiGlu {
    static constexpr bool HAS_MID = false;
    const bf16* Z; const float* bias; bf16* O;
    __device__ __forceinline__ void one(int row, int col, f32x4 v0, f32x4 v1) const {
        float v[8], z[8]; f4to8(v0, v1, v); unpack8(*(const u32x4*)(Z + (size_t)row * 1024 + col), z);
        const f32x4 c0 = *(const f32x4*)(bias + col), c1 = *(const f32x4*)(bias + col + 4); float bb[8]; f4to8(c0, c1, bb);
#pragma unroll
        for (int j = 0; j < 8; ++j) v[j] = z[j] * sigmoidf_(v[j] + bb[j]);
        *(u32x4*)(O + (size_t)row * 1024 + col) = pack8(v);
    }
    __device__ __forceinline__ void row8(int row, int col, f32x4 a0, f32x4 a1, f32x4 b0, f32x4 b1, int, int) const { one(row, col, a0, a1); one(row, col + 128, b0, b1); }
};
struct EpiBr {
    static constexpr bool HAS_MID = true;
    const bf16* GSp; const bf16* GAp; bf16* MIX;
    __device__ __forceinline__ void mid1(int row, int col, f32x4& v0, f32x4& v1) const {
        float gs[8], ga[8]; unpack8(*(const u32x4*)(GSp + (size_t)row * 1024 + col), gs); unpack8(*(const u32x4*)(GAp + (size_t)row * 1024 + col), ga);
#pragma unroll
        for (int j = 0; j < 4; ++j) { v0[j] *= gs[j] * __builtin_amdgcn_rcpf(fmaxf(ga[j], 1e-20f)); v1[j] *= gs[4 + j] * __builtin_amdgcn_rcpf(fmaxf(ga[4 + j], 1e-20f)); }
    }
    __device__ __forceinline__ void mid(int row, int col, f32x4& a0, f32x4& a1, f32x4& b0, f32x4& b1) const { mid1(row, col, a0, a1); mid1(row, col + 128, b0, b1); }
    __device__ __forceinline__ void one(int row, int col, f32x4 v0, f32x4 v1) const {
        float v[8], ga[8]; f4to8(v0, v1, v); unpack8(*(const u32x4*)(GAp + (size_t)row * 1024 + col), ga);
#pragma unroll
        for (int j = 0; j < 8; ++j) v[j] *= ga[j];
        *(u32x4*)(MIX + (size_t)row * 1024 + col) = pack8(v);
    }
    __device__ __forceinline__ void row8(int row, int col, f32x4 a0, f32x4 a1, f32x4 b0, f32x4 b1, int, int) const {
        if (row >= M) { row -= M; col -= 1024; }
        one(row, col, a0, a1); one(row, col + 128, b0, b1); }
};
struct EpiOut {
    static constexpr bool HAS_MID = false;
    const float* X; float* H1;
    __device__ __forceinline__ void one(int row, int col, f32x4 v0, f32x4 v1) const {
        const size_t o = (size_t)row * 1024 + col;
        *(f32x4*)(H1 + o) = *(const f32x4*)(X + o) + v0; *(f32x4*)(H1 + o + 4) = *(const f32x4*)(X + o + 4) + v1;
    }
    __device__ __forceinline__ void row8(int row, int col, f32x4 a0, f32x4 a1, f32x4 b0, f32x4 b1, int, int) const { one(row, col, a0, a1); one(row, col + 128, b0, b1); }
};
struct EpiMoe1 {
    static constexpr bool HAS_MID = false;
    const float* bgu; const float* SR; unsigned char* HID;
    __device__ __forceinline__ void row8(int row, int col, f32x4 a0, f32x4 a1, f32x4 b0, f32x4 b1, int, int pn) const {
        const int e = pn >> 3, ct = pn & 7, j0 = 128 * ct + (col - pn * 256); const float rs = SR[row] * 0.0625f;
        float g[8], up[8], bg[8], bu[8]; f4to8(a0 * rs, a1 * rs, g); f4to8(b0 * rs, b1 * rs, up);
        const float* bp = bgu + (size_t)e * 2048 + j0;
        f4to8(*(const f32x4*)bp, *(const f32x4*)(bp + 4), bg); f4to8(*(const f32x4*)(bp + 1024), *(const f32x4*)(bp + 1028), bu);
#pragma unroll
        for (int j = 0; j < 8; ++j) { const float gg = fminf(g[j] + bg[j], 7.0f), uu = fminf(fmaxf(up[j] + bu[j], -7.0f), 7.0f); g[j] = gg * sigmoidf_(1.702f * gg) * (uu + 1.0f); }
        u32x2 w; w.x = pk4_fp8(g[0], g[1], g[2], g[3]); w.y = pk4_fp8(g[4], g[5], g[6], g[7]); *(u32x2*)(HID + (size_t)row * 1024 + j0) = w;
    }
};
struct EpiMoe2 {
    static constexpr bool HAS_MID = false;
    const float* bd; const float* SG; unsigned char* YS;
    __device__ __forceinline__ void one(int row, int e, int c0, f32x4 v0, f32x4 v1, float gt) const {
        float v[8], bb[8]; f4to8(v0, v1, v); const float* bp = bd + (size_t)e * 1024 + c0; f4to8(*(const f32x4*)bp, *(const f32x4*)(bp + 4), bb);
#pragma unroll
        for (int j = 0; j < 8; ++j) v[j] = (v[j] + bb[j] * 16.0f) * gt;
        u32x2 w; w.x = pk4_fp8(v[0], v[1], v[2], v[3]); w.y = pk4_fp8(v[4], v[5], v[6], v[7]); *(u32x2*)(YS + (size_t)row * 1024 + c0) = w;
    }
    __device__ __forceinline__ void row8(int row, int col, f32x4 a0, f32x4 a1, f32x4 b0, f32x4 b1, int, int pn) const {
        const int e = pn >> 2, ct = pn & 3, c0 = 256 * ct + (col - pn * 256); const float gt = SG[row];
        one(row, e, c0, a0, a1, gt); one(row, e, c0 + 128, b0, b1, gt);
    }
};
#define XB_TMO      128
#define XB_XCNT(j)  (256  + 64 * (j))
#define XB_XSUB(j)  (1280 + 64 * (j))
#define XB_XGEN(j)  (2304 + 64 * (j))
#define XB_TOP      3328
#define XB_TOPGEN   3392
#define XCD_BAR_WORDS 3456
#define XB_SPIN_CAP (1u << 18)

__device__ __forceinline__ unsigned xb_ld(unsigned* p)              { return __hip_atomic_load(p, __ATOMIC_RELAXED, __HIP_MEMORY_SCOPE_AGENT); }
__device__ __forceinline__ unsigned xb_add(unsigned* p, unsigned v) { return __hip_atomic_fetch_add(p, v, __ATOMIC_RELAXED, __HIP_MEMORY_SCOPE_AGENT); }
__device__ __forceinline__ unsigned xb_xcc_id() { return (unsigned)__builtin_amdgcn_s_getreg((3 << 11) | 20) & 0xFu; }
#define XB_SPIN(cond, bar) do { unsigned _sp = 0; while (cond) { __builtin_amdgcn_s_sleep(1); \
    if ((++_sp & 255u) == 0u) { if (xb_ld(&(bar)[XB_TMO])) break; if (_sp > XB_SPIN_CAP) { atomicAdd(&(bar)[XB_TMO], 1u); break; } } } } while (0)

struct XcdBarrier {
    unsigned* bar; unsigned x;
    volatile LAS unsigned* st;
};

__device__ __forceinline__ XcdBarrier xcd_barrier_post(unsigned* bar, volatile LAS unsigned* st) {
    XcdBarrier b; b.bar = bar; b.x = xb_xcc_id(); b.st = st;
    if (threadIdx.x == 0) (void)xb_add(&bar[XB_XCNT(b.x)], 1u);
    return b;
}
__device__ __forceinline__ void xcd_barrier_complete(unsigned* bar, unsigned x, unsigned& nloc, unsigned& nx) {
    const unsigned G = gridDim.x * gridDim.y * gridDim.z;
    unsigned sum, cnt, mine, sp = 0u;
    for (;;) {
        sum = 0u; cnt = 0u; mine = 0u;
#pragma unroll
        for (unsigned j = 0; j < 16; ++j) { const unsigned c = xb_ld(&bar[XB_XCNT(j)]); sum += c; cnt += (c > 0u) ? 1u : 0u; mine = (j == x) ? c : mine; }
        if (sum == G) break;
        __builtin_amdgcn_s_sleep(1);
        if ((++sp & 255u) == 0u) { if (xb_ld(&bar[XB_TMO])) break; if (sp > XB_SPIN_CAP) { atomicAdd(&bar[XB_TMO], 1u); break; } }
    }
    nloc = mine > 0u ? mine : 1u; nx = cnt > 0u ? cnt : 1u;
}

__device__ __forceinline__ void xcd_barrier(const XcdBarrier& b, const bool thread0) {
    asm volatile("s_waitcnt vmcnt(0)" ::: "memory");
    __syncthreads();
    if (thread0) {
        unsigned* bar = b.bar;
        __builtin_amdgcn_s_waitcnt(0);
        unsigned nloc = b.st[0], nx = b.st[1];
        if (nloc == 0u) { xcd_barrier_complete(bar, b.x, nloc, nx); b.st[0] = nloc; b.st[1] = nx; }
        const unsigned old = xb_add(&bar[XB_XSUB(b.x)], 1u);
        const unsigned gen = old / nloc;
        if (old + 1u == (gen + 1u) * nloc) {
            __builtin_amdgcn_fence(__ATOMIC_RELEASE, "agent");
            asm volatile("s_waitcnt vmcnt(0)" ::: "memory");
            const unsigned og = xb_add(&bar[XB_TOP], 1u);
            const unsigned tg = og / nx;
            if (og + 1u == (tg + 1u) * nx) xb_add(&bar[XB_TOPGEN], 1u);
            else XB_SPIN(xb_ld(&bar[XB_TOPGEN]) == tg, bar);
            __builtin_amdgcn_fence(__ATOMIC_ACQUIRE, "agent");
            xb_add(&bar[XB_XGEN(b.x)], 1u);
            asm volatile("s_waitcnt vmcnt(0)" ::: "memory");
        } else {
            XB_SPIN(xb_ld(&bar[XB_XGEN(b.x)]) == gen, bar);
            __builtin_amdgcn_fence(__ATOMIC_ACQUIRE, "agent");
            asm volatile("s_waitcnt vmcnt(0)" ::: "memory");
        }
    }
    __syncthreads();
}

constexpr size_t SSM_A16 = 1 * MiB, SSM_TF = 2 * MiB, SSM_VF = 4 * MiB, SSM_WF = 8 * MiB;
constexpr int NCI = 2 * NCH;
constexpr int NCB = (NCI + 15) / 16;
constexpr int CW_Q = 2048;

__device__ __forceinline__ void p0_ssm_prep(const Args& a, const Ctx& c, int g) {
    LAS float* AP = (LAS float*)(c.lds);
    LAS float* BBl = AP + 64 * 17 * 2;
    LAS float* Cc = BBl + 64 * 16 * 2;
    LAS float* Kt = Cc + 16 * 64 * 2;
    unsigned char* sp = c.ws + WS_SSMP;
    const int tid = c.tid;
    if (tid < 64) { const int p = tid, i = g * 64 + p;
        const float lr = a.in[4][i], li = a.in[5][i], dt = expf(a.in[6][g]);
        for (int tau = 0; tau <= 16; ++tau) { const float mag = expf((float)tau * dt * lr), ang = (float)tau * dt * li; AP[(p * 17 + tau) * 2] = mag * cosf(ang); AP[(p * 17 + tau) * 2 + 1] = mag * sinf(ang); }
        const float mag = expf(dt * lr), ar = mag * cosf(dt * li), ai = mag * sinf(dt * li);
        const float den = lr * lr + li * li, nr = ar - 1.0f, ni = ai, fr_ = (nr * lr + ni * li) / den, fi_ = (ni * lr - nr * li) / den;
        for (int h = 0; h < 16; ++h) { const float br = a.in[7][i * 16 + h], bi = a.in[8][i * 16 + h]; BBl[(p * 16 + h) * 2] = fr_ * br - fi_ * bi; BBl[(p * 16 + h) * 2 + 1] = fr_ * bi + fi_ * br; }
        float* A16 = (float*)(sp + SSM_A16); const float m16 = expf(16.0f * dt * lr), a16 = 16.0f * dt * li; A16[i * 2] = m16 * cosf(a16); A16[i * 2 + 1] = m16 * sinf(a16);
    }
    for (int idx = tid; idx < 1024; idx += NWAVES * 64) { const int h = idx >> 6, p = idx & 63; Cc[idx * 2] = a.in[9][(g * 16 + h) * 64 + p]; Cc[idx * 2 + 1] = a.in[10][(g * 16 + h) * 64 + p]; }
    __syncthreads();
    for (int idx = tid; idx < 4096; idx += NWAVES * 64) { const int tau = idx >> 8, h = (idx >> 4) & 15, hp = idx & 15; float s = 0.f;
        for (int p = 0; p < 64; ++p) { const float ar = AP[(p * 17 + tau) * 2], ai = AP[(p * 17 + tau) * 2 + 1], br = BBl[(p * 16 + hp) * 2], bi = BBl[(p * 16 + hp) * 2 + 1];
            const float gr = ar * br - ai * bi, gi = ar * bi + ai * br; s += Cc[(h * 64 + p) * 2] * gr - Cc[(h * 64 + p) * 2 + 1] * gi; }
        if (tau == 0 && h == hp) s += a.in[11][g * 16 + h];
        Kt[idx] = s; }
    __syncthreads();
    bf16* TF = (bf16*)(sp + SSM_TF); bf16* VF = (bf16*)(sp + SSM_VF); bf16* WF = (bf16*)(sp + SSM_WF);
    for (int idx = tid; idx < 1024; idx += NWAVES * 64) { const int dl = idx >> 6, ln = idx & 63, fr = ln & 15, fq = ln >> 4; float v[8];
#pragma unroll
        for (int e = 0; e < 8; ++e) { const int j = 8 * fq + e, tau = dl - (j >> 4), hp = j & 15; v[e] = tau >= 0 ? Kt[(tau * 16 + fr) * 16 + hp] : 0.f; }
        *(u32x4*)(TF + ((size_t)(g * 16 + dl) * 64 + ln) * 8) = pack8(v); }
    for (int idx = tid; idx < 4096; idx += NWAVES * 64) { const int t = idx >> 8, kx = (idx >> 6) & 3, ln = idx & 63, fr = ln & 15, fq = ln >> 4; float v[8];
#pragma unroll
        for (int e = 0; e < 8; ++e) { const int pp = 32 * kx + 8 * fq + e, p = pp & 63; const float cr = Cc[(fr * 64 + p) * 2], ci = Cc[(fr * 64 + p) * 2 + 1], ar = AP[(p * 17 + t + 1) * 2], ai = AP[(p * 17 + t + 1) * 2 + 1];
            v[e] = pp < 64 ? (cr * ar - ci * ai) : -(cr * ai + ci * ar); }
        *(u32x4*)(VF + ((size_t)((g * 16 + t) * 4 + kx) * 64 + ln) * 8) = pack8(v); }
    for (int idx = tid; idx < 4096; idx += NWAVES * 64) { const int pb = idx >> 9, ks = (idx >> 6) & 7, ln = idx & 63, fr = ln & 15, fq = ln >> 4, pp = 16 * pb + fr, p = pp & 63; float v[8];
#pragma unroll
        for (int e = 0; e < 8; ++e) { const int k = 32 * ks + 8 * fq + e, s = k >> 4, h = k & 15; const float ar = AP[(p * 17 + 15 - s) * 2], ai = AP[(p * 17 + 15 - s) * 2 + 1], br = BBl[(p * 16 + h) * 2], bi = BBl[(p * 16 + h) * 2 + 1];
            v[e] = pp < 64 ? (ar * br - ai * bi) : (ar * bi + ai * br); }
        *(u32x4*)(WF + ((size_t)((g * 8 + pb) * 8 + ks) * 64 + ln) * 8) = pack8(v); }
    __syncthreads();
}
__device__ __forceinline__ void ssm_phase_a(const Ctx& c) {
    const bf16* U = (const bf16*)(c.ws + WS_U); const bf16* WF = (const bf16*)(c.ws + WS_SSMP + SSM_WF); float* S16 = (float*)(c.ws + WS_S16);
    const int fr = c.lane & 15, fq = c.lane >> 4;
    for (int it = c.gw; it < 64 * NCB; it += c.ngw) {
        const int g = it / NCB, cb = it % NCB, cidx = 16 * cb + fr, cl = cidx < NCI ? cidx : NCI - 1;
        bf16x8 uf[8];
#pragma unroll
        for (int ks = 0; ks < 8; ++ks) uf[ks] = *(const bf16x8*)(U + ((size_t)(g * NCI + cl)) * 256 + 32 * ks + 8 * fq);
#pragma unroll 2
        for (int pb = 0; pb < 8; ++pb) { f32x4 acc = {0.f, 0.f, 0.f, 0.f};
#pragma unroll
            for (int ks = 0; ks < 8; ++ks) { const bf16x8 wf = *(const bf16x8*)(WF + ((size_t)((g * 8 + pb) * 8 + ks) * 64 + c.lane) * 8); acc = __builtin_amdgcn_mfma_f32_16x16x32_bf16(wf, uf[ks], acc, 0, 0, 0); }
            if (cidx < NCI) *(f32x4*)(S16 + ((size_t)(g * NCI + cidx)) * 128 + 16 * pb + 4 * fq) = acc; }
    }
}
__device__ __forceinline__ void ssm_carry(const Ctx& c) {
    LAS float* E = (LAS float*)(c.lds + LDSCTL_OFF + 4096);
    for (int it = c.bid; it < 128; it += c.G) {
        const int g = it >> 1, b = it & 1, p = c.lane, seg = c.wave, c0 = 64 * seg;
        const float* A16 = (const float*)(c.ws + WS_SSMP + SSM_A16); const float ar = A16[(g * 64 + p) * 2], ai = A16[(g * 64 + p) * 2 + 1];
        const float* sp = (const float*)(c.ws + WS_S16) + ((size_t)(g * NCI + b * NCH + c0)) * 128; bf16* xp = (bf16*)(c.ws + WS_XC) + ((size_t)(g * NCI + b * NCH + c0)) * 128;
        float lr[64], li[64];
#pragma unroll
        for (int j = 0; j < 64; ++j) { lr[j] = sp[j * 128 + p]; li[j] = sp[j * 128 + 64 + p]; }
        float xr = 0.f, xi = 0.f;
#pragma unroll
        for (int j = 0; j < 64; ++j) { const float tr = ar * xr - ai * xi + lr[j], ti = ar * xi + ai * xr + li[j]; xr = tr; xi = ti; lr[j] = xr; li[j] = xi; }
        __syncthreads();
        E[(seg * 64 + p) * 2] = xr; E[(seg * 64 + p) * 2 + 1] = xi;
        float a64r = ar, a64i = ai;
#pragma unroll
        for (int k = 0; k < 6; ++k) { const float tr = a64r * a64r - a64i * a64i, ti = 2.0f * a64r * a64i; a64r = tr; a64i = ti; }
        __syncthreads();
        float cr = 0.f, ci = 0.f;
        for (int s2 = 0; s2 < seg; ++s2) { const float er = E[(s2 * 64 + p) * 2], ei = E[(s2 * 64 + p) * 2 + 1]; const float tr = a64r * cr - a64i * ci + er, ti = a64r * ci + a64i * cr + ei; cr = tr; ci = ti; }
        float pr = ar, pi = ai; bf16* xq = xp + 128 + p;
#pragma unroll
        for (int j = 0; j < 64; ++j) { const float vr = lr[j] + pr * cr - pi * ci, vi = li[j] + pr * ci + pi * cr;
            xq[0] = (bf16)f2bf(vr); xq[64] = (bf16)f2bf(vi); xq += 128; asm volatile("" : "+v"(xq));
            const float tr = pr * ar - pi * ai, ti = pr * ai + pi * ar; pr = tr; pi = ti; }
    }
}
__device__ __forceinline__ void ssm_phase_c(const Ctx& c) {
    const bf16* U = (const bf16*)(c.ws + WS_U); const bf16* XC = (const bf16*)(c.ws + WS_XC); bf16* Z = (bf16*)(c.ws + WS_Z);
    const bf16* TF = (const bf16*)(c.ws + WS_SSMP + SSM_TF); const bf16* VF = (const bf16*)(c.ws + WS_SSMP + SSM_VF);
    const int fr = c.lane & 15, fq = c.lane >> 4;
    for (int it = c.bid; it < 256; it += c.G) {
        const int g = it >> 2, q = it & 3;
        __syncthreads();
        for (int idx = c.tid; idx < 4096; idx += NWAVES * 64) *(LAS u32x4*)(c.lds + idx * 16) = *(const u32x4*)(VF + (size_t)g * 32768 + idx * 8);
        bf16x8 tf[16];
#pragma unroll
        for (int dl = 0; dl < 16; ++dl) tf[dl] = *(const bf16x8*)(TF + ((size_t)(g * 16 + dl) * 64 + c.lane) * 8);
        __syncthreads();
        for (int cb = q + 4 * c.wave; cb < NCB; cb += 32) {
            const int cidx = 16 * cb + fr, cl = cidx < NCI ? cidx : NCI - 1;
            bf16x8 uf[8], xf[4];
#pragma unroll
            for (int ks = 0; ks < 8; ++ks) uf[ks] = *(const bf16x8*)(U + ((size_t)(g * NCI + cl)) * 256 + 32 * ks + 8 * fq);
#pragma unroll
            for (int kx = 0; kx < 4; ++kx) xf[kx] = *(const bf16x8*)(XC + ((size_t)(g * NCI + cl)) * 128 + 32 * kx + 8 * fq);
            const int b = cidx >= NCH ? 1 : 0, cc = cidx - b * NCH; const bool ok = cidx < NCI && cc >= 1;
            bf16* zp = Z + (size_t)(b * SEQ + 16 * (cc - 1)) * 1024 + g * 16 + 4 * fq;
#pragma unroll
            for (int t = 0; t < 16; ++t) { f32x4 acc = {0.f, 0.f, 0.f, 0.f};
#pragma unroll
                for (int ks = 0; ks <= t / 2; ++ks) acc = __builtin_amdgcn_mfma_f32_16x16x32_bf16(tf[t - 2 * ks], uf[ks], acc, 0, 0, 0);
#pragma unroll
                for (int kx = 0; kx < 4; ++kx) { const bf16x8 vf = *(const LAS bf16x8*)(c.lds + ((t * 4 + kx) * 64 + c.lane) * 16); acc = __builtin_amdgcn_mfma_f32_16x16x32_bf16(vf, xf[kx], acc, 0, 0, 0); }
                if (ok) { u32x2 w; w.x = pk2(gelu_tanh(acc[0]), gelu_tanh(acc[1])); w.y = pk2(gelu_tanh(acc[2]), gelu_tanh(acc[3])); *(u32x2*)(zp + (size_t)t * 1024) = w; }
                asm volatile("" ::: "memory"); }
        }
    }
}

__device__ __forceinline__ float ld_sc1_f32(const float* p) { return __uint_as_float(__hip_atomic_load((const unsigned*)p, RLX_AGENT)); }
__device__ __forceinline__ void ssm_chain(const Ctx& c, int g, int b) {
    const int fr = c.lane & 15, fq = c.lane >> 4, w = c.wave, p = c.lane;
    const bf16* Ub = (const bf16*)(c.ws + WS_U) + ((size_t)(g * NCI + b * NCH)) * 256;
    float* Sb = (float*)(c.ws + WS_S16) + ((size_t)(g * NCI + b * NCH)) * 128;
    bf16* Xb = (bf16*)(c.ws + WS_XC) + ((size_t)(g * NCI + b * NCH)) * 128;
    bf16* Z = (bf16*)(c.ws + WS_Z);
    const bf16* TF = (const bf16*)(c.ws + WS_SSMP + SSM_TF); const bf16* VF = (const bf16*)(c.ws + WS_SSMP + SSM_VF); const bf16* WF = (const bf16*)(c.ws + WS_SSMP + SSM_WF);
    LAS float* E = (LAS float*)(c.lds + LDSCTL_OFF + 4096);
    __syncthreads();
    for (int idx = c.tid; idx < 4096; idx += NWAVES * 64) { *(LAS u32x4*)(c.lds + idx * 16) = *(const u32x4*)(VF + (size_t)g * 32768 + idx * 8); *(LAS u32x4*)(c.lds + 65536 + idx * 16) = *(const u32x4*)(WF + (size_t)g * 32768 + idx * 8); }
    {
        __syncthreads();
#pragma unroll 1
        for (int h2 = 0; h2 < 2; ++h2) {
            bf16x8 uf[2][8];
#pragma unroll
            for (int i = 0; i < 2; ++i)
#pragma unroll
                for (int ks = 0; ks < 8; ++ks) uf[i][ks] = *(const bf16x8*)(Ub + (size_t)(16 * (w + 8 * (2 * h2 + i)) + fr) * 256 + 32 * ks + 8 * fq);
#pragma unroll
            for (int i = 0; i < 2; ++i) {
#pragma unroll 2
                for (int pb = 0; pb < 8; ++pb) { f32x4 acc = {0.f, 0.f, 0.f, 0.f};
#pragma unroll
                    for (int ks = 0; ks < 8; ++ks) acc = __builtin_amdgcn_mfma_f32_16x16x32_bf16(*(const LAS bf16x8*)(c.lds + 65536 + ((pb * 8 + ks) * 64 + c.lane) * 16), uf[i][ks], acc, 0, 0, 0);
                    *(f32x4*)(Sb + (size_t)(16 * (w + 8 * (2 * h2 + i)) + fr) * 128 + 16 * pb + 4 * fq) = acc; }
            }
        }
    }
    VM_WAIT(); __syncthreads();
    {
        const float* A16 = (const float*)(c.ws + WS_SSMP + SSM_A16); const float ar = A16[(g * 64 + p) * 2], ai = A16[(g * 64 + p) * 2 + 1];
        const float* sp = Sb + (size_t)(64 * w) * 128;
        float xr = 0.f, xi = 0.f;
#pragma unroll 1
        for (int h2 = 0; h2 < 2; ++h2) { float lr[32], li[32];
#pragma unroll
            for (int j = 0; j < 32; ++j) { lr[j] = ld_sc1_f32(sp + (32 * h2 + j) * 128 + p); li[j] = ld_sc1_f32(sp + (32 * h2 + j) * 128 + 64 + p); }
#pragma unroll
            for (int j = 0; j < 32; ++j) { const float tr = ar * xr - ai * xi + lr[j], ti = ar * xi + ai * xr + li[j]; xr = tr; xi = ti; } }
        E[(w * 64 + p) * 2] = xr; E[(w * 64 + p) * 2 + 1] = xi;
        float a64r = ar, a64i = ai;
#pragma unroll
        for (int k = 0; k < 6; ++k) { const float tr = a64r * a64r - a64i * a64i, ti = 2.0f * a64r * a64i; a64r = tr; a64i = ti; }
        __syncthreads();
        xr = 0.f; xi = 0.f;
        for (int s2 = 0; s2 < w; ++s2) { const float er = E[(s2 * 64 + p) * 2], ei = E[(s2 * 64 + p) * 2 + 1]; const float tr = a64r * xr - a64i * xi + er, ti = a64r * xi + a64i * xr + ei; xr = tr; xi = ti; }
        bf16* xq = Xb + (size_t)(64 * w + 1) * 128 + p;
#pragma unroll 1
        for (int h2 = 0; h2 < 2; ++h2) { float lr[32], li[32];
#pragma unroll
            for (int j = 0; j < 32; ++j) { lr[j] = ld_sc1_f32(sp + (32 * h2 + j) * 128 + p); li[j] = ld_sc1_f32(sp + (32 * h2 + j) * 128 + 64 + p); }
#pragma unroll
            for (int j = 0; j < 32; ++j) { const float tr = ar * xr - ai * xi + lr[j], ti = ar * xi + ai * xr + li[j]; xr = tr; xi = ti;
                xq[0] = (bf16)f2bf(xr); xq[64] = (bf16)f2bf(xi); xq += 128; asm volatile("" : "+v"(xq)); } }
    }
    VM_WAIT(); __syncthreads();
    {
        bf16x8 tf[16];
#pragma unroll
        for (int dl = 0; dl < 16; ++dl) tf[dl] = *(const bf16x8*)(TF + ((size_t)(g * 16 + dl) * 64 + c.lane) * 8);
        bf16x8 uf[8], xf[4], un[8], xn[4];
        { const int cl = 16 * w + fr;
#pragma unroll
            for (int ks = 0; ks < 8; ++ks) uf[ks] = *(const bf16x8*)(Ub + (size_t)cl * 256 + 32 * ks + 8 * fq);
#pragma unroll
            for (int kx = 0; kx < 4; ++kx) xf[kx] = *(const bf16x8*)(Xb + (size_t)cl * 128 + 32 * kx + 8 * fq); }
#pragma unroll 1
        for (int cb = w; cb < 33; cb += 8) {
            const int ci_ = 16 * cb + fr;
            if (cb + 8 < 33) { const int cn = 16 * (cb + 8) + fr, cl = cn < NCH ? cn : NCH - 1;
#pragma unroll
                for (int ks = 0; ks < 8; ++ks) un[ks] = *(const bf16x8*)(Ub + (size_t)cl * 256 + 32 * ks + 8 * fq);
#pragma unroll
                for (int kx = 0; kx < 4; ++kx) xn[kx] = *(const bf16x8*)(Xb + (size_t)cl * 128 + 32 * kx + 8 * fq); }
            const bool ok = ci_ >= 1 && ci_ < NCH;
            bf16* zp = Z + (size_t)(b * SEQ + 16 * (ci_ - 1)) * 1024 + g * 16 + 4 * fq;
#pragma unroll
            for (int t = 0; t < 16; ++t) { f32x4 acc = {0.f, 0.f, 0.f, 0.f};
#pragma unroll
                for (int ks = 0; ks <= t / 2; ++ks) acc = __builtin_amdgcn_mfma_f32_16x16x32_bf16(tf[t - 2 * ks], uf[ks], acc, 0, 0, 0);
#pragma unroll
                for (int kx = 0; kx < 4; ++kx) { const bf16x8 vf = *(const LAS bf16x8*)(c.lds + ((t * 4 + kx) * 64 + c.lane) * 16); acc = __builtin_amdgcn_mfma_f32_16x16x32_bf16(vf, xf[kx], acc, 0, 0, 0); }
                if (ok) { u32x2 wv; wv.x = pk2(gelu_tanh(acc[0]), gelu_tanh(acc[1])); wv.y = pk2(gelu_tanh(acc[2]), gelu_tanh(acc[3])); *(u32x2*)(zp + (size_t)t * 1024) = wv; }
                asm volatile("" ::: "memory"); }
#pragma unroll
            for (int ks = 0; ks < 8; ++ks) uf[ks] = un[ks];
#pragma unroll
            for (int kx = 0; kx < 4; ++kx) xf[kx] = xn[kx];
        }
    }
}

template <bool FIRST>
__device__ __forceinline__ void attn_qblocks(LAS unsigned char* Ks, LAS unsigned char* Vs, const bf16* qp, bf16x8 (&qc)[2], bf16* ao, int t0, float sink, int fr, int fq) {
    constexpr int KST = 144, VST = 432;
#pragma unroll 2
    for (int qa = 0; qa < 4; ++qa) {
        bf16x8 qf[2]; qf[0] = qc[0]; qf[1] = qc[1];
        if (qa < 3) { qc[0] = *(const bf16x8*)(qp + (size_t)(16 * (qa + 1)) * 1024); qc[1] = *(const bf16x8*)(qp + (size_t)(16 * (qa + 1)) * 1024 + 32); }
        f32x4 s[10];
#pragma unroll
        for (int jb = 0; jb < 10; ++jb) { const int j = jb < 9 ? qa + jb : 12; f32x4 acc = {0.f, 0.f, 0.f, 0.f};
#pragma unroll
            for (int ks = 0; ks < 2; ++ks) { const bf16x8 kf = *(const LAS bf16x8*)(Ks + (16 * j + fr) * KST + (32 * ks + 8 * fq) * 2); acc = __builtin_amdgcn_mfma_f32_16x16x32_bf16(kf, qf[ks], acc, 0, 0, 0); }
            s[jb] = acc; }
#pragma unroll
        for (int i = 0; i < 4; ++i) { if (4 * fq + i - fr < 1) s[0][i] = -1e30f; if (4 * fq + i - fr > 0) s[8][i] = -1e30f; }
        if constexpr (FIRST) {
#pragma unroll
            for (int jb = 0; jb < 9; ++jb)
#pragma unroll
                for (int i = 0; i < 4; ++i) if (t0 - 128 + 16 * (qa + jb) + 4 * fq + i < 0) s[jb][i] = -1e30f; }
        float mx = sink;
#pragma unroll
        for (int jb = 0; jb < 10; ++jb) mx = fmaxf(fmaxf(mx, fmaxf(s[jb][0], s[jb][1])), fmaxf(s[jb][2], s[jb][3]));
        mx = fmaxf(mx, __shfl_xor(mx, 16)); mx = fmaxf(mx, __shfl_xor(mx, 32));
        float l = 0.f;
#pragma unroll
        for (int jb = 0; jb < 10; ++jb)
#pragma unroll
            for (int i = 0; i < 4; ++i) { s[jb][i] = __builtin_amdgcn_exp2f(s[jb][i] - mx); l += s[jb][i]; }
        l += __shfl_xor(l, 16); l += __shfl_xor(l, 32); l += __builtin_amdgcn_exp2f(sink - mx);
        f32x4 o[4];
#pragma unroll
        for (int db = 0; db < 4; ++db) o[db] = (f32x4){0.f, 0.f, 0.f, 0.f};
#pragma unroll
        for (int pr = 0; pr < 5; ++pr) { const int ja = qa + 2 * pr, jbk = pr < 4 ? qa + 2 * pr + 1 : 12;
            u32x4 pw; pw.x = pk2(s[2 * pr][0], s[2 * pr][1]); pw.y = pk2(s[2 * pr][2], s[2 * pr][3]); pw.z = pk2(s[2 * pr + 1][0], s[2 * pr + 1][1]); pw.w = pk2(s[2 * pr + 1][2], s[2 * pr + 1][3]);
            const bf16x8 pf = __builtin_bit_cast(bf16x8, pw);
#pragma unroll
            for (int db = 0; db < 4; ++db) { const u32x2 lo = *(const LAS u32x2*)(Vs + (16 * db + fr) * VST + (16 * ja + 4 * fq) * 2), hi = *(const LAS u32x2*)(Vs + (16 * db + fr) * VST + (16 * jbk + 4 * fq) * 2);
                u32x4 vw; vw.x = lo.x; vw.y = lo.y; vw.z = hi.x; vw.w = hi.y; o[db] = __builtin_amdgcn_mfma_f32_16x16x32_bf16(__builtin_bit_cast(bf16x8, vw), pf, o[db], 0, 0, 0); } }
        const float inv = __builtin_amdgcn_rcpf(l);
#pragma unroll
        for (int db = 0; db < 4; ++db) { u32x2 w; w.x = pk2(o[db][0] * inv, o[db][1] * inv); w.y = pk2(o[db][2] * inv, o[db][3] * inv); *(u32x2*)(ao + (size_t)(16 * qa) * 1024 + 16 * db) = w; }
    }
}
__device__ __forceinline__ void attn_fast(const Args& a, const Ctx& c) {
    const bf16* Q = (const bf16*)(c.ws + WS_Q); const bf16* Kb = (const bf16*)(c.ws + WS_K); const bf16* Vt = (const bf16*)(c.ws + WS_VT); bf16* AO = (bf16*)(c.ws + WS_BRA) + (size_t)M * 1024;
    unsigned* qctr = (unsigned*)(c.ws + WS_CTL) + CW_Q;
    LAS unsigned char* Ks = c.lds; LAS unsigned char* Vs = c.lds + 30720; volatile LAS int* uslot = (volatile LAS int*)(c.lds + LDSCTL_OFF + 64);
    constexpr int KST = 144, VST = 432;
    const int fr = c.lane & 15, fq = c.lane >> 4;
    volatile LAS int* ncall = (volatile LAS int*)(c.lds + LDSCTL_OFF + 68);
    __syncthreads(); if (c.tid == 0) *ncall = *ncall + 1; __syncthreads();
    const int qbase = (*ncall - 1) * (512 + c.G);
    int nxt = 0; if (c.tid == 0) nxt = (int)__hip_atomic_fetch_add(qctr, 1u, RLX_AGENT) - qbase;
    for (;;) {
        __syncthreads();
        if (c.tid == 0) *uslot = nxt;
        __syncthreads();
        const int unit = *uslot; if (unit >= 512) break;
        if (c.tid == 0) nxt = (int)__hip_atomic_fetch_add(qctr, 1u, RLX_AGENT) - qbase;
        const int b = unit >> 8, kvh = (unit >> 7) & 1, t0 = 64 * (unit & 127);
        const int head = kvh * 8 + c.wave;
        const bf16* qp = Q + (size_t)(b * SEQ + t0 + fr) * 1024 + head * 64 + 8 * fq;
        bf16x8 qc[2]; qc[0] = *(const bf16x8*)qp; qc[1] = *(const bf16x8*)(qp + 32);
        for (int idx = c.tid; idx < 1664; idx += NWAVES * 64) { const int row = idx >> 3, pc = idx & 7; int pos; bool ok = true;
            if (row < 192) { const int tok = t0 - 128 + row; ok = tok >= 0; pos = NMETA + tok; } else pos = row - 192;
            u32x4 v = {0u, 0u, 0u, 0u}; if (ok) v = *(const u32x4*)(Kb + ((size_t)(b * LTOT + pos)) * 128 + kvh * 64 + pc * 8);
            *(LAS u32x4*)(Ks + row * KST + pc * 16) = v; }
        for (int idx = c.tid; idx < 1664; idx += NWAVES * 64) { const int row = idx >> 3, pc = idx & 7; int pos; bool ok = true;
            if (row < 192) { const int tok = t0 - 128 + row; ok = tok >= 0; pos = NMETA + tok; } else pos = row - 192;
            u32x4 v = {0u, 0u, 0u, 0u}; if (ok) v = *(const u32x4*)(Vt + ((size_t)(b * LTOT + pos)) * 128 + kvh * 64 + pc * 8);
            LAS bf16* vd = (LAS bf16*)(Vs + (8 * pc) * VST + row * 2);
            vd[0 * (VST / 2)] = (bf16)(v.x & 0xffffu); vd[1 * (VST / 2)] = (bf16)(v.x >> 16); vd[2 * (VST / 2)] = (bf16)(v.y & 0xffffu); vd[3 * (VST / 2)] = (bf16)(v.y >> 16);
            vd[4 * (VST / 2)] = (bf16)(v.z & 0xffffu); vd[5 * (VST / 2)] = (bf16)(v.z >> 16); vd[6 * (VST / 2)] = (bf16)(v.w & 0xffffu); vd[7 * (VST / 2)] = (bf16)(v.w >> 16); }
        __syncthreads();
        const float sink = a.in[14][head] * 1.4426950408889634f;
        if (t0 < 128) attn_qblocks<true>(Ks, Vs, qp, qc, AO + (size_t)(b * SEQ + t0 + fr) * 1024 + head * 64 + 4 * fq, t0, sink, fr, fq);
        else attn_qblocks<false>(Ks, Vs, qp, qc, AO + (size_t)(b * SEQ + t0 + fr) * 1024 + head * 64 + 4 * fq, t0, sink, fr, fq);
    }
}

constexpr size_t SSM_WRF = 16 * MiB;
__device__ __forceinline__ void p0_router_frags(const Args& a, const Ctx& c) {
    bf16* WRF = (bf16*)(c.ws + WS_SSMP + SSM_WRF); const float* wr = a.in[19];
    const int gt = c.bid * (NWAVES * 64) + c.tid, ngt = c.G * NWAVES * 64;
    for (int idx = gt; idx < 4096; idx += ngt) { const int ks = idx >> 7, eb = (idx >> 6) & 1, ln = idx & 63, fr = ln & 15, fq = ln >> 4; float hi[8], lo[8];
#pragma unroll
        for (int e = 0; e < 8; ++e) { const float w = wr[(size_t)(32 * ks + 8 * fq + e) * 32 + 16 * eb + fr]; const float h = bf2f((bf16)f2bf(w)); hi[e] = h; lo[e] = w - h; }
        *(u32x4*)(WRF + (size_t)idx * 8) = pack8(hi); *(u32x4*)(WRF + 32768 + (size_t)idx * 8) = pack8(lo); }
}

__device__ __forceinline__ int swap23(int p) { return (p & 3) | ((p & 4) << 1) | ((p & 8) >> 1); }
__device__ __forceinline__ void tr_item(const float* __restrict__ W, int ldw, int k0, int n0src, bool perm, bf16* WT, int ldt, int rowdst0, int kdst, LAS float* scr, int lane) {
    float tv[32];
#pragma unroll
    for (int i = 0; i < 32; ++i) tv[i] = W[(size_t)(k0 + 2 * i + (lane >> 5)) * ldw + n0src + (lane & 31)];
#pragma unroll
    for (int i = 0; i < 32; ++i) scr[(2 * i + (lane >> 5)) * 33 + (lane & 31)] = tv[i];
    LDS_WAIT(); asm volatile("" ::: "memory");
    const int c = lane & 7;
#pragma unroll
    for (int j = 0; j < 4; ++j) { const int n = (lane >> 3) + 8 * j; const int ns = (perm && n < 16) ? swap23(n) : n; const LAS float* s = scr + (8 * c) * 33 + ns;
        u32x4 o; o.x = pk2(s[0 * 33], s[1 * 33]); o.y = pk2(s[2 * 33], s[3 * 33]); o.z = pk2(s[4 * 33], s[5 * 33]); o.w = pk2(s[6 * 33], s[7 * 33]);
        *(u32x4*)(WT + (size_t)(rowdst0 + n) * ldt + kdst + k0 + 8 * c) = o; }
    LDS_WAIT(); asm volatile("" ::: "memory");
}
struct Tr8Item { const float* src; unsigned char* dst; int ldw; };
__device__ __forceinline__ Tr8Item tr8_item_of(const Args& a, unsigned char* Wgu8, unsigned char* Wdn8, int id, int wave, int lane) {
    Tr8Item t;
    if (id < 2048) { const int e = id >> 6, kb = (id >> 3) & 7, jt = id & 7; const int col = lane < 32 ? 128 * jt + 4 * lane : 1024 + 128 * jt + 4 * (lane - 32);
        t.src = a.in[21] + (size_t)e * 1024 * 2048 + (size_t)(128 * kb + 16 * wave) * 2048 + col; t.ldw = 2048; t.dst = Wgu8 + (size_t)e * 2048 * 1024 + (size_t)(256 * jt) * 1024 + 128 * kb; }
    else { const int r = id - 2048, e = r >> 5, kb = (r >> 2) & 7, nb = r & 3;
        t.src = a.in[23] + (size_t)e * 1024 * 1024 + (size_t)(128 * kb + 16 * wave) * 1024 + 256 * nb + 4 * lane; t.ldw = 1024; t.dst = Wdn8 + (size_t)e * 1024 * 1024 + (size_t)(256 * nb) * 1024 + 128 * kb; }
    return t;
}
__device__ __forceinline__ void tr8_load(const Tr8Item& t, f32x4 (&v)[16]) {
#pragma unroll
    for (int j = 0; j < 16; ++j) v[j] = *(const f32x4*)(t.src + (size_t)j * t.ldw);
}
__device__ __forceinline__ void tr8_finish(const Tr8Item& t, const f32x4 (&v)[16], LAS unsigned char* tile, int tid, int wave, int lane) {
    __syncthreads();
#pragma unroll
    for (int cc = 0; cc < 4; ++cc) { u32x4 o;
        o.x = pk4_fp8(v[0][cc] * 16.0f, v[1][cc] * 16.0f, v[2][cc] * 16.0f, v[3][cc] * 16.0f);    o.y = pk4_fp8(v[4][cc] * 16.0f, v[5][cc] * 16.0f, v[6][cc] * 16.0f, v[7][cc] * 16.0f);
        o.z = pk4_fp8(v[8][cc] * 16.0f, v[9][cc] * 16.0f, v[10][cc] * 16.0f, v[11][cc] * 16.0f); o.w = pk4_fp8(v[12][cc] * 16.0f, v[13][cc] * 16.0f, v[14][cc] * 16.0f, v[15][cc] * 16.0f);
        *(LAS u32x4*)(tile + (4 * lane + cc) * 144 + 16 * wave) = o; }
    __syncthreads();
#pragma unroll
    for (int i = 0; i < 4; ++i) { const int p = tid + 512 * i, n = p >> 3, q = p & 7;
        *(u32x4*)(t.dst + (size_t)n * 1024 + 16 * q) = *(const LAS u32x4*)(tile + n * 144 + 16 * q); }
}
__device__ __forceinline__ void rms_row_to_bf16(const float* xrow, const float* gain, bf16* orow, int lane) {
    f32x4 v[4]; float s = 0.f;
#pragma unroll
    for (int j = 0; j < 4; ++j) { v[j] = *(const f32x4*)(xrow + 4 * lane + 256 * j); s += (v[j].x * v[j].x + v[j].y * v[j].y) + (v[j].z * v[j].z + v[j].w * v[j].w); }
    const float rstd = 1.0f / sqrtf(wave_sum(s) * (1.0f / D) + RMS_EPS);
#pragma unroll
    for (int j = 0; j < 4; ++j) { const f32x4 g = *(const f32x4*)(gain + 4 * lane + 256 * j); u32x2 w; w.x = pk2(v[j].x * rstd * g.x, v[j].y * rstd * g.y); w.y = pk2(v[j].z * rstd * g.z, v[j].w * rstd * g.w);
        *(u32x2*)(orow + 4 * lane + 256 * j) = w; }
}
#ifndef P0REP
#define P0REP 0
#endif
#ifdef FAST_MIX
constexpr bool FAST_MIX_P0 = FAST_MIX != 0;
#else
constexpr bool FAST_MIX_P0 = false;
#endif
__device__ __forceinline__ void p0_prologue(const Args& a, const Ctx& c) {
    for (int rp = 0; rp < 1 + (P0REP & 1); ++rp)
    for (int g = c.bid; g < 64; g += c.G) p0_ssm_prep(a, c, g);
    LAS float* scr = (LAS float*)(c.lds + c.wave * 16384);
    bf16* WinT = (bf16*)(c.ws + WS_WIN); bf16* WgluT = (bf16*)(c.ws + WS_WGLU); bf16* WbrT = (bf16*)(c.ws + WS_WBR); bf16* WoutT = (bf16*)(c.ws + WS_WOUT);
    unsigned char* Wgu8 = c.ws + WS_WGU; unsigned char* Wdn8 = c.ws + WS_WDN;
    constexpr int NI_IN = 16 * 136, NI_SQ = 512, NI_ALL = NI_IN + 4 * NI_SQ;
    for (int rp = 0; rp < 1 + ((P0REP >> 1) & 1); ++rp)
    for (int it = c.gw; it < NI_ALL; it += c.ngw) {
        int r = it;
        if (r < NI_IN) { const int kb = r / 136, nb = r % 136, n0 = 32 * nb; const bool perm = (n0 >= 1024 && n0 < 2176 && (n0 & 63) == 0);
            tr_item(a.in[3], INW, 64 * kb, n0, perm, WinT, 1024, n0, 0, scr, c.lane); continue; } r -= NI_IN;
        if (r < NI_SQ) { tr_item(a.in[12], 1024, 64 * (r >> 5), 32 * (r & 31), false, WgluT, 1024, 32 * (r & 31), 0, scr, c.lane); continue; } r -= NI_SQ;
        if (r < NI_SQ) { tr_item(a.in[15], 1024, 64 * (r >> 5), 32 * (r & 31), false, WbrT, 1024, 32 * (r & 31), 0, scr, c.lane); continue; } r -= NI_SQ;
        if (r < NI_SQ) { tr_item(a.in[16], 1024, 64 * (r >> 5), 32 * (r & 31), false, WbrT, 1024, 1024 + 32 * (r & 31), 0, scr, c.lane); continue; } r -= NI_SQ;
        tr_item(a.in[17], 1024, 64 * (r >> 5), 32 * (r & 31), false, WoutT, 1024, 32 * (r & 31), 0, scr, c.lane);
    }
    for (int rp = 0; rp < 1 + ((P0REP >> 2) & 1); ++rp)
    {
        f32x4 va[16], vb[16];
        int id = c.bid;
        Tr8Item ta = tr8_item_of(a, Wgu8, Wdn8, id < 3072 ? id : 0, c.wave, c.lane), tb = ta;
        if (id < 3072) tr8_load(ta, va);
        while (id < 3072) {
            const int id1 = id + c.G;
            if (id1 < 3072) { tb = tr8_item_of(a, Wgu8, Wdn8, id1, c.wave, c.lane); tr8_load(tb, vb); }
            tr8_finish(ta, va, c.lds, c.tid, c.wave, c.lane);
            if (id1 >= 3072) break;
            const int id2 = id1 + c.G;
            if (id2 < 3072) { ta = tr8_item_of(a, Wgu8, Wdn8, id2, c.wave, c.lane); tr8_load(ta, va); }
            tr8_finish(tb, vb, c.lds, c.tid, c.wave, c.lane);
            id = id2;
        }
        __syncthreads();
    }
    bf16* XN = (bf16*)(c.ws + WS_XN);
    for (int rp = 0; rp < 1 + ((P0REP >> 3) & 1); ++rp)
    for (int m = c.gw; m < MP; m += c.ngw) {
        if (m < M + NMETA) rms_row_to_bf16(m < M ? a.in[0] + (size_t)m * D : a.in[1] + (size_t)(m - M) * D, a.in[2], XN + (size_t)m * D, c.lane);
        else { u32x4 z = {0u, 0u, 0u, 0u}; *(u32x4*)(XN + (size_t)m * D + 8 * c.lane) = z; *(u32x4*)(XN + (size_t)m * D + 512 + 8 * c.lane) = z; }
    }
    p0_router_frags(a, c);
    const int gt = c.bid * (NWAVES * 64) + c.tid, ngt = c.G * NWAVES * 64;
    float* rot = (float*)(c.ws + WS_ROT);
    for (int i = gt; i < LTOT * 8; i += ngt) { const int pos = i >> 3, j = i & 7;
        const float invs[8] = {1.0f, 0.1939227432012558f, 0.03760603070259094f, 0.007292664609849453f, 0.0014142135623842478f, 0.00027424818836152554f, 5.318296098266728e-05f, 1.0313386155758053e-05f};
        float inv = invs[0];
#pragma unroll
        for (int q = 1; q < 8; ++q) inv = (j == q) ? invs[q] : inv;
        const float ang = (float)pos * inv; const double rev = (double)ang * 0.15915494309189535; const float fr_ = (float)(rev - floor(rev));
        rot[pos * 16 + j] = __builtin_amdgcn_cosf(fr_); rot[pos * 16 + 8 + j] = __builtin_amdgcn_sinf(fr_); }
    if constexpr (!FAST_MIX_P0) {
    float* Ab = (float*)(c.ws + WS_SSMP); float* BB = Ab + 16384;
    for (int i = gt; i < 4096; i += ngt) { const int g = i >> 6;
        const float lr = a.in[4][i], li = a.in[5][i], dt = expf(a.in[6][g]), mag = expf(dt * lr), ar = mag * cosf(dt * li), ai = mag * sinf(dt * li);
        const float den = lr * lr + li * li, nr = ar - 1.0f, ni = ai, fr = (nr * lr + ni * li) / den, fi = (ni * lr - nr * li) / den;
        Ab[2 * i] = ar; Ab[2 * i + 1] = ai;
        for (int h = 0; h < 16; ++h) { const float br = a.in[7][i * 16 + h], bi = a.in[8][i * 16 + h]; BB[(i * 16 + h) * 2] = fr * br - fi * bi; BB[(i * 16 + h) * 2 + 1] = fr * bi + fi * br; }
    }
    }
}

__device__ __forceinline__ void p2_ssm_naive(const Args& a, const Ctx& c) {
    const float* Ab = (const float*)(c.ws + WS_SSMP); const float* BB = Ab + 16384;
    const bf16* U = (const bf16*)(c.ws + WS_U); bf16* Z = (bf16*)(c.ws + WS_Z);
    for (int it = c.gw; it < 128; it += c.ngw) {
        const int g = it >> 1, b = it & 1, p = c.lane, gp = g * 64 + p;
        const float ar = Ab[2 * gp], ai = Ab[2 * gp + 1];
        float bbr[16], bbi[16], cr[16], ci[16], dd[16];
#pragma unroll
        for (int h = 0; h < 16; ++h) { bbr[h] = BB[(gp * 16 + h) * 2]; bbi[h] = BB[(gp * 16 + h) * 2 + 1]; cr[h] = a.in[9][(g * 16 + h) * 64 + p]; ci[h] = a.in[10][(g * 16 + h) * 64 + p]; dd[h] = a.in[11][g * 16 + h]; }
        float xr = 0.f, xi = 0.f;
        const bf16* up = U + (size_t)((g * 2 + b) * NCH) * 256;
        for (int t = 0; t < LTOT; ++t) {
            float u[16]; { float t0[8], t1[8]; unpack8(*(const u32x4*)(up + t * 16), t0); unpack8(*(const u32x4*)(up + t * 16 + 8), t1);
#pragma unroll
                for (int h = 0; h < 8; ++h) { u[h] = t0[h]; u[8 + h] = t1[h]; } }
            float br_ = 0.f, bi_ = 0.f;
#pragma unroll
            for (int h = 0; h < 16; ++h) { br_ += bbr[h] * u[h]; bi_ += bbi[h] * u[h]; }
            const float nxr = ar * xr - ai * xi + br_, nxi = ar * xi + ai * xr + bi_; xr = nxr; xi = nxi;
            if (t >= NMETA) {
                float mine = 0.f;
#pragma unroll
                for (int h = 0; h < 16; ++h) { float v = wave_sum(cr[h] * xr - ci[h] * xi); if (c.lane == h) mine = v + dd[h] * u[h]; }
                if (c.lane < 16) Z[(size_t)(b * SEQ + t - NMETA) * 1024 + g * 16 + c.lane] = (bf16)f2bf(gelu_tanh(mine));
            }
        }
    }
}
__device__ __forceinline__ float dot8(u32x4 q, u32x4 k) {
    return (bflo(q.x) * bflo(k.x) + bfhi(q.x) * bfhi(k.x)) + (bflo(q.y) * bflo(k.y) + bfhi(q.y) * bfhi(k.y)) + (bflo(q.z) * bflo(k.z) + bfhi(q.z) * bfhi(k.z)) + (bflo(q.w) * bflo(k.w) + bfhi(q.w) * bfhi(k.w));
}
__device__ __forceinline__ void p2_attn_naive(const Args& a, const Ctx& c) {
    const bf16* Q = (const bf16*)(c.ws + WS_Q); const bf16* Kb = (const bf16*)(c.ws + WS_K); const bf16* Vt = (const bf16*)(c.ws + WS_VT); bf16* BRA = (bf16*)(c.ws + WS_BRA);
    const int lane = c.lane;
    for (int it = c.gw; it < M * 16; it += c.ngw) {
        const int r = it >> 4, h = it & 15, kvh = h >> 3, b = r >> 13, t = r & (SEQ - 1);
        u32x4 qv[8];
#pragma unroll
        for (int i = 0; i < 8; ++i) qv[i] = *(const u32x4*)(Q + (size_t)r * 1024 + h * 64 + 8 * i);
        float s[3];
#pragma unroll
        for (int sl = 0; sl < 3; ++sl) {
            int pos; bool ok;
            if (sl < 2) { const int tok = t - 127 + lane + 64 * sl; ok = tok >= 0; pos = NMETA + (ok ? tok : 0); } else { ok = lane < NMETA; pos = ok ? lane : 0; }
            const bf16* kp = Kb + ((size_t)(b * LTOT + pos)) * 128 + kvh * 64; float acc = 0.f;
#pragma unroll
            for (int i = 0; i < 8; ++i) acc += dot8(qv[i], *(const u32x4*)(kp + 8 * i));
            s[sl] = ok ? acc : -1e30f;
        }
        const float sink = a.in[14][h] * 1.4426950408889634f;
        const float mx = wave_max(fmaxf(fmaxf(s[0], s[1]), fmaxf(s[2], sink)));
        const float p0 = exp2f(s[0] - mx), p1 = exp2f(s[1] - mx), p2 = exp2f(s[2] - mx);
        const float l = wave_sum(p0 + p1 + p2) + exp2f(sink - mx);
        const bf16* vrow = Vt + (size_t)(b * LTOT) * 128 + kvh * 64 + lane;
        float o = 0.f;
        for (int j = 0; j < 128; ++j) { const int tok = t - 127 + j; const float pj = __shfl(j < 64 ? p0 : p1, j & 63); if (tok >= 0) o += pj * bf2f(vrow[(size_t)(NMETA + tok) * 128]); }
        for (int j = 0; j < NMETA; ++j) { const float pj = __shfl(p2, j); o += pj * bf2f(vrow[(size_t)j * 128]); }
        BRA[(size_t)(M + r) * 1024 + h * 64 + lane] = (bf16)f2bf(o / l);
    }
}

__device__ __forceinline__ void p6_router(const Args& a, const Ctx& c) {
    const float* H1 = (const float*)(c.ws + WS_H1); unsigned char* XG = c.ws + WS_HN2;
    int* TE = (int*)(c.ws + WS_TOK); int* TP = TE + M * 4; float* TG = (float*)(TP + M * 4); float* RS = (float*)(c.ws + WS_TOK) + M * 16 + NSLOT * 2;
    unsigned* cnt = (unsigned*)(c.ws + WS_CTL) + CW_CNT;
    const float* brt = a.in[20];
    LAS float* gl = (LAS float*)(c.lds + LDSCTL_OFF + 8192);
    LAS unsigned* hist = (LAS unsigned*)(c.lds + LDSCTL_OFF + 12288); LAS unsigned* ebase = hist + 32;
    const int lane = c.lane, fr = lane & 15, fq = lane >> 4;
    __syncthreads();
    for (int idx = c.tid; idx < 8192; idx += NWAVES * 64) *(LAS u32x4*)(c.lds + idx * 16) = *(const u32x4*)(c.ws + WS_SSMP + SSM_WRF + (size_t)idx * 16);
    for (int idx = c.tid; idx < 1024; idx += NWAVES * 64) gl[idx] = a.in[18][idx];
    for (int t0 = 0; t0 < M / 16; t0 += 4 * c.G) {
        if (c.tid < 32) hist[c.tid] = 0u;
        __syncthreads();
        const int kh = c.wave >> 2;
        const int tile = t0 + (c.wave & 3) * c.G + c.bid; const bool work = tile < M / 16;
        LAS float* part = (LAS float*)(c.lds + LDSCTL_OFF + 16384) + ((c.wave & 3) * 64 + lane) * 9;
        int te[4]; unsigned rk[4]; const int row = 16 * tile + fr;
        f32x4 racc0 = {0.f, 0.f, 0.f, 0.f}, racc1 = {0.f, 0.f, 0.f, 0.f}; float rss = 0.f;
        if (work) {
            const float* xr = H1 + (size_t)row * D + 8 * fq;
            f32x4 acc0 = {0.f, 0.f, 0.f, 0.f}, acc1 = {0.f, 0.f, 0.f, 0.f}; float ss = 0.f;
#pragma unroll 4
            for (int ks = 16 * kh; ks < 16 * kh + 16; ++ks) {
                const f32x4 x0 = *(const f32x4*)(xr + 32 * ks), x1 = *(const f32x4*)(xr + 32 * ks + 4);
                const f32x4 g0 = *(const LAS f32x4*)(gl + 32 * ks + 8 * fq), g1 = *(const LAS f32x4*)(gl + 32 * ks + 8 * fq + 4);
                ss += (x0.x * x0.x + x0.y * x0.y) + (x0.z * x0.z + x0.w * x0.w) + (x1.x * x1.x + x1.y * x1.y) + (x1.z * x1.z + x1.w * x1.w);
                const f32x4 v0 = x0 * g0, v1 = x1 * g1;
                u32x4 hw; hw.x = pk2(v0.x, v0.y); hw.y = pk2(v0.z, v0.w); hw.z = pk2(v1.x, v1.y); hw.w = pk2(v1.z, v1.w);
                { u32x2 w8; w8.x = pk4_fp8(v0.x, v0.y, v0.z, v0.w); w8.y = pk4_fp8(v1.x, v1.y, v1.z, v1.w); *(u32x2*)(XG + (size_t)row * D + 32 * ks + 8 * fq) = w8; }
                u32x4 lw; lw.x = pk2(v0.x - bflo(hw.x), v0.y - bfhi(hw.x)); lw.y = pk2(v0.z - bflo(hw.y), v0.w - bfhi(hw.y)); lw.z = pk2(v1.x - bflo(hw.z), v1.y - bfhi(hw.z)); lw.w = pk2(v1.z - bflo(hw.w), v1.w - bfhi(hw.w));
                const bf16x8 hi = __builtin_bit_cast(bf16x8, hw), lo = __builtin_bit_cast(bf16x8, lw);
                const bf16x8 wh0 = *(const LAS bf16x8*)(c.lds + ((ks * 2 + 0) * 64 + lane) * 16), wh1 = *(const LAS bf16x8*)(c.lds + ((ks * 2 + 1) * 64 + lane) * 16);
                const bf16x8 wl0 = *(const LAS bf16x8*)(c.lds + 65536 + ((ks * 2 + 0) * 64 + lane) * 16), wl1 = *(const LAS bf16x8*)(c.lds + 65536 + ((ks * 2 + 1) * 64 + lane) * 16);
                acc0 = __builtin_amdgcn_mfma_f32_16x16x32_bf16(wh0, hi, acc0, 0, 0, 0); acc1 = __builtin_amdgcn_mfma_f32_16x16x32_bf16(wh1, hi, acc1, 0, 0, 0);
                acc0 = __builtin_amdgcn_mfma_f32_16x16x32_bf16(wl0, hi, acc0, 0, 0, 0); acc1 = __builtin_amdgcn_mfma_f32_16x16x32_bf16(wl1, hi, acc1, 0, 0, 0);
                acc0 = __builtin_amdgcn_mfma_f32_16x16x32_bf16(wh0, lo, acc0, 0, 0, 0); acc1 = __builtin_amdgcn_mfma_f32_16x16x32_bf16(wh1, lo, acc1, 0, 0, 0);
            }
            racc0 = acc0; racc1 = acc1; rss = ss;
            if (kh == 1) { part[0] = acc0[0]; part[1] = acc0[1]; part[2] = acc0[2]; part[3] = acc0[3]; part[4] = acc1[0]; part[5] = acc1[1]; part[6] = acc1[2]; part[7] = acc1[3]; part[8] = ss; }
        }
        __syncthreads();
        if (work && kh == 0) {
            f32x4 acc0, acc1; float ss;
            acc0 = racc0; acc1 = racc1; ss = rss;
            acc0[0] += part[0]; acc0[1] += part[1]; acc0[2] += part[2]; acc0[3] += part[3]; acc1[0] += part[4]; acc1[1] += part[5]; acc1[2] += part[6]; acc1[3] += part[7]; ss += part[8];
            ss += __shfl_xor(ss, 16); ss += __shfl_xor(ss, 32);
            const float rstd = 1.0f / sqrtf(ss * (1.0f / D) + RMS_EPS);
            float lg[32];
#pragma unroll
            for (int q = 0; q < 4; ++q)
#pragma unroll
                for (int r = 0; r < 4; ++r) { lg[4 * q + r] = __shfl(acc0[r], fr + 16 * q) * rstd + brt[4 * q + r]; lg[16 + 4 * q + r] = __shfl(acc1[r], fr + 16 * q) * rstd + brt[16 + 4 * q + r]; }
            float tv[4];
#pragma unroll
            for (int k = 0; k < 4; ++k) { float best = -3.0e38f; int bi = 0;
#pragma unroll
                for (int e = 0; e < 32; ++e) if (lg[e] > best) { best = lg[e]; bi = e; }
                te[k] = bi; tv[k] = best;
#pragma unroll
                for (int e = 0; e < 32; ++e) if (e == bi) lg[e] = -3.0e38f; }
            if (fq == 0) {
                const float e1 = __expf(tv[1] - tv[0]), e2 = __expf(tv[2] - tv[0]), e3 = __expf(tv[3] - tv[0]), inv = 1.0f / (1.0f + e1 + e2 + e3);
                *(f32x4*)(TG + row * 4) = (f32x4){inv, e1 * inv, e2 * inv, e3 * inv};
                *(u32x4*)(TE + row * 4) = (u32x4){(unsigned)te[0], (unsigned)te[1], (unsigned)te[2], (unsigned)te[3]};
                RS[row] = rstd;
#pragma unroll
                for (int k = 0; k < 4; ++k) rk[k] = __hip_atomic_fetch_add(hist + te[k], 1u, __ATOMIC_RELAXED, __HIP_MEMORY_SCOPE_WORKGROUP);
            }
        }
        __syncthreads();
        if (c.tid < 32) ebase[c.tid] = __hip_atomic_fetch_add(cnt + c.tid, hist[c.tid], RLX_AGENT);
        __syncthreads();
        if (work && kh == 0 && fq == 0) *(u32x4*)(TP + row * 4) = (u32x4){ebase[te[0]] + rk[0], ebase[te[1]] + rk[1], ebase[te[2]] + rk[2], ebase[te[3]] + rk[3]};
        __syncthreads();
    }
}
__device__ __forceinline__ int moe_tables(const Ctx& c, LAS int* tb, LAS int* tile_e) {
    __syncthreads();
    if (c.wave == 0) {
        const gu32* cnt = (const gu32*)(c.ws + WS_CTL) + CW_CNT; const int lane = c.lane;
        const int n = lane < NE ? ((int)__hip_atomic_load(cnt + (lane & 31), RLX_AGENT) + 255) >> 8 : 0;
        int incl = n;
#pragma unroll
        for (int o = 1; o < 32; o <<= 1) { const int t = __shfl_up(incl, o); if (lane >= o) incl += t; }
        int excl = incl - n; if (excl > MAXT) excl = MAXT;
        if (lane < NE) tb[lane] = excl;
        if (lane == NE - 1) tb[NE] = incl > MAXT ? MAXT : incl;
        if (lane < NE) for (int i = 0; i < n && excl + i < MAXT; ++i) tile_e[excl + i] = lane;
    }
    __syncthreads();
    return __builtin_amdgcn_readfirstlane(tb[NE]);
}
__device__ __forceinline__ void p7_gather(const Args& a, const Ctx& c, LAS int* tb) {
    const unsigned char* HN2 = c.ws + WS_HN2; unsigned char* XS = c.ws + WS_XS;
    const int* TE = (const int*)(c.ws + WS_TOK); const int* TP = TE + M * 4; const float* TG = (const float*)(TP + M * 4); int* TS = (int*)(TG + M * 4); float* SG = (float*)(TS + M * 4);
    float* SR = SG + NSLOT; const float* RS = SG + 2 * NSLOT;
    for (int row0 = 4 * c.gw; row0 < M; row0 += 4 * c.ngw) {
        u32x4 w[4];
#pragma unroll
        for (int r = 0; r < 4; ++r) w[r] = *(const u32x4*)(HN2 + (size_t)(row0 + r) * D + 16 * c.lane);
        int slot = 0;
        if (c.lane < 16) { const int i = row0 * 4 + c.lane; slot = tb[TE[i]] * 256 + TP[i]; TS[i] = slot; SG[slot] = TG[i]; SR[slot] = RS[row0 + (c.lane >> 2)]; }
#pragma unroll
        for (int r = 0; r < 4; ++r)
#pragma unroll
            for (int k = 0; k < 4; ++k) { const int sl = __builtin_amdgcn_readlane(slot, r * 4 + k); *(u32x4*)(XS + (size_t)sl * D + 16 * c.lane) = w[r]; }
    }
}
__device__ __forceinline__ void p10_final(const Args& a, const Ctx& c) {
    const float* H1 = (const float*)(c.ws + WS_H1); const unsigned char* YS = c.ws + WS_YS;
    const int* TS = (const int*)(c.ws + WS_TOK) + M * 12; const float* gain = a.in[25];
    for (int row = c.gw; row < M; row += c.ngw) {
        f32x4 v[4];
#pragma unroll
        for (int j = 0; j < 4; ++j) v[j] = *(const f32x4*)(H1 + (size_t)row * D + 4 * c.lane + 256 * j);
        const u32x4 ts = *(const u32x4*)(TS + row * 4);
        unsigned yw[4][4];
#pragma unroll
        for (int k = 0; k < 4; ++k) { const unsigned char* ys = YS + (size_t)ts[k] * D;
#pragma unroll
            for (int j = 0; j < 4; ++j) yw[k][j] = *(const unsigned*)(ys + 4 * c.lane + 256 * j); }
#pragma unroll
        for (int k = 0; k < 4; ++k)
#pragma unroll
            for (int j = 0; j < 4; ++j) { typedef float f32x2v __attribute__((ext_vector_type(2)));
                const f32x2v lo = __builtin_amdgcn_cvt_pk_f32_fp8(yw[k][j], false), hi = __builtin_amdgcn_cvt_pk_f32_fp8(yw[k][j], true);
                v[j].x += lo.x * 0.0625f; v[j].y += lo.y * 0.0625f; v[j].z += hi.x * 0.0625f; v[j].w += hi.y * 0.0625f; }
        float s = 0.f;
#pragma unroll
        for (int j = 0; j < 4; ++j) s += (v[j].x * v[j].x + v[j].y * v[j].y) + (v[j].z * v[j].z + v[j].w * v[j].w);
        const float rstd = 1.0f / sqrtf(wave_sum(s) * (1.0f / D) + RMS_EPS);
#pragma unroll
        for (int j = 0; j < 4; ++j) { const f32x4 g = *(const f32x4*)(gain + 4 * c.lane + 256 * j); *(f32x4*)(a.out + (size_t)row * D + 4 * c.lane + 256 * j) = v[j] * rstd * g; }
    }
}

#ifndef ONE_LAUNCH
#define ONE_LAUNCH 0
#endif
#ifndef FAST_GEMM
#define FAST_GEMM 0
#endif
#ifndef FAST_MIX
#define FAST_MIX 0
#endif
constexpr int NPH = 11;

template <bool FAST, class E, class S, bool F8 = false>
__device__ __forceinline__ void run_gemm(const Ctx& c, const bf16* A, const bf16* Bt, int K, const S& s, const E& e) {
    if constexpr (FAST) { pg8::Gemm g{A, Bt, 0, 0, K, c.wave}; FastEpi<E> fe{e}; pg8::gemm_phase<FastEpi<E>, S, true, true, F8>(c.lds, g, s, fe); }
    else { Unit u; for (int i = 0; s.next(i, u); ++i) naive_gemm_unit(A, K, Bt, K, K, u.pm, u.pn, e, c.wave, c.lane); }
}

__global__ void __launch_bounds__(NWAVES * 64, 2) fwd(Args args) {
    extern __shared__ __attribute__((aligned(16))) unsigned char lds_raw[];
    Ctx c0; c0.lds = (LAS unsigned char*)lds_raw; c0.ws = args.ws; c0.tid = threadIdx.x; c0.lane = c0.tid & 63; c0.wave = __builtin_amdgcn_readfirstlane(c0.tid >> 6);
    c0.G = gridDim.x; c0.bid = blockIdx.x; c0.gw = c0.bid * NWAVES + c0.wave; c0.ngw = c0.G * NWAVES;
    const Ctx& c = c0;
    volatile LAS unsigned* MISC = (volatile LAS unsigned*)(c.lds + LDSCTL_OFF);
    LAS int* tb = (LAS int*)(c.lds + LDSCTL_OFF + 512); LAS int* tile_e = (LAS int*)(c.lds + LDSCTL_OFF + 1024);
    for (int u = c.tid; u < (LDS_BYTES - LDSCTL_OFF) / 4; u += NWAVES * 64) ((LAS unsigned*)(c.lds + LDSCTL_OFF))[u] = 0u;
    __syncthreads();
    const int lo = args.ph_lo, hi = args.ph_hi;
    XcdBarrier bar; bar.bar = (unsigned*)(c.ws + WS_CTL) + CW_BAR; bar.x = 0; bar.st = nullptr;
    if (hi - lo > 1) bar = xcd_barrier_post((unsigned*)(c.ws + WS_CTL) + CW_BAR, MISC + 8);
#ifndef DISMASK
#define DISMASK 0
#endif
#define IN(k) (lo <= (k) && (k) < hi && !((DISMASK >> (k)) & 1))
#define GRID_BAR() xcd_barrier(bar, c0.wave == 0 && pg8::fresh_lane() == 0)
#define SEAM(k) do { if (IN(k) && IN((k) + 1)) GRID_BAR(); } while (0)
    unsigned char* ws = c.ws;
    bf16* XN = (bf16*)(ws + WS_XN); bf16* U = (bf16*)(ws + WS_U); bf16* Q = (bf16*)(ws + WS_Q); bf16* Kb = (bf16*)(ws + WS_K); bf16* Vt = (bf16*)(ws + WS_VT);
    bf16* GSp = (bf16*)(ws + WS_GS); bf16* GAp = (bf16*)(ws + WS_GA); bf16* Z = (bf16*)(ws + WS_Z); bf16* BRA = (bf16*)(ws + WS_BRA); bf16* MIX = (bf16*)(ws + WS_MIX);
    float* H1 = (float*)(ws + WS_H1); bf16* XS = (bf16*)(ws + WS_XS); bf16* HID = (bf16*)(ws + WS_HID); bf16* YS = (bf16*)(ws + WS_YS);

#ifndef REPMASK
#define REPMASK 0
#endif
    int mixpass = 0, glupass = 0;
#ifndef GLU_NOSTORE
#define GLU_NOSTORE 0
#endif
#define PHASE(k, ...) if (IN(k)) { Ctx c = c0; c.lane = pg8::fresh_lane(); c.tid = c.wave * 64 + c.lane; __VA_ARGS__ if constexpr ((REPMASK >> (k)) & 1) { GRID_BAR(); __VA_ARGS__ } } SEAM(k);
    PHASE(0, p0_prologue(args, c);)
    PHASE(1, {
        EpiInProj E{U, Q, Kb, Vt, GSp, GAp, (const float*)(ws + WS_ROT)};
        if constexpr (FAST_GEMM && FAST_MIX) { InProjOrder S; S.so.init(M, 4096, c.G, c.bid); run_gemm<true>(c, XN, (const bf16*)(ws + WS_WIN), 1024, S, E); }
        else { pg8::StaticOrder S; S.init(MP, INW, c.G, c.bid); run_gemm<FAST_GEMM>(c, XN, (const bf16*)(ws + WS_WIN), 1024, S, E); } })
    PHASE(2, if constexpr (FAST_MIX) {
#ifndef DEFER_REP
#define DEFER_REP 0
#endif
#ifndef MIXSKIP
#define MIXSKIP 0
#endif
 if (!(MIXSKIP & 1) || mixpass == 0) { for (int it = c.bid; it < 128; it += c.G) ssm_chain(c, it >> 1, it & 1); }
 if constexpr (FAST_GEMM) { if (mixpass == 0 || DEFER_REP) { EpiInProj E{U, Q, Kb, Vt, GSp, GAp, (const float*)(ws + WS_ROT)}; DeferredOrder S{c.G >= 197 ? c.bid - 128 : (c.bid == 0 ? 0 : -1)};
     if (c.G >= 197) { run_gemm<true>(c, XN, (const bf16*)(ws + WS_WIN), 1024, S, E); } else { for (int j = c.bid; j < 69; j += c.G) { DeferredOrder S1{j}; run_gemm<true>(c, XN, (const bf16*)(ws + WS_WIN), 1024, S1, E); } } __syncthreads(); } }
 if (!(MIXSKIP & 2) || mixpass == 0) attn_fast(args, c);
 ++mixpass;
 } else { p2_ssm_naive(args, c); p2_attn_naive(args, c); })
    PHASE(3, {
        pg8::StaticOrder S; S.init(M, 1024, c.G, c.bid);
        EpiGlu E{Z, args.in[13], BRA};
        run_gemm<FAST_GEMM>(c, Z, (const bf16*)(ws + WS_WGLU), 1024, S, E); })
    PHASE(4, {
        EpiBr E{GSp, GAp, MIX};
        if constexpr (FAST_GEMM) { PairOrder S; S.so.init(M, 1024, c.G, c.bid); run_gemm<true>(c, BRA, (const bf16*)(ws + WS_WBR), 1024, S, E); }
        else { pg8::StaticOrder S; S.init(M, 1024, c.G, c.bid); run_gemm<false>(c, BRA, (const bf16*)(ws + WS_WBR), 1024, S, E); } })
    PHASE(5, {
        pg8::StaticOrder S; S.init(M, 1024, c.G, c.bid);
        EpiOut E{args.in[0], H1};
        run_gemm<FAST_GEMM>(c, MIX, (const bf16*)(ws + WS_WOUT), 1024, S, E); })
    PHASE(6, p6_router(args, c);)
    PHASE(7, { moe_tables(c, tb, tile_e); p7_gather(args, c, tb); })
    PHASE(8, {
        const int nt = moe_tables(c, tb, tile_e);
        MoeOrder S{tile_e, nt, 8, c.G, c.bid};
        EpiMoe1 E{args.in[22], (const float*)(ws + WS_TOK) + M * 16 + NSLOT, (unsigned char*)HID};
        run_gemm<true, EpiMoe1, MoeOrder, true>(c, XS, (const bf16*)(ws + WS_WGU), 512, S, E); })
    PHASE(9, {
        const int nt = moe_tables(c, tb, tile_e);
        MoeOrder S{tile_e, nt, 4, c.G, c.bid};
        EpiMoe2 E{args.in[24], (const float*)(ws + WS_TOK) + M * 16, (unsigned char*)YS};
        run_gemm<true, EpiMoe2, MoeOrder, true>(c, HID, (const bf16*)(ws + WS_WDN), 512, S, E); })
    PHASE(10, p10_final(args, c);)
#undef PHASE
#undef IN
#undef SEAM
}

extern "C" void kernel_launch(void* const* d_in, const int* in_sizes, int n_in, void* d_out, int out_size, void* d_ws, size_t ws_size, hipStream_t stream) {
    static int grid = 0;
    if (grid == 0) {
        if (n_in != 26 || in_sizes[0] != M * D || out_size != M * D || ws_size < WS_END) { fprintf(stderr, "kernel_launch: unexpected shapes (n_in %d, in0 %d, out %d, ws %zu)\n", n_in, n_in > 0 ? in_sizes[0] : -1, out_size, ws_size); grid = -1; return; }
        int dev = 0, cus = 0, per_cu = 0;
        if (hipGetDevice(&dev) != hipSuccess || hipDeviceGetAttribute(&cus, hipDeviceAttributeMultiprocessorCount, dev) != hipSuccess) { grid = -1; return; }
        if (hipFuncSetAttribute((const void*)fwd, hipFuncAttributeMaxDynamicSharedMemorySize, LDS_BYTES) != hipSuccess) { fprintf(stderr, "kernel_launch: hipFuncSetAttribute failed\n"); grid = -1; return; }
        if (hipOccupancyMaxActiveBlocksPerMultiprocessor(&per_cu, (const void*)fwd, NWAVES * 64, LDS_BYTES) != hipSuccess || per_cu < 1) fprintf(stderr, "kernel_launch: occupancy query says %d\n", per_cu);
        (void)hipGetLastError();
        grid = cus;
    }
    if (grid < 0) return;
    if (hipMemsetAsync((char*)d_ws + WS_CTL, 0, CTL_ZERO_BYTES, stream) != hipSuccess) return;
    Args a{};
    for (int i = 0; i < 26; ++i) a.in[i] = (const float*)d_in[i];
    a.out = (float*)d_out; a.ws = (unsigned char*)d_ws;
#if ONE_LAUNCH
    a.ph_lo = 0; a.ph_hi = NPH;
    hipLaunchKernelGGL(fwd, dim3(grid), dim3(NWAVES * 64), LDS_BYTES, stream, a);
#else
    for (int p = 0; p < NPH; ++p) { a.ph_lo = p; a.ph_hi = p + 1; hipLaunchKernelGGL(fwd, dim3(grid), dim3(NWAVES * 64), LDS_BYTES, stream, a); }
#endif
}
```

```cpp
#include <hip/hip_runtime.h>
#include <cstdio>
#include <cstdint>
#define ONE_LAUNCH 1
#define FAST_GEMM 1
#define FAST_MIX 1
#define EPI_FENCE 0
namespace pg8 {
#define PG8_LAS __attribute__((address_space(3)))
typedef unsigned short bf16_t;
typedef short bf16x8 __attribute__((ext_vector_type(8)));
typedef float f32x4 __attribute__((ext_vector_type(4)));
typedef unsigned u32x4 __attribute__((ext_vector_type(4)));
constexpr int BM = 256, BK = 64, HALF = 128, HTB = HALF * BK * 2  , STAGE_BYTES = 8 * HTB, NXCD = 8, WGM = 8;

__host__ __device__ __forceinline__ int lds_byte(int r, int c) { const int st = (r >> 4) * 2 + (c >> 5), rr = r & 15, cc = c & 31, ob = rr * 64 + cc * 2; return st * 1024 + (ob ^ (((ob >> 9) & 1) << 5)); }
__host__ __device__ __forceinline__ void stage_rc(int b, int& R, int& C) { const int st = b / 1024, sb = b % 1024, swz = sb ^ (((sb >> 9) & 1) << 5); R = (st >> 1) * 16 + swz / 64; C = (st & 1) * 32 + (swz % 64) / 2; }
__host__ __device__ __forceinline__ int perm32(int rho) { const int n = rho >> 4, i = rho & 15; return 8 * (i >> 2) + 4 * n + (i & 3); }

struct Unit { int pm, pn; };
struct Gemm { const bf16_t* A; const bf16_t* Bt; int M, N, K; int wid; };
__device__ __forceinline__ int fresh_lane() { int l; asm volatile("v_mbcnt_lo_u32_b32 %0, -1, 0\n\tv_mbcnt_hi_u32_b32 %0, -1, %0" : "=v"(l)); return l; }

struct StaticOrder {
    int nM, nN, nwg, G, c;
    __host__ __device__ void init(int M, int N, int G_, int c_) { nM = M / BM; nN = N / BM; nwg = nM * nN; G = G_; c = c_; }
    __host__ __device__ bool next(int i, Unit& u) const {
        const long L = (long)i * G + c; if (L >= nwg) return false;
        int wgid = (int)L; { const int q = nwg / NXCD, r = nwg % NXCD, xcd = wgid % NXCD, off = wgid / NXCD; wgid = (xcd < r ? xcd * (q + 1) : r * (q + 1) + (xcd - r) * q) + off; }
        const int nig = WGM * nN, gid = wgid / nig, fm = gid * WGM, gsz = (nM - fm) < WGM ? (nM - fm) : WGM;
        u.pm = fm + ((wgid % nig) % gsz); u.pn = (wgid % nig) / gsz; return true;
    }
    __device__ __forceinline__ void a_ready(const Unit&) const {}
    __device__ __forceinline__ void done(const Unit&) const {}
};
__device__ __forceinline__ unsigned cvt_pk_bf16(float lo, float hi) { unsigned r; asm volatile("v_cvt_pk_bf16_f32 %0, %1, %2" : "=v"(r) : "v"(lo), "v"(hi)); return r; }
typedef int pg8_v8i __attribute__((ext_vector_type(8))); typedef int pg8_v4i __attribute__((ext_vector_type(4)));
__device__ __forceinline__ pg8_v8i pg8_cat(bf16x8 lo, bf16x8 hi) { return __builtin_shufflevector(__builtin_bit_cast(pg8_v4i, lo), __builtin_bit_cast(pg8_v4i, hi), 0, 1, 2, 3, 4, 5, 6, 7); }
template <class Epi, class Sched, bool ALIGN_EPI = false, bool SP2 = false, bool F8 = false, bool GATHER = false>
__device__ __forceinline__ void gemm_phase(PG8_LAS unsigned char* lds, const Gemm g, const Sched& S, const Epi& E) {
    const int lane = fresh_lane(), wid = g.wid, tid = wid * 64 + lane, wr = wid >> 2, wc = wid & 3, fr = lane & 15, fq = lane >> 4;
    const int K = g.K, nt = K / BK;
    unsigned voffA[2], voffB[2];
#pragma unroll
    for (int i = 0; i < 2; ++i) { int R, C; stage_rc(tid * 16 + i * 8192, R, C); const int Rb = Epi::PERM ? ((R & ~31) + perm32(R & 31)) : R;
        voffA[i] = (unsigned)(R * K + C) * 2u; voffB[i] = (unsigned)(Rb * K + C) * 2u; }
    unsigned vA[2], nvA[2], gC = 0u;
    const unsigned kstep = (unsigned)(BK * 2);
    const unsigned hstep = (unsigned)HALF * K * 2;
    const unsigned tstep = 2 * hstep;
    const __amdgpu_buffer_rsrc_t rsA = __builtin_amdgcn_make_buffer_rsrc((void*)g.A, (short)0, -1, 0x00020000), rsB = __builtin_amdgcn_make_buffer_rsrc((void*)g.Bt, (short)0, -1, 0x00020000);
    const unsigned ldsw = (unsigned)wid * 1024u;
    const int aoff = lds_byte(wr * 64 + fr, fq * 8), boff = lds_byte(wc * 32 + fr, fq * 8);
#define PG8_SA(b, h) (((b) * 2 + (h)) * HTB)
#define PG8_SB(b, h) ((4 + (b) * 2 + (h)) * HTB)
#define PG8_STAGE(bufoff, gbase, voff) do { _Pragma("unroll") for (int _i = 0; _i < 2; ++_i) \
        __builtin_amdgcn_raw_ptr_buffer_load_lds(PG8_RS_##voff, (PG8_LAS unsigned*)(lds + (bufoff) + ldsw + _i * 8192), 16, (int)(voff)[_i], (int)(gbase), 0, 0); } while (0)
#define PG8_RS_voffA rsA
#define PG8_RS_voffB rsB
#define PG8_STAGE_A(bufoff, h, off) do { if constexpr (GATHER) { const unsigned _pk = ((off) >> 31) != 0u ? nvA[h] : vA[h]; _Pragma("unroll") for (int _i = 0; _i < 2; ++_i) \
        __builtin_amdgcn_raw_ptr_buffer_load_lds(rsA, (PG8_LAS unsigned*)(lds + (bufoff) + ldsw + _i * 8192), 16, (int)(((_pk >> (16 * _i)) & 0xffffu) * (unsigned)(K * 2) + gC), (int)((off) & 0x7fffffffu), 0, 0); } \
        else { PG8_STAGE(bufoff, (off) + (h) * hstep, voffA); } } while (0)
#define PG8_LOADROWS(dst, u) do { const int _ln = fresh_lane(); int _R, _C; stage_rc((wid * 64 + _ln) * 16, _R, _C); gC = (unsigned)_C * 2u; \
        _Pragma("unroll") for (int _h = 0; _h < 2; ++_h) dst[_h] = S.row_id(u, _R + 128 * _h) | (S.row_id(u, _R + 64 + 128 * _h) << 16); } while (0)
#define PG8_LDA(dst, b, h) do { _Pragma("unroll") for (int m = 0; m < 4; ++m) _Pragma("unroll") for (int k = 0; k < 2; ++k) dst[m][k] = *(const PG8_LAS bf16x8*)(lds + PG8_SA(b, h) + aoff + m * 2048 + k * 1024); } while (0)
#define PG8_LDB(dst, b, h) do { _Pragma("unroll") for (int n = 0; n < 2; ++n) _Pragma("unroll") for (int k = 0; k < 2; ++k) dst[n][k] = *(const PG8_LAS bf16x8*)(lds + PG8_SB(b, h) + boff + n * 2048 + k * 1024); } while (0)
#define PG8_MMA(ai, bj, At, Bt) do { __builtin_amdgcn_s_setprio(1); if constexpr (F8) { _Pragma("unroll") for (int m = 0; m < 4; ++m) _Pragma("unroll") for (int n = 0; n < 2; ++n) \
        acc[ai][bj][m][n] = __builtin_amdgcn_mfma_scale_f32_16x16x128_f8f6f4(pg8_cat(Bt[n][0], Bt[n][1]), pg8_cat(At[m][0], At[m][1]), acc[ai][bj][m][n], 0, 0, 0, 0, 0, 0); } else { \
        _Pragma("unroll") for (int m = 0; m < 4; ++m) _Pragma("unroll") for (int n = 0; n < 2; ++n) _Pragma("unroll") for (int k = 0; k < 2; ++k) \
        acc[ai][bj][m][n] = __builtin_amdgcn_mfma_f32_16x16x32_bf16(Bt[n][k], At[m][k], acc[ai][bj][m][n], 0, 0, 0); } __builtin_amdgcn_s_setprio(0); } while (0)
#define PG8_WAIT_V(n) asm volatile("s_waitcnt vmcnt(" #n ")" ::: "memory")
#define PG8_WAIT_L(n) asm volatile("s_waitcnt lgkmcnt(" #n ")" ::: "memory")
#define PG8_BAR __builtin_amdgcn_s_barrier()
#define PG8_SCHED __builtin_amdgcn_sched_barrier(0)
    Unit cur, nxt; int ui = 0;
    if (!S.next(0, cur)) return;
    f32x4 acc[2][2][4][2];
#pragma unroll
    for (int a = 0; a < 2; ++a)
#pragma unroll
        for (int b = 0; b < 2; ++b)
#pragma unroll
            for (int m = 0; m < 4; ++m)
#pragma unroll
                for (int n = 0; n < 2; ++n) acc[a][b][m][n] = (f32x4){0.f, 0.f, 0.f, 0.f};
    bf16x8 At[4][2], B0[2][2], B1[2][2];
    unsigned cA = GATHER ? 0u : (unsigned)cur.pm * tstep, cB = (unsigned)cur.pn * tstep;
    if constexpr (GATHER) { PG8_LOADROWS(vA, cur); PG8_LOADROWS(nvA, cur); }
    S.a_ready(cur);
    if constexpr (SP2) {
        PG8_STAGE(PG8_SB(0, 0), cB, voffB); PG8_STAGE(PG8_SB(0, 1), cB + hstep, voffB); PG8_STAGE_A(PG8_SA(0, 0), 0, cA); PG8_STAGE_A(PG8_SA(0, 1), 1, cA);
        if (wr == 1) PG8_BAR;
        PG8_WAIT_V(2); PG8_BAR;
        PG8_STAGE(PG8_SB(1, 0), cB + kstep, voffB); PG8_STAGE_A(PG8_SA(1, 0), 0, cA + kstep); PG8_STAGE(PG8_SB(1, 1), cB + hstep + kstep, voffB);
        PG8_WAIT_V(6); PG8_BAR;
    } else {
        PG8_STAGE(PG8_SB(0, 0), cB, voffB); PG8_STAGE_A(PG8_SA(0, 0), 0, cA); PG8_STAGE(PG8_SB(0, 1), cB + hstep, voffB); PG8_STAGE_A(PG8_SA(0, 1), 1, cA);
        if (wr == 1) PG8_BAR;
        PG8_WAIT_V(4); PG8_BAR;
        PG8_STAGE(PG8_SB(1, 0), cB + kstep, voffB); PG8_STAGE_A(PG8_SA(1, 0), 0, cA + kstep); PG8_STAGE(PG8_SB(1, 1), cB + hstep + kstep, voffB);
        PG8_WAIT_V(6); PG8_BAR;
    }
    for (;;) {
        const bool has_next = S.next(ui + 1, nxt);
        const unsigned nA = GATHER ? (has_next ? 0x80000000u : 0u) : (has_next ? (unsigned)nxt.pm * tstep : cA), nB = has_next ? (unsigned)nxt.pn * tstep : cB;
        if constexpr (GATHER) { if (has_next) PG8_LOADROWS(nvA, nxt); }
#pragma unroll 1
        for (int t = 0; t < nt; t += 2) {
            const bool last = (t == nt - 2);
            const unsigned a1 = cA + (unsigned)(t + 1) * kstep;
            const unsigned a2 = last ? nA : cA + (unsigned)(t + 2) * kstep, b2 = last ? nB : cB + (unsigned)(t + 2) * kstep;
            const unsigned a3 = a2 + kstep, b3 = b2 + kstep;
            if (last && has_next) S.a_ready(nxt);
            if constexpr (SP2) {
            PG8_LDB(B0, 0, 0); PG8_LDB(B1, 0, 1); PG8_SCHED; PG8_LDA(At, 0, 0); PG8_STAGE_A(PG8_SA(1, 1), 1, a1);
            PG8_WAIT_V(8); PG8_WAIT_L(0); PG8_BAR; PG8_MMA(0, 0, At, B0); PG8_MMA(0, 1, At, B1); PG8_BAR; PG8_SCHED;
            PG8_LDA(At, 0, 1); PG8_STAGE(PG8_SB(0, 0), b2, voffB); PG8_STAGE(PG8_SB(0, 1), b2 + hstep, voffB); PG8_STAGE_A(PG8_SA(0, 0), 0, a2);
            PG8_WAIT_V(8); PG8_WAIT_L(0); PG8_BAR; PG8_MMA(1, 0, At, B0); PG8_MMA(1, 1, At, B1); PG8_BAR; PG8_SCHED;
            PG8_LDB(B0, 1, 0); PG8_LDB(B1, 1, 1); PG8_SCHED; PG8_LDA(At, 1, 0); PG8_STAGE_A(PG8_SA(0, 1), 1, a2);
            PG8_WAIT_V(8); PG8_WAIT_L(0); PG8_BAR; PG8_MMA(0, 0, At, B0); PG8_MMA(0, 1, At, B1); PG8_BAR; PG8_SCHED;
            PG8_LDA(At, 1, 1); PG8_STAGE(PG8_SB(1, 0), b3, voffB); PG8_STAGE(PG8_SB(1, 1), b3 + hstep, voffB); PG8_STAGE_A(PG8_SA(1, 0), 0, a3);
            PG8_WAIT_V(8); PG8_WAIT_L(0); PG8_BAR; PG8_MMA(1, 0, At, B0); PG8_MMA(1, 1, At, B1); PG8_BAR; PG8_SCHED;
            } else {
            PG8_LDB(B0, 0, 0); PG8_SCHED; PG8_LDA(At, 0, 0); PG8_STAGE_A(PG8_SA(1, 1), 1, a1);
            PG8_WAIT_L(8); PG8_BAR; PG8_WAIT_L(0); PG8_MMA(0, 0, At, B0); PG8_BAR; PG8_SCHED;
            PG8_LDB(B1, 0, 1); PG8_STAGE(PG8_SB(0, 0), b2, voffB);
            PG8_BAR; PG8_WAIT_L(0); PG8_MMA(0, 1, At, B1); PG8_BAR;
            PG8_LDA(At, 0, 1); PG8_STAGE_A(PG8_SA(0, 0), 0, a2);
            PG8_BAR; PG8_WAIT_L(0); PG8_MMA(1, 0, At, B0); PG8_BAR; PG8_SCHED;
            PG8_STAGE(PG8_SB(0, 1), b2 + hstep, voffB);
            PG8_WAIT_V(6); PG8_BAR; PG8_MMA(1, 1, At, B1); PG8_BAR;
            PG8_LDB(B0, 1, 0); PG8_SCHED; PG8_LDA(At, 1, 0); PG8_STAGE_A(PG8_SA(0, 1), 1, a2);
            PG8_WAIT_L(8); PG8_BAR; PG8_WAIT_L(0); PG8_MMA(0, 0, At, B0); PG8_BAR; PG8_SCHED;
            PG8_LDB(B1, 1, 1); PG8_STAGE(PG8_SB(1, 0), b3, voffB);
            PG8_BAR; PG8_WAIT_L(0); PG8_MMA(0, 1, At, B1); PG8_BAR;
            PG8_LDA(At, 1, 1); PG8_STAGE_A(PG8_SA(1, 0), 0, a3);
            PG8_BAR; PG8_WAIT_L(0); PG8_MMA(1, 0, At, B0); PG8_BAR; PG8_SCHED;
            PG8_STAGE(PG8_SB(1, 1), b3 + hstep, voffB);
            PG8_WAIT_V(6); PG8_BAR; PG8_MMA(1, 1, At, B1); PG8_BAR;
            }
        }
        if constexpr (ALIGN_EPI) { if (wr == 0) PG8_BAR; }
        bool keep = false;
        if constexpr (Epi::HAS_MID) keep = E.first_half(cur);
        if constexpr (!Epi::AFTER_DRAIN) { if (keep) E.mid(acc, cur, wr, wc, fr, fq); else E(acc, cur, wr, wc, fr, fq); S.done(cur); }
        if (!has_next) break;
        if (!keep) {
#pragma unroll
        for (int a = 0; a < 2; ++a)
#pragma unroll
            for (int b = 0; b < 2; ++b)
#pragma unroll
                for (int m = 0; m < 4; ++m)
#pragma unroll
                    for (int n = 0; n < 2; ++n) acc[a][b][m][n] = (f32x4){0.f, 0.f, 0.f, 0.f};
        }
        cur = nxt; cA = GATHER ? 0u : nA; cB = nB; ++ui;
        if constexpr (GATHER) { vA[0] = nvA[0]; vA[1] = nvA[1]; }
        if constexpr (ALIGN_EPI) { if (wr == 1) PG8_BAR; }
    }
    PG8_WAIT_V(0);
    if constexpr (!ALIGN_EPI) { if (wr == 0) PG8_BAR; }
    PG8_BAR;
    if constexpr (Epi::AFTER_DRAIN) { E.fused(acc, cur, wr, wc, fr, fq, lds, wid, lane); S.done(cur); }
#undef PG8_SA
#undef PG8_SB
#undef PG8_STAGE
#undef PG8_RS_voffA
#undef PG8_STAGE_A
#undef PG8_LOADROWS
#undef PG8_RS_voffB
#undef PG8_LDA
#undef PG8_LDB
#undef PG8_MMA
#undef PG8_WAIT_V
#undef PG8_WAIT_L
#undef PG8_BAR
#undef PG8_SCHED
}
}

#define GAS __attribute__((address_space(1)))
#define LAS __attribute__((address_space(3)))
typedef unsigned short bf16;
typedef float f32x4 __attribute__((ext_vector_type(4)));
typedef short bf16x8 __attribute__((ext_vector_type(8)));
typedef unsigned u32x4 __attribute__((ext_vector_type(4)));
typedef unsigned u32x2 __attribute__((ext_vector_type(2)));
typedef GAS unsigned gu32;

constexpr int NWAVES = 8;
constexpr int D = 1024, SEQ = 8192, NBATCH = 2, NMETA = 16, LTOT = SEQ + NMETA;
constexpr int M = NBATCH * SEQ;
constexpr int MP = M + 256;
constexpr int INW = 4352;
constexpr int NCH = LTOT / 16;
constexpr int NE = 32, TOPK = 4;
constexpr int MAXT = M * TOPK / 256 + NE;
constexpr int NSLOT = MAXT * 256;
constexpr int VP = 8320;
constexpr float RMS_EPS = 1e-5f;

constexpr size_t MiB = 1ull << 20;
constexpr size_t WS_CTL = 0, CTL_ZERO_BYTES = 65536;
constexpr size_t WS_ROT = 1 * MiB;
constexpr size_t WS_TOK = 2 * MiB;
constexpr size_t WS_SSMP = 4 * MiB;
constexpr size_t WS_TOKOF = 24 * MiB;
constexpr size_t WS_GATEOF = 26 * MiB;
constexpr size_t WS_RSOF = 28 * MiB;
constexpr size_t WS_WIN = 32 * MiB;
constexpr size_t WS_WGLU = 41 * MiB;
constexpr size_t WS_WBR = 43 * MiB;
constexpr size_t WS_WOUT = 47 * MiB;
constexpr size_t WS_WGU = 49 * MiB;
constexpr size_t WS_WDN = 177 * MiB;
constexpr size_t WS_XN = 241 * MiB;
constexpr size_t WS_U = 274 * MiB;
constexpr size_t WS_Q = 307 * MiB;
constexpr size_t WS_K = 339 * MiB;
constexpr size_t WS_VT = 344 * MiB;
constexpr size_t WS_GS = 349 * MiB;
constexpr size_t WS_GA = 381 * MiB;
constexpr size_t WS_Z = 413 * MiB;
constexpr size_t WS_BRA = 445 * MiB;
constexpr size_t WS_MIX = 509 * MiB;
constexpr size_t WS_H1 = 541 * MiB;
constexpr size_t WS_HN2 = 605 * MiB;
constexpr size_t WS_S16 = 637 * MiB;
constexpr size_t WS_XC = 671 * MiB;
constexpr size_t WS_XS = 241 * MiB;
constexpr size_t WS_HID = 385 * MiB;
constexpr size_t WS_YS = 688 * MiB;
constexpr size_t WS_END = 832 * MiB;
static_assert((size_t)NSLOT * 2048 <= 144 * MiB, "slot buffers");
constexpr int CW_TMO = 0, CW_CNT = 1024, CW_BAR = 4096;

constexpr int RING_BYTES = 131072;
constexpr int LDSCTL_OFF = RING_BYTES;
constexpr int LDS_BYTES = 163840;

#define LDS_WAIT() asm volatile("s_waitcnt lgkmcnt(0)" ::: "memory")
#define VM_WAIT() asm volatile("s_waitcnt vmcnt(0)" ::: "memory")
#define RLX_AGENT __ATOMIC_RELAXED, __HIP_MEMORY_SCOPE_AGENT

__device__ __forceinline__ unsigned f2bf(float f) { unsigned u = __builtin_bit_cast(unsigned, f); return (u + 0x7fffu + ((u >> 16) & 1u)) >> 16; }
typedef float f32x2_t __attribute__((ext_vector_type(2))); typedef __bf16 bf16x2_t __attribute__((ext_vector_type(2)));
__device__ __forceinline__ unsigned pk2(float lo, float hi) { f32x2_t v = {lo, hi}; bf16x2_t b = __builtin_convertvector(v, bf16x2_t); return __builtin_bit_cast(unsigned, b); }
__device__ __forceinline__ float bflo(unsigned w) { return __uint_as_float(w << 16); }
__device__ __forceinline__ float bfhi(unsigned w) { return __uint_as_float(w & 0xffff0000u); }
__device__ __forceinline__ float bf2f(bf16 b) { return __uint_as_float((unsigned)b << 16); }
__device__ __forceinline__ float wave_sum(float v) {
#pragma unroll
    for (int o = 1; o < 64; o <<= 1) v += __shfl_xor(v, o);
    return v;
}
__device__ __forceinline__ float wave_max(float v) {
#pragma unroll
    for (int o = 1; o < 64; o <<= 1) v = fmaxf(v, __shfl_xor(v, o));
    return v;
}
__device__ __forceinline__ float sigmoidf_(float x) { return __builtin_amdgcn_rcpf(1.0f + __builtin_amdgcn_exp2f(-1.4426950408889634f * x)); }
__device__ __forceinline__ float gelu_tanh(float x) { const float e = __builtin_amdgcn_exp2f(x * (-2.3022082f + -0.1029432f * (x * x))); return x * __builtin_amdgcn_rcpf(1.0f + e); }
__device__ __forceinline__ void unpack8(u32x4 w, float (&v)[8]) { v[0] = bflo(w.x); v[1] = bfhi(w.x); v[2] = bflo(w.y); v[3] = bfhi(w.y); v[4] = bflo(w.z); v[5] = bfhi(w.z); v[6] = bflo(w.w); v[7] = bfhi(w.w); }
__device__ __forceinline__ u32x4 pack8(const float (&v)[8]) { u32x4 w; w.x = pk2(v[0], v[1]); w.y = pk2(v[2], v[3]); w.z = pk2(v[4], v[5]); w.w = pk2(v[6], v[7]); return w; }

__device__ __forceinline__ unsigned pk4_fp8(float a, float b, float c, float d) { unsigned w = 0u; w = __builtin_amdgcn_cvt_pk_fp8_f32(a, b, w, false); w = __builtin_amdgcn_cvt_pk_fp8_f32(c, d, w, true); return w; }
struct Args { const float* in[26]; float* out; unsigned char* ws; int ph_lo, ph_hi; };
struct Ctx { LAS unsigned char* lds; unsigned char* ws; int tid, lane, wave, G, bid, gw, ngw; };
using pg8::Unit;

template <class E>
__device__ __forceinline__ void naive_gemm_unit(const bf16* __restrict__ A, int lda, const bf16* __restrict__ Bt, int ldb, int K, int pm, int pn, const E& e, int wave, int lane) {
    const int fr = lane & 15, fq = lane >> 4;
    const int row0 = pm * 256 + wave * 32;
#pragma unroll 1
    for (int cg = 0; cg < 4; ++cg) {
        f32x4 acc[2][2][2];
#pragma unroll
        for (int i = 0; i < 2; ++i)
#pragma unroll
            for (int j = 0; j < 2; ++j)
#pragma unroll
                for (int n = 0; n < 2; ++n) acc[i][j][n] = (f32x4){0.f, 0.f, 0.f, 0.f};
#pragma unroll 1
        for (int half = 0; half < (E::HAS_MID ? 2 : 1); ++half) {
            const bf16* ap[2]; const bf16* bp[2][2];
#pragma unroll
            for (int mi = 0; mi < 2; ++mi) ap[mi] = A + (size_t)(half * M + row0 + 16 * mi + fr) * lda + 8 * fq;
#pragma unroll
            for (int bj = 0; bj < 2; ++bj)
#pragma unroll
                for (int n = 0; n < 2; ++n) bp[bj][n] = Bt + (size_t)(half * 1024 + pn * 256 + 128 * bj + 32 * cg + pg8::perm32(16 * n + fr)) * ldb + 8 * fq;
#pragma unroll 1
            for (int k0 = 0; k0 < K; k0 += 32) {
                bf16x8 av[2], bv[2][2];
#pragma unroll
                for (int mi = 0; mi < 2; ++mi) av[mi] = *(const bf16x8*)(ap[mi] + k0);
#pragma unroll
                for (int bj = 0; bj < 2; ++bj)
#pragma unroll
                    for (int n = 0; n < 2; ++n) bv[bj][n] = *(const bf16x8*)(bp[bj][n] + k0);
#pragma unroll
                for (int mi = 0; mi < 2; ++mi)
#pragma unroll
                    for (int bj = 0; bj < 2; ++bj)
#pragma unroll
                        for (int n = 0; n < 2; ++n) acc[mi][bj][n] = __builtin_amdgcn_mfma_f32_16x16x32_bf16(bv[bj][n], av[mi], acc[mi][bj][n], 0, 0, 0);
            }
            if constexpr (E::HAS_MID) {
                if (half == 0) {
#pragma unroll
                    for (int mi = 0; mi < 2; ++mi) e.mid(row0 + 16 * mi + fr, pn * 256 + 32 * cg + 8 * fq, acc[mi][0][0], acc[mi][0][1], acc[mi][1][0], acc[mi][1][1]);
                }
            }
        }
#pragma unroll
        for (int mi = 0; mi < 2; ++mi) e.row8(row0 + 16 * mi + fr, pn * 256 + 32 * cg + 8 * fq, acc[mi][0][0], acc[mi][0][1], acc[mi][1][0], acc[mi][1][1], pm, pn);
    }
}
#ifndef EPI_FENCE
#define EPI_FENCE 0
#endif
template <class E> struct FastEpi {
    static constexpr bool PERM = true, AFTER_DRAIN = false, HAS_MID = E::HAS_MID;
    E e;
    __device__ __forceinline__ void operator()(const f32x4 (&acc)[2][2][4][2], const Unit& u, int wr, int wc, int fr, int fq) const {
#pragma unroll
        for (int ai = 0; ai < 2; ++ai)
#pragma unroll
            for (int m = 0; m < 4; ++m) {
                e.row8(u.pm * 256 + ai * 128 + wr * 64 + m * 16 + fr, u.pn * 256 + wc * 32 + 8 * fq, acc[ai][0][m][0], acc[ai][0][m][1], acc[ai][1][m][0], acc[ai][1][m][1], u.pm, u.pn);
                if constexpr (EPI_FENCE > 0) { if ((m % EPI_FENCE) == EPI_FENCE - 1) asm volatile("" ::: "memory"); } }
    }
    __device__ __forceinline__ bool first_half(const Unit& u) const { if constexpr (E::HAS_MID) return u.pm < M / 256; else return false; }
    __device__ __forceinline__ void mid(f32x4 (&acc)[2][2][4][2], const Unit& u, int wr, int wc, int fr, int fq) const {
        if constexpr (E::HAS_MID) {
#pragma unroll
            for (int ai = 0; ai < 2; ++ai)
#pragma unroll
                for (int m = 0; m < 4; ++m)
                    e.mid(u.pm * 256 + ai * 128 + wr * 64 + m * 16 + fr, u.pn * 256 + wc * 32 + 8 * fq, acc[ai][0][m][0], acc[ai][0][m][1], acc[ai][1][m][0], acc[ai][1][m][1]);
        }
    }
};
struct PairOrder {
    pg8::StaticOrder so;
    __device__ __forceinline__ bool next(int i, Unit& u) const { Unit t; if (!so.next(i >> 1, t)) return false; const int h = i & 1; u.pm = t.pm + h * (M / 256); u.pn = t.pn + h * 4; return true; }
    __device__ __forceinline__ void a_ready(const Unit&) const {}
    __device__ __forceinline__ void done(const Unit&) const {}
};
struct RowMajorOrder {
    int nN, nwg, G, c;
    __device__ __forceinline__ bool next(int i, Unit& u) const { const long L = (long)i * G + c; if (L >= nwg) return false; u.pm = (int)L / nN; u.pn = (int)L % nN; return true; }
    __device__ __forceinline__ void a_ready(const Unit&) const {}
    __device__ __forceinline__ void done(const Unit&) const {}
};
struct InProjOrder {
    pg8::StaticOrder so;
    __device__ __forceinline__ bool next(int i, Unit& u) const { if (!so.next(i, u)) return false; if (u.pn == 15 && u.pm < 5) { u.pn = u.pm < 4 ? u.pm : 8; u.pm = M / 256; } return true; }
    __device__ __forceinline__ void a_ready(const Unit&) const {}
    __device__ __forceinline__ void done(const Unit&) const {}
};
struct DeferredOrder {
    int j;
    __device__ __forceinline__ bool next(int i, Unit& u) const { if (i != 0 || j < 0 || j >= 69) return false; if (j < 64) { u.pm = j; u.pn = 16; } else { u.pm = j - 64; u.pn = 15; } return true; }
    __device__ __forceinline__ void a_ready(const Unit&) const {}
    __device__ __forceinline__ void done(const Unit&) const {}
};
struct MoeTabs { const LAS int* tile_e; const LAS int* tb; const LAS int* cnt; const int* tok_of; const float* gate_of; const float* rs_of; };
__device__ __forceinline__ int moe_slot_pos(const MoeTabs& T, int e, int slot_row, bool& ok) { const int p = slot_row - T.tb[e] * 256; ok = p < T.cnt[e]; return p; }
struct MoeOrder {
    static constexpr bool HAS_HALF = false;
    MoeTabs T; int ntiles, nct, G, c;
    __device__ __forceinline__ bool next(int i, Unit& u) const {
        if ((G & 7) != 0) { const long L = (long)i * G + c; if (L >= (long)ntiles * nct) return false; u.pm = (int)L / nct; u.pn = __builtin_amdgcn_readfirstlane(T.tile_e[u.pm]) * nct + (int)L % nct; return true; }
        const int per = G >> 3, x = c & 7, j = c >> 3, rpb = 32 / nct;
        const long slot = (long)i * per + j;
        const long blk = (slot >> 5) * 8 + x; const int w = (int)(slot & 31);
        const long rt = blk * rpb + w / nct;
        if (rt >= ntiles) return false;
        u.pm = (int)rt; u.pn = __builtin_amdgcn_readfirstlane(T.tile_e[rt]) * nct + w % nct; return true; }
    __device__ __forceinline__ unsigned row_id(const Unit& u, int r) const { const int e = u.pn / nct; bool ok; const int p = moe_slot_pos(T, e, u.pm * 256 + r, ok); return ok ? (unsigned)T.tok_of[e * M + p] : 0u; }
    __device__ __forceinline__ void a_ready(const Unit&) const {}
    __device__ __forceinline__ void done(const Unit&) const {}
};

__device__ __forceinline__ void f4to8(f32x4 a0, f32x4 a1, float (&v)[8]) { v[0] = a0[0]; v[1] = a0[1]; v[2] = a0[2]; v[3] = a0[3]; v[4] = a1[0]; v[5] = a1[1]; v[6] = a1[2]; v[7] = a1[3]; }

struct EpiInProj {
    static constexpr bool HAS_MID = false;
    bf16 *U, *Q, *Kb, *Vt, *GSp, *GAp; const float* rot;
    __device__ __forceinline__ void one(int row, int col, f32x4 v0, f32x4 v1) const {
        const bool meta = row >= M;
        if (meta) { if (row >= M + NMETA) return; if (!(col < 1024 || (col >= 2048 && col < 2304))) return; }
        const int pos = meta ? row - M : NMETA + (row & (SEQ - 1));
        const int b0 = meta ? 0 : (row >> 13), nb = meta ? 2 : 1;
        float v[8]; f4to8(v0, v1, v);
        if (col < 1024) {
            const int g = col >> 4, h0 = col & 15; const u32x4 w = pack8(v);
            for (int bi = 0; bi < nb; ++bi) { const int b = b0 + bi; *(u32x4*)(U + ((size_t)((g * 2 + b) * NCH + (pos >> 4)) * 256 + (pos & 15) * 16 + h0)) = w; }
        } else if (col < 2176) {
            if ((col & 63) < 16) {
                const int i0 = (col & 8) ? 4 : 0; const float* cs = rot + pos * 16;
#pragma unroll
                for (int j = 0; j < 4; ++j) { const float c = cs[i0 + j], s = cs[8 + i0 + j], x1 = v[j], x2 = v[4 + j]; v[j] = x1 * c - x2 * s; v[4 + j] = x2 * c + x1 * s; }
            }
            if (col < 2048) {
#pragma unroll
                for (int j = 0; j < 8; ++j) v[j] *= 0.18033688011112042f;
                *(u32x4*)(Q + (size_t)row * 1024 + (col - 1024)) = pack8(v);
            } else {
                const u32x4 w = pack8(v);
                for (int bi = 0; bi < nb; ++bi) { const int b = b0 + bi; *(u32x4*)(Kb + ((size_t)(b * LTOT + pos)) * 128 + (col - 2048)) = w; }
            }
        } else if (col < 2304) {
            const u32x4 w = pack8(v);
            for (int bi = 0; bi < nb; ++bi) { const int b = b0 + bi; *(u32x4*)(Vt + ((size_t)(b * LTOT + pos)) * 128 + (col - 2176)) = w; }
        } else {
#pragma unroll
            for (int j = 0; j < 8; ++j) v[j] = sigmoidf_(v[j]);
            if (col < 3328) *(u32x4*)(GSp + (size_t)row * 1024 + (col - 2304)) = pack8(v);
            else *(u32x4*)(GAp + (size_t)row * 1024 + (col - 3328)) = pack8(v);
        }
    }
    __device__ __forceinline__ void row8(int row, int col, f32x4 a0, f32x4 a1, f32x4 b0, f32x4 b1, int, int) const { one(row, col, a0, a1); one(row, col + 128, b0, b1); }
};
struct EpiGlu {
    static constexpr bool HAS_MID = false;
    const bf16* Z; const float* bias; bf16* O;
    __device__ __forceinline__ void one(int row, int col, f32x4 v0, f32x4 v1) const {
        float v[8], z[8]; f4to8(v0, v1, v); unpack8(*(const u32x4*)(Z + (size_t)row * 1024 + col), z);
        const f32x4 c0 = *(const f32x4*)(bias + col), c1 = *(const f32x4*)(bias + col + 4); float bb[8]; f4to8(c0, c1, bb);
#pragma unroll
        for (int j = 0; j < 8; ++j) v[j] = z[j] * sigmoidf_(v[j] + bb[j]);
        *(u32x4*)(O + (size_t)row * 1024 + col) = pack8(v);
    }
    __device__ __forceinline__ void row8(int row, int col, f32x4 a0, f32x4 a1, f32x4 b0, f32x4 b1, int, int) const { one(row, col, a0, a1); one(row, col + 128, b0, b1); }
};
struct EpiBr {
    static constexpr bool HAS_MID = true;
    const bf16* GSp; const bf16* GAp; bf16* MIX;
    __device__ __forceinline__ void mid1(int row, int col, f32x4& v0, f32x4& v1) const {
        float gs[8], ga[8]; unpack8(*(const u32x4*)(GSp + (size_t)row * 1024 + col), gs); unpack8(*(const u32x4*)(GAp + (size_t)row * 1024 + col), ga);
#pragma unroll
        for (int j = 0; j < 4; ++j) { v0[j] *= gs[j] * __builtin_amdgcn_rcpf(fmaxf(ga[j], 1e-20f)); v1[j] *= gs[4 + j] * __builtin_amdgcn_rcpf(fmaxf(ga[4 + j], 1e-20f)); }
    }
    __device__ __forceinline__ void mid(int row, int col, f32x4& a0, f32x4& a1, f32x4& b0, f32x4& b1) const { mid1(row, col, a0, a1); mid1(row, col + 128, b0, b1); }
    __device__ __forceinline__ void one(int row, int col, f32x4 v0, f32x4 v1) const {
        float v[8], ga[8]; f4to8(v0, v1, v); unpack8(*(const u32x4*)(GAp + (size_t)row * 1024 + col), ga);
#pragma unroll
        for (int j = 0; j < 8; ++j) v[j] *= ga[j];
        *(u32x4*)(MIX + (size_t)row * 1024 + col) = pack8(v);
    }
    __device__ __forceinline__ void row8(int row, int col, f32x4 a0, f32x4 a1, f32x4 b0, f32x4 b1, int, int) const {
        if (row >= M) { row -= M; col -= 1024; }
        one(row, col, a0, a1); one(row, col + 128, b0, b1); }
};
struct EpiOut {
    static constexpr bool HAS_MID = false;
    const float* X; float* H1;
    __device__ __forceinline__ void one(int row, int col, f32x4 v0, f32x4 v1) const {
        const size_t o = (size_t)row * 1024 + col;
        *(f32x4*)(H1 + o) = *(const f32x4*)(X + o) + v0; *(f32x4*)(H1 + o + 4) = *(const f32x4*)(X + o + 4) + v1;
    }
    __device__ __forceinline__ void row8(int row, int col, f32x4 a0, f32x4 a1, f32x4 b0, f32x4 b1, int, int) const { one(row, col, a0, a1); one(row, col + 128, b0, b1); }
};
struct EpiMoe1 {
    static constexpr bool HAS_MID = false;
    const float* bgu; unsigned char* HID; MoeTabs T;
    __device__ __forceinline__ void row8(int row, int col, f32x4 a0, f32x4 a1, f32x4 b0, f32x4 b1, int, int pn) const {
        const int e = pn >> 3, ct = pn & 7, j0 = 128 * ct + (col - pn * 256); bool ok; const int p = moe_slot_pos(T, e, row, ok);
        const float rs = (ok ? T.rs_of[e * M + p] : 0.f) * 0.0625f;
        float g[8], up[8], bg[8], bu[8]; f4to8(a0 * rs, a1 * rs, g); f4to8(b0 * rs, b1 * rs, up);
        const float* bp = bgu + (size_t)e * 2048 + j0;
        f4to8(*(const f32x4*)bp, *(const f32x4*)(bp + 4), bg); f4to8(*(const f32x4*)(bp + 1024), *(const f32x4*)(bp + 1028), bu);
#pragma unroll
        for (int j = 0; j < 8; ++j) { const float gg = fminf(g[j] + bg[j], 7.0f), uu = fminf(fmaxf(up[j] + bu[j], -7.0f), 7.0f); g[j] = gg * sigmoidf_(1.702f * gg) * (uu + 1.0f); }
        u32x2 w; w.x = pk4_fp8(g[0], g[1], g[2], g[3]); w.y = pk4_fp8(g[4], g[5], g[6], g[7]); *(u32x2*)(HID + (size_t)row * 1024 + j0) = w;
    }
};
struct EpiMoe2 {
    static constexpr bool HAS_MID = false;
    const float* bd; unsigned char* YS; MoeTabs T;
    __device__ __forceinline__ void one(int row, int e, int c0, f32x4 v0, f32x4 v1, float gt) const {
        float v[8], bb[8]; f4to8(v0, v1, v); const float* bp = bd + (size_t)e * 1024 + c0; f4to8(*(const f32x4*)bp, *(const f32x4*)(bp + 4), bb);
#pragma unroll
        for (int j = 0; j < 8; ++j) v[j] = (v[j] + bb[j] * 16.0f) * gt;
        u32x2 w; w.x = pk4_fp8(v[0], v[1], v[2], v[3]); w.y = pk4_fp8(v[4], v[5], v[6], v[7]); *(u32x2*)(YS + (size_t)row * 1024 + c0) = w;
    }
    __device__ __forceinline__ void row8(int row, int col, f32x4 a0, f32x4 a1, f32x4 b0, f32x4 b1, int, int pn) const {
        const int e = pn >> 2, ct = pn & 3, c0 = 256 * ct + (col - pn * 256); bool ok; const int p = moe_slot_pos(T, e, row, ok); const float gt = ok ? T.gate_of[e * M + p] : 0.f;
        one(row, e, c0, a0, a1, gt); one(row, e, c0 + 128, b0, b1, gt);
    }
};
#define XB_TMO      128
#define XB_XCNT(j)  (256  + 64 * (j))
#define XB_XSUB(j)  (1280 + 64 * (j))
#define XB_XGEN(j)  (2304 + 64 * (j))
#define XB_TOP      3328
#define XB_TOPGEN   3392
#define XCD_BAR_WORDS 3456
#define XB_SPIN_CAP (1u << 18)

__device__ __forceinline__ unsigned xb_ld(unsigned* p)              { return __hip_atomic_load(p, __ATOMIC_RELAXED, __HIP_MEMORY_SCOPE_AGENT); }
__device__ __forceinline__ unsigned xb_add(unsigned* p, unsigned v) { return __hip_atomic_fetch_add(p, v, __ATOMIC_RELAXED, __HIP_MEMORY_SCOPE_AGENT); }
__device__ __forceinline__ unsigned xb_xcc_id() { return (unsigned)__builtin_amdgcn_s_getreg((3 << 11) | 20) & 0xFu; }
#define XB_SPIN(cond, bar) do { unsigned _sp = 0; while (cond) { __builtin_amdgcn_s_sleep(1); \
    if ((++_sp & 255u) == 0u) { if (xb_ld(&(bar)[XB_TMO])) break; if (_sp > XB_SPIN_CAP) { atomicAdd(&(bar)[XB_TMO], 1u); break; } } } } while (0)

struct XcdBarrier {
    unsigned* bar; unsigned x;
    volatile LAS unsigned* st;
};

__device__ __forceinline__ XcdBarrier xcd_barrier_post(unsigned* bar, volatile LAS unsigned* st) {
    XcdBarrier b; b.bar = bar; b.x = xb_xcc_id(); b.st = st;
    if (threadIdx.x == 0) (void)xb_add(&bar[XB_XCNT(b.x)], 1u);
    return b;
}
__device__ __forceinline__ void xcd_barrier_complete(unsigned* bar, unsigned x, unsigned& nloc, unsigned& nx) {
    const unsigned G = gridDim.x * gridDim.y * gridDim.z;
    unsigned sum, cnt, mine, sp = 0u;
    for (;;) {
        sum = 0u; cnt = 0u; mine = 0u;
#pragma unroll
        for (unsigned j = 0; j < 16; ++j) { const unsigned c = xb_ld(&bar[XB_XCNT(j)]); sum += c; cnt += (c > 0u) ? 1u : 0u; mine = (j == x) ? c : mine; }
        if (sum == G) break;
        __builtin_amdgcn_s_sleep(1);
        if ((++sp & 255u) == 0u) { if (xb_ld(&bar[XB_TMO])) break; if (sp > XB_SPIN_CAP) { atomicAdd(&bar[XB_TMO], 1u); break; } }
    }
    nloc = mine > 0u ? mine : 1u; nx = cnt > 0u ? cnt : 1u;
}

__device__ __forceinline__ void xcd_barrier(const XcdBarrier& b, const bool thread0) {
    asm volatile("s_waitcnt vmcnt(0)" ::: "memory");
    __syncthreads();
    if (thread0) {
        unsigned* bar = b.bar;
        __builtin_amdgcn_s_waitcnt(0);
        unsigned nloc = b.st[0], nx = b.st[1];
        if (nloc == 0u) { xcd_barrier_complete(bar, b.x, nloc, nx); b.st[0] = nloc; b.st[1] = nx; }
        const unsigned old = xb_add(&bar[XB_XSUB(b.x)], 1u);
        const unsigned gen = old / nloc;
        if (old + 1u == (gen + 1u) * nloc) {
            __builtin_amdgcn_fence(__ATOMIC_RELEASE, "agent");
            asm volatile("s_waitcnt vmcnt(0)" ::: "memory");
            const unsigned og = xb_add(&bar[XB_TOP], 1u);
            const unsigned tg = og / nx;
            if (og + 1u == (tg + 1u) * nx) xb_add(&bar[XB_TOPGEN], 1u);
            else XB_SPIN(xb_ld(&bar[XB_TOPGEN]) == tg, bar);
            __builtin_amdgcn_fence(__ATOMIC_ACQUIRE, "agent");
            xb_add(&bar[XB_XGEN(b.x)], 1u);
            asm volatile("s_waitcnt vmcnt(0)" ::: "memory");
        } else {
            XB_SPIN(xb_ld(&bar[XB_XGEN(b.x)]) == gen, bar);
            __builtin_amdgcn_fence(__ATOMIC_ACQUIRE, "agent");
            asm volatile("s_waitcnt vmcnt(0)" ::: "memory");
        }
    }
    __syncthreads();
}

constexpr size_t SSM_A16 = 1 * MiB, SSM_TF = 2 * MiB, SSM_VF = 4 * MiB, SSM_WF = 8 * MiB;
constexpr int NCI = 2 * NCH;
constexpr int NCB = (NCI + 15) / 16;
constexpr int CW_Q = 2048;

__device__ __forceinline__ void p0_ssm_prep(const Args& a, const Ctx& c, int g) {
    LAS float* AP = (LAS float*)(c.lds);
    LAS float* BBl = AP + 64 * 17 * 2;
    LAS float* Cc = BBl + 64 * 16 * 2;
    LAS float* Kt = Cc + 16 * 64 * 2;
    unsigned char* sp = c.ws + WS_SSMP;
    const int tid = c.tid;
    if (tid < 64) { const int p = tid, i = g * 64 + p;
        const float lr = a.in[4][i], li = a.in[5][i], dt = expf(a.in[6][g]);
        for (int tau = 0; tau <= 16; ++tau) { const float mag = expf((float)tau * dt * lr), ang = (float)tau * dt * li; AP[(p * 17 + tau) * 2] = mag * cosf(ang); AP[(p * 17 + tau) * 2 + 1] = mag * sinf(ang); }
        const float mag = expf(dt * lr), ar = mag * cosf(dt * li), ai = mag * sinf(dt * li);
        const float den = lr * lr + li * li, nr = ar - 1.0f, ni = ai, fr_ = (nr * lr + ni * li) / den, fi_ = (ni * lr - nr * li) / den;
        for (int h = 0; h < 16; ++h) { const float br = a.in[7][i * 16 + h], bi = a.in[8][i * 16 + h]; BBl[(p * 16 + h) * 2] = fr_ * br - fi_ * bi; BBl[(p * 16 + h) * 2 + 1] = fr_ * bi + fi_ * br; }
        float* A16 = (float*)(sp + SSM_A16); const float m16 = expf(16.0f * dt * lr), a16 = 16.0f * dt * li; A16[i * 2] = m16 * cosf(a16); A16[i * 2 + 1] = m16 * sinf(a16);
    }
    for (int idx = tid; idx < 1024; idx += NWAVES * 64) { const int h = idx >> 6, p = idx & 63; Cc[idx * 2] = a.in[9][(g * 16 + h) * 64 + p]; Cc[idx * 2 + 1] = a.in[10][(g * 16 + h) * 64 + p]; }
    __syncthreads();
    for (int idx = tid; idx < 4096; idx += NWAVES * 64) { const int tau = idx >> 8, h = (idx >> 4) & 15, hp = idx & 15; float s = 0.f;
        for (int p = 0; p < 64; ++p) { const float ar = AP[(p * 17 + tau) * 2], ai = AP[(p * 17 + tau) * 2 + 1], br = BBl[(p * 16 + hp) * 2], bi = BBl[(p * 16 + hp) * 2 + 1];
            const float gr = ar * br - ai * bi, gi = ar * bi + ai * br; s += Cc[(h * 64 + p) * 2] * gr - Cc[(h * 64 + p) * 2 + 1] * gi; }
        if (tau == 0 && h == hp) s += a.in[11][g * 16 + h];
        Kt[idx] = s; }
    __syncthreads();
    bf16* TF = (bf16*)(sp + SSM_TF); bf16* VF = (bf16*)(sp + SSM_VF); bf16* WF = (bf16*)(sp + SSM_WF);
    for (int idx = tid; idx < 1024; idx += NWAVES * 64) { const int dl = idx >> 6, ln = idx & 63, fr = ln & 15, fq = ln >> 4; float v[8];
#pragma unroll
        for (int e = 0; e < 8; ++e) { const int j = 8 * fq + e, tau = dl - (j >> 4), hp = j & 15; v[e] = tau >= 0 ? Kt[(tau * 16 + fr) * 16 + hp] : 0.f; }
        *(u32x4*)(TF + ((size_t)(g * 16 + dl) * 64 + ln) * 8) = pack8(v); }
    for (int idx = tid; idx < 4096; idx += NWAVES * 64) { const int t = idx >> 8, kx = (idx >> 6) & 3, ln = idx & 63, fr = ln & 15, fq = ln >> 4; float v[8];
#pragma unroll
        for (int e = 0; e < 8; ++e) { const int pp = 32 * kx + 8 * fq + e, p = pp & 63; const float cr = Cc[(fr * 64 + p) * 2], ci = Cc[(fr * 64 + p) * 2 + 1], ar = AP[(p * 17 + t + 1) * 2], ai = AP[(p * 17 + t + 1) * 2 + 1];
            v[e] = pp < 64 ? (cr * ar - ci * ai) : -(cr * ai + ci * ar); }
        *(u32x4*)(VF + ((size_t)((g * 16 + t) * 4 + kx) * 64 + ln) * 8) = pack8(v); }
    for (int idx = tid; idx < 4096; idx += NWAVES * 64) { const int pb = idx >> 9, ks = (idx >> 6) & 7, ln = idx & 63, fr = ln & 15, fq = ln >> 4, pp = 16 * pb + fr, p = pp & 63; float v[8];
#pragma unroll
        for (int e = 0; e < 8; ++e) { const int k = 32 * ks + 8 * fq + e, s = k >> 4, h = k & 15; const float ar = AP[(p * 17 + 15 - s) * 2], ai = AP[(p * 17 + 15 - s) * 2 + 1], br = BBl[(p * 16 + h) * 2], bi = BBl[(p * 16 + h) * 2 + 1];
            v[e] = pp < 64 ? (ar * br - ai * bi) : (ar * bi + ai * br); }
        *(u32x4*)(WF + ((size_t)((g * 8 + pb) * 8 + ks) * 64 + ln) * 8) = pack8(v); }
    __syncthreads();
}
__device__ __forceinline__ void ssm_phase_a(const Ctx& c) {
    const bf16* U = (const bf16*)(c.ws + WS_U); const bf16* WF = (const bf16*)(c.ws + WS_SSMP + SSM_WF); float* S16 = (float*)(c.ws + WS_S16);
    const int fr = c.lane & 15, fq = c.lane >> 4;
    for (int it = c.gw; it < 64 * NCB; it += c.ngw) {
        const int g = it / NCB, cb = it % NCB, cidx = 16 * cb + fr, cl = cidx < NCI ? cidx : NCI - 1;
        bf16x8 uf[8];
#pragma unroll
        for (int ks = 0; ks < 8; ++ks) uf[ks] = *(const bf16x8*)(U + ((size_t)(g * NCI + cl)) * 256 + 32 * ks + 8 * fq);
#pragma unroll 2
        for (int pb = 0; pb < 8; ++pb) { f32x4 acc = {0.f, 0.f, 0.f, 0.f};
#pragma unroll
            for (int ks = 0; ks < 8; ++ks) { const bf16x8 wf = *(const bf16x8*)(WF + ((size_t)((g * 8 + pb) * 8 + ks) * 64 + c.lane) * 8); acc = __builtin_amdgcn_mfma_f32_16x16x32_bf16(wf, uf[ks], acc, 0, 0, 0); }
            if (cidx < NCI) *(f32x4*)(S16 + ((size_t)(g * NCI + cidx)) * 128 + 16 * pb + 4 * fq) = acc; }
    }
}
__device__ __forceinline__ void ssm_carry(const Ctx& c) {
    LAS float* E = (LAS float*)(c.lds + LDSCTL_OFF + 4096);
    for (int it = c.bid; it < 128; it += c.G) {
        const int g = it >> 1, b = it & 1, p = c.lane, seg = c.wave, c0 = 64 * seg;
        const float* A16 = (const float*)(c.ws + WS_SSMP + SSM_A16); const float ar = A16[(g * 64 + p) * 2], ai = A16[(g * 64 + p) * 2 + 1];
        const float* sp = (const float*)(c.ws + WS_S16) + ((size_t)(g * NCI + b * NCH + c0)) * 128; bf16* xp = (bf16*)(c.ws + WS_XC) + ((size_t)(g * NCI + b * NCH + c0)) * 128;
        float lr[64], li[64];
#pragma unroll
        for (int j = 0; j < 64; ++j) { lr[j] = sp[j * 128 + p]; li[j] = sp[j * 128 + 64 + p]; }
        float xr = 0.f, xi = 0.f;
#pragma unroll
        for (int j = 0; j < 64; ++j) { const float tr = ar * xr - ai * xi + lr[j], ti = ar * xi + ai * xr + li[j]; xr = tr; xi = ti; lr[j] = xr; li[j] = xi; }
        __syncthreads();
        E[(seg * 64 + p) * 2] = xr; E[(seg * 64 + p) * 2 + 1] = xi;
        float a64r = ar, a64i = ai;
#pragma unroll
        for (int k = 0; k < 6; ++k) { const float tr = a64r * a64r - a64i * a64i, ti = 2.0f * a64r * a64i; a64r = tr; a64i = ti; }
        __syncthreads();
        float cr = 0.f, ci = 0.f;
        for (int s2 = 0; s2 < seg; ++s2) { const float er = E[(s2 * 64 + p) * 2], ei = E[(s2 * 64 + p) * 2 + 1]; const float tr = a64r * cr - a64i * ci + er, ti = a64r * ci + a64i * cr + ei; cr = tr; ci = ti; }
        float pr = ar, pi = ai; bf16* xq = xp + 128 + p;
#pragma unroll
        for (int j = 0; j < 64; ++j) { const float vr = lr[j] + pr * cr - pi * ci, vi = li[j] + pr * ci + pi * cr;
            xq[0] = (bf16)f2bf(vr); xq[64] = (bf16)f2bf(vi); xq += 128; asm volatile("" : "+v"(xq));
            const float tr = pr * ar - pi * ai, ti = pr * ai + pi * ar; pr = tr; pi = ti; }
    }
}
__device__ __forceinline__ void ssm_phase_c(const Ctx& c) {
    const bf16* U = (const bf16*)(c.ws + WS_U); const bf16* XC = (const bf16*)(c.ws + WS_XC); bf16* Z = (bf16*)(c.ws + WS_Z);
    const bf16* TF = (const bf16*)(c.ws + WS_SSMP + SSM_TF); const bf16* VF = (const bf16*)(c.ws + WS_SSMP + SSM_VF);
    const int fr = c.lane & 15, fq = c.lane >> 4;
    for (int it = c.bid; it < 256; it += c.G) {
        const int g = it >> 2, q = it & 3;
        __syncthreads();
        for (int idx = c.tid; idx < 4096; idx += NWAVES * 64) *(LAS u32x4*)(c.lds + idx * 16) = *(const u32x4*)(VF + (size_t)g * 32768 + idx * 8);
        bf16x8 tf[16];
#pragma unroll
        for (int dl = 0; dl < 16; ++dl) tf[dl] = *(const bf16x8*)(TF + ((size_t)(g * 16 + dl) * 64 + c.lane) * 8);
        __syncthreads();
        for (int cb = q + 4 * c.wave; cb < NCB; cb += 32) {
            const int cidx = 16 * cb + fr, cl = cidx < NCI ? cidx : NCI - 1;
            bf16x8 uf[8], xf[4];
#pragma unroll
            for (int ks = 0; ks < 8; ++ks) uf[ks] = *(const bf16x8*)(U + ((size_t)(g * NCI + cl)) * 256 + 32 * ks + 8 * fq);
#pragma unroll
            for (int kx = 0; kx < 4; ++kx) xf[kx] = *(const bf16x8*)(XC + ((size_t)(g * NCI + cl)) * 128 + 32 * kx + 8 * fq);
            const int b = cidx >= NCH ? 1 : 0, cc = cidx - b * NCH; const bool ok = cidx < NCI && cc >= 1;
            bf16* zp = Z + (size_t)(b * SEQ + 16 * (cc - 1)) * 1024 + g * 16 + 4 * fq;
#pragma unroll
            for (int t = 0; t < 16; ++t) { f32x4 acc = {0.f, 0.f, 0.f, 0.f};
#pragma unroll
                for (int ks = 0; ks <= t / 2; ++ks) acc = __builtin_amdgcn_mfma_f32_16x16x32_bf16(tf[t - 2 * ks], uf[ks], acc, 0, 0, 0);
#pragma unroll
                for (int kx = 0; kx < 4; ++kx) { const bf16x8 vf = *(const LAS bf16x8*)(c.lds + ((t * 4 + kx) * 64 + c.lane) * 16); acc = __builtin_amdgcn_mfma_f32_16x16x32_bf16(vf, xf[kx], acc, 0, 0, 0); }
                if (ok) { u32x2 w; w.x = pk2(gelu_tanh(acc[0]), gelu_tanh(acc[1])); w.y = pk2(gelu_tanh(acc[2]), gelu_tanh(acc[3])); *(u32x2*)(zp + (size_t)t * 1024) = w; }
                asm volatile("" ::: "memory"); }
        }
    }
}

__device__ __forceinline__ float ld_sc1_f32(const float* p) { return __uint_as_float(__hip_atomic_load((const unsigned*)p, RLX_AGENT)); }
__device__ __forceinline__ void ssm_chain(const Ctx& c, int g, int b) {
    const int fr = c.lane & 15, fq = c.lane >> 4, w = c.wave, p = c.lane;
    const bf16* Ub = (const bf16*)(c.ws + WS_U) + ((size_t)(g * NCI + b * NCH)) * 256;
    float* Sb = (float*)(c.ws + WS_S16) + ((size_t)(g * NCI + b * NCH)) * 128;
    bf16* Xb = (bf16*)(c.ws + WS_XC) + ((size_t)(g * NCI + b * NCH)) * 128;
    bf16* Z = (bf16*)(c.ws + WS_Z);
    const bf16* TF = (const bf16*)(c.ws + WS_SSMP + SSM_TF); const bf16* VF = (const bf16*)(c.ws + WS_SSMP + SSM_VF); const bf16* WF = (const bf16*)(c.ws + WS_SSMP + SSM_WF);
    LAS float* E = (LAS float*)(c.lds + LDSCTL_OFF + 4096);
    __syncthreads();
    for (int idx = c.tid; idx < 4096; idx += NWAVES * 64) { *(LAS u32x4*)(c.lds + idx * 16) = *(const u32x4*)(VF + (size_t)g * 32768 + idx * 8); *(LAS u32x4*)(c.lds + 65536 + idx * 16) = *(const u32x4*)(WF + (size_t)g * 32768 + idx * 8); }
    {
        __syncthreads();
#pragma unroll 1
        for (int h2 = 0; h2 < 2; ++h2) {
            bf16x8 uf[2][8];
#pragma unroll
            for (int i = 0; i < 2; ++i)
#pragma unroll
                for (int ks = 0; ks < 8; ++ks) uf[i][ks] = *(const bf16x8*)(Ub + (size_t)(16 * (w + 8 * (2 * h2 + i)) + fr) * 256 + 32 * ks + 8 * fq);
#pragma unroll
            for (int i = 0; i < 2; ++i) {
#pragma unroll 2
                for (int pb = 0; pb < 8; ++pb) { f32x4 acc = {0.f, 0.f, 0.f, 0.f};
#pragma unroll
                    for (int ks = 0; ks < 8; ++ks) acc = __builtin_amdgcn_mfma_f32_16x16x32_bf16(*(const LAS bf16x8*)(c.lds + 65536 + ((pb * 8 + ks) * 64 + c.lane) * 16), uf[i][ks], acc, 0, 0, 0);
                    *(f32x4*)(Sb + (size_t)(16 * (w + 8 * (2 * h2 + i)) + fr) * 128 + 16 * pb + 4 * fq) = acc; }
            }
        }
    }
    VM_WAIT(); __syncthreads();
    {
        const float* A16 = (const float*)(c.ws + WS_SSMP + SSM_A16); const float ar = A16[(g * 64 + p) * 2], ai = A16[(g * 64 + p) * 2 + 1];
        const float* sp = Sb + (size_t)(64 * w) * 128;
        float xr = 0.f, xi = 0.f;
#pragma unroll 1
        for (int h2 = 0; h2 < 2; ++h2) { float lr[32], li[32];
#pragma unroll
            for (int j = 0; j < 32; ++j) { lr[j] = ld_sc1_f32(sp + (32 * h2 + j) * 128 + p); li[j] = ld_sc1_f32(sp + (32 * h2 + j) * 128 + 64 + p); }
#pragma unroll
            for (int j = 0; j < 32; ++j) { const float tr = ar * xr - ai * xi + lr[j], ti = ar * xi + ai * xr + li[j]; xr = tr; xi = ti; } }
        E[(w * 64 + p) * 2] = xr; E[(w * 64 + p) * 2 + 1] = xi;
        float a64r = ar, a64i = ai;
#pragma unroll
        for (int k = 0; k < 6; ++k) { const float tr = a64r * a64r - a64i * a64i, ti = 2.0f * a64r * a64i; a64r = tr; a64i = ti; }
        __syncthreads();
        xr = 0.f; xi = 0.f;
        for (int s2 = 0; s2 < w; ++s2) { const float er = E[(s2 * 64 + p) * 2], ei = E[(s2 * 64 + p) * 2 + 1]; const float tr = a64r * xr - a64i * xi + er, ti = a64r * xi + a64i * xr + ei; xr = tr; xi = ti; }
        bf16* xq = Xb + (size_t)(64 * w + 1) * 128 + p;
#pragma unroll 1
        for (int h2 = 0; h2 < 2; ++h2) { float lr[32], li[32];
#pragma unroll
            for (int j = 0; j < 32; ++j) { lr[j] = ld_sc1_f32(sp + (32 * h2 + j) * 128 + p); li[j] = ld_sc1_f32(sp + (32 * h2 + j) * 128 + 64 + p); }
#pragma unroll
            for (int j = 0; j < 32; ++j) { const float tr = ar * xr - ai * xi + lr[j], ti = ar * xi + ai * xr + li[j]; xr = tr; xi = ti;
                xq[0] = (bf16)f2bf(xr); xq[64] = (bf16)f2bf(xi); xq += 128; asm volatile("" : "+v"(xq)); } }
    }
    VM_WAIT(); __syncthreads();
    {
        bf16x8 tf[16];
#pragma unroll
        for (int dl = 0; dl < 16; ++dl) tf[dl] = *(const bf16x8*)(TF + ((size_t)(g * 16 + dl) * 64 + c.lane) * 8);
        bf16x8 uf[8], xf[4], un[8], xn[4];
        { const int cl = 16 * w + fr;
#pragma unroll
            for (int ks = 0; ks < 8; ++ks) uf[ks] = *(const bf16x8*)(Ub + (size_t)cl * 256 + 32 * ks + 8 * fq);
#pragma unroll
            for (int kx = 0; kx < 4; ++kx) xf[kx] = *(const bf16x8*)(Xb + (size_t)cl * 128 + 32 * kx + 8 * fq); }
#pragma unroll 1
        for (int cb = w; cb < 33; cb += 8) {
            const int ci_ = 16 * cb + fr;
            if (cb + 8 < 33) { const int cn = 16 * (cb + 8) + fr, cl = cn < NCH ? cn : NCH - 1;
#pragma unroll
                for (int ks = 0; ks < 8; ++ks) un[ks] = *(const bf16x8*)(Ub + (size_t)cl * 256 + 32 * ks + 8 * fq);
#pragma unroll
                for (int kx = 0; kx < 4; ++kx) xn[kx] = *(const bf16x8*)(Xb + (size_t)cl * 128 + 32 * kx + 8 * fq); }
            const bool ok = ci_ >= 1 && ci_ < NCH;
            bf16* zp = Z + (size_t)(b * SEQ + 16 * (ci_ - 1)) * 1024 + g * 16 + 4 * fq;
#pragma unroll
            for (int t = 0; t < 16; ++t) { f32x4 acc = {0.f, 0.f, 0.f, 0.f};
#pragma unroll
                for (int ks = 0; ks <= t / 2; ++ks) acc = __builtin_amdgcn_mfma_f32_16x16x32_bf16(tf[t - 2 * ks], uf[ks], acc, 0, 0, 0);
#pragma unroll
                for (int kx = 0; kx < 4; ++kx) { const bf16x8 vf = *(const LAS bf16x8*)(c.lds + ((t * 4 + kx) * 64 + c.lane) * 16); acc = __builtin_amdgcn_mfma_f32_16x16x32_bf16(vf, xf[kx], acc, 0, 0, 0); }
                if (ok) { u32x2 wv; wv.x = pk2(gelu_tanh(acc[0]), gelu_tanh(acc[1])); wv.y = pk2(gelu_tanh(acc[2]), gelu_tanh(acc[3])); *(u32x2*)(zp + (size_t)t * 1024) = wv; }
                asm volatile("" ::: "memory"); }
#pragma unroll
            for (int ks = 0; ks < 8; ++ks) uf[ks] = un[ks];
#pragma unroll
            for (int kx = 0; kx < 4; ++kx) xf[kx] = xn[kx];
        }
    }
}

template <bool FIRST>
__device__ __forceinline__ void attn_qblocks(LAS unsigned char* Ks, LAS unsigned char* Vs, const bf16* qp, bf16x8 (&qc)[2], bf16* ao, int t0, float sink, int fr, int fq) {
    constexpr int KST = 144, VST = 432;
#pragma unroll 2
    for (int qa = 0; qa < 4; ++qa) {
        bf16x8 qf[2]; qf[0] = qc[0]; qf[1] = qc[1];
        if (qa < 3) { qc[0] = *(const bf16x8*)(qp + (size_t)(16 * (qa + 1)) * 1024); qc[1] = *(const bf16x8*)(qp + (size_t)(16 * (qa + 1)) * 1024 + 32); }
        f32x4 s[10];
#pragma unroll
        for (int jb = 0; jb < 10; ++jb) { const int j = jb < 9 ? qa + jb : 12; f32x4 acc = {0.f, 0.f, 0.f, 0.f};
#pragma unroll
            for (int ks = 0; ks < 2; ++ks) { const bf16x8 kf = *(const LAS bf16x8*)(Ks + (16 * j + fr) * KST + (32 * ks + 8 * fq) * 2); acc = __builtin_amdgcn_mfma_f32_16x16x32_bf16(kf, qf[ks], acc, 0, 0, 0); }
            s[jb] = acc; }
#pragma unroll
        for (int i = 0; i < 4; ++i) { if (4 * fq + i - fr < 1) s[0][i] = -1e30f; if (4 * fq + i - fr > 0) s[8][i] = -1e30f; }
        if constexpr (FIRST) {
#pragma unroll
            for (int jb = 0; jb < 9; ++jb)
#pragma unroll
                for (int i = 0; i < 4; ++i) if (t0 - 128 + 16 * (qa + jb) + 4 * fq + i < 0) s[jb][i] = -1e30f; }
        float mx = sink;
#pragma unroll
        for (int jb = 0; jb < 10; ++jb) mx = fmaxf(fmaxf(mx, fmaxf(s[jb][0], s[jb][1])), fmaxf(s[jb][2], s[jb][3]));
        mx = fmaxf(mx, __shfl_xor(mx, 16)); mx = fmaxf(mx, __shfl_xor(mx, 32));
        float l = 0.f;
#pragma unroll
        for (int jb = 0; jb < 10; ++jb)
#pragma unroll
            for (int i = 0; i < 4; ++i) { s[jb][i] = __builtin_amdgcn_exp2f(s[jb][i] - mx); l += s[jb][i]; }
        l += __shfl_xor(l, 16); l += __shfl_xor(l, 32); l += __builtin_amdgcn_exp2f(sink - mx);
        f32x4 o[4];
#pragma unroll
        for (int db = 0; db < 4; ++db) o[db] = (f32x4){0.f, 0.f, 0.f, 0.f};
#pragma unroll
        for (int pr = 0; pr < 5; ++pr) { const int ja = qa + 2 * pr, jbk = pr < 4 ? qa + 2 * pr + 1 : 12;
            u32x4 pw; pw.x = pk2(s[2 * pr][0], s[2 * pr][1]); pw.y = pk2(s[2 * pr][2], s[2 * pr][3]); pw.z = pk2(s[2 * pr + 1][0], s[2 * pr + 1][1]); pw.w = pk2(s[2 * pr + 1][2], s[2 * pr + 1][3]);
            const bf16x8 pf = __builtin_bit_cast(bf16x8, pw);
#pragma unroll
            for (int db = 0; db < 4; ++db) { const u32x2 lo = *(const LAS u32x2*)(Vs + (16 * db + fr) * VST + (16 * ja + 4 * fq) * 2), hi = *(const LAS u32x2*)(Vs + (16 * db + fr) * VST + (16 * jbk + 4 * fq) * 2);
                u32x4 vw; vw.x = lo.x; vw.y = lo.y; vw.z = hi.x; vw.w = hi.y; o[db] = __builtin_amdgcn_mfma_f32_16x16x32_bf16(__builtin_bit_cast(bf16x8, vw), pf, o[db], 0, 0, 0); } }
        const float inv = __builtin_amdgcn_rcpf(l);
#pragma unroll
        for (int db = 0; db < 4; ++db) { u32x2 w; w.x = pk2(o[db][0] * inv, o[db][1] * inv); w.y = pk2(o[db][2] * inv, o[db][3] * inv); *(u32x2*)(ao + (size_t)(16 * qa) * 1024 + 16 * db) = w; }
    }
}
__device__ __forceinline__ void attn_fast(const Args& a, const Ctx& c) {
    const bf16* Q = (const bf16*)(c.ws + WS_Q); const bf16* Kb = (const bf16*)(c.ws + WS_K); const bf16* Vt = (const bf16*)(c.ws + WS_VT); bf16* AO = (bf16*)(c.ws + WS_BRA) + (size_t)M * 1024;
    unsigned* qctr = (unsigned*)(c.ws + WS_CTL) + CW_Q;
    LAS unsigned char* Ks = c.lds; LAS unsigned char* Vs = c.lds + 30720; volatile LAS int* uslot = (volatile LAS int*)(c.lds + LDSCTL_OFF + 64);
    constexpr int KST = 144, VST = 432;
    const int fr = c.lane & 15, fq = c.lane >> 4;
    volatile LAS int* ncall = (volatile LAS int*)(c.lds + LDSCTL_OFF + 68);
    __syncthreads(); if (c.tid == 0) *ncall = *ncall + 1; __syncthreads();
    const int qbase = (*ncall - 1) * (512 + c.G);
    int nxt = 0; if (c.tid == 0) nxt = (int)__hip_atomic_fetch_add(qctr, 1u, RLX_AGENT) - qbase;
    for (;;) {
        __syncthreads();
        if (c.tid == 0) *uslot = nxt;
        __syncthreads();
        const int unit = *uslot; if (unit >= 512) break;
        if (c.tid == 0) nxt = (int)__hip_atomic_fetch_add(qctr, 1u, RLX_AGENT) - qbase;
        const int b = unit >> 8, kvh = (unit >> 7) & 1, t0 = 64 * (unit & 127);
        const int head = kvh * 8 + c.wave;
        const bf16* qp = Q + (size_t)(b * SEQ + t0 + fr) * 1024 + head * 64 + 8 * fq;
        bf16x8 qc[2]; qc[0] = *(const bf16x8*)qp; qc[1] = *(const bf16x8*)(qp + 32);
        for (int idx = c.tid; idx < 1664; idx += NWAVES * 64) { const int row = idx >> 3, pc = idx & 7; int pos; bool ok = true;
            if (row < 192) { const int tok = t0 - 128 + row; ok = tok >= 0; pos = NMETA + tok; } else pos = row - 192;
            u32x4 v = {0u, 0u, 0u, 0u}; if (ok) v = *(const u32x4*)(Kb + ((size_t)(b * LTOT + pos)) * 128 + kvh * 64 + pc * 8);
            *(LAS u32x4*)(Ks + row * KST + pc * 16) = v; }
        for (int idx = c.tid; idx < 1664; idx += NWAVES * 64) { const int row = idx >> 3, pc = idx & 7; int pos; bool ok = true;
            if (row < 192) { const int tok = t0 - 128 + row; ok = tok >= 0; pos = NMETA + tok; } else pos = row - 192;
            u32x4 v = {0u, 0u, 0u, 0u}; if (ok) v = *(const u32x4*)(Vt + ((size_t)(b * LTOT + pos)) * 128 + kvh * 64 + pc * 8);
            LAS bf16* vd = (LAS bf16*)(Vs + (8 * pc) * VST + row * 2);
            vd[0 * (VST / 2)] = (bf16)(v.x & 0xffffu); vd[1 * (VST / 2)] = (bf16)(v.x >> 16); vd[2 * (VST / 2)] = (bf16)(v.y & 0xffffu); vd[3 * (VST / 2)] = (bf16)(v.y >> 16);
            vd[4 * (VST / 2)] = (bf16)(v.z & 0xffffu); vd[5 * (VST / 2)] = (bf16)(v.z >> 16); vd[6 * (VST / 2)] = (bf16)(v.w & 0xffffu); vd[7 * (VST / 2)] = (bf16)(v.w >> 16); }
        __syncthreads();
        const float sink = a.in[14][head] * 1.4426950408889634f;
        if (t0 < 128) attn_qblocks<true>(Ks, Vs, qp, qc, AO + (size_t)(b * SEQ + t0 + fr) * 1024 + head * 64 + 4 * fq, t0, sink, fr, fq);
        else attn_qblocks<false>(Ks, Vs, qp, qc, AO + (size_t)(b * SEQ + t0 + fr) * 1024 + head * 64 + 4 * fq, t0, sink, fr, fq);
    }
}

constexpr size_t SSM_WRF = 16 * MiB;
__device__ __forceinline__ void p0_router_frags(const Args& a, const Ctx& c) {
    bf16* WRF = (bf16*)(c.ws + WS_SSMP + SSM_WRF); const float* wr = a.in[19];
    const int gt = c.bid * (NWAVES * 64) + c.tid, ngt = c.G * NWAVES * 64;
    for (int idx = gt; idx < 4096; idx += ngt) { const int ks = idx >> 7, eb = (idx >> 6) & 1, ln = idx & 63, fr = ln & 15, fq = ln >> 4; float hi[8], lo[8];
#pragma unroll
        for (int e = 0; e < 8; ++e) { const float w = wr[(size_t)(32 * ks + 8 * fq + e) * 32 + 16 * eb + fr]; const float h = bf2f((bf16)f2bf(w)); hi[e] = h; lo[e] = w - h; }
        *(u32x4*)(WRF + (size_t)idx * 8) = pack8(hi); *(u32x4*)(WRF + 32768 + (size_t)idx * 8) = pack8(lo); }
}

__device__ __forceinline__ int swap23(int p) { return (p & 3) | ((p & 4) << 1) | ((p & 8) >> 1); }
__device__ __forceinline__ void tr_item(const float* __restrict__ W, int ldw, int k0, int n0src, bool perm, bf16* WT, int ldt, int rowdst0, int kdst, LAS float* scr, int lane) {
    float tv[32];
#pragma unroll
    for (int i = 0; i < 32; ++i) tv[i] = W[(size_t)(k0 + 2 * i + (lane >> 5)) * ldw + n0src + (lane & 31)];
#pragma unroll
    for (int i = 0; i < 32; ++i) scr[(2 * i + (lane >> 5)) * 33 + (lane & 31)] = tv[i];
    LDS_WAIT(); asm volatile("" ::: "memory");
    const int c = lane & 7;
#pragma unroll
    for (int j = 0; j < 4; ++j) { const int n = (lane >> 3) + 8 * j; const int ns = (perm && n < 16) ? swap23(n) : n; const LAS float* s = scr + (8 * c) * 33 + ns;
        u32x4 o; o.x = pk2(s[0 * 33], s[1 * 33]); o.y = pk2(s[2 * 33], s[3 * 33]); o.z = pk2(s[4 * 33], s[5 * 33]); o.w = pk2(s[6 * 33], s[7 * 33]);
        *(u32x4*)(WT + (size_t)(rowdst0 + n) * ldt + kdst + k0 + 8 * c) = o; }
    LDS_WAIT(); asm volatile("" ::: "memory");
}
struct Tr8Item { const float* src; unsigned char* dst; int ldw; };
__device__ __forceinline__ Tr8Item tr8_item_of(const Args& a, unsigned char* Wgu8, unsigned char* Wdn8, int id, int wave, int lane) {
    Tr8Item t;
    if (id < 2048) { const int e = id >> 6, kb = (id >> 3) & 7, jt = id & 7; const int col = lane < 32 ? 128 * jt + 4 * lane : 1024 + 128 * jt + 4 * (lane - 32);
        t.src = a.in[21] + (size_t)e * 1024 * 2048 + (size_t)(128 * kb + 16 * wave) * 2048 + col; t.ldw = 2048; t.dst = Wgu8 + (size_t)e * 2048 * 1024 + (size_t)(256 * jt) * 1024 + 128 * kb; }
    else { const int r = id - 2048, e = r >> 5, kb = (r >> 2) & 7, nb = r & 3;
        t.src = a.in[23] + (size_t)e * 1024 * 1024 + (size_t)(128 * kb + 16 * wave) * 1024 + 256 * nb + 4 * lane; t.ldw = 1024; t.dst = Wdn8 + (size_t)e * 1024 * 1024 + (size_t)(256 * nb) * 1024 + 128 * kb; }
    return t;
}
__device__ __forceinline__ void tr8_load(const Tr8Item& t, f32x4 (&v)[16]) {
#pragma unroll
    for (int j = 0; j < 16; ++j) v[j] = *(const f32x4*)(t.src + (size_t)j * t.ldw);
}
__device__ __forceinline__ void tr8_finish(const Tr8Item& t, const f32x4 (&v)[16], LAS unsigned char* tile, int tid, int wave, int lane) {
    __syncthreads();
#pragma unroll
    for (int cc = 0; cc < 4; ++cc) { u32x4 o;
        o.x = pk4_fp8(v[0][cc] * 16.0f, v[1][cc] * 16.0f, v[2][cc] * 16.0f, v[3][cc] * 16.0f);    o.y = pk4_fp8(v[4][cc] * 16.0f, v[5][cc] * 16.0f, v[6][cc] * 16.0f, v[7][cc] * 16.0f);
        o.z = pk4_fp8(v[8][cc] * 16.0f, v[9][cc] * 16.0f, v[10][cc] * 16.0f, v[11][cc] * 16.0f); o.w = pk4_fp8(v[12][cc] * 16.0f, v[13][cc] * 16.0f, v[14][cc] * 16.0f, v[15][cc] * 16.0f);
        *(LAS u32x4*)(tile + (4 * lane + cc) * 144 + 16 * wave) = o; }
    __syncthreads();
#pragma unroll
    for (int i = 0; i < 4; ++i) { const int p = tid + 512 * i, n = p >> 3, q = p & 7;
        *(u32x4*)(t.dst + (size_t)n * 1024 + 16 * q) = *(const LAS u32x4*)(tile + n * 144 + 16 * q); }
}
__device__ __forceinline__ void rms_row_to_bf16(const float* xrow, const float* gain, bf16* orow, int lane) {
    f32x4 v[4]; float s = 0.f;
#pragma unroll
    for (int j = 0; j < 4; ++j) { v[j] = *(const f32x4*)(xrow + 4 * lane + 256 * j); s += (v[j].x * v[j].x + v[j].y * v[j].y) + (v[j].z * v[j].z + v[j].w * v[j].w); }
    const float rstd = 1.0f / sqrtf(wave_sum(s) * (1.0f / D) + RMS_EPS);
#pragma unroll
    for (int j = 0; j < 4; ++j) { const f32x4 g = *(const f32x4*)(gain + 4 * lane + 256 * j); u32x2 w; w.x = pk2(v[j].x * rstd * g.x, v[j].y * rstd * g.y); w.y = pk2(v[j].z * rstd * g.z, v[j].w * rstd * g.w);
        *(u32x2*)(orow + 4 * lane + 256 * j) = w; }
}
#ifndef P0REP
#define P0REP 0
#endif
#ifdef FAST_MIX
constexpr bool FAST_MIX_P0 = FAST_MIX != 0;
#else
constexpr bool FAST_MIX_P0 = false;
#endif
__device__ __forceinline__ void p0_prologue(const Args& a, const Ctx& c) {
    for (int rp = 0; rp < 1 + (P0REP & 1); ++rp)
    for (int g = c.bid; g < 64; g += c.G) p0_ssm_prep(a, c, g);
    LAS float* scr = (LAS float*)(c.lds + c.wave * 16384);
    bf16* WinT = (bf16*)(c.ws + WS_WIN); bf16* WgluT = (bf16*)(c.ws + WS_WGLU); bf16* WbrT = (bf16*)(c.ws + WS_WBR); bf16* WoutT = (bf16*)(c.ws + WS_WOUT);
    unsigned char* Wgu8 = c.ws + WS_WGU; unsigned char* Wdn8 = c.ws + WS_WDN;
    constexpr int NI_IN = 16 * 136, NI_SQ = 512, NI_ALL = NI_IN + 4 * NI_SQ;
    for (int rp = 0; rp < 1 + ((P0REP >> 1) & 1); ++rp)
    for (int it = c.gw; it < NI_ALL; it += c.ngw) {
        int r = it;
        if (r < NI_IN) { const int kb = r / 136, nb = r % 136, n0 = 32 * nb; const bool perm = (n0 >= 1024 && n0 < 2176 && (n0 & 63) == 0);
            tr_item(a.in[3], INW, 64 * kb, n0, perm, WinT, 1024, n0, 0, scr, c.lane); continue; } r -= NI_IN;
        if (r < NI_SQ) { tr_item(a.in[12], 1024, 64 * (r >> 5), 32 * (r & 31), false, WgluT, 1024, 32 * (r & 31), 0, scr, c.lane); continue; } r -= NI_SQ;
        if (r < NI_SQ) { tr_item(a.in[15], 1024, 64 * (r >> 5), 32 * (r & 31), false, WbrT, 1024, 32 * (r & 31), 0, scr, c.lane); continue; } r -= NI_SQ;
        if (r < NI_SQ) { tr_item(a.in[16], 1024, 64 * (r >> 5), 32 * (r & 31), false, WbrT, 1024, 1024 + 32 * (r & 31), 0, scr, c.lane); continue; } r -= NI_SQ;
        tr_item(a.in[17], 1024, 64 * (r >> 5), 32 * (r & 31), false, WoutT, 1024, 32 * (r & 31), 0, scr, c.lane);
    }
    for (int rp = 0; rp < 1 + ((P0REP >> 2) & 1); ++rp)
    {
        f32x4 va[16], vb[16];
        int id = c.bid;
        Tr8Item ta = tr8_item_of(a, Wgu8, Wdn8, id < 3072 ? id : 0, c.wave, c.lane), tb = ta;
        if (id < 3072) tr8_load(ta, va);
        while (id < 3072) {
            const int id1 = id + c.G;
            if (id1 < 3072) { tb = tr8_item_of(a, Wgu8, Wdn8, id1, c.wave, c.lane); tr8_load(tb, vb); }
            tr8_finish(ta, va, c.lds, c.tid, c.wave, c.lane);
            if (id1 >= 3072) break;
            const int id2 = id1 + c.G;
            if (id2 < 3072) { ta = tr8_item_of(a, Wgu8, Wdn8, id2, c.wave, c.lane); tr8_load(ta, va); }
            tr8_finish(tb, vb, c.lds, c.tid, c.wave, c.lane);
            id = id2;
        }
        __syncthreads();
    }
    bf16* XN = (bf16*)(c.ws + WS_XN);
    for (int rp = 0; rp < 1 + ((P0REP >> 3) & 1); ++rp)
    for (int m0 = 2 * c.gw; m0 < MP; m0 += 2 * c.ngw) {
        f32x4 v[2][4]; float ss[2];
#pragma unroll
        for (int r = 0; r < 2; ++r) { const int m = m0 + r; const float* xrow = m < M ? a.in[0] + (size_t)m * D : a.in[1] + (size_t)((m < M + NMETA ? m : M) - M) * D;
#pragma unroll
            for (int j = 0; j < 4; ++j) v[r][j] = *(const f32x4*)(xrow + 4 * c.lane + 256 * j); }
#pragma unroll
        for (int r = 0; r < 2; ++r) { float s = 0.f;
#pragma unroll
            for (int j = 0; j < 4; ++j) s += (v[r][j].x * v[r][j].x + v[r][j].y * v[r][j].y) + (v[r][j].z * v[r][j].z + v[r][j].w * v[r][j].w);
            ss[r] = wave_sum(s); }
#pragma unroll
        for (int r = 0; r < 2; ++r) { const int m = m0 + r; const float rstd = (m < M + NMETA) ? 1.0f / sqrtf(ss[r] * (1.0f / D) + RMS_EPS) : 0.f;
#pragma unroll
            for (int j = 0; j < 4; ++j) { const f32x4 g = *(const f32x4*)(a.in[2] + 4 * c.lane + 256 * j); u32x2 w; w.x = pk2(v[r][j].x * rstd * g.x, v[r][j].y * rstd * g.y); w.y = pk2(v[r][j].z * rstd * g.z, v[r][j].w * rstd * g.w);
                *(u32x2*)(XN + (size_t)m * D + 4 * c.lane + 256 * j) = w; } }
    }
    p0_router_frags(a, c);
    const int gt = c.bid * (NWAVES * 64) + c.tid, ngt = c.G * NWAVES * 64;
    float* rot = (float*)(c.ws + WS_ROT);
    for (int i = gt; i < LTOT * 8; i += ngt) { const int pos = i >> 3, j = i & 7;
        const float invs[8] = {1.0f, 0.1939227432012558f, 0.03760603070259094f, 0.007292664609849453f, 0.0014142135623842478f, 0.00027424818836152554f, 5.318296098266728e-05f, 1.0313386155758053e-05f};
        float inv = invs[0];
#pragma unroll
        for (int q = 1; q < 8; ++q) inv = (j == q) ? invs[q] : inv;
        const float ang = (float)pos * inv; const double rev = (double)ang * 0.15915494309189535; const float fr_ = (float)(rev - floor(rev));
        rot[pos * 16 + j] = __builtin_amdgcn_cosf(fr_); rot[pos * 16 + 8 + j] = __builtin_amdgcn_sinf(fr_); }
    if constexpr (!FAST_MIX_P0) {
    float* Ab = (float*)(c.ws + WS_SSMP); float* BB = Ab + 16384;
    for (int i = gt; i < 4096; i += ngt) { const int g = i >> 6;
        const float lr = a.in[4][i], li = a.in[5][i], dt = expf(a.in[6][g]), mag = expf(dt * lr), ar = mag * cosf(dt * li), ai = mag * sinf(dt * li);
        const float den = lr * lr + li * li, nr = ar - 1.0f, ni = ai, fr = (nr * lr + ni * li) / den, fi = (ni * lr - nr * li) / den;
        Ab[2 * i] = ar; Ab[2 * i + 1] = ai;
        for (int h = 0; h < 16; ++h) { const float br = a.in[7][i * 16 + h], bi = a.in[8][i * 16 + h]; BB[(i * 16 + h) * 2] = fr * br - fi * bi; BB[(i * 16 + h) * 2 + 1] = fr * bi + fi * br; }
    }
    }
}

__device__ __forceinline__ void p2_ssm_naive(const Args& a, const Ctx& c) {
    const float* Ab = (const float*)(c.ws + WS_SSMP); const float* BB = Ab + 16384;
    const bf16* U = (const bf16*)(c.ws + WS_U); bf16* Z = (bf16*)(c.ws + WS_Z);
    for (int it = c.gw; it < 128; it += c.ngw) {
        const int g = it >> 1, b = it & 1, p = c.lane, gp = g * 64 + p;
        const float ar = Ab[2 * gp], ai = Ab[2 * gp + 1];
        float bbr[16], bbi[16], cr[16], ci[16], dd[16];
#pragma unroll
        for (int h = 0; h < 16; ++h) { bbr[h] = BB[(gp * 16 + h) * 2]; bbi[h] = BB[(gp * 16 + h) * 2 + 1]; cr[h] = a.in[9][(g * 16 + h) * 64 + p]; ci[h] = a.in[10][(g * 16 + h) * 64 + p]; dd[h] = a.in[11][g * 16 + h]; }
        float xr = 0.f, xi = 0.f;
        const bf16* up = U + (size_t)((g * 2 + b) * NCH) * 256;
        for (int t = 0; t < LTOT; ++t) {
            float u[16]; { float t0[8], t1[8]; unpack8(*(const u32x4*)(up + t * 16), t0); unpack8(*(const u32x4*)(up + t * 16 + 8), t1);
#pragma unroll
                for (int h = 0; h < 8; ++h) { u[h] = t0[h]; u[8 + h] = t1[h]; } }
            float br_ = 0.f, bi_ = 0.f;
#pragma unroll
            for (int h = 0; h < 16; ++h) { br_ += bbr[h] * u[h]; bi_ += bbi[h] * u[h]; }
            const float nxr = ar * xr - ai * xi + br_, nxi = ar * xi + ai * xr + bi_; xr = nxr; xi = nxi;
            if (t >= NMETA) {
                float mine = 0.f;
#pragma unroll
                for (int h = 0; h < 16; ++h) { float v = wave_sum(cr[h] * xr - ci[h] * xi); if (c.lane == h) mine = v + dd[h] * u[h]; }
                if (c.lane < 16) Z[(size_t)(b * SEQ + t - NMETA) * 1024 + g * 16 + c.lane] = (bf16)f2bf(gelu_tanh(mine));
            }
        }
    }
}
__device__ __forceinline__ float dot8(u32x4 q, u32x4 k) {
    return (bflo(q.x) * bflo(k.x) + bfhi(q.x) * bfhi(k.x)) + (bflo(q.y) * bflo(k.y) + bfhi(q.y) * bfhi(k.y)) + (bflo(q.z) * bflo(k.z) + bfhi(q.z) * bfhi(k.z)) + (bflo(q.w) * bflo(k.w) + bfhi(q.w) * bfhi(k.w));
}
__device__ __forceinline__ void p2_attn_naive(const Args& a, const Ctx& c) {
    const bf16* Q = (const bf16*)(c.ws + WS_Q); const bf16* Kb = (const bf16*)(c.ws + WS_K); const bf16* Vt = (const bf16*)(c.ws + WS_VT); bf16* BRA = (bf16*)(c.ws + WS_BRA);
    const int lane = c.lane;
    for (int it = c.gw; it < M * 16; it += c.ngw) {
        const int r = it >> 4, h = it & 15, kvh = h >> 3, b = r >> 13, t = r & (SEQ - 1);
        u32x4 qv[8];
#pragma unroll
        for (int i = 0; i < 8; ++i) qv[i] = *(const u32x4*)(Q + (size_t)r * 1024 + h * 64 + 8 * i);
        float s[3];
#pragma unroll
        for (int sl = 0; sl < 3; ++sl) {
            int pos; bool ok;
            if (sl < 2) { const int tok = t - 127 + lane + 64 * sl; ok = tok >= 0; pos = NMETA + (ok ? tok : 0); } else { ok = lane < NMETA; pos = ok ? lane : 0; }
            const bf16* kp = Kb + ((size_t)(b * LTOT + pos)) * 128 + kvh * 64; float acc = 0.f;
#pragma unroll
            for (int i = 0; i < 8; ++i) acc += dot8(qv[i], *(const u32x4*)(kp + 8 * i));
            s[sl] = ok ? acc : -1e30f;
        }
        const float sink = a.in[14][h] * 1.4426950408889634f;
        const float mx = wave_max(fmaxf(fmaxf(s[0], s[1]), fmaxf(s[2], sink)));
        const float p0 = exp2f(s[0] - mx), p1 = exp2f(s[1] - mx), p2 = exp2f(s[2] - mx);
        const float l = wave_sum(p0 + p1 + p2) + exp2f(sink - mx);
        const bf16* vrow = Vt + (size_t)(b * LTOT) * 128 + kvh * 64 + lane;
        float o = 0.f;
        for (int j = 0; j < 128; ++j) { const int tok = t - 127 + j; const float pj = __shfl(j < 64 ? p0 : p1, j & 63); if (tok >= 0) o += pj * bf2f(vrow[(size_t)(NMETA + tok) * 128]); }
        for (int j = 0; j < NMETA; ++j) { const float pj = __shfl(p2, j); o += pj * bf2f(vrow[(size_t)j * 128]); }
        BRA[(size_t)(M + r) * 1024 + h * 64 + lane] = (bf16)f2bf(o / l);
    }
}

__device__ __forceinline__ void p6_router(const Args& a, const Ctx& c) {
    const float* H1 = (const float*)(c.ws + WS_H1); unsigned char* XG = c.ws + WS_HN2;
    int* TE = (int*)(c.ws + WS_TOK); int* TP = TE + M * 4; float* RS = (float*)(c.ws + WS_TOK) + M * 16 + NSLOT * 2;
    int* TOKOF = (int*)(c.ws + WS_TOKOF); float* GATEOF = (float*)(c.ws + WS_GATEOF); float* RSOF = (float*)(c.ws + WS_RSOF);
    unsigned* cnt = (unsigned*)(c.ws + WS_CTL) + CW_CNT;
    const float* brt = a.in[20];
    LAS float* gl = (LAS float*)(c.lds + LDSCTL_OFF + 8192);
    LAS unsigned* hist = (LAS unsigned*)(c.lds + LDSCTL_OFF + 12288); LAS unsigned* ebase = hist + 32;
    const int lane = c.lane, fr = lane & 15, fq = lane >> 4;
    __syncthreads();
    for (int idx = c.tid; idx < 8192; idx += NWAVES * 64) *(LAS u32x4*)(c.lds + idx * 16) = *(const u32x4*)(c.ws + WS_SSMP + SSM_WRF + (size_t)idx * 16);
    for (int idx = c.tid; idx < 1024; idx += NWAVES * 64) gl[idx] = a.in[18][idx];
    for (int t0 = 0; t0 < M / 16; t0 += 4 * c.G) {
        if (c.tid < 32) hist[c.tid] = 0u;
        __syncthreads();
        const int kh = c.wave >> 2;
        const int tile = t0 + (c.wave & 3) * c.G + c.bid; const bool work = tile < M / 16;
        LAS float* part = (LAS float*)(c.lds + LDSCTL_OFF + 16384) + ((c.wave & 3) * 64 + lane) * 9;
        int te[4]; unsigned rk[4]; float gts[4] = {0.f, 0.f, 0.f, 0.f}, rstd_keep = 0.f; const int row = 16 * tile + fr;
        f32x4 racc0 = {0.f, 0.f, 0.f, 0.f}, racc1 = {0.f, 0.f, 0.f, 0.f}; float rss = 0.f;
        if (work) {
            const float* xr = H1 + (size_t)row * D + 8 * fq;
            f32x4 acc0 = {0.f, 0.f, 0.f, 0.f}, acc1 = {0.f, 0.f, 0.f, 0.f}; float ss = 0.f;
#pragma unroll 4
            for (int ks = 16 * kh; ks < 16 * kh + 16; ++ks) {
                const f32x4 x0 = *(const f32x4*)(xr + 32 * ks), x1 = *(const f32x4*)(xr + 32 * ks + 4);
                const f32x4 g0 = *(const LAS f32x4*)(gl + 32 * ks + 8 * fq), g1 = *(const LAS f32x4*)(gl + 32 * ks + 8 * fq + 4);
                ss += (x0.x * x0.x + x0.y * x0.y) + (x0.z * x0.z + x0.w * x0.w) + (x1.x * x1.x + x1.y * x1.y) + (x1.z * x1.z + x1.w * x1.w);
                const f32x4 v0 = x0 * g0, v1 = x1 * g1;
                u32x4 hw; hw.x = pk2(v0.x, v0.y); hw.y = pk2(v0.z, v0.w); hw.z = pk2(v1.x, v1.y); hw.w = pk2(v1.z, v1.w);
                { u32x2 w8; w8.x = pk4_fp8(v0.x, v0.y, v0.z, v0.w); w8.y = pk4_fp8(v1.x, v1.y, v1.z, v1.w); *(u32x2*)(XG + (size_t)row * D + 32 * ks + 8 * fq) = w8; }
                u32x4 lw; lw.x = pk2(v0.x - bflo(hw.x), v0.y - bfhi(hw.x)); lw.y = pk2(v0.z - bflo(hw.y), v0.w - bfhi(hw.y)); lw.z = pk2(v1.x - bflo(hw.z), v1.y - bfhi(hw.z)); lw.w = pk2(v1.z - bflo(hw.w), v1.w - bfhi(hw.w));
                const bf16x8 hi = __builtin_bit_cast(bf16x8, hw), lo = __builtin_bit_cast(bf16x8, lw);
                const bf16x8 wh0 = *(const LAS bf16x8*)(c.lds + ((ks * 2 + 0) * 64 + lane) * 16), wh1 = *(const LAS bf16x8*)(c.lds + ((ks * 2 + 1) * 64 + lane) * 16);
                const bf16x8 wl0 = *(const LAS bf16x8*)(c.lds + 65536 + ((ks * 2 + 0) * 64 + lane) * 16), wl1 = *(const LAS bf16x8*)(c.lds + 65536 + ((ks * 2 + 1) * 64 + lane) * 16);
                acc0 = __builtin_amdgcn_mfma_f32_16x16x32_bf16(wh0, hi, acc0, 0, 0, 0); acc1 = __builtin_amdgcn_mfma_f32_16x16x32_bf16(wh1, hi, acc1, 0, 0, 0);
                acc0 = __builtin_amdgcn_mfma_f32_16x16x32_bf16(wl0, hi, acc0, 0, 0, 0); acc1 = __builtin_amdgcn_mfma_f32_16x16x32_bf16(wl1, hi, acc1, 0, 0, 0);
                acc0 = __builtin_amdgcn_mfma_f32_16x16x32_bf16(wh0, lo, acc0, 0, 0, 0); acc1 = __builtin_amdgcn_mfma_f32_16x16x32_bf16(wh1, lo, acc1, 0, 0, 0);
            }
            racc0 = acc0; racc1 = acc1; rss = ss;
            if (kh == 1) { part[0] = acc0[0]; part[1] = acc0[1]; part[2] = acc0[2]; part[3] = acc0[3]; part[4] = acc1[0]; part[5] = acc1[1]; part[6] = acc1[2]; part[7] = acc1[3]; part[8] = ss; }
        }
        __syncthreads();
        if (work && kh == 0) {
            f32x4 acc0, acc1; float ss;
            acc0 = racc0; acc1 = racc1; ss = rss;
            acc0[0] += part[0]; acc0[1] += part[1]; acc0[2] += part[2]; acc0[3] += part[3]; acc1[0] += part[4]; acc1[1] += part[5]; acc1[2] += part[6]; acc1[3] += part[7]; ss += part[8];
            ss += __shfl_xor(ss, 16); ss += __shfl_xor(ss, 32);
            const float rstd = 1.0f / sqrtf(ss * (1.0f / D) + RMS_EPS);
            float lg[32];
#pragma unroll
            for (int q = 0; q < 4; ++q)
#pragma unroll
                for (int r = 0; r < 4; ++r) { lg[4 * q + r] = __shfl(acc0[r], fr + 16 * q) * rstd + brt[4 * q + r]; lg[16 + 4 * q + r] = __shfl(acc1[r], fr + 16 * q) * rstd + brt[16 + 4 * q + r]; }
            float tv[4];
#pragma unroll
            for (int k = 0; k < 4; ++k) { float best = -3.0e38f; int bi = 0;
#pragma unroll
                for (int e = 0; e < 32; ++e) if (lg[e] > best) { best = lg[e]; bi = e; }
                te[k] = bi; tv[k] = best;
#pragma unroll
                for (int e = 0; e < 32; ++e) if (e == bi) lg[e] = -3.0e38f; }
            if (fq == 0) {
                const float e1 = __expf(tv[1] - tv[0]), e2 = __expf(tv[2] - tv[0]), e3 = __expf(tv[3] - tv[0]), inv = 1.0f / (1.0f + e1 + e2 + e3);
                gts[0] = inv; gts[1] = e1 * inv; gts[2] = e2 * inv; gts[3] = e3 * inv;
                *(u32x4*)(TE + row * 4) = (u32x4){(unsigned)te[0], (unsigned)te[1], (unsigned)te[2], (unsigned)te[3]};
                rstd_keep = rstd;
#pragma unroll
                for (int k = 0; k < 4; ++k) rk[k] = __hip_atomic_fetch_add(hist + te[k], 1u, __ATOMIC_RELAXED, __HIP_MEMORY_SCOPE_WORKGROUP);
            }
        }
        __syncthreads();
        if (c.tid < 32) ebase[c.tid] = __hip_atomic_fetch_add(cnt + c.tid, hist[c.tid], RLX_AGENT);
        __syncthreads();
        if (work && kh == 0 && fq == 0) { const u32x4 pp = {ebase[te[0]] + rk[0], ebase[te[1]] + rk[1], ebase[te[2]] + rk[2], ebase[te[3]] + rk[3]}; *(u32x4*)(TP + row * 4) = pp;
#pragma unroll
            for (int k = 0; k < 4; ++k) { TOKOF[te[k] * M + (int)pp[k]] = row; GATEOF[te[k] * M + (int)pp[k]] = gts[k]; RSOF[te[k] * M + (int)pp[k]] = rstd_keep; } }
        __syncthreads();
    }
}
__device__ __forceinline__ int moe_tables(const Ctx& c, LAS int* tb, LAS int* tile_e, LAS int* cntl) {
    __syncthreads();
    if (c.wave == 0) {
        const gu32* cnt = (const gu32*)(c.ws + WS_CTL) + CW_CNT; const int lane = c.lane;
        const int cn = lane < NE ? (int)__hip_atomic_load(cnt + (lane & 31), RLX_AGENT) : 0; if (lane < NE) cntl[lane] = cn;
        const int n = (cn + 255) >> 8;
        int incl = n;
#pragma unroll
        for (int o = 1; o < 32; o <<= 1) { const int t = __shfl_up(incl, o); if (lane >= o) incl += t; }
        int excl = incl - n; if (excl > MAXT) excl = MAXT;
        if (lane < NE) tb[lane] = excl;
        if (lane == NE - 1) tb[NE] = incl > MAXT ? MAXT : incl;
        if (lane < NE) for (int i = 0; i < n && excl + i < MAXT; ++i) tile_e[excl + i] = lane;
    }
    __syncthreads();
    return __builtin_amdgcn_readfirstlane(tb[NE]);
}
__device__ __forceinline__ void p10_final(const Args& a, const Ctx& c, const LAS int* tb) {
    const float* H1 = (const float*)(c.ws + WS_H1); const unsigned char* YS = c.ws + WS_YS;
    const int* TE = (const int*)(c.ws + WS_TOK); const int* TP = TE + M * 4; const float* gain = a.in[25];
    for (int row = c.gw; row < M; row += c.ngw) {
        f32x4 v[4];
#pragma unroll
        for (int j = 0; j < 4; ++j) v[j] = *(const f32x4*)(H1 + (size_t)row * D + 4 * c.lane + 256 * j);
        const u32x4 te4 = *(const u32x4*)(TE + row * 4), tp4 = *(const u32x4*)(TP + row * 4); u32x4 ts;
#pragma unroll
        for (int k = 0; k < 4; ++k) ts[k] = (unsigned)tb[te4[k]] * 256u + tp4[k];
        unsigned yw[4][4];
#pragma unroll
        for (int k = 0; k < 4; ++k) { const unsigned char* ys = YS + (size_t)ts[k] * D;
#pragma unroll
            for (int j = 0; j < 4; ++j) yw[k][j] = *(const unsigned*)(ys + 4 * c.lane + 256 * j); }
#pragma unroll
        for (int k = 0; k < 4; ++k)
#pragma unroll
            for (int j = 0; j < 4; ++j) { typedef float f32x2v __attribute__((ext_vector_type(2)));
                const f32x2v lo = __builtin_amdgcn_cvt_pk_f32_fp8(yw[k][j], false), hi = __builtin_amdgcn_cvt_pk_f32_fp8(yw[k][j], true);
                v[j].x += lo.x * 0.0625f; v[j].y += lo.y * 0.0625f; v[j].z += hi.x * 0.0625f; v[j].w += hi.y * 0.0625f; }
        float s = 0.f;
#pragma unroll
        for (int j = 0; j < 4; ++j) s += (v[j].x * v[j].x + v[j].y * v[j].y) + (v[j].z * v[j].z + v[j].w * v[j].w);
        const float rstd = 1.0f / sqrtf(wave_sum(s) * (1.0f / D) + RMS_EPS);
#pragma unroll
        for (int j = 0; j < 4; ++j) { const f32x4 g = *(const f32x4*)(gain + 4 * c.lane + 256 * j); *(f32x4*)(a.out + (size_t)row * D + 4 * c.lane + 256 * j) = v[j] * rstd * g; }
    }
}

#ifndef ONE_LAUNCH
#define ONE_LAUNCH 0
#endif
#ifndef FAST_GEMM
#define FAST_GEMM 0
#endif
#ifndef FAST_MIX
#define FAST_MIX 0
#endif
constexpr int NPH = 10;

template <bool FAST, class E, class S, bool F8 = false, bool GATHER = false>
__device__ __forceinline__ void run_gemm(const Ctx& c, const bf16* A, const bf16* Bt, int K, const S& s, const E& e) {
    if constexpr (FAST) { pg8::Gemm g{A, Bt, 0, 0, K, c.wave}; FastEpi<E> fe{e}; pg8::gemm_phase<FastEpi<E>, S, true, true, F8, GATHER>(c.lds, g, s, fe); }
    else { Unit u; for (int i = 0; s.next(i, u); ++i) naive_gemm_unit(A, K, Bt, K, K, u.pm, u.pn, e, c.wave, c.lane); }
}

__global__ void __launch_bounds__(NWAVES * 64, 2) fwd(Args args) {
    extern __shared__ __attribute__((aligned(16))) unsigned char lds_raw[];
    Ctx c0; c0.lds = (LAS unsigned char*)lds_raw; c0.ws = args.ws; c0.tid = threadIdx.x; c0.lane = c0.tid & 63; c0.wave = __builtin_amdgcn_readfirstlane(c0.tid >> 6);
    c0.G = gridDim.x; c0.bid = blockIdx.x; c0.gw = c0.bid * NWAVES + c0.wave; c0.ngw = c0.G * NWAVES;
    const Ctx& c = c0;
    volatile LAS unsigned* MISC = (volatile LAS unsigned*)(c.lds + LDSCTL_OFF);
    LAS int* tb = (LAS int*)(c.lds + LDSCTL_OFF + 512); LAS int* tile_e = (LAS int*)(c.lds + LDSCTL_OFF + 1024); LAS int* cntl = (LAS int*)(c.lds + LDSCTL_OFF + 256);
    for (int u = c.tid; u < (LDS_BYTES - LDSCTL_OFF) / 4; u += NWAVES * 64) ((LAS unsigned*)(c.lds + LDSCTL_OFF))[u] = 0u;
    __syncthreads();
    volatile LAS unsigned long long* ptab = (volatile LAS unsigned long long*)(c0.lds + LDSCTL_OFF + 2560);
    if (c0.tid < 26) ptab[c0.tid] = (unsigned long long)args.in[c0.tid];
    if (c0.tid == 26) ptab[26] = (unsigned long long)args.out;
    __syncthreads();
    const int lo = args.ph_lo, hi = args.ph_hi;
    XcdBarrier bar; bar.bar = (unsigned*)(c.ws + WS_CTL) + CW_BAR; bar.x = 0; bar.st = nullptr;
    if (hi - lo > 1) bar = xcd_barrier_post((unsigned*)(c.ws + WS_CTL) + CW_BAR, MISC + 8);
#ifndef DISMASK
#define DISMASK 0
#endif
#define IN(k) (lo <= (k) && (k) < hi && !((DISMASK >> (k)) & 1))
#define GRID_BAR() xcd_barrier(bar, c0.wave == 0 && pg8::fresh_lane() == 0)
#define SEAM(k) do { if (IN(k) && IN((k) + 1)) GRID_BAR(); } while (0)
#define WSB (c0.ws)
#define XN ((bf16*)(WSB + WS_XN))
#define U ((bf16*)(WSB + WS_U))
#define Q ((bf16*)(WSB + WS_Q))
#define Kb ((bf16*)(WSB + WS_K))
#define Vt ((bf16*)(WSB + WS_VT))
#define GSp ((bf16*)(WSB + WS_GS))
#define GAp ((bf16*)(WSB + WS_GA))
#define Z ((bf16*)(WSB + WS_Z))
#define BRA ((bf16*)(WSB + WS_BRA))
#define MIX ((bf16*)(WSB + WS_MIX))
#define H1 ((float*)(WSB + WS_H1))
#define HID ((bf16*)(WSB + WS_HID))
#define YS ((bf16*)(WSB + WS_YS))

#ifndef REPMASK
#define REPMASK 0
#endif
    int mixpass = 0, glupass = 0;
#ifndef GLU_NOSTORE
#define GLU_NOSTORE 0
#endif
#define PHASE(k, ...) if (IN(k)) { Ctx c = c0; c.lane = pg8::fresh_lane(); c.tid = c.wave * 64 + c.lane; Args pa; \
        _Pragma("unroll") for (int _k = 0; _k < 26; ++_k) { const unsigned long long _v = ptab[_k]; pa.in[_k] = (const float*)(((unsigned long long)(unsigned)__builtin_amdgcn_readfirstlane((int)(_v >> 32)) << 32) | (unsigned)__builtin_amdgcn_readfirstlane((int)_v)); } \
        { const unsigned long long _v = ptab[26]; pa.out = (float*)(((unsigned long long)(unsigned)__builtin_amdgcn_readfirstlane((int)(_v >> 32)) << 32) | (unsigned)__builtin_amdgcn_readfirstlane((int)_v)); } pa.ws = c0.ws; pa.ph_lo = 0; pa.ph_hi = 0; __VA_ARGS__ if constexpr ((REPMASK >> (k)) & 1) { GRID_BAR(); __VA_ARGS__ } } SEAM(k);
    PHASE(0, p0_prologue(pa, c);)
    PHASE(1, {
        EpiInProj E{U, Q, Kb, Vt, GSp, GAp, (const float*)(WSB + WS_ROT)};
        if constexpr (FAST_GEMM && FAST_MIX) { InProjOrder S; S.so.init(M, 4096, c.G, c.bid); run_gemm<true>(c, XN, (const bf16*)(WSB + WS_WIN), 1024, S, E); }
        else { pg8::StaticOrder S; S.init(MP, INW, c.G, c.bid); run_gemm<FAST_GEMM>(c, XN, (const bf16*)(WSB + WS_WIN), 1024, S, E); } })
    PHASE(2, if constexpr (FAST_MIX) {
#ifndef DEFER_REP
#define DEFER_REP 0
#endif
#ifndef MIXSKIP
#define MIXSKIP 0
#endif
 if (!(MIXSKIP & 1) || mixpass == 0) { for (int it = c.bid; it < 128; it += c.G) ssm_chain(c, it >> 1, it & 1); }
 if constexpr (FAST_GEMM) { if (mixpass == 0 || DEFER_REP) { EpiInProj E{U, Q, Kb, Vt, GSp, GAp, (const float*)(WSB + WS_ROT)}; DeferredOrder S{c.G >= 197 ? c.bid - 128 : (c.bid == 0 ? 0 : -1)};
     if (c.G >= 197) { run_gemm<true>(c, XN, (const bf16*)(WSB + WS_WIN), 1024, S, E); } else { for (int j = c.bid; j < 69; j += c.G) { DeferredOrder S1{j}; run_gemm<true>(c, XN, (const bf16*)(WSB + WS_WIN), 1024, S1, E); } } __syncthreads(); } }
 if (!(MIXSKIP & 2) || mixpass == 0) attn_fast(pa, c);
 ++mixpass;
 } else { p2_ssm_naive(pa, c); p2_attn_naive(pa, c); })
    PHASE(3, {
        pg8::StaticOrder S; S.init(M, 1024, c.G, c.bid);
        EpiGlu E{Z, pa.in[13], BRA};
        run_gemm<FAST_GEMM>(c, Z, (const bf16*)(WSB + WS_WGLU), 1024, S, E); })
    PHASE(4, {
        EpiBr E{GSp, GAp, MIX};
        if constexpr (FAST_GEMM) { PairOrder S; S.so.init(M, 1024, c.G, c.bid); run_gemm<true>(c, BRA, (const bf16*)(WSB + WS_WBR), 1024, S, E); }
        else { pg8::StaticOrder S; S.init(M, 1024, c.G, c.bid); run_gemm<false>(c, BRA, (const bf16*)(WSB + WS_WBR), 1024, S, E); } })
    PHASE(5, {
        pg8::StaticOrder S; S.init(M, 1024, c.G, c.bid);
        EpiOut E{pa.in[0], H1};
        run_gemm<FAST_GEMM>(c, MIX, (const bf16*)(WSB + WS_WOUT), 1024, S, E); })
    PHASE(6, p6_router(pa, c);)
    PHASE(7, {
        const int nt = moe_tables(c, tb, tile_e, cntl);
        const MoeTabs T{tile_e, tb, cntl, (const int*)(WSB + WS_TOKOF), (const float*)(WSB + WS_GATEOF), (const float*)(WSB + WS_RSOF)};
        MoeOrder S{T, nt, 8, c.G, c.bid};
        EpiMoe1 E{pa.in[22], (unsigned char*)HID, T};
        run_gemm<true, EpiMoe1, MoeOrder, true, true>(c, (const bf16*)(WSB + WS_HN2), (const bf16*)(WSB + WS_WGU), 512, S, E); })
    PHASE(8, {
        const int nt = moe_tables(c, tb, tile_e, cntl);
        const MoeTabs T{tile_e, tb, cntl, (const int*)(WSB + WS_TOKOF), (const float*)(WSB + WS_GATEOF), (const float*)(WSB + WS_RSOF)};
        MoeOrder S{T, nt, 4, c.G, c.bid};
        EpiMoe2 E{pa.in[24], (unsigned char*)YS, T};
        run_gemm<true, EpiMoe2, MoeOrder, true>(c, HID, (const bf16*)(WSB + WS_WDN), 512, S, E); })
    PHASE(9, { moe_tables(c, tb, tile_e, cntl); p10_final(pa, c, tb); })
#undef PHASE
#undef WSB
#undef XN
#undef U
#undef Q
#undef Kb
#undef Vt
#undef GSp
#undef GAp
#undef Z
#undef BRA
#undef MIX
#undef H1
#undef HID
#undef YS
#undef IN
#undef SEAM
}

extern "C" void kernel_launch(void* const* d_in, const int* in_sizes, int n_in, void* d_out, int out_size, void* d_ws, size_t ws_size, hipStream_t stream) {
    static int grid = 0;
    if (grid == 0) {
        if (n_in != 26 || in_sizes[0] != M * D || out_size != M * D || ws_size < WS_END) { fprintf(stderr, "kernel_launch: unexpected shapes (n_in %d, in0 %d, out %d, ws %zu)\n", n_in, n_in > 0 ? in_sizes[0] : -1, out_size, ws_size); grid = -1; return; }
        int dev = 0, cus = 0, per_cu = 0;
        if (hipGetDevice(&dev) != hipSuccess || hipDeviceGetAttribute(&cus, hipDeviceAttributeMultiprocessorCount, dev) != hipSuccess) { grid = -1; return; }
        if (hipFuncSetAttribute((const void*)fwd, hipFuncAttributeMaxDynamicSharedMemorySize, LDS_BYTES) != hipSuccess) { fprintf(stderr, "kernel_launch: hipFuncSetAttribute failed\n"); grid = -1; return; }
        if (hipOccupancyMaxActiveBlocksPerMultiprocessor(&per_cu, (const void*)fwd, NWAVES * 64, LDS_BYTES) != hipSuccess || per_cu < 1) fprintf(stderr, "kernel_launch: occupancy query says %d\n", per_cu);
        (void)hipGetLastError();
        grid = cus;
    }
    if (grid < 0) return;
    if (hipMemsetAsync((char*)d_ws + WS_CTL, 0, CTL_ZERO_BYTES, stream) != hipSuccess) return;
    Args a{};
    for (int i = 0; i < 26; ++i) a.in[i] = (const float*)d_in[i];
    a.out = (float*)d_out; a.ws = (unsigned char*)d_ws;
#if ONE_LAUNCH
    a.ph_lo = 0; a.ph_hi = NPH;
    hipLaunchKernelGGL(fwd, dim3(grid), dim3(NWAVES * 64), LDS_BYTES, stream, a);
#else
    for (int p = 0; p < NPH; ++p) { a.ph_lo = p; a.ph_hi = p + 1; hipLaunchKernelGGL(fwd, dim3(grid), dim3(NWAVES * 64), LDS_BYTES, stream, a); }
#endif
}
```

```cpp
#include <hip/hip_runtime.h>
#include <cstdio>
#include <cstdint>
#define ONE_LAUNCH 1
#define FAST_GEMM 1
#define FAST_MIX 1
#define EPI_FENCE 0
namespace pg8 {
#define PG8_LAS __attribute__((address_space(3)))
typedef unsigned short bf16_t;
typedef short bf16x8 __attribute__((ext_vector_type(8)));
typedef float f32x4 __attribute__((ext_vector_type(4)));
typedef unsigned u32x4 __attribute__((ext_vector_type(4)));
constexpr int BM = 256, BK = 64, HALF = 128, HTB = HALF * BK * 2  , STAGE_BYTES = 8 * HTB, NXCD = 8, WGM = 4;

__host__ __device__ __forceinline__ int lds_byte(int r, int c) { const int st = (r >> 4) * 2 + (c >> 5), rr = r & 15, cc = c & 31, ob = rr * 64 + cc * 2; return st * 1024 + (ob ^ (((ob >> 9) & 1) << 5)); }
__host__ __device__ __forceinline__ void stage_rc(int b, int& R, int& C) { const int st = b / 1024, sb = b % 1024, swz = sb ^ (((sb >> 9) & 1) << 5); R = (st >> 1) * 16 + swz / 64; C = (st & 1) * 32 + (swz % 64) / 2; }
__host__ __device__ __forceinline__ int perm32(int rho) { const int n = rho >> 4, i = rho & 15; return 8 * (i >> 2) + 4 * n + (i & 3); }

struct Unit { int pm, pn; };
struct Gemm { const bf16_t* A; const bf16_t* Bt; int M, N, K; int wid; };
__device__ __forceinline__ int fresh_lane() { int l; asm volatile("v_mbcnt_lo_u32_b32 %0, -1, 0\n\tv_mbcnt_hi_u32_b32 %0, -1, %0" : "=v"(l)); return l; }

struct StaticOrder {
    int nM, nN, nwg, G, c;
    __host__ __device__ void init(int M, int N, int G_, int c_) { nM = M / BM; nN = N / BM; nwg = nM * nN; G = G_; c = c_; }
    __host__ __device__ bool next(int i, Unit& u) const {
        const long L = (long)i * G + c; if (L >= nwg) return false;
        int wgid = (int)L; { const int q = nwg / NXCD, r = nwg % NXCD, xcd = wgid % NXCD, off = wgid / NXCD; wgid = (xcd < r ? xcd * (q + 1) : r * (q + 1) + (xcd - r) * q) + off; }
        const int nig = WGM * nN, gid = wgid / nig, fm = gid * WGM, gsz = (nM - fm) < WGM ? (nM - fm) : WGM;
        u.pm = fm + ((wgid % nig) % gsz); u.pn = (wgid % nig) / gsz; return true;
    }
    __device__ __forceinline__ void a_ready(const Unit&) const {}
    __device__ __forceinline__ void done(const Unit&) const {}
};
__device__ __forceinline__ unsigned cvt_pk_bf16(float lo, float hi) { unsigned r; asm volatile("v_cvt_pk_bf16_f32 %0, %1, %2" : "=v"(r) : "v"(lo), "v"(hi)); return r; }
typedef int pg8_v8i __attribute__((ext_vector_type(8))); typedef int pg8_v4i __attribute__((ext_vector_type(4)));
__device__ __forceinline__ pg8_v8i pg8_cat(bf16x8 lo, bf16x8 hi) { return __builtin_shufflevector(__builtin_bit_cast(pg8_v4i, lo), __builtin_bit_cast(pg8_v4i, hi), 0, 1, 2, 3, 4, 5, 6, 7); }
template <class Epi, class Sched, bool ALIGN_EPI = false, bool SP2 = false, bool F8 = false, bool GATHER = false>
__device__ __forceinline__ void gemm_phase(PG8_LAS unsigned char* lds, const Gemm g, const Sched& S, const Epi& E) {
    const int lane = fresh_lane(), wid = g.wid, tid = wid * 64 + lane, wr = wid >> 2, wc = wid & 3, fr = lane & 15, fq = lane >> 4;
    const int K = g.K, nt = K / BK;
    unsigned voffA[2], voffB[2];
#pragma unroll
    for (int i = 0; i < 2; ++i) { int R, C; stage_rc(tid * 16 + i * 8192, R, C); const int Rb = Epi::PERM ? ((R & ~31) + perm32(R & 31)) : R;
        voffA[i] = (unsigned)(R * K + C) * 2u; voffB[i] = (unsigned)(Rb * K + C) * 2u; }
    unsigned vA[2], nvA[2], gC = 0u;
    const unsigned kstep = (unsigned)(BK * 2);
    const unsigned hstep = (unsigned)HALF * K * 2;
    const unsigned tstep = 2 * hstep;
    const __amdgpu_buffer_rsrc_t rsA = __builtin_amdgcn_make_buffer_rsrc((void*)g.A, (short)0, -1, 0x00020000), rsB = __builtin_amdgcn_make_buffer_rsrc((void*)g.Bt, (short)0, -1, 0x00020000);
    const unsigned ldsw = (unsigned)wid * 1024u;
    const int aoff = lds_byte(wr * 64 + fr, fq * 8), boff = lds_byte(wc * 32 + fr, fq * 8);
#define PG8_SA(b, h) (((b) * 2 + (h)) * HTB)
#define PG8_SB(b, h) ((4 + (b) * 2 + (h)) * HTB)
#define PG8_STAGE(bufoff, gbase, voff) do { _Pragma("unroll") for (int _i = 0; _i < 2; ++_i) \
        __builtin_amdgcn_raw_ptr_buffer_load_lds(PG8_RS_##voff, (PG8_LAS unsigned*)(lds + (bufoff) + ldsw + _i * 8192), 16, (int)(voff)[_i], (int)(gbase), 0, 0); } while (0)
#define PG8_RS_voffA rsA
#define PG8_RS_voffB rsB
#define PG8_STAGE_A(bufoff, h, off) do { if constexpr (GATHER) { const unsigned _pk = ((off) >> 31) != 0u ? nvA[h] : vA[h]; _Pragma("unroll") for (int _i = 0; _i < 2; ++_i) \
        __builtin_amdgcn_raw_ptr_buffer_load_lds(rsA, (PG8_LAS unsigned*)(lds + (bufoff) + ldsw + _i * 8192), 16, (int)(((_pk >> (16 * _i)) & 0xffffu) * (unsigned)(K * 2) + gC), (int)((off) & 0x7fffffffu), 0, 0); } \
        else { PG8_STAGE(bufoff, (off) + (h) * hstep, voffA); } } while (0)
#define PG8_LOADROWS(dst, u) do { const int _ln = fresh_lane(); int _R, _C; stage_rc((wid * 64 + _ln) * 16, _R, _C); gC = (unsigned)_C * 2u; \
        _Pragma("unroll") for (int _h = 0; _h < 2; ++_h) dst[_h] = S.row_id(u, _R + 128 * _h) | (S.row_id(u, _R + 64 + 128 * _h) << 16); } while (0)
#define PG8_LDA(dst, b, h) do { _Pragma("unroll") for (int m = 0; m < 4; ++m) _Pragma("unroll") for (int k = 0; k < 2; ++k) dst[m][k] = *(const PG8_LAS bf16x8*)(lds + PG8_SA(b, h) + aoff + m * 2048 + k * 1024); } while (0)
#define PG8_LDB(dst, b, h) do { _Pragma("unroll") for (int n = 0; n < 2; ++n) _Pragma("unroll") for (int k = 0; k < 2; ++k) dst[n][k] = *(const PG8_LAS bf16x8*)(lds + PG8_SB(b, h) + boff + n * 2048 + k * 1024); } while (0)
#define PG8_MMA(ai, bj, At, Bt) do { __builtin_amdgcn_s_setprio(1); if constexpr (F8) { _Pragma("unroll") for (int m = 0; m < 4; ++m) _Pragma("unroll") for (int n = 0; n < 2; ++n) \
        acc[ai][bj][m][n] = __builtin_amdgcn_mfma_scale_f32_16x16x128_f8f6f4(pg8_cat(Bt[n][0], Bt[n][1]), pg8_cat(At[m][0], At[m][1]), acc[ai][bj][m][n], 0, 0, 0, 0, 0, 0); } else { \
        _Pragma("unroll") for (int m = 0; m < 4; ++m) _Pragma("unroll") for (int n = 0; n < 2; ++n) _Pragma("unroll") for (int k = 0; k < 2; ++k) \
        acc[ai][bj][m][n] = __builtin_amdgcn_mfma_f32_16x16x32_bf16(Bt[n][k], At[m][k], acc[ai][bj][m][n], 0, 0, 0); } __builtin_amdgcn_s_setprio(0); } while (0)
#define PG8_WAIT_V(n) asm volatile("s_waitcnt vmcnt(" #n ")" ::: "memory")
#define PG8_WAIT_L(n) asm volatile("s_waitcnt lgkmcnt(" #n ")" ::: "memory")
#define PG8_BAR __builtin_amdgcn_s_barrier()
#define PG8_SCHED __builtin_amdgcn_sched_barrier(0)
    Unit cur, nxt; int ui = 0;
    if (!S.next(0, cur)) return;
    f32x4 acc[2][2][4][2];
#pragma unroll
    for (int a = 0; a < 2; ++a)
#pragma unroll
        for (int b = 0; b < 2; ++b)
#pragma unroll
            for (int m = 0; m < 4; ++m)
#pragma unroll
                for (int n = 0; n < 2; ++n) acc[a][b][m][n] = (f32x4){0.f, 0.f, 0.f, 0.f};
    bf16x8 At[4][2], B0[2][2], B1[2][2];
    unsigned cA = GATHER ? 0u : (unsigned)cur.pm * tstep, cB = (unsigned)cur.pn * tstep;
    if constexpr (GATHER) { PG8_LOADROWS(vA, cur); PG8_LOADROWS(nvA, cur); }
    S.a_ready(cur);
    if constexpr (SP2) {
        PG8_STAGE(PG8_SB(0, 0), cB, voffB); PG8_STAGE(PG8_SB(0, 1), cB + hstep, voffB); PG8_STAGE_A(PG8_SA(0, 0), 0, cA); PG8_STAGE_A(PG8_SA(0, 1), 1, cA);
        if (wr == 1) PG8_BAR;
        PG8_WAIT_V(2); PG8_BAR;
        PG8_STAGE(PG8_SB(1, 0), cB + kstep, voffB); PG8_STAGE_A(PG8_SA(1, 0), 0, cA + kstep); PG8_STAGE(PG8_SB(1, 1), cB + hstep + kstep, voffB);
        PG8_WAIT_V(6); PG8_BAR;
    } else {
        PG8_STAGE(PG8_SB(0, 0), cB, voffB); PG8_STAGE_A(PG8_SA(0, 0), 0, cA); PG8_STAGE(PG8_SB(0, 1), cB + hstep, voffB); PG8_STAGE_A(PG8_SA(0, 1), 1, cA);
        if (wr == 1) PG8_BAR;
        PG8_WAIT_V(4); PG8_BAR;
        PG8_STAGE(PG8_SB(1, 0), cB + kstep, voffB); PG8_STAGE_A(PG8_SA(1, 0), 0, cA + kstep); PG8_STAGE(PG8_SB(1, 1), cB + hstep + kstep, voffB);
        PG8_WAIT_V(6); PG8_BAR;
    }
    for (;;) {
        const bool has_next = S.next(ui + 1, nxt);
        const unsigned nA = GATHER ? (has_next ? 0x80000000u : 0u) : (has_next ? (unsigned)nxt.pm * tstep : cA), nB = has_next ? (unsigned)nxt.pn * tstep : cB;
        if constexpr (GATHER) { if (has_next) PG8_LOADROWS(nvA, nxt); }
#pragma unroll 1
        for (int t = 0; t < nt; t += 2) {
            const bool last = (t == nt - 2);
            const unsigned a1 = cA + (unsigned)(t + 1) * kstep;
            const unsigned a2 = last ? nA : cA + (unsigned)(t + 2) * kstep, b2 = last ? nB : cB + (unsigned)(t + 2) * kstep;
            const unsigned a3 = a2 + kstep, b3 = b2 + kstep;
            if (last && has_next) S.a_ready(nxt);
            if constexpr (SP2) {
            PG8_LDB(B0, 0, 0); PG8_LDB(B1, 0, 1); PG8_SCHED; PG8_LDA(At, 0, 0); PG8_STAGE_A(PG8_SA(1, 1), 1, a1);
            PG8_WAIT_V(8); PG8_WAIT_L(0); PG8_BAR; PG8_MMA(0, 0, At, B0); PG8_MMA(0, 1, At, B1); PG8_BAR; PG8_SCHED;
            PG8_LDA(At, 0, 1); PG8_STAGE(PG8_SB(0, 0), b2, voffB); PG8_STAGE(PG8_SB(0, 1), b2 + hstep, voffB); PG8_STAGE_A(PG8_SA(0, 0), 0, a2);
            PG8_WAIT_V(8); PG8_WAIT_L(0); PG8_BAR; PG8_MMA(1, 0, At, B0); PG8_MMA(1, 1, At, B1); PG8_BAR; PG8_SCHED;
            PG8_LDB(B0, 1, 0); PG8_LDB(B1, 1, 1); PG8_SCHED; PG8_LDA(At, 1, 0); PG8_STAGE_A(PG8_SA(0, 1), 1, a2);
            PG8_WAIT_V(8); PG8_WAIT_L(0); PG8_BAR; PG8_MMA(0, 0, At, B0); PG8_MMA(0, 1, At, B1); PG8_BAR; PG8_SCHED;
            PG8_LDA(At, 1, 1); PG8_STAGE(PG8_SB(1, 0), b3, voffB); PG8_STAGE(PG8_SB(1, 1), b3 + hstep, voffB); PG8_STAGE_A(PG8_SA(1, 0), 0, a3);
            PG8_WAIT_V(8); PG8_WAIT_L(0); PG8_BAR; PG8_MMA(1, 0, At, B0); PG8_MMA(1, 1, At, B1); PG8_BAR; PG8_SCHED;
            } else {
            PG8_LDB(B0, 0, 0); PG8_SCHED; PG8_LDA(At, 0, 0); PG8_STAGE_A(PG8_SA(1, 1), 1, a1);
            PG8_WAIT_L(8); PG8_BAR; PG8_WAIT_L(0); PG8_MMA(0, 0, At, B0); PG8_BAR; PG8_SCHED;
            PG8_LDB(B1, 0, 1); PG8_STAGE(PG8_SB(0, 0), b2, voffB);
            PG8_BAR; PG8_WAIT_L(0); PG8_MMA(0, 1, At, B1); PG8_BAR;
            PG8_LDA(At, 0, 1); PG8_STAGE_A(PG8_SA(0, 0), 0, a2);
            PG8_BAR; PG8_WAIT_L(0); PG8_MMA(1, 0, At, B0); PG8_BAR; PG8_SCHED;
            PG8_STAGE(PG8_SB(0, 1), b2 + hstep, voffB);
            PG8_WAIT_V(6); PG8_BAR; PG8_MMA(1, 1, At, B1); PG8_BAR;
            PG8_LDB(B0, 1, 0); PG8_SCHED; PG8_LDA(At, 1, 0); PG8_STAGE_A(PG8_SA(0, 1), 1, a2);
            PG8_WAIT_L(8); PG8_BAR; PG8_WAIT_L(0); PG8_MMA(0, 0, At, B0); PG8_BAR; PG8_SCHED;
            PG8_LDB(B1, 1, 1); PG8_STAGE(PG8_SB(1, 0), b3, voffB);
            PG8_BAR; PG8_WAIT_L(0); PG8_MMA(0, 1, At, B1); PG8_BAR;
            PG8_LDA(At, 1, 1); PG8_STAGE_A(PG8_SA(1, 0), 0, a3);
            PG8_BAR; PG8_WAIT_L(0); PG8_MMA(1, 0, At, B0); PG8_BAR; PG8_SCHED;
            PG8_STAGE(PG8_SB(1, 1), b3 + hstep, voffB);
            PG8_WAIT_V(6); PG8_BAR; PG8_MMA(1, 1, At, B1); PG8_BAR;
            }
        }
        if constexpr (ALIGN_EPI) { if (wr == 0) PG8_BAR; }
        bool keep = false;
        if constexpr (Epi::HAS_MID) keep = E.first_half(cur);
        if constexpr (!Epi::AFTER_DRAIN) { if (keep) E.mid(acc, cur, wr, wc, fr, fq); else E(acc, cur, wr, wc, fr, fq); S.done(cur); }
        if (!has_next) break;
        if (!keep) {
#pragma unroll
        for (int a = 0; a < 2; ++a)
#pragma unroll
            for (int b = 0; b < 2; ++b)
#pragma unroll
                for (int m = 0; m < 4; ++m)
#pragma unroll
                    for (int n = 0; n < 2; ++n) acc[a][b][m][n] = (f32x4){0.f, 0.f, 0.f, 0.f};
        }
        cur = nxt; cA = GATHER ? 0u : nA; cB = nB; ++ui;
        if constexpr (GATHER) { vA[0] = nvA[0]; vA[1] = nvA[1]; }
        if constexpr (ALIGN_EPI) { if (wr == 1) PG8_BAR; }
    }
    PG8_WAIT_V(0);
    if constexpr (!ALIGN_EPI) { if (wr == 0) PG8_BAR; }
    PG8_BAR;
    if constexpr (Epi::AFTER_DRAIN) { E.fused(acc, cur, wr, wc, fr, fq, lds, wid, lane); S.done(cur); }
#undef PG8_SA
#undef PG8_SB
#undef PG8_STAGE
#undef PG8_RS_voffA
#undef PG8_STAGE_A
#undef PG8_LOADROWS
#undef PG8_RS_voffB
#undef PG8_LDA
#undef PG8_LDB
#undef PG8_MMA
#undef PG8_WAIT_V
#undef PG8_WAIT_L
#undef PG8_BAR
#undef PG8_SCHED
}
}

#define GAS __attribute__((address_space(1)))
#define LAS __attribute__((address_space(3)))
typedef unsigned short bf16;
typedef float f32x4 __attribute__((ext_vector_type(4)));
typedef short bf16x8 __attribute__((ext_vector_type(8)));
typedef unsigned u32x4 __attribute__((ext_vector_type(4)));
typedef unsigned u32x2 __attribute__((ext_vector_type(2)));
typedef GAS unsigned gu32;

constexpr int NWAVES = 8;
constexpr int D = 1024, SEQ = 8192, NBATCH = 2, NMETA = 16, LTOT = SEQ + NMETA;
constexpr int M = NBATCH * SEQ;
constexpr int MP = M + 256;
constexpr int INW = 4352;
constexpr int NCH = LTOT / 16;
constexpr int NE = 32, TOPK = 4;
constexpr int MAXT = M * TOPK / 256 + NE;
constexpr int NSLOT = MAXT * 256;
constexpr int VP = 8320;
constexpr float RMS_EPS = 1e-5f;

constexpr size_t MiB = 1ull << 20;
constexpr size_t WS_CTL = 0, CTL_ZERO_BYTES = 65536;
constexpr size_t WS_ROT = 1 * MiB;
constexpr size_t WS_TOK = 2 * MiB;
constexpr size_t WS_SSMP = 4 * MiB;
constexpr size_t WS_TOKOF = 24 * MiB;
constexpr size_t WS_GATEOF = 26 * MiB;
constexpr size_t WS_RSOF = 28 * MiB;
constexpr size_t WS_WIN = 32 * MiB;
constexpr size_t WS_WGLU = 41 * MiB;
constexpr size_t WS_WBR = 43 * MiB;
constexpr size_t WS_WOUT = 47 * MiB;
constexpr size_t WS_WGU = 49 * MiB;
constexpr size_t WS_WDN = 177 * MiB;
constexpr size_t WS_XN = 241 * MiB;
constexpr size_t WS_U = 274 * MiB;
constexpr size_t WS_Q = 307 * MiB;
constexpr size_t WS_K = 339 * MiB;
constexpr size_t WS_VT = 344 * MiB;
constexpr size_t WS_GS = 349 * MiB;
constexpr size_t WS_GA = 381 * MiB;
constexpr size_t WS_Z = 413 * MiB;
constexpr size_t WS_BRA = 445 * MiB;
constexpr size_t WS_MIX = 509 * MiB;
constexpr size_t WS_H1 = 541 * MiB;
constexpr size_t WS_HN2 = 605 * MiB;
constexpr size_t WS_S16 = 637 * MiB;
constexpr size_t WS_XC = 671 * MiB;
constexpr size_t WS_XS = 241 * MiB;
constexpr size_t WS_HID = 385 * MiB;
constexpr size_t WS_YS = 688 * MiB;
constexpr size_t WS_END = 832 * MiB;
static_assert((size_t)NSLOT * 2048 <= 144 * MiB, "slot buffers");
constexpr int CW_TMO = 0, CW_CNT = 1024, CW_BAR = 4096;

constexpr int RING_BYTES = 131072;
constexpr int LDSCTL_OFF = RING_BYTES;
constexpr int LDS_BYTES = 163840;

#define LDS_WAIT() asm volatile("s_waitcnt lgkmcnt(0)" ::: "memory")
#define VM_WAIT() asm volatile("s_waitcnt vmcnt(0)" ::: "memory")
#define RLX_AGENT __ATOMIC_RELAXED, __HIP_MEMORY_SCOPE_AGENT

__device__ __forceinline__ unsigned f2bf(float f) { unsigned u = __builtin_bit_cast(unsigned, f); return (u + 0x7fffu + ((u >> 16) & 1u)) >> 16; }
typedef float f32x2_t __attribute__((ext_vector_type(2))); typedef __bf16 bf16x2_t __attribute__((ext_vector_type(2)));
__device__ __forceinline__ unsigned pk2(float lo, float hi) { f32x2_t v = {lo, hi}; bf16x2_t b = __builtin_convertvector(v, bf16x2_t); return __builtin_bit_cast(unsigned, b); }
__device__ __forceinline__ float bflo(unsigned w) { return __uint_as_float(w << 16); }
__device__ __forceinline__ float bfhi(unsigned w) { return __uint_as_float(w & 0xffff0000u); }
__device__ __forceinline__ float bf2f(bf16 b) { return __uint_as_float((unsigned)b << 16); }
__device__ __forceinline__ float wave_sum(float v) {
#pragma unroll
    for (int o = 1; o < 64; o <<= 1) v += __shfl_xor(v, o);
    return v;
}
__device__ __forceinline__ float wave_max(float v) {
#pragma unroll
    for (int o = 1; o < 64; o <<= 1) v = fmaxf(v, __shfl_xor(v, o));
    return v;
}
__device__ __forceinline__ float sigmoidf_(float x) { return __builtin_amdgcn_rcpf(1.0f + __builtin_amdgcn_exp2f(-1.4426950408889634f * x)); }
__device__ __forceinline__ float gelu_tanh(float x) { const float e = __builtin_amdgcn_exp2f(x * (-2.3022082f + -0.1029432f * (x * x))); return x * __builtin_amdgcn_rcpf(1.0f + e); }
__device__ __forceinline__ void unpack8(u32x4 w, float (&v)[8]) { v[0] = bflo(w.x); v[1] = bfhi(w.x); v[2] = bflo(w.y); v[3] = bfhi(w.y); v[4] = bflo(w.z); v[5] = bfhi(w.z); v[6] = bflo(w.w); v[7] = bfhi(w.w); }
__device__ __forceinline__ u32x4 pack8(const float (&v)[8]) { u32x4 w; w.x = pk2(v[0], v[1]); w.y = pk2(v[2], v[3]); w.z = pk2(v[4], v[5]); w.w = pk2(v[6], v[7]); return w; }

__device__ __forceinline__ unsigned pk4_fp8(float a, float b, float c, float d) { unsigned w = 0u; w = __builtin_amdgcn_cvt_pk_fp8_f32(a, b, w, false); w = __builtin_amdgcn_cvt_pk_fp8_f32(c, d, w, true); return w; }
struct Args { const float* in[26]; float* out; unsigned char* ws; int ph_lo, ph_hi; };
struct Ctx { LAS unsigned char* lds; unsigned char* ws; int tid, lane, wave, G, bid, gw, ngw; };
using pg8::Unit;

template <class E>
__device__ __forceinline__ void naive_gemm_unit(const bf16* __restrict__ A, int lda, const bf16* __restrict__ Bt, int ldb, int K, int pm, int pn, const E& e, int wave, int lane) {
    const int fr = lane & 15, fq = lane >> 4;
    const int row0 = pm * 256 + wave * 32;
#pragma unroll 1
    for (int cg = 0; cg < 4; ++cg) {
        f32x4 acc[2][2][2];
#pragma unroll
        for (int i = 0; i < 2; ++i)
#pragma unroll
            for (int j = 0; j < 2; ++j)
#pragma unroll
                for (int n = 0; n < 2; ++n) acc[i][j][n] = (f32x4){0.f, 0.f, 0.f, 0.f};
#pragma unroll 1
        for (int half = 0; half < (E::HAS_MID ? 2 : 1); ++half) {
            const bf16* ap[2]; const bf16* bp[2][2];
#pragma unroll
            for (int mi = 0; mi < 2; ++mi) ap[mi] = A + (size_t)(half * M + row0 + 16 * mi + fr) * lda + 8 * fq;
#pragma unroll
            for (int bj = 0; bj < 2; ++bj)
#pragma unroll
                for (int n = 0; n < 2; ++n) bp[bj][n] = Bt + (size_t)(half * 1024 + pn * 256 + 128 * bj + 32 * cg + pg8::perm32(16 * n + fr)) * ldb + 8 * fq;
#pragma unroll 1
            for (int k0 = 0; k0 < K; k0 += 32) {
                bf16x8 av[2], bv[2][2];
#pragma unroll
                for (int mi = 0; mi < 2; ++mi) av[mi] = *(const bf16x8*)(ap[mi] + k0);
#pragma unroll
                for (int bj = 0; bj < 2; ++bj)
#pragma unroll
                    for (int n = 0; n < 2; ++n) bv[bj][n] = *(const bf16x8*)(bp[bj][n] + k0);
#pragma unroll
                for (int mi = 0; mi < 2; ++mi)
#pragma unroll
                    for (int bj = 0; bj < 2; ++bj)
#pragma unroll
                        for (int n = 0; n < 2; ++n) acc[mi][bj][n] = __builtin_amdgcn_mfma_f32_16x16x32_bf16(bv[bj][n], av[mi], acc[mi][bj][n], 0, 0, 0);
            }
            if constexpr (E::HAS_MID) {
                if (half == 0) {
#pragma unroll
                    for (int mi = 0; mi < 2; ++mi) e.mid(row0 + 16 * mi + fr, pn * 256 + 32 * cg + 8 * fq, acc[mi][0][0], acc[mi][0][1], acc[mi][1][0], acc[mi][1][1]);
                }
            }
        }
#pragma unroll
        for (int mi = 0; mi < 2; ++mi) e.row8(row0 + 16 * mi + fr, pn * 256 + 32 * cg + 8 * fq, acc[mi][0][0], acc[mi][0][1], acc[mi][1][0], acc[mi][1][1], pm, pn);
    }
}
#ifndef EPI_FENCE
#define EPI_FENCE 0
#endif
template <class E> struct FastEpi {
    static constexpr bool PERM = true, AFTER_DRAIN = false, HAS_MID = E::HAS_MID;
    E e;
    __device__ __forceinline__ void operator()(const f32x4 (&acc)[2][2][4][2], const Unit& u, int wr, int wc, int fr, int fq) const {
#pragma unroll
        for (int ai = 0; ai < 2; ++ai)
#pragma unroll
            for (int m = 0; m < 4; ++m) {
                e.row8(u.pm * 256 + ai * 128 + wr * 64 + m * 16 + fr, u.pn * 256 + wc * 32 + 8 * fq, acc[ai][0][m][0], acc[ai][0][m][1], acc[ai][1][m][0], acc[ai][1][m][1], u.pm, u.pn);
                if constexpr (EPI_FENCE > 0) { if ((m % EPI_FENCE) == EPI_FENCE - 1) asm volatile("" ::: "memory"); } }
    }
    __device__ __forceinline__ bool first_half(const Unit& u) const { if constexpr (E::HAS_MID) return u.pm < M / 256; else return false; }
    __device__ __forceinline__ void mid(f32x4 (&acc)[2][2][4][2], const Unit& u, int wr, int wc, int fr, int fq) const {
        if constexpr (E::HAS_MID) {
#pragma unroll
            for (int ai = 0; ai < 2; ++ai)
#pragma unroll
                for (int m = 0; m < 4; ++m)
                    e.mid(u.pm * 256 + ai * 128 + wr * 64 + m * 16 + fr, u.pn * 256 + wc * 32 + 8 * fq, acc[ai][0][m][0], acc[ai][0][m][1], acc[ai][1][m][0], acc[ai][1][m][1]);
        }
    }
};
struct PairOrder {
    pg8::StaticOrder so;
    __device__ __forceinline__ bool next(int i, Unit& u) const { Unit t; if (!so.next(i >> 1, t)) return false; const int h = i & 1; u.pm = t.pm + h * (M / 256); u.pn = t.pn + h * 4; return true; }
    __device__ __forceinline__ void a_ready(const Unit&) const {}
    __device__ __forceinline__ void done(const Unit&) const {}
};
struct RowMajorOrder {
    int nN, nwg, G, c;
    __device__ __forceinline__ bool next(int i, Unit& u) const { const long L = (long)i * G + c; if (L >= nwg) return false; u.pm = (int)L / nN; u.pn = (int)L % nN; return true; }
    __device__ __forceinline__ void a_ready(const Unit&) const {}
    __device__ __forceinline__ void done(const Unit&) const {}
};
struct InProjOrder {
    pg8::StaticOrder so;
    __device__ __forceinline__ bool next(int i, Unit& u) const { if (!so.next(i, u)) return false; if (u.pn == 15 && u.pm < 5) { u.pn = u.pm < 4 ? u.pm : 8; u.pm = M / 256; } return true; }
    __device__ __forceinline__ void a_ready(const Unit&) const {}
    __device__ __forceinline__ void done(const Unit&) const {}
};
struct DeferredOrder {
    int j;
    __device__ __forceinline__ bool next(int i, Unit& u) const { if (i != 0 || j < 0 || j >= 69) return false; if (j < 64) { u.pm = j; u.pn = 16; } else { u.pm = j - 64; u.pn = 15; } return true; }
    __device__ __forceinline__ void a_ready(const Unit&) const {}
    __device__ __forceinline__ void done(const Unit&) const {}
};
struct MoeTabs { const LAS int* tile_e; const LAS int* tb; const LAS int* cnt; const int* tok_of; const float* gate_of; const float* rs_of; };
__device__ __forceinline__ int moe_slot_pos(const MoeTabs& T, int e, int slot_row, bool& ok) { const int p = slot_row - T.tb[e] * 256; ok = p < T.cnt[e]; return p; }
struct MoeOrder {
    static constexpr bool HAS_HALF = false;
    MoeTabs T; int ntiles, nct, G, c;
    __device__ __forceinline__ bool next(int i, Unit& u) const {
        if ((G & 7) != 0) { const long L = (long)i * G + c; if (L >= (long)ntiles * nct) return false; u.pm = (int)L / nct; u.pn = __builtin_amdgcn_readfirstlane(T.tile_e[u.pm]) * nct + (int)L % nct; return true; }
        const int per = G >> 3, x = c & 7, j = c >> 3, rpb = 32 / nct;
        const long slot = (long)i * per + j;
        const long blk = (slot >> 5) * 8 + x; const int w = (int)(slot & 31);
        const long rt = blk * rpb + w / nct;
        if (rt >= ntiles) return false;
        u.pm = (int)rt; u.pn = __builtin_amdgcn_readfirstlane(T.tile_e[rt]) * nct + w % nct; return true; }
    __device__ __forceinline__ unsigned row_id(const Unit& u, int r) const { const int e = u.pn / nct; bool ok; const int p = moe_slot_pos(T, e, u.pm * 256 + r, ok); return ok ? (unsigned)T.tok_of[e * M + p] : 0u; }
    __device__ __forceinline__ void a_ready(const Unit&) const {}
    __device__ __forceinline__ void done(const Unit&) const {}
};

__device__ __forceinline__ void f4to8(f32x4 a0, f32x4 a1, float (&v)[8]) { v[0] = a0[0]; v[1] = a0[1]; v[2] = a0[2]; v[3] = a0[3]; v[4] = a1[0]; v[5] = a1[1]; v[6] = a1[2]; v[7] = a1[3]; }

struct EpiInProj {
    static constexpr bool HAS_MID = false;
    bf16 *U, *Q, *Kb, *Vt, *GSp, *GAp; const float* rot;
    __device__ __forceinline__ void one(int row, int col, f32x4 v0, f32x4 v1) const {
        const bool meta = row >= M;
        if (meta) { if (row >= M + NMETA) return; if (!(col < 1024 || (col >= 2048 && col < 2304))) return; }
        const int pos = meta ? row - M : NMETA + (row & (SEQ - 1));
        const int b0 = meta ? 0 : (row >> 13), nb = meta ? 2 : 1;
        float v[8]; f4to8(v0, v1, v);
        if (col < 1024) {
            const int g = col >> 4, h0 = col & 15; const u32x4 w = pack8(v);
            for (int bi = 0; bi < nb; ++bi) { const int b = b0 + bi; *(u32x4*)(U + ((size_t)((g * 2 + b) * NCH + (pos >> 4)) * 256 + (pos & 15) * 16 + h0)) = w; }
        } else if (col < 2176) {
            if ((col & 63) < 16) {
                const int i0 = (col & 8) ? 4 : 0; const float* cs = rot + pos * 16;
#pragma unroll
                for (int j = 0; j < 4; ++j) { const float c = cs[i0 + j], s = cs[8 + i0 + j], x1 = v[j], x2 = v[4 + j]; v[j] = x1 * c - x2 * s; v[4 + j] = x2 * c + x1 * s; }
            }
            if (col < 2048) {
#pragma unroll
                for (int j = 0; j < 8; ++j) v[j] *= 0.18033688011112042f;
                *(u32x4*)(Q + (size_t)row * 1024 + (col - 1024)) = pack8(v);
            } else {
                const u32x4 w = pack8(v);
                for (int bi = 0; bi < nb; ++bi) { const int b = b0 + bi; *(u32x4*)(Kb + ((size_t)(b * LTOT + pos)) * 128 + (col - 2048)) = w; }
            }
        } else if (col < 2304) {
            const u32x4 w = pack8(v);
            for (int bi = 0; bi < nb; ++bi) { const int b = b0 + bi; *(u32x4*)(Vt + ((size_t)(b * LTOT + pos)) * 128 + (col - 2176)) = w; }
        } else {
#pragma unroll
            for (int j = 0; j < 8; ++j) v[j] = sigmoidf_(v[j]);
            if (col < 3328) *(u32x4*)(GSp + (size_t)row * 1024 + (col - 2304)) = pack8(v);
            else *(u32x4*)(GAp + (size_t)row * 1024 + (col - 3328)) = pack8(v);
        }
    }
    __device__ __forceinline__ void row8(int row, int col, f32x4 a0, f32x4 a1, f32x4 b0, f32x4 b1, int, int) const { one(row, col, a0, a1); one(row, col + 128, b0, b1); }
};
struct EpiGlu {
    static constexpr bool HAS_MID = false;
    const bf16* Z; const float* bias; bf16* O;
    __device__ __forceinline__ void one(int row, int col, f32x4 v0, f32x4 v1) const {
        float v[8], z[8]; f4to8(v0, v1, v); unpack8(*(const u32x4*)(Z + (size_t)row * 1024 + col), z);
        const f32x4 c0 = *(const f32x4*)(bias + col), c1 = *(const f32x4*)(bias + col + 4); float bb[8]; f4to8(c0, c1, bb);
#pragma unroll
        for (int j = 0; j < 8; ++j) v[j] = z[j] * sigmoidf_(v[j] + bb[j]);
        *(u32x4*)(O + (size_t)row * 1024 + col) = pack8(v);
    }
    __device__ __forceinline__ void row8(int row, int col, f32x4 a0, f32x4 a1, f32x4 b0, f32x4 b1, int, int) const { one(row, col, a0, a1); one(row, col + 128, b0, b1); }
};
struct EpiBr {
    static constexpr bool HAS_MID = true;
    const bf16* GSp; const bf16* GAp; bf16* MIX;
    __device__ __forceinline__ void mid1(int row, int col, f32x4& v0, f32x4& v1) const {
        float gs[8], ga[8]; unpack8(*(const u32x4*)(GSp + (size_t)row * 1024 + col), gs); unpack8(*(const u32x4*)(GAp + (size_t)row * 1024 + col), ga);
#pragma unroll
        for (int j = 0; j < 4; ++j) { v0[j] *= gs[j] * __builtin_amdgcn_rcpf(fmaxf(ga[j], 1e-20f)); v1[j] *= gs[4 + j] * __builtin_amdgcn_rcpf(fmaxf(ga[4 + j], 1e-20f)); }
    }
    __device__ __forceinline__ void mid(int row, int col, f32x4& a0, f32x4& a1, f32x4& b0, f32x4& b1) const { mid1(row, col, a0, a1); mid1(row, col + 128, b0, b1); }
    __device__ __forceinline__ void one(int row, int col, f32x4 v0, f32x4 v1) const {
        float v[8], ga[8]; f4to8(v0, v1, v); unpack8(*(const u32x4*)(GAp + (size_t)row * 1024 + col), ga);
#pragma unroll
        for (int j = 0; j < 8; ++j) v[j] *= ga[j];
        *(u32x4*)(MIX + (size_t)row * 1024 + col) = pack8(v);
    }
    __device__ __forceinline__ void row8(int row, int col, f32x4 a0, f32x4 a1, f32x4 b0, f32x4 b1, int, int) const {
        if (row >= M) { row -= M; col -= 1024; }
        one(row, col, a0, a1); one(row, col + 128, b0, b1); }
};
struct EpiOut {
    static constexpr bool HAS_MID = false;
    const float* X; float* H1;
    __device__ __forceinline__ void one(int row, int col, f32x4 v0, f32x4 v1) const {
        const size_t o = (size_t)row * 1024 + col;
        *(f32x4*)(H1 + o) = *(const f32x4*)(X + o) + v0; *(f32x4*)(H1 + o + 4) = *(const f32x4*)(X + o + 4) + v1;
    }
    __device__ __forceinline__ void row8(int row, int col, f32x4 a0, f32x4 a1, f32x4 b0, f32x4 b1, int, int) const { one(row, col, a0, a1); one(row, col + 128, b0, b1); }
};
struct EpiMoe1 {
    static constexpr bool HAS_MID = false;
    const float* bgu; unsigned char* HID; MoeTabs T;
    __device__ __forceinline__ void row8(int row, int col, f32x4 a0, f32x4 a1, f32x4 b0, f32x4 b1, int, int pn) const {
        const int e = pn >> 3, ct = pn & 7, j0 = 128 * ct + (col - pn * 256); bool ok; const int p = moe_slot_pos(T, e, row, ok);
        const float rs = (ok ? T.rs_of[e * M + p] : 0.f) * 0.0625f;
        float g[8], up[8], bg[8], bu[8]; f4to8(a0 * rs, a1 * rs, g); f4to8(b0 * rs, b1 * rs, up);
        const float* bp = bgu + (size_t)e * 2048 + j0;
        f4to8(*(const f32x4*)bp, *(const f32x4*)(bp + 4), bg); f4to8(*(const f32x4*)(bp + 1024), *(const f32x4*)(bp + 1028), bu);
#pragma unroll
        for (int j = 0; j < 8; ++j) { const float gg = fminf(g[j] + bg[j], 7.0f), uu = fminf(fmaxf(up[j] + bu[j], -7.0f), 7.0f); g[j] = gg * sigmoidf_(1.702f * gg) * (uu + 1.0f); }
        u32x2 w; w.x = pk4_fp8(g[0], g[1], g[2], g[3]); w.y = pk4_fp8(g[4], g[5], g[6], g[7]); *(u32x2*)(HID + (size_t)row * 1024 + j0) = w;
    }
};
struct EpiMoe2 {
    static constexpr bool HAS_MID = false;
    const float* bd; unsigned char* YS; MoeTabs T;
    __device__ __forceinline__ void one(int row, int e, int c0, f32x4 v0, f32x4 v1, float gt) const {
        float v[8], bb[8]; f4to8(v0, v1, v); const float* bp = bd + (size_t)e * 1024 + c0; f4to8(*(const f32x4*)bp, *(const f32x4*)(bp + 4), bb);
#pragma unroll
        for (int j = 0; j < 8; ++j) v[j] = (v[j] + bb[j] * 16.0f) * gt;
        u32x2 w; w.x = pk4_fp8(v[0], v[1], v[2], v[3]); w.y = pk4_fp8(v[4], v[5], v[6], v[7]); *(u32x2*)(YS + (size_t)row * 1024 + c0) = w;
    }
    __device__ __forceinline__ void row8(int row, int col, f32x4 a0, f32x4 a1, f32x4 b0, f32x4 b1, int, int pn) const {
        const int e = pn >> 2, ct = pn & 3, c0 = 256 * ct + (col - pn * 256); bool ok; const int p = moe_slot_pos(T, e, row, ok); const float gt = ok ? T.gate_of[e * M + p] : 0.f;
        one(row, e, c0, a0, a1, gt); one(row, e, c0 + 128, b0, b1, gt);
    }
};
#define XB_TMO      128
#define XB_XCNT(j)  (256  + 64 * (j))
#define XB_XSUB(j)  (1280 + 64 * (j))
#define XB_XGEN(j)  (2304 + 64 * (j))
#define XB_TOP      3328
#define XB_TOPGEN   3392
#define XCD_BAR_WORDS 3456
#define XB_SPIN_CAP (1u << 18)

__device__ __forceinline__ unsigned xb_ld(unsigned* p)              { return __hip_atomic_load(p, __ATOMIC_RELAXED, __HIP_MEMORY_SCOPE_AGENT); }
__device__ __forceinline__ unsigned xb_add(unsigned* p, unsigned v) { return __hip_atomic_fetch_add(p, v, __ATOMIC_RELAXED, __HIP_MEMORY_SCOPE_AGENT); }
__device__ __forceinline__ unsigned xb_xcc_id() { return (unsigned)__builtin_amdgcn_s_getreg((3 << 11) | 20) & 0xFu; }
#define XB_SPIN(cond, bar) do { unsigned _sp = 0; while (cond) { __builtin_amdgcn_s_sleep(1); \
    if ((++_sp & 255u) == 0u) { if (xb_ld(&(bar)[XB_TMO])) break; if (_sp > XB_SPIN_CAP) { atomicAdd(&(bar)[XB_TMO], 1u); break; } } } } while (0)

struct XcdBarrier {
    unsigned* bar; unsigned x;
    volatile LAS unsigned* st;
};

__device__ __forceinline__ XcdBarrier xcd_barrier_post(unsigned* bar, volatile LAS unsigned* st) {
    XcdBarrier b; b.bar = bar; b.x = xb_xcc_id(); b.st = st;
    if (threadIdx.x == 0) (void)xb_add(&bar[XB_XCNT(b.x)], 1u);
    return b;
}
__device__ __forceinline__ void xcd_barrier_complete(unsigned* bar, unsigned x, unsigned& nloc, unsigned& nx) {
    const unsigned G = gridDim.x * gridDim.y * gridDim.z;
    unsigned sum, cnt, mine, sp = 0u;
    for (;;) {
        sum = 0u; cnt = 0u; mine = 0u;
#pragma unroll
        for (unsigned j = 0; j < 16; ++j) { const unsigned c = xb_ld(&bar[XB_XCNT(j)]); sum += c; cnt += (c > 0u) ? 1u : 0u; mine = (j == x) ? c : mine; }
        if (sum == G) break;
        __builtin_amdgcn_s_sleep(1);
        if ((++sp & 255u) == 0u) { if (xb_ld(&bar[XB_TMO])) break; if (sp > XB_SPIN_CAP) { atomicAdd(&bar[XB_TMO], 1u); break; } }
    }
    nloc = mine > 0u ? mine : 1u; nx = cnt > 0u ? cnt : 1u;
}

__device__ __forceinline__ void xcd_barrier(const XcdBarrier& b, const bool thread0) {
    asm volatile("s_waitcnt vmcnt(0)" ::: "memory");
    __syncthreads();
    if (thread0) {
        unsigned* bar = b.bar;
        __builtin_amdgcn_s_waitcnt(0);
        unsigned nloc = b.st[0], nx = b.st[1];
        if (nloc == 0u) { xcd_barrier_complete(bar, b.x, nloc, nx); b.st[0] = nloc; b.st[1] = nx; }
        const unsigned old = xb_add(&bar[XB_XSUB(b.x)], 1u);
        const unsigned gen = old / nloc;
        if (old + 1u == (gen + 1u) * nloc) {
            __builtin_amdgcn_fence(__ATOMIC_RELEASE, "agent");
            asm volatile("s_waitcnt vmcnt(0)" ::: "memory");
            const unsigned og = xb_add(&bar[XB_TOP], 1u);
            const unsigned tg = og / nx;
            if (og + 1u == (tg + 1u) * nx) xb_add(&bar[XB_TOPGEN], 1u);
            else XB_SPIN(xb_ld(&bar[XB_TOPGEN]) == tg, bar);
            __builtin_amdgcn_fence(__ATOMIC_ACQUIRE, "agent");
            xb_add(&bar[XB_XGEN(b.x)], 1u);
            asm volatile("s_waitcnt vmcnt(0)" ::: "memory");
        } else {
            XB_SPIN(xb_ld(&bar[XB_XGEN(b.x)]) == gen, bar);
            __builtin_amdgcn_fence(__ATOMIC_ACQUIRE, "agent");
            asm volatile("s_waitcnt vmcnt(0)" ::: "memory");
        }
    }
    __syncthreads();
}

constexpr size_t SSM_A16 = 1 * MiB, SSM_TF = 2 * MiB, SSM_VF = 4 * MiB, SSM_WF = 8 * MiB;
constexpr int NCI = 2 * NCH;
constexpr int NCB = (NCI + 15) / 16;
constexpr int CW_Q = 2048;

__device__ __forceinline__ void p0_ssm_prep(const Args& a, const Ctx& c, int g) {
    LAS float* AP = (LAS float*)(c.lds);
    LAS float* BBl = AP + 64 * 17 * 2;
    LAS float* Cc = BBl + 64 * 16 * 2;
    LAS float* Kt = Cc + 16 * 64 * 2;
    unsigned char* sp = c.ws + WS_SSMP;
    const int tid = c.tid;
    if (tid < 64) { const int p = tid, i = g * 64 + p;
        const float lr = a.in[4][i], li = a.in[5][i], dt = expf(a.in[6][g]);
        for (int tau = 0; tau <= 16; ++tau) { const float mag = expf((float)tau * dt * lr), ang = (float)tau * dt * li; AP[(p * 17 + tau) * 2] = mag * cosf(ang); AP[(p * 17 + tau) * 2 + 1] = mag * sinf(ang); }
        const float mag = expf(dt * lr), ar = mag * cosf(dt * li), ai = mag * sinf(dt * li);
        const float den = lr * lr + li * li, nr = ar - 1.0f, ni = ai, fr_ = (nr * lr + ni * li) / den, fi_ = (ni * lr - nr * li) / den;
        for (int h = 0; h < 16; ++h) { const float br = a.in[7][i * 16 + h], bi = a.in[8][i * 16 + h]; BBl[(p * 16 + h) * 2] = fr_ * br - fi_ * bi; BBl[(p * 16 + h) * 2 + 1] = fr_ * bi + fi_ * br; }
        float* A16 = (float*)(sp + SSM_A16); const float m16 = expf(16.0f * dt * lr), a16 = 16.0f * dt * li; A16[i * 2] = m16 * cosf(a16); A16[i * 2 + 1] = m16 * sinf(a16);
    }
    for (int idx = tid; idx < 1024; idx += NWAVES * 64) { const int h = idx >> 6, p = idx & 63; Cc[idx * 2] = a.in[9][(g * 16 + h) * 64 + p]; Cc[idx * 2 + 1] = a.in[10][(g * 16 + h) * 64 + p]; }
    __syncthreads();
    for (int idx = tid; idx < 4096; idx += NWAVES * 64) { const int tau = idx >> 8, h = (idx >> 4) & 15, hp = idx & 15; float s = 0.f;
        for (int p = 0; p < 64; ++p) { const float ar = AP[(p * 17 + tau) * 2], ai = AP[(p * 17 + tau) * 2 + 1], br = BBl[(p * 16 + hp) * 2], bi = BBl[(p * 16 + hp) * 2 + 1];
            const float gr = ar * br - ai * bi, gi = ar * bi + ai * br; s += Cc[(h * 64 + p) * 2] * gr - Cc[(h * 64 + p) * 2 + 1] * gi; }
        if (tau == 0 && h == hp) s += a.in[11][g * 16 + h];
        Kt[idx] = s; }
    __syncthreads();
    bf16* TF = (bf16*)(sp + SSM_TF); bf16* VF = (bf16*)(sp + SSM_VF); bf16* WF = (bf16*)(sp + SSM_WF);
    for (int idx = tid; idx < 1024; idx += NWAVES * 64) { const int dl = idx >> 6, ln = idx & 63, fr = ln & 15, fq = ln >> 4; float v[8];
#pragma unroll
        for (int e = 0; e < 8; ++e) { const int j = 8 * fq + e, tau = dl - (j >> 4), hp = j & 15; v[e] = tau >= 0 ? Kt[(tau * 16 + fr) * 16 + hp] : 0.f; }
        *(u32x4*)(TF + ((size_t)(g * 16 + dl) * 64 + ln) * 8) = pack8(v); }
    for (int idx = tid; idx < 4096; idx += NWAVES * 64) { const int t = idx >> 8, kx = (idx >> 6) & 3, ln = idx & 63, fr = ln & 15, fq = ln >> 4; float v[8];
#pragma unroll
        for (int e = 0; e < 8; ++e) { const int pp = 32 * kx + 8 * fq + e, p = pp & 63; const float cr = Cc[(fr * 64 + p) * 2], ci = Cc[(fr * 64 + p) * 2 + 1], ar = AP[(p * 17 + t + 1) * 2], ai = AP[(p * 17 + t + 1) * 2 + 1];
            v[e] = pp < 64 ? (cr * ar - ci * ai) : -(cr * ai + ci * ar); }
        *(u32x4*)(VF + ((size_t)((g * 16 + t) * 4 + kx) * 64 + ln) * 8) = pack8(v); }
    for (int idx = tid; idx < 4096; idx += NWAVES * 64) { const int pb = idx >> 9, ks = (idx >> 6) & 7, ln = idx & 63, fr = ln & 15, fq = ln >> 4, pp = 16 * pb + fr, p = pp & 63; float v[8];
#pragma unroll
        for (int e = 0; e < 8; ++e) { const int k = 32 * ks + 8 * fq + e, s = k >> 4, h = k & 15; const float ar = AP[(p * 17 + 15 - s) * 2], ai = AP[(p * 17 + 15 - s) * 2 + 1], br = BBl[(p * 16 + h) * 2], bi = BBl[(p * 16 + h) * 2 + 1];
            v[e] = pp < 64 ? (ar * br - ai * bi) : (ar * bi + ai * br); }
        *(u32x4*)(WF + ((size_t)((g * 8 + pb) * 8 + ks) * 64 + ln) * 8) = pack8(v); }
    __syncthreads();
}
__device__ __forceinline__ void ssm_phase_a(const Ctx& c) {
    const bf16* U = (const bf16*)(c.ws + WS_U); const bf16* WF = (const bf16*)(c.ws + WS_SSMP + SSM_WF); float* S16 = (float*)(c.ws + WS_S16);
    const int fr = c.lane & 15, fq = c.lane >> 4;
    for (int it = c.gw; it < 64 * NCB; it += c.ngw) {
        const int g = it / NCB, cb = it % NCB, cidx = 16 * cb + fr, cl = cidx < NCI ? cidx : NCI - 1;
        bf16x8 uf[8];
#pragma unroll
        for (int ks = 0; ks < 8; ++ks) uf[ks] = *(const bf16x8*)(U + ((size_t)(g * NCI + cl)) * 256 + 32 * ks + 8 * fq);
#pragma unroll 2
        for (int pb = 0; pb < 8; ++pb) { f32x4 acc = {0.f, 0.f, 0.f, 0.f};
#pragma unroll
            for (int ks = 0; ks < 8; ++ks) { const bf16x8 wf = *(const bf16x8*)(WF + ((size_t)((g * 8 + pb) * 8 + ks) * 64 + c.lane) * 8); acc = __builtin_amdgcn_mfma_f32_16x16x32_bf16(wf, uf[ks], acc, 0, 0, 0); }
            if (cidx < NCI) *(f32x4*)(S16 + ((size_t)(g * NCI + cidx)) * 128 + 16 * pb + 4 * fq) = acc; }
    }
}
__device__ __forceinline__ void ssm_carry(const Ctx& c) {
    LAS float* E = (LAS float*)(c.lds + LDSCTL_OFF + 4096);
    for (int it = c.bid; it < 128; it += c.G) {
        const int g = it >> 1, b = it & 1, p = c.lane, seg = c.wave, c0 = 64 * seg;
        const float* A16 = (const float*)(c.ws + WS_SSMP + SSM_A16); const float ar = A16[(g * 64 + p) * 2], ai = A16[(g * 64 + p) * 2 + 1];
        const float* sp = (const float*)(c.ws + WS_S16) + ((size_t)(g * NCI + b * NCH + c0)) * 128; bf16* xp = (bf16*)(c.ws + WS_XC) + ((size_t)(g * NCI + b * NCH + c0)) * 128;
        float lr[64], li[64];
#pragma unroll
        for (int j = 0; j < 64; ++j) { lr[j] = sp[j * 128 + p]; li[j] = sp[j * 128 + 64 + p]; }
        float xr = 0.f, xi = 0.f;
#pragma unroll
        for (int j = 0; j < 64; ++j) { const float tr = ar * xr - ai * xi + lr[j], ti = ar * xi + ai * xr + li[j]; xr = tr; xi = ti; lr[j] = xr; li[j] = xi; }
        __syncthreads();
        E[(seg * 64 + p) * 2] = xr; E[(seg * 64 + p) * 2 + 1] = xi;
        float a64r = ar, a64i = ai;
#pragma unroll
        for (int k = 0; k < 6; ++k) { const float tr = a64r * a64r - a64i * a64i, ti = 2.0f * a64r * a64i; a64r = tr; a64i = ti; }
        __syncthreads();
        float cr = 0.f, ci = 0.f;
        for (int s2 = 0; s2 < seg; ++s2) { const float er = E[(s2 * 64 + p) * 2], ei = E[(s2 * 64 + p) * 2 + 1]; const float tr = a64r * cr - a64i * ci + er, ti = a64r * ci + a64i * cr + ei; cr = tr; ci = ti; }
        float pr = ar, pi = ai; bf16* xq = xp + 128 + p;
#pragma unroll
        for (int j = 0; j < 64; ++j) { const float vr = lr[j] + pr * cr - pi * ci, vi = li[j] + pr * ci + pi * cr;
            xq[0] = (bf16)f2bf(vr); xq[64] = (bf16)f2bf(vi); xq += 128; asm volatile("" : "+v"(xq));
            const float tr = pr * ar - pi * ai, ti = pr * ai + pi * ar; pr = tr; pi = ti; }
    }
}
__device__ __forceinline__ void ssm_phase_c(const Ctx& c) {
    const bf16* U = (const bf16*)(c.ws + WS_U); const bf16* XC = (const bf16*)(c.ws + WS_XC); bf16* Z = (bf16*)(c.ws + WS_Z);
    const bf16* TF = (const bf16*)(c.ws + WS_SSMP + SSM_TF); const bf16* VF = (const bf16*)(c.ws + WS_SSMP + SSM_VF);
    const int fr = c.lane & 15, fq = c.lane >> 4;
    for (int it = c.bid; it < 256; it += c.G) {
        const int g = it >> 2, q = it & 3;
        __syncthreads();
        for (int idx = c.tid; idx < 4096; idx += NWAVES * 64) *(LAS u32x4*)(c.lds + idx * 16) = *(const u32x4*)(VF + (size_t)g * 32768 + idx * 8);
        bf16x8 tf[16];
#pragma unroll
        for (int dl = 0; dl < 16; ++dl) tf[dl] = *(const bf16x8*)(TF + ((size_t)(g * 16 + dl) * 64 + c.lane) * 8);
        __syncthreads();
        for (int cb = q + 4 * c.wave; cb < NCB; cb += 32) {
            const int cidx = 16 * cb + fr, cl = cidx < NCI ? cidx : NCI - 1;
            bf16x8 uf[8], xf[4];
#pragma unroll
            for (int ks = 0; ks < 8; ++ks) uf[ks] = *(const bf16x8*)(U + ((size_t)(g * NCI + cl)) * 256 + 32 * ks + 8 * fq);
#pragma unroll
            for (int kx = 0; kx < 4; ++kx) xf[kx] = *(const bf16x8*)(XC + ((size_t)(g * NCI + cl)) * 128 + 32 * kx + 8 * fq);
            const int b = cidx >= NCH ? 1 : 0, cc = cidx - b * NCH; const bool ok = cidx < NCI && cc >= 1;
            bf16* zp = Z + (size_t)(b * SEQ + 16 * (cc - 1)) * 1024 + g * 16 + 4 * fq;
#pragma unroll
            for (int t = 0; t < 16; ++t) { f32x4 acc = {0.f, 0.f, 0.f, 0.f};
#pragma unroll
                for (int ks = 0; ks <= t / 2; ++ks) acc = __builtin_amdgcn_mfma_f32_16x16x32_bf16(tf[t - 2 * ks], uf[ks], acc, 0, 0, 0);
#pragma unroll
                for (int kx = 0; kx < 4; ++kx) { const bf16x8 vf = *(const LAS bf16x8*)(c.lds + ((t * 4 + kx) * 64 + c.lane) * 16); acc = __builtin_amdgcn_mfma_f32_16x16x32_bf16(vf, xf[kx], acc, 0, 0, 0); }
                if (ok) { u32x2 w; w.x = pk2(gelu_tanh(acc[0]), gelu_tanh(acc[1])); w.y = pk2(gelu_tanh(acc[2]), gelu_tanh(acc[3])); *(u32x2*)(zp + (size_t)t * 1024) = w; }
                asm volatile("" ::: "memory"); }
        }
    }
}

__device__ __forceinline__ float ld_sc1_f32(const float* p) { return __uint_as_float(__hip_atomic_load((const unsigned*)p, RLX_AGENT)); }
__device__ __forceinline__ void ssm_chain(const Ctx& c, int g, int b) {
    const int fr = c.lane & 15, fq = c.lane >> 4, w = c.wave, p = c.lane;
    const bf16* Ub = (const bf16*)(c.ws + WS_U) + ((size_t)(g * NCI + b * NCH)) * 256;
    float* Sb = (float*)(c.ws + WS_S16) + ((size_t)(g * NCI + b * NCH)) * 128;
    bf16* Xb = (bf16*)(c.ws + WS_XC) + ((size_t)(g * NCI + b * NCH)) * 128;
    bf16* Z = (bf16*)(c.ws + WS_Z);
    const bf16* TF = (const bf16*)(c.ws + WS_SSMP + SSM_TF); const bf16* VF = (const bf16*)(c.ws + WS_SSMP + SSM_VF); const bf16* WF = (const bf16*)(c.ws + WS_SSMP + SSM_WF);
    LAS float* E = (LAS float*)(c.lds + LDSCTL_OFF + 4096);
    __syncthreads();
    for (int idx = c.tid; idx < 4096; idx += NWAVES * 64) { *(LAS u32x4*)(c.lds + idx * 16) = *(const u32x4*)(VF + (size_t)g * 32768 + idx * 8); *(LAS u32x4*)(c.lds + 65536 + idx * 16) = *(const u32x4*)(WF + (size_t)g * 32768 + idx * 8); }
    {
        __syncthreads();
#pragma unroll 1
        for (int h2 = 0; h2 < 2; ++h2) {
            bf16x8 uf[2][8];
#pragma unroll
            for (int i = 0; i < 2; ++i)
#pragma unroll
                for (int ks = 0; ks < 8; ++ks) uf[i][ks] = *(const bf16x8*)(Ub + (size_t)(16 * (w + 8 * (2 * h2 + i)) + fr) * 256 + 32 * ks + 8 * fq);
#pragma unroll
            for (int i = 0; i < 2; ++i) {
#pragma unroll 2
                for (int pb = 0; pb < 8; ++pb) { f32x4 acc = {0.f, 0.f, 0.f, 0.f};
#pragma unroll
                    for (int ks = 0; ks < 8; ++ks) acc = __builtin_amdgcn_mfma_f32_16x16x32_bf16(*(const LAS bf16x8*)(c.lds + 65536 + ((pb * 8 + ks) * 64 + c.lane) * 16), uf[i][ks], acc, 0, 0, 0);
                    *(f32x4*)(Sb + (size_t)(16 * (w + 8 * (2 * h2 + i)) + fr) * 128 + 16 * pb + 4 * fq) = acc; }
            }
        }
    }
    VM_WAIT(); __syncthreads();
    {
        const float* A16 = (const float*)(c.ws + WS_SSMP + SSM_A16); const float ar = A16[(g * 64 + p) * 2], ai = A16[(g * 64 + p) * 2 + 1];
        const float* sp = Sb + (size_t)(64 * w) * 128;
        float xr = 0.f, xi = 0.f;
#pragma unroll 1
        for (int h2 = 0; h2 < 2; ++h2) { float lr[32], li[32];
#pragma unroll
            for (int j = 0; j < 32; ++j) { lr[j] = ld_sc1_f32(sp + (32 * h2 + j) * 128 + p); li[j] = ld_sc1_f32(sp + (32 * h2 + j) * 128 + 64 + p); }
#pragma unroll
            for (int j = 0; j < 32; ++j) { const float tr = ar * xr - ai * xi + lr[j], ti = ar * xi + ai * xr + li[j]; xr = tr; xi = ti; } }
        E[(w * 64 + p) * 2] = xr; E[(w * 64 + p) * 2 + 1] = xi;
        float a64r = ar, a64i = ai;
#pragma unroll
        for (int k = 0; k < 6; ++k) { const float tr = a64r * a64r - a64i * a64i, ti = 2.0f * a64r * a64i; a64r = tr; a64i = ti; }
        __syncthreads();
        xr = 0.f; xi = 0.f;
        for (int s2 = 0; s2 < w; ++s2) { const float er = E[(s2 * 64 + p) * 2], ei = E[(s2 * 64 + p) * 2 + 1]; const float tr = a64r * xr - a64i * xi + er, ti = a64r * xi + a64i * xr + ei; xr = tr; xi = ti; }
        bf16* xq = Xb + (size_t)(64 * w + 1) * 128 + p;
#pragma unroll 1
        for (int h2 = 0; h2 < 2; ++h2) { float lr[32], li[32];
#pragma unroll
            for (int j = 0; j < 32; ++j) { lr[j] = ld_sc1_f32(sp + (32 * h2 + j) * 128 + p); li[j] = ld_sc1_f32(sp + (32 * h2 + j) * 128 + 64 + p); }
#pragma unroll
            for (int j = 0; j < 32; ++j) { const float tr = ar * xr - ai * xi + lr[j], ti = ar * xi + ai * xr + li[j]; xr = tr; xi = ti;
                xq[0] = (bf16)f2bf(xr); xq[64] = (bf16)f2bf(xi); xq += 128; asm volatile("" : "+v"(xq)); } }
    }
    VM_WAIT(); __syncthreads();
    {
        bf16x8 tf[16];
#pragma unroll
        for (int dl = 0; dl < 16; ++dl) tf[dl] = *(const bf16x8*)(TF + ((size_t)(g * 16 + dl) * 64 + c.lane) * 8);
        bf16x8 uf[8], xf[4], un[8], xn[4];
        { const int cl = 16 * w + fr;
#pragma unroll
            for (int ks = 0; ks < 8; ++ks) uf[ks] = *(const bf16x8*)(Ub + (size_t)cl * 256 + 32 * ks + 8 * fq);
#pragma unroll
            for (int kx = 0; kx < 4; ++kx) xf[kx] = *(const bf16x8*)(Xb + (size_t)cl * 128 + 32 * kx + 8 * fq); }
#pragma unroll 1
        for (int cb = w; cb < 33; cb += 8) {
            const int ci_ = 16 * cb + fr;
            if (cb + 8 < 33) { const int cn = 16 * (cb + 8) + fr, cl = cn < NCH ? cn : NCH - 1;
#pragma unroll
                for (int ks = 0; ks < 8; ++ks) un[ks] = *(const bf16x8*)(Ub + (size_t)cl * 256 + 32 * ks + 8 * fq);
#pragma unroll
                for (int kx = 0; kx < 4; ++kx) xn[kx] = *(const bf16x8*)(Xb + (size_t)cl * 128 + 32 * kx + 8 * fq); }
            const bool ok = ci_ >= 1 && ci_ < NCH;
            bf16* zp = Z + (size_t)(b * SEQ + 16 * (ci_ - 1)) * 1024 + g * 16 + 4 * fq;
#pragma unroll
            for (int t = 0; t < 16; ++t) { f32x4 acc = {0.f, 0.f, 0.f, 0.f};
#pragma unroll
                for (int ks = 0; ks <= t / 2; ++ks) acc = __builtin_amdgcn_mfma_f32_16x16x32_bf16(tf[t - 2 * ks], uf[ks], acc, 0, 0, 0);
#pragma unroll
                for (int kx = 0; kx < 4; ++kx) { const bf16x8 vf = *(const LAS bf16x8*)(c.lds + ((t * 4 + kx) * 64 + c.lane) * 16); acc = __builtin_amdgcn_mfma_f32_16x16x32_bf16(vf, xf[kx], acc, 0, 0, 0); }
                if (ok) { u32x2 wv; wv.x = pk2(gelu_tanh(acc[0]), gelu_tanh(acc[1])); wv.y = pk2(gelu_tanh(acc[2]), gelu_tanh(acc[3])); *(u32x2*)(zp + (size_t)t * 1024) = wv; }
                asm volatile("" ::: "memory"); }
#pragma unroll
            for (int ks = 0; ks < 8; ++ks) uf[ks] = un[ks];
#pragma unroll
            for (int kx = 0; kx < 4; ++kx) xf[kx] = xn[kx];
        }
    }
}

template <bool FIRST>
__device__ __forceinline__ void attn_qblocks(LAS unsigned char* Ks, LAS unsigned char* Vs, const bf16* qp, bf16x8 (&qc)[2], bf16* ao, int t0, float sink, int fr, int fq) {
    constexpr int KST = 144, VST = 432;
#pragma unroll 2
    for (int qa = 0; qa < 4; ++qa) {
        bf16x8 qf[2]; qf[0] = qc[0]; qf[1] = qc[1];
        if (qa < 3) { qc[0] = *(const bf16x8*)(qp + (size_t)(16 * (qa + 1)) * 1024); qc[1] = *(const bf16x8*)(qp + (size_t)(16 * (qa + 1)) * 1024 + 32); }
        f32x4 s[10];
#pragma unroll
        for (int jb = 0; jb < 10; ++jb) { const int j = jb < 9 ? qa + jb : 12; f32x4 acc = {0.f, 0.f, 0.f, 0.f};
#pragma unroll
            for (int ks = 0; ks < 2; ++ks) { const bf16x8 kf = *(const LAS bf16x8*)(Ks + (16 * j + fr) * KST + (32 * ks + 8 * fq) * 2); acc = __builtin_amdgcn_mfma_f32_16x16x32_bf16(kf, qf[ks], acc, 0, 0, 0); }
            s[jb] = acc; }
#pragma unroll
        for (int i = 0; i < 4; ++i) { if (4 * fq + i - fr < 1) s[0][i] = -1e30f; if (4 * fq + i - fr > 0) s[8][i] = -1e30f; }
        if constexpr (FIRST) {
#pragma unroll
            for (int jb = 0; jb < 9; ++jb)
#pragma unroll
                for (int i = 0; i < 4; ++i) if (t0 - 128 + 16 * (qa + jb) + 4 * fq + i < 0) s[jb][i] = -1e30f; }
        float mx = sink;
#pragma unroll
        for (int jb = 0; jb < 10; ++jb) mx = fmaxf(fmaxf(mx, fmaxf(s[jb][0], s[jb][1])), fmaxf(s[jb][2], s[jb][3]));
        mx = fmaxf(mx, __shfl_xor(mx, 16)); mx = fmaxf(mx, __shfl_xor(mx, 32));
        float l = 0.f;
#pragma unroll
        for (int jb = 0; jb < 10; ++jb)
#pragma unroll
            for (int i = 0; i < 4; ++i) { s[jb][i] = __builtin_amdgcn_exp2f(s[jb][i] - mx); l += s[jb][i]; }
        l += __shfl_xor(l, 16); l += __shfl_xor(l, 32); l += __builtin_amdgcn_exp2f(sink - mx);
        f32x4 o[4];
#pragma unroll
        for (int db = 0; db < 4; ++db) o[db] = (f32x4){0.f, 0.f, 0.f, 0.f};
#pragma unroll
        for (int pr = 0; pr < 5; ++pr) { const int ja = qa + 2 * pr, jbk = pr < 4 ? qa + 2 * pr + 1 : 12;
            u32x4 pw; pw.x = pk2(s[2 * pr][0], s[2 * pr][1]); pw.y = pk2(s[2 * pr][2], s[2 * pr][3]); pw.z = pk2(s[2 * pr + 1][0], s[2 * pr + 1][1]); pw.w = pk2(s[2 * pr + 1][2], s[2 * pr + 1][3]);
            const bf16x8 pf = __builtin_bit_cast(bf16x8, pw);
#pragma unroll
            for (int db = 0; db < 4; ++db) { const u32x2 lo = *(const LAS u32x2*)(Vs + (16 * db + fr) * VST + (16 * ja + 4 * fq) * 2), hi = *(const LAS u32x2*)(Vs + (16 * db + fr) * VST + (16 * jbk + 4 * fq) * 2);
                u32x4 vw; vw.x = lo.x; vw.y = lo.y; vw.z = hi.x; vw.w = hi.y; o[db] = __builtin_amdgcn_mfma_f32_16x16x32_bf16(__builtin_bit_cast(bf16x8, vw), pf, o[db], 0, 0, 0); } }
        const float inv = __builtin_amdgcn_rcpf(l);
#pragma unroll
        for (int db = 0; db < 4; ++db) { u32x2 w; w.x = pk2(o[db][0] * inv, o[db][1] * inv); w.y = pk2(o[db][2] * inv, o[db][3] * inv); *(u32x2*)(ao + (size_t)(16 * qa) * 1024 + 16 * db) = w; }
    }
}
__device__ __forceinline__ void attn_fast(const Args& a, const Ctx& c) {
    const bf16* Q = (const bf16*)(c.ws + WS_Q); const bf16* Kb = (const bf16*)(c.ws + WS_K); const bf16* Vt = (const bf16*)(c.ws + WS_VT); bf16* AO = (bf16*)(c.ws + WS_BRA) + (size_t)M * 1024;
    unsigned* qctr = (unsigned*)(c.ws + WS_CTL) + CW_Q;
    LAS unsigned char* Ks = c.lds; LAS unsigned char* Vs = c.lds + 30720; volatile LAS int* uslot = (volatile LAS int*)(c.lds + LDSCTL_OFF + 64);
    constexpr int KST = 144, VST = 432;
    const int fr = c.lane & 15, fq = c.lane >> 4;
    volatile LAS int* ncall = (volatile LAS int*)(c.lds + LDSCTL_OFF + 68);
    __syncthreads(); if (c.tid == 0) *ncall = *ncall + 1; __syncthreads();
    const int qbase = (*ncall - 1) * (512 + c.G);
    int nxt = 0; if (c.tid == 0) nxt = (int)__hip_atomic_fetch_add(qctr, 1u, RLX_AGENT) - qbase;
    for (;;) {
        __syncthreads();
        if (c.tid == 0) *uslot = nxt;
        __syncthreads();
        const int unit = *uslot; if (unit >= 512) break;
        if (c.tid == 0) nxt = (int)__hip_atomic_fetch_add(qctr, 1u, RLX_AGENT) - qbase;
        const int b = unit >> 8, kvh = (unit >> 7) & 1, t0 = 64 * (unit & 127);
        const int head = kvh * 8 + c.wave;
        const bf16* qp = Q + (size_t)(b * SEQ + t0 + fr) * 1024 + head * 64 + 8 * fq;
        bf16x8 qc[2]; qc[0] = *(const bf16x8*)qp; qc[1] = *(const bf16x8*)(qp + 32);
        for (int idx = c.tid; idx < 1664; idx += NWAVES * 64) { const int row = idx >> 3, pc = idx & 7; int pos; bool ok = true;
            if (row < 192) { const int tok = t0 - 128 + row; ok = tok >= 0; pos = NMETA + tok; } else pos = row - 192;
            u32x4 v = {0u, 0u, 0u, 0u}; if (ok) v = *(const u32x4*)(Kb + ((size_t)(b * LTOT + pos)) * 128 + kvh * 64 + pc * 8);
            *(LAS u32x4*)(Ks + row * KST + pc * 16) = v; }
        for (int idx = c.tid; idx < 1664; idx += NWAVES * 64) { const int row = idx >> 3, pc = idx & 7; int pos; bool ok = true;
            if (row < 192) { const int tok = t0 - 128 + row; ok = tok >= 0; pos = NMETA + tok; } else pos = row - 192;
            u32x4 v = {0u, 0u, 0u, 0u}; if (ok) v = *(const u32x4*)(Vt + ((size_t)(b * LTOT + pos)) * 128 + kvh * 64 + pc * 8);
            LAS bf16* vd = (LAS bf16*)(Vs + (8 * pc) * VST + row * 2);
            vd[0 * (VST / 2)] = (bf16)(v.x & 0xffffu); vd[1 * (VST / 2)] = (bf16)(v.x >> 16); vd[2 * (VST / 2)] = (bf16)(v.y & 0xffffu); vd[3 * (VST / 2)] = (bf16)(v.y >> 16);
            vd[4 * (VST / 2)] = (bf16)(v.z & 0xffffu); vd[5 * (VST / 2)] = (bf16)(v.z >> 16); vd[6 * (VST / 2)] = (bf16)(v.w & 0xffffu); vd[7 * (VST / 2)] = (bf16)(v.w >> 16); }
        __syncthreads();
        const float sink = a.in[14][head] * 1.4426950408889634f;
        if (t0 < 128) attn_qblocks<true>(Ks, Vs, qp, qc, AO + (size_t)(b * SEQ + t0 + fr) * 1024 + head * 64 + 4 * fq, t0, sink, fr, fq);
        else attn_qblocks<false>(Ks, Vs, qp, qc, AO + (size_t)(b * SEQ + t0 + fr) * 1024 + head * 64 + 4 * fq, t0, sink, fr, fq);
    }
}

constexpr size_t SSM_WRF = 16 * MiB;
__device__ __forceinline__ void p0_router_frags(const Args& a, const Ctx& c) {
    bf16* WRF = (bf16*)(c.ws + WS_SSMP + SSM_WRF); const float* wr = a.in[19];
    const int gt = c.bid * (NWAVES * 64) + c.tid, ngt = c.G * NWAVES * 64;
    for (int idx = gt; idx < 4096; idx += ngt) { const int ks = idx >> 7, eb = (idx >> 6) & 1, ln = idx & 63, fr = ln & 15, fq = ln >> 4; float hi[8], lo[8];
#pragma unroll
        for (int e = 0; e < 8; ++e) { const float w = wr[(size_t)(32 * ks + 8 * fq + e) * 32 + 16 * eb + fr]; const float h = bf2f((bf16)f2bf(w)); hi[e] = h; lo[e] = w - h; }
        *(u32x4*)(WRF + (size_t)idx * 8) = pack8(hi); *(u32x4*)(WRF + 32768 + (size_t)idx * 8) = pack8(lo); }
}

__device__ __forceinline__ int swap23(int p) { return (p & 3) | ((p & 4) << 1) | ((p & 8) >> 1); }
__device__ __forceinline__ void tr_item(const float* __restrict__ W, int ldw, int k0, int n0src, bool perm, bf16* WT, int ldt, int rowdst0, int kdst, LAS float* scr, int lane) {
    float tv[32];
#pragma unroll
    for (int i = 0; i < 32; ++i) tv[i] = W[(size_t)(k0 + 2 * i + (lane >> 5)) * ldw + n0src + (lane & 31)];
#pragma unroll
    for (int i = 0; i < 32; ++i) scr[(2 * i + (lane >> 5)) * 33 + (lane & 31)] = tv[i];
    LDS_WAIT(); asm volatile("" ::: "memory");
    const int c = lane & 7;
#pragma unroll
    for (int j = 0; j < 4; ++j) { const int n = (lane >> 3) + 8 * j; const int ns = (perm && n < 16) ? swap23(n) : n; const LAS float* s = scr + (8 * c) * 33 + ns;
        u32x4 o; o.x = pk2(s[0 * 33], s[1 * 33]); o.y = pk2(s[2 * 33], s[3 * 33]); o.z = pk2(s[4 * 33], s[5 * 33]); o.w = pk2(s[6 * 33], s[7 * 33]);
        *(u32x4*)(WT + (size_t)(rowdst0 + n) * ldt + kdst + k0 + 8 * c) = o; }
    LDS_WAIT(); asm volatile("" ::: "memory");
}
struct Tr8Item { const float* src; unsigned char* dst; int ldw; };
__device__ __forceinline__ Tr8Item tr8_item_of(const Args& a, unsigned char* Wgu8, unsigned char* Wdn8, int id, int wave, int lane) {
    Tr8Item t;
    if (id < 2048) { const int e = id >> 6, kb = (id >> 3) & 7, jt = id & 7; const int col = lane < 32 ? 128 * jt + 4 * lane : 1024 + 128 * jt + 4 * (lane - 32);
        t.src = a.in[21] + (size_t)e * 1024 * 2048 + (size_t)(128 * kb + 16 * wave) * 2048 + col; t.ldw = 2048; t.dst = Wgu8 + (size_t)e * 2048 * 1024 + (size_t)(256 * jt) * 1024 + 128 * kb; }
    else { const int r = id - 2048, e = r >> 5, kb = (r >> 2) & 7, nb = r & 3;
        t.src = a.in[23] + (size_t)e * 1024 * 1024 + (size_t)(128 * kb + 16 * wave) * 1024 + 256 * nb + 4 * lane; t.ldw = 1024; t.dst = Wdn8 + (size_t)e * 1024 * 1024 + (size_t)(256 * nb) * 1024 + 128 * kb; }
    return t;
}
__device__ __forceinline__ void tr8_load(const Tr8Item& t, f32x4 (&v)[16]) {
#pragma unroll
    for (int j = 0; j < 16; ++j) v[j] = *(const f32x4*)(t.src + (size_t)j * t.ldw);
}
__device__ __forceinline__ void tr8_finish(const Tr8Item& t, const f32x4 (&v)[16], LAS unsigned char* tile, int tid, int wave, int lane) {
    __syncthreads();
#pragma unroll
    for (int cc = 0; cc < 4; ++cc) { u32x4 o;
        o.x = pk4_fp8(v[0][cc] * 16.0f, v[1][cc] * 16.0f, v[2][cc] * 16.0f, v[3][cc] * 16.0f);    o.y = pk4_fp8(v[4][cc] * 16.0f, v[5][cc] * 16.0f, v[6][cc] * 16.0f, v[7][cc] * 16.0f);
        o.z = pk4_fp8(v[8][cc] * 16.0f, v[9][cc] * 16.0f, v[10][cc] * 16.0f, v[11][cc] * 16.0f); o.w = pk4_fp8(v[12][cc] * 16.0f, v[13][cc] * 16.0f, v[14][cc] * 16.0f, v[15][cc] * 16.0f);
        *(LAS u32x4*)(tile + (4 * lane + cc) * 144 + 16 * wave) = o; }
    __syncthreads();
#pragma unroll
    for (int i = 0; i < 4; ++i) { const int p = tid + 512 * i, n = p >> 3, q = p & 7;
        *(u32x4*)(t.dst + (size_t)n * 1024 + 16 * q) = *(const LAS u32x4*)(tile + n * 144 + 16 * q); }
}
__device__ __forceinline__ void rms_row_to_bf16(const float* xrow, const float* gain, bf16* orow, int lane) {
    f32x4 v[4]; float s = 0.f;
#pragma unroll
    for (int j = 0; j < 4; ++j) { v[j] = *(const f32x4*)(xrow + 4 * lane + 256 * j); s += (v[j].x * v[j].x + v[j].y * v[j].y) + (v[j].z * v[j].z + v[j].w * v[j].w); }
    const float rstd = 1.0f / sqrtf(wave_sum(s) * (1.0f / D) + RMS_EPS);
#pragma unroll
    for (int j = 0; j < 4; ++j) { const f32x4 g = *(const f32x4*)(gain + 4 * lane + 256 * j); u32x2 w; w.x = pk2(v[j].x * rstd * g.x, v[j].y * rstd * g.y); w.y = pk2(v[j].z * rstd * g.z, v[j].w * rstd * g.w);
        *(u32x2*)(orow + 4 * lane + 256 * j) = w; }
}
#ifndef P0REP
#define P0REP 0
#endif
#ifdef FAST_MIX
constexpr bool FAST_MIX_P0 = FAST_MIX != 0;
#else
constexpr bool FAST_MIX_P0 = false;
#endif
__device__ __forceinline__ void p0_prologue(const Args& a, const Ctx& c) {
    for (int rp = 0; rp < 1 + (P0REP & 1); ++rp)
    for (int g = c.bid; g < 64; g += c.G) p0_ssm_prep(a, c, g);
    LAS float* scr = (LAS float*)(c.lds + c.wave * 16384);
    bf16* WinT = (bf16*)(c.ws + WS_WIN); bf16* WgluT = (bf16*)(c.ws + WS_WGLU); bf16* WbrT = (bf16*)(c.ws + WS_WBR); bf16* WoutT = (bf16*)(c.ws + WS_WOUT);
    unsigned char* Wgu8 = c.ws + WS_WGU; unsigned char* Wdn8 = c.ws + WS_WDN;
    constexpr int NI_IN = 16 * 136, NI_SQ = 512, NI_ALL = NI_IN + 4 * NI_SQ;
    for (int rp = 0; rp < 1 + ((P0REP >> 1) & 1); ++rp)
    for (int it = c.gw; it < NI_ALL; it += c.ngw) {
        int r = it;
        if (r < NI_IN) { const int kb = r / 136, nb = r % 136, n0 = 32 * nb; const bool perm = (n0 >= 1024 && n0 < 2176 && (n0 & 63) == 0);
            tr_item(a.in[3], INW, 64 * kb, n0, perm, WinT, 1024, n0, 0, scr, c.lane); continue; } r -= NI_IN;
        if (r < NI_SQ) { tr_item(a.in[12], 1024, 64 * (r >> 5), 32 * (r & 31), false, WgluT, 1024, 32 * (r & 31), 0, scr, c.lane); continue; } r -= NI_SQ;
        if (r < NI_SQ) { tr_item(a.in[15], 1024, 64 * (r >> 5), 32 * (r & 31), false, WbrT, 1024, 32 * (r & 31), 0, scr, c.lane); continue; } r -= NI_SQ;
        if (r < NI_SQ) { tr_item(a.in[16], 1024, 64 * (r >> 5), 32 * (r & 31), false, WbrT, 1024, 1024 + 32 * (r & 31), 0, scr, c.lane); continue; } r -= NI_SQ;
        tr_item(a.in[17], 1024, 64 * (r >> 5), 32 * (r & 31), false, WoutT, 1024, 32 * (r & 31), 0, scr, c.lane);
    }
    for (int rp = 0; rp < 1 + ((P0REP >> 2) & 1); ++rp)
    {
        f32x4 va[16], vb[16];
        int id = c.bid;
        Tr8Item ta = tr8_item_of(a, Wgu8, Wdn8, id < 3072 ? id : 0, c.wave, c.lane), tb = ta;
        if (id < 3072) tr8_load(ta, va);
        while (id < 3072) {
            const int id1 = id + c.G;
            if (id1 < 3072) { tb = tr8_item_of(a, Wgu8, Wdn8, id1, c.wave, c.lane); tr8_load(tb, vb); }
            tr8_finish(ta, va, c.lds, c.tid, c.wave, c.lane);
            if (id1 >= 3072) break;
            const int id2 = id1 + c.G;
            if (id2 < 3072) { ta = tr8_item_of(a, Wgu8, Wdn8, id2, c.wave, c.lane); tr8_load(ta, va); }
            tr8_finish(tb, vb, c.lds, c.tid, c.wave, c.lane);
            id = id2;
        }
        __syncthreads();
    }
    bf16* XN = (bf16*)(c.ws + WS_XN);
    for (int rp = 0; rp < 1 + ((P0REP >> 3) & 1); ++rp)
    for (int m0 = 2 * c.gw; m0 < MP; m0 += 2 * c.ngw) {
        f32x4 v[2][4]; float ss[2];
#pragma unroll
        for (int r = 0; r < 2; ++r) { const int m = m0 + r; const float* xrow = m < M ? a.in[0] + (size_t)m * D : a.in[1] + (size_t)((m < M + NMETA ? m : M) - M) * D;
#pragma unroll
            for (int j = 0; j < 4; ++j) v[r][j] = *(const f32x4*)(xrow + 4 * c.lane + 256 * j); }
#pragma unroll
        for (int r = 0; r < 2; ++r) { float s = 0.f;
#pragma unroll
            for (int j = 0; j < 4; ++j) s += (v[r][j].x * v[r][j].x + v[r][j].y * v[r][j].y) + (v[r][j].z * v[r][j].z + v[r][j].w * v[r][j].w);
            ss[r] = wave_sum(s); }
#pragma unroll
        for (int r = 0; r < 2; ++r) { const int m = m0 + r; const float rstd = (m < M + NMETA) ? 1.0f / sqrtf(ss[r] * (1.0f / D) + RMS_EPS) : 0.f;
#pragma unroll
            for (int j = 0; j < 4; ++j) { const f32x4 g = *(const f32x4*)(a.in[2] + 4 * c.lane + 256 * j); u32x2 w; w.x = pk2(v[r][j].x * rstd * g.x, v[r][j].y * rstd * g.y); w.y = pk2(v[r][j].z * rstd * g.z, v[r][j].w * rstd * g.w);
                *(u32x2*)(XN + (size_t)m * D + 4 * c.lane + 256 * j) = w; } }
    }
    p0_router_frags(a, c);
    const int gt = c.bid * (NWAVES * 64) + c.tid, ngt = c.G * NWAVES * 64;
    float* rot = (float*)(c.ws + WS_ROT);
    for (int i = gt; i < LTOT * 8; i += ngt) { const int pos = i >> 3, j = i & 7;
        const float invs[8] = {1.0f, 0.1939227432012558f, 0.03760603070259094f, 0.007292664609849453f, 0.0014142135623842478f, 0.00027424818836152554f, 5.318296098266728e-05f, 1.0313386155758053e-05f};
        float inv = invs[0];
#pragma unroll
        for (int q = 1; q < 8; ++q) inv = (j == q) ? invs[q] : inv;
        const float ang = (float)pos * inv; const double rev = (double)ang * 0.15915494309189535; const float fr_ = (float)(rev - floor(rev));
        rot[pos * 16 + j] = __builtin_amdgcn_cosf(fr_); rot[pos * 16 + 8 + j] = __builtin_amdgcn_sinf(fr_); }
    if constexpr (!FAST_MIX_P0) {
    float* Ab = (float*)(c.ws + WS_SSMP); float* BB = Ab + 16384;
    for (int i = gt; i < 4096; i += ngt) { const int g = i >> 6;
        const float lr = a.in[4][i], li = a.in[5][i], dt = expf(a.in[6][g]), mag = expf(dt * lr), ar = mag * cosf(dt * li), ai = mag * sinf(dt * li);
        const float den = lr * lr + li * li, nr = ar - 1.0f, ni = ai, fr = (nr * lr + ni * li) / den, fi = (ni * lr - nr * li) / den;
        Ab[2 * i] = ar; Ab[2 * i + 1] = ai;
        for (int h = 0; h < 16; ++h) { const float br = a.in[7][i * 16 + h], bi = a.in[8][i * 16 + h]; BB[(i * 16 + h) * 2] = fr * br - fi * bi; BB[(i * 16 + h) * 2 + 1] = fr * bi + fi * br; }
    }
    }
}

__device__ __forceinline__ void p2_ssm_naive(const Args& a, const Ctx& c) {
    const float* Ab = (const float*)(c.ws + WS_SSMP); const float* BB = Ab + 16384;
    const bf16* U = (const bf16*)(c.ws + WS_U); bf16* Z = (bf16*)(c.ws + WS_Z);
    for (int it = c.gw; it < 128; it += c.ngw) {
        const int g = it >> 1, b = it & 1, p = c.lane, gp = g * 64 + p;
        const float ar = Ab[2 * gp], ai = Ab[2 * gp + 1];
        float bbr[16], bbi[16], cr[16], ci[16], dd[16];
#pragma unroll
        for (int h = 0; h < 16; ++h) { bbr[h] = BB[(gp * 16 + h) * 2]; bbi[h] = BB[(gp * 16 + h) * 2 + 1]; cr[h] = a.in[9][(g * 16 + h) * 64 + p]; ci[h] = a.in[10][(g * 16 + h) * 64 + p]; dd[h] = a.in[11][g * 16 + h]; }
        float xr = 0.f, xi = 0.f;
        const bf16* up = U + (size_t)((g * 2 + b) * NCH) * 256;
        for (int t = 0; t < LTOT; ++t) {
            float u[16]; { float t0[8], t1[8]; unpack8(*(const u32x4*)(up + t * 16), t0); unpack8(*(const u32x4*)(up + t * 16 + 8), t1);
#pragma unroll
                for (int h = 0; h < 8; ++h) { u[h] = t0[h]; u[8 + h] = t1[h]; } }
            float br_ = 0.f, bi_ = 0.f;
#pragma unroll
            for (int h = 0; h < 16; ++h) { br_ += bbr[h] * u[h]; bi_ += bbi[h] * u[h]; }
            const float nxr = ar * xr - ai * xi + br_, nxi = ar * xi + ai * xr + bi_; xr = nxr; xi = nxi;
            if (t >= NMETA) {
                float mine = 0.f;
#pragma unroll
                for (int h = 0; h < 16; ++h) { float v = wave_sum(cr[h] * xr - ci[h] * xi); if (c.lane == h) mine = v + dd[h] * u[h]; }
                if (c.lane < 16) Z[(size_t)(b * SEQ + t - NMETA) * 1024 + g * 16 + c.lane] = (bf16)f2bf(gelu_tanh(mine));
            }
        }
    }
}
__device__ __forceinline__ float dot8(u32x4 q, u32x4 k) {
    return (bflo(q.x) * bflo(k.x) + bfhi(q.x) * bfhi(k.x)) + (bflo(q.y) * bflo(k.y) + bfhi(q.y) * bfhi(k.y)) + (bflo(q.z) * bflo(k.z) + bfhi(q.z) * bfhi(k.z)) + (bflo(q.w) * bflo(k.w) + bfhi(q.w) * bfhi(k.w));
}
__device__ __forceinline__ void p2_attn_naive(const Args& a, const Ctx& c) {
    const bf16* Q = (const bf16*)(c.ws + WS_Q); const bf16* Kb = (const bf16*)(c.ws + WS_K); const bf16* Vt = (const bf16*)(c.ws + WS_VT); bf16* BRA = (bf16*)(c.ws + WS_BRA);
    const int lane = c.lane;
    for (int it = c.gw; it < M * 16; it += c.ngw) {
        const int r = it >> 4, h = it & 15, kvh = h >> 3, b = r >> 13, t = r & (SEQ - 1);
        u32x4 qv[8];
#pragma unroll
        for (int i = 0; i < 8; ++i) qv[i] = *(const u32x4*)(Q + (size_t)r * 1024 + h * 64 + 8 * i);
        float s[3];
#pragma unroll
        for (int sl = 0; sl < 3; ++sl) {
            int pos; bool ok;
            if (sl < 2) { const int tok = t - 127 + lane + 64 * sl; ok = tok >= 0; pos = NMETA + (ok ? tok : 0); } else { ok = lane < NMETA; pos = ok ? lane : 0; }
            const bf16* kp = Kb + ((size_t)(b * LTOT + pos)) * 128 + kvh * 64; float acc = 0.f;
#pragma unroll
            for (int i = 0; i < 8; ++i) acc += dot8(qv[i], *(const u32x4*)(kp + 8 * i));
            s[sl] = ok ? acc : -1e30f;
        }
        const float sink = a.in[14][h] * 1.4426950408889634f;
        const float mx = wave_max(fmaxf(fmaxf(s[0], s[1]), fmaxf(s[2], sink)));
        const float p0 = exp2f(s[0] - mx), p1 = exp2f(s[1] - mx), p2 = exp2f(s[2] - mx);
        const float l = wave_sum(p0 + p1 + p2) + exp2f(sink - mx);
        const bf16* vrow = Vt + (size_t)(b * LTOT) * 128 + kvh * 64 + lane;
        float o = 0.f;
        for (int j = 0; j < 128; ++j) { const int tok = t - 127 + j; const float pj = __shfl(j < 64 ? p0 : p1, j & 63); if (tok >= 0) o += pj * bf2f(vrow[(size_t)(NMETA + tok) * 128]); }
        for (int j = 0; j < NMETA; ++j) { const float pj = __shfl(p2, j); o += pj * bf2f(vrow[(size_t)j * 128]); }
        BRA[(size_t)(M + r) * 1024 + h * 64 + lane] = (bf16)f2bf(o / l);
    }
}

__device__ __forceinline__ void p6_router(const Args& a, const Ctx& c) {
    const float* H1 = (const float*)(c.ws + WS_H1); unsigned char* XG = c.ws + WS_HN2;
    int* TE = (int*)(c.ws + WS_TOK); int* TP = TE + M * 4; float* RS = (float*)(c.ws + WS_TOK) + M * 16 + NSLOT * 2;
    int* TOKOF = (int*)(c.ws + WS_TOKOF); float* GATEOF = (float*)(c.ws + WS_GATEOF); float* RSOF = (float*)(c.ws + WS_RSOF);
    unsigned* cnt = (unsigned*)(c.ws + WS_CTL) + CW_CNT;
    const float* brt = a.in[20];
    LAS float* gl = (LAS float*)(c.lds + LDSCTL_OFF + 8192);
    LAS unsigned* hist = (LAS unsigned*)(c.lds + LDSCTL_OFF + 12288); LAS unsigned* ebase = hist + 32;
    const int lane = c.lane, fr = lane & 15, fq = lane >> 4;
    __syncthreads();
    for (int idx = c.tid; idx < 8192; idx += NWAVES * 64) *(LAS u32x4*)(c.lds + idx * 16) = *(const u32x4*)(c.ws + WS_SSMP + SSM_WRF + (size_t)idx * 16);
    for (int idx = c.tid; idx < 1024; idx += NWAVES * 64) gl[idx] = a.in[18][idx];
    for (int t0 = 0; t0 < M / 16; t0 += 4 * c.G) {
        if (c.tid < 32) hist[c.tid] = 0u;
        __syncthreads();
        const int kh = c.wave >> 2;
        const int tile = t0 + (c.wave & 3) * c.G + c.bid; const bool work = tile < M / 16;
        LAS float* part = (LAS float*)(c.lds + LDSCTL_OFF + 16384) + ((c.wave & 3) * 64 + lane) * 9;
        int te[4]; unsigned rk[4]; float gts[4] = {0.f, 0.f, 0.f, 0.f}, rstd_keep = 0.f; const int row = 16 * tile + fr;
        f32x4 racc0 = {0.f, 0.f, 0.f, 0.f}, racc1 = {0.f, 0.f, 0.f, 0.f}; float rss = 0.f;
        if (work) {
            const float* xr = H1 + (size_t)row * D + 8 * fq;
            f32x4 acc0 = {0.f, 0.f, 0.f, 0.f}, acc1 = {0.f, 0.f, 0.f, 0.f}; float ss = 0.f;
#pragma unroll 4
            for (int ks = 16 * kh; ks < 16 * kh + 16; ++ks) {
                const f32x4 x0 = *(const f32x4*)(xr + 32 * ks), x1 = *(const f32x4*)(xr + 32 * ks + 4);
                const f32x4 g0 = *(const LAS f32x4*)(gl + 32 * ks + 8 * fq), g1 = *(const LAS f32x4*)(gl + 32 * ks + 8 * fq + 4);
                ss += (x0.x * x0.x + x0.y * x0.y) + (x0.z * x0.z + x0.w * x0.w) + (x1.x * x1.x + x1.y * x1.y) + (x1.z * x1.z + x1.w * x1.w);
                const f32x4 v0 = x0 * g0, v1 = x1 * g1;
                u32x4 hw; hw.x = pk2(v0.x, v0.y); hw.y = pk2(v0.z, v0.w); hw.z = pk2(v1.x, v1.y); hw.w = pk2(v1.z, v1.w);
                { u32x2 w8; w8.x = pk4_fp8(v0.x, v0.y, v0.z, v0.w); w8.y = pk4_fp8(v1.x, v1.y, v1.z, v1.w); *(u32x2*)(XG + (size_t)row * D + 32 * ks + 8 * fq) = w8; }
                u32x4 lw; lw.x = pk2(v0.x - bflo(hw.x), v0.y - bfhi(hw.x)); lw.y = pk2(v0.z - bflo(hw.y), v0.w - bfhi(hw.y)); lw.z = pk2(v1.x - bflo(hw.z), v1.y - bfhi(hw.z)); lw.w = pk2(v1.z - bflo(hw.w), v1.w - bfhi(hw.w));
                const bf16x8 hi = __builtin_bit_cast(bf16x8, hw), lo = __builtin_bit_cast(bf16x8, lw);
                const bf16x8 wh0 = *(const LAS bf16x8*)(c.lds + ((ks * 2 + 0) * 64 + lane) * 16), wh1 = *(const LAS bf16x8*)(c.lds + ((ks * 2 + 1) * 64 + lane) * 16);
                const bf16x8 wl0 = *(const LAS bf16x8*)(c.lds + 65536 + ((ks * 2 + 0) * 64 + lane) * 16), wl1 = *(const LAS bf16x8*)(c.lds + 65536 + ((ks * 2 + 1) * 64 + lane) * 16);
                acc0 = __builtin_amdgcn_mfma_f32_16x16x32_bf16(wh0, hi, acc0, 0, 0, 0); acc1 = __builtin_amdgcn_mfma_f32_16x16x32_bf16(wh1, hi, acc1, 0, 0, 0);
                acc0 = __builtin_amdgcn_mfma_f32_16x16x32_bf16(wl0, hi, acc0, 0, 0, 0); acc1 = __builtin_amdgcn_mfma_f32_16x16x32_bf16(wl1, hi, acc1, 0, 0, 0);
                acc0 = __builtin_amdgcn_mfma_f32_16x16x32_bf16(wh0, lo, acc0, 0, 0, 0); acc1 = __builtin_amdgcn_mfma_f32_16x16x32_bf16(wh1, lo, acc1, 0, 0, 0);
            }
            racc0 = acc0; racc1 = acc1; rss = ss;
            if (kh == 1) { part[0] = acc0[0]; part[1] = acc0[1]; part[2] = acc0[2]; part[3] = acc0[3]; part[4] = acc1[0]; part[5] = acc1[1]; part[6] = acc1[2]; part[7] = acc1[3]; part[8] = ss; }
        }
        __syncthreads();
        if (work && kh == 0) {
            f32x4 acc0, acc1; float ss;
            acc0 = racc0; acc1 = racc1; ss = rss;
            acc0[0] += part[0]; acc0[1] += part[1]; acc0[2] += part[2]; acc0[3] += part[3]; acc1[0] += part[4]; acc1[1] += part[5]; acc1[2] += part[6]; acc1[3] += part[7]; ss += part[8];
            ss += __shfl_xor(ss, 16); ss += __shfl_xor(ss, 32);
            const float rstd = 1.0f / sqrtf(ss * (1.0f / D) + RMS_EPS);
            float lg[32];
#pragma unroll
            for (int q = 0; q < 4; ++q)
#pragma unroll
                for (int r = 0; r < 4; ++r) { lg[4 * q + r] = __shfl(acc0[r], fr + 16 * q) * rstd + brt[4 * q + r]; lg[16 + 4 * q + r] = __shfl(acc1[r], fr + 16 * q) * rstd + brt[16 + 4 * q + r]; }
            float tv[4];
#pragma unroll
            for (int k = 0; k < 4; ++k) { float best = -3.0e38f; int bi = 0;
#pragma unroll
                for (int e = 0; e < 32; ++e) if (lg[e] > best) { best = lg[e]; bi = e; }
                te[k] = bi; tv[k] = best;
#pragma unroll
                for (int e = 0; e < 32; ++e) if (e == bi) lg[e] = -3.0e38f; }
            if (fq == 0) {
                const float e1 = __expf(tv[1] - tv[0]), e2 = __expf(tv[2] - tv[0]), e3 = __expf(tv[3] - tv[0]), inv = 1.0f / (1.0f + e1 + e2 + e3);
                gts[0] = inv; gts[1] = e1 * inv; gts[2] = e2 * inv; gts[3] = e3 * inv;
                *(u32x4*)(TE + row * 4) = (u32x4){(unsigned)te[0], (unsigned)te[1], (unsigned)te[2], (unsigned)te[3]};
                rstd_keep = rstd;
#pragma unroll
                for (int k = 0; k < 4; ++k) rk[k] = __hip_atomic_fetch_add(hist + te[k], 1u, __ATOMIC_RELAXED, __HIP_MEMORY_SCOPE_WORKGROUP);
            }
        }
        __syncthreads();
        if (c.tid < 32) ebase[c.tid] = __hip_atomic_fetch_add(cnt + c.tid, hist[c.tid], RLX_AGENT);
        __syncthreads();
        if (work && kh == 0 && fq == 0) { const u32x4 pp = {ebase[te[0]] + rk[0], ebase[te[1]] + rk[1], ebase[te[2]] + rk[2], ebase[te[3]] + rk[3]}; *(u32x4*)(TP + row * 4) = pp;
#pragma unroll
            for (int k = 0; k < 4; ++k) { TOKOF[te[k] * M + (int)pp[k]] = row; GATEOF[te[k] * M + (int)pp[k]] = gts[k]; RSOF[te[k] * M + (int)pp[k]] = rstd_keep; } }
        __syncthreads();
    }
}
__device__ __forceinline__ int moe_tables(const Ctx& c, LAS int* tb, LAS int* tile_e, LAS int* cntl) {
    __syncthreads();
    if (c.wave == 0) {
        const gu32* cnt = (const gu32*)(c.ws + WS_CTL) + CW_CNT; const int lane = c.lane;
        const int cn = lane < NE ? (int)__hip_atomic_load(cnt + (lane & 31), RLX_AGENT) : 0; if (lane < NE) cntl[lane] = cn;
        const int n = (cn + 255) >> 8;
        int incl = n;
#pragma unroll
        for (int o = 1; o < 32; o <<= 1) { const int t = __shfl_up(incl, o); if (lane >= o) incl += t; }
        int excl = incl - n; if (excl > MAXT) excl = MAXT;
        if (lane < NE) tb[lane] = excl;
        if (lane == NE - 1) tb[NE] = incl > MAXT ? MAXT : incl;
        if (lane < NE) for (int i = 0; i < n && excl + i < MAXT; ++i) tile_e[excl + i] = lane;
    }
    __syncthreads();
    return __builtin_amdgcn_readfirstlane(tb[NE]);
}
__device__ __forceinline__ void p10_final(const Args& a, const Ctx& c, const LAS int* tb) {
    const float* H1 = (const float*)(c.ws + WS_H1); const unsigned char* YS = c.ws + WS_YS;
    const int* TE = (const int*)(c.ws + WS_TOK); const int* TP = TE + M * 4; const float* gain = a.in[25];
    for (int row = c.gw; row < M; row += c.ngw) {
        f32x4 v[4];
#pragma unroll
        for (int j = 0; j < 4; ++j) v[j] = *(const f32x4*)(H1 + (size_t)row * D + 4 * c.lane + 256 * j);
        const u32x4 te4 = *(const u32x4*)(TE + row * 4), tp4 = *(const u32x4*)(TP + row * 4); u32x4 ts;
#pragma unroll
        for (int k = 0; k < 4; ++k) ts[k] = (unsigned)tb[te4[k]] * 256u + tp4[k];
        unsigned yw[4][4];
#pragma unroll
        for (int k = 0; k < 4; ++k) { const unsigned char* ys = YS + (size_t)ts[k] * D;
#pragma unroll
            for (int j = 0; j < 4; ++j) yw[k][j] = *(const unsigned*)(ys + 4 * c.lane + 256 * j); }
#pragma unroll
        for (int k = 0; k < 4; ++k)
#pragma unroll
            for (int j = 0; j < 4; ++j) { typedef float f32x2v __attribute__((ext_vector_type(2)));
                const f32x2v lo = __builtin_amdgcn_cvt_pk_f32_fp8(yw[k][j], false), hi = __builtin_amdgcn_cvt_pk_f32_fp8(yw[k][j], true);
                v[j].x += lo.x * 0.0625f; v[j].y += lo.y * 0.0625f; v[j].z += hi.x * 0.0625f; v[j].w += hi.y * 0.0625f; }
        float s = 0.f;
#pragma unroll
        for (int j = 0; j < 4; ++j) s += (v[j].x * v[j].x + v[j].y * v[j].y) + (v[j].z * v[j].z + v[j].w * v[j].w);
        const float rstd = 1.0f / sqrtf(wave_sum(s) * (1.0f / D) + RMS_EPS);
#pragma unroll
        for (int j = 0; j < 4; ++j) { const f32x4 g = *(const f32x4*)(gain + 4 * c.lane + 256 * j); *(f32x4*)(a.out + (size_t)row * D + 4 * c.lane + 256 * j) = v[j] * rstd * g; }
    }
}

#ifndef ONE_LAUNCH
#define ONE_LAUNCH 0
#endif
#ifndef FAST_GEMM
#define FAST_GEMM 0
#endif
#ifndef FAST_MIX
#define FAST_MIX 0
#endif
constexpr int NPH = 10;

template <bool FAST, class E, class S, bool F8 = false, bool GATHER = false>
__device__ __forceinline__ void run_gemm(const Ctx& c, const bf16* A, const bf16* Bt, int K, const S& s, const E& e) {
    if constexpr (FAST) { pg8::Gemm g{A, Bt, 0, 0, K, c.wave}; FastEpi<E> fe{e}; pg8::gemm_phase<FastEpi<E>, S, true, true, F8, GATHER>(c.lds, g, s, fe); }
    else { Unit u; for (int i = 0; s.next(i, u); ++i) naive_gemm_unit(A, K, Bt, K, K, u.pm, u.pn, e, c.wave, c.lane); }
}

__global__ void __launch_bounds__(NWAVES * 64, 2) fwd(Args args) {
    extern __shared__ __attribute__((aligned(16))) unsigned char lds_raw[];
    Ctx c0; c0.lds = (LAS unsigned char*)lds_raw; c0.ws = args.ws; c0.tid = threadIdx.x; c0.lane = c0.tid & 63; c0.wave = __builtin_amdgcn_readfirstlane(c0.tid >> 6);
    c0.G = gridDim.x; c0.bid = blockIdx.x; c0.gw = c0.bid * NWAVES + c0.wave; c0.ngw = c0.G * NWAVES;
    const Ctx& c = c0;
    volatile LAS unsigned* MISC = (volatile LAS unsigned*)(c.lds + LDSCTL_OFF);
    LAS int* tb = (LAS int*)(c.lds + LDSCTL_OFF + 512); LAS int* tile_e = (LAS int*)(c.lds + LDSCTL_OFF + 1024); LAS int* cntl = (LAS int*)(c.lds + LDSCTL_OFF + 256);
    for (int u = c.tid; u < (LDS_BYTES - LDSCTL_OFF) / 4; u += NWAVES * 64) ((LAS unsigned*)(c.lds + LDSCTL_OFF))[u] = 0u;
    __syncthreads();
    volatile LAS unsigned long long* ptab = (volatile LAS unsigned long long*)(c0.lds + LDSCTL_OFF + 2560);
    if (c0.tid < 26) ptab[c0.tid] = (unsigned long long)args.in[c0.tid];
    if (c0.tid == 26) ptab[26] = (unsigned long long)args.out;
    __syncthreads();
    const int lo = args.ph_lo, hi = args.ph_hi;
    XcdBarrier bar; bar.bar = (unsigned*)(c.ws + WS_CTL) + CW_BAR; bar.x = 0; bar.st = nullptr;
    if (hi - lo > 1) bar = xcd_barrier_post((unsigned*)(c.ws + WS_CTL) + CW_BAR, MISC + 8);
#ifndef DISMASK
#define DISMASK 0
#endif
#define IN(k) (lo <= (k) && (k) < hi && !((DISMASK >> (k)) & 1))
#define GRID_BAR() xcd_barrier(bar, c0.wave == 0 && pg8::fresh_lane() == 0)
#define SEAM(k) do { if (IN(k) && IN((k) + 1)) GRID_BAR(); } while (0)
#define WSB (c0.ws)
#define XN ((bf16*)(WSB + WS_XN))
#define U ((bf16*)(WSB + WS_U))
#define Q ((bf16*)(WSB + WS_Q))
#define Kb ((bf16*)(WSB + WS_K))
#define Vt ((bf16*)(WSB + WS_VT))
#define GSp ((bf16*)(WSB + WS_GS))
#define GAp ((bf16*)(WSB + WS_GA))
#define Z ((bf16*)(WSB + WS_Z))
#define BRA ((bf16*)(WSB + WS_BRA))
#define MIX ((bf16*)(WSB + WS_MIX))
#define H1 ((float*)(WSB + WS_H1))
#define HID ((bf16*)(WSB + WS_HID))
#define YS ((bf16*)(WSB + WS_YS))

#ifndef REPMASK
#define REPMASK 0
#endif
    int mixpass = 0, glupass = 0;
#ifndef GLU_NOSTORE
#define GLU_NOSTORE 0
#endif
#define PHASE(k, ...) if (IN(k)) { Ctx c = c0; c.lane = pg8::fresh_lane(); c.tid = c.wave * 64 + c.lane; Args pa; \
        _Pragma("unroll") for (int _k = 0; _k < 26; ++_k) { const unsigned long long _v = ptab[_k]; pa.in[_k] = (const float*)(((unsigned long long)(unsigned)__builtin_amdgcn_readfirstlane((int)(_v >> 32)) << 32) | (unsigned)__builtin_amdgcn_readfirstlane((int)_v)); } \
        { const unsigned long long _v = ptab[26]; pa.out = (float*)(((unsigned long long)(unsigned)__builtin_amdgcn_readfirstlane((int)(_v >> 32)) << 32) | (unsigned)__builtin_amdgcn_readfirstlane((int)_v)); } pa.ws = c0.ws; pa.ph_lo = 0; pa.ph_hi = 0; __VA_ARGS__ if constexpr ((REPMASK >> (k)) & 1) { GRID_BAR(); __VA_ARGS__ } } SEAM(k);
    PHASE(0, p0_prologue(pa, c);)
    PHASE(1, {
        EpiInProj E{U, Q, Kb, Vt, GSp, GAp, (const float*)(WSB + WS_ROT)};
        if constexpr (FAST_GEMM && FAST_MIX) { InProjOrder S; S.so.init(M, 4096, c.G, c.bid); run_gemm<true>(c, XN, (const bf16*)(WSB + WS_WIN), 1024, S, E); }
        else { pg8::StaticOrder S; S.init(MP, INW, c.G, c.bid); run_gemm<FAST_GEMM>(c, XN, (const bf16*)(WSB + WS_WIN), 1024, S, E); } })
    PHASE(2, if constexpr (FAST_MIX) {
#ifndef DEFER_REP
#define DEFER_REP 0
#endif
#ifndef MIXSKIP
#define MIXSKIP 0
#endif
 if (!(MIXSKIP & 1) || mixpass == 0) { for (int it = c.bid; it < 128; it += c.G) ssm_chain(c, it >> 1, it & 1); }
 if constexpr (FAST_GEMM) { if (mixpass == 0 || DEFER_REP) { EpiInProj E{U, Q, Kb, Vt, GSp, GAp, (const float*)(WSB + WS_ROT)}; DeferredOrder S{c.G >= 197 ? c.bid - 128 : (c.bid == 0 ? 0 : -1)};
     if (c.G >= 197) { run_gemm<true>(c, XN, (const bf16*)(WSB + WS_WIN), 1024, S, E); } else { for (int j = c.bid; j < 69; j += c.G) { DeferredOrder S1{j}; run_gemm<true>(c, XN, (const bf16*)(WSB + WS_WIN), 1024, S1, E); } } __syncthreads(); } }
 if (!(MIXSKIP & 2) || mixpass == 0) attn_fast(pa, c);
 ++mixpass;
 } else { p2_ssm_naive(pa, c); p2_attn_naive(pa, c); })
    PHASE(3, {
        pg8::StaticOrder S; S.init(M, 1024, c.G, c.bid);
        EpiGlu E{Z, pa.in[13], BRA};
        run_gemm<FAST_GEMM>(c, Z, (const bf16*)(WSB + WS_WGLU), 1024, S, E); })
    PHASE(4, {
        EpiBr E{GSp, GAp, MIX};
        if constexpr (FAST_GEMM) { PairOrder S; S.so.init(M, 1024, c.G, c.bid); run_gemm<true>(c, BRA, (const bf16*)(WSB + WS_WBR), 1024, S, E); }
        else { pg8::StaticOrder S; S.init(M, 1024, c.G, c.bid); run_gemm<false>(c, BRA, (const bf16*)(WSB + WS_WBR), 1024, S, E); } })
    PHASE(5, {
        pg8::StaticOrder S; S.init(M, 1024, c.G, c.bid);
        EpiOut E{pa.in[0], H1};
        run_gemm<FAST_GEMM>(c, MIX, (const bf16*)(WSB + WS_WOUT), 1024, S, E); })
    PHASE(6, p6_router(pa, c);)
    PHASE(7, {
        const int nt = moe_tables(c, tb, tile_e, cntl);
        const MoeTabs T{tile_e, tb, cntl, (const int*)(WSB + WS_TOKOF), (const float*)(WSB + WS_GATEOF), (const float*)(WSB + WS_RSOF)};
        MoeOrder S{T, nt, 8, c.G, c.bid};
        EpiMoe1 E{pa.in[22], (unsigned char*)HID, T};
        run_gemm<true, EpiMoe1, MoeOrder, true, true>(c, (const bf16*)(WSB + WS_HN2), (const bf16*)(WSB + WS_WGU), 512, S, E); })
    PHASE(8, {
        const int nt = moe_tables(c, tb, tile_e, cntl);
        const MoeTabs T{tile_e, tb, cntl, (const int*)(WSB + WS_TOKOF), (const float*)(WSB + WS_GATEOF), (const float*)(WSB + WS_RSOF)};
        MoeOrder S{T, nt, 4, c.G, c.bid};
        EpiMoe2 E{pa.in[24], (unsigned char*)YS, T};
        run_gemm<true, EpiMoe2, MoeOrder, true>(c, HID, (const bf16*)(WSB + WS_WDN), 512, S, E); })
    PHASE(9, { moe_tables(c, tb, tile_e, cntl); p10_final(pa, c, tb); })
#undef PHASE
#undef WSB
#undef XN
#undef U
#undef Q
#undef Kb
#undef Vt
#undef GSp
#undef GAp
#undef Z
#undef BRA
#undef MIX
#undef H1
#undef HID
#undef YS
#undef IN
#undef SEAM
}

extern "C" void kernel_launch(void* const* d_in, const int* in_sizes, int n_in, void* d_out, int out_size, void* d_ws, size_t ws_size, hipStream_t stream) {
    static int grid = 0;
    if (grid == 0) {
        if (n_in != 26 || in_sizes[0] != M * D || out_size != M * D || ws_size < WS_END) { fprintf(stderr, "kernel_launch: unexpected shapes (n_in %d, in0 %d, out %d, ws %zu)\n", n_in, n_in > 0 ? in_sizes[0] : -1, out_size, ws_size); grid = -1; return; }
        int dev = 0, cus = 0, per_cu = 0;
        if (hipGetDevice(&dev) != hipSuccess || hipDeviceGetAttribute(&cus, hipDeviceAttributeMultiprocessorCount, dev) != hipSuccess) { grid = -1; return; }
        if (hipFuncSetAttribute((const void*)fwd, hipFuncAttributeMaxDynamicSharedMemorySize, LDS_BYTES) != hipSuccess) { fprintf(stderr, "kernel_launch: hipFuncSetAttribute failed\n"); grid = -1; return; }
        if (hipOccupancyMaxActiveBlocksPerMultiprocessor(&per_cu, (const void*)fwd, NWAVES * 64, LDS_BYTES) != hipSuccess || per_cu < 1) fprintf(stderr, "kernel_launch: occupancy query says %d\n", per_cu);
        (void)hipGetLastError();
        grid = cus;
    }
    if (grid < 0) return;
    if (hipMemsetAsync((char*)d_ws + WS_CTL, 0, CTL_ZERO_BYTES, stream) != hipSuccess) return;
    Args a{};
    for (int i = 0; i < 26; ++i) a.in[i] = (const float*)d_in[i];
    a.out = (float*)d_out; a.ws = (unsigned char*)d_ws;
#if ONE_LAUNCH
    a.ph_lo = 0; a.ph_hi = NPH;
    hipLaunchKernelGGL(fwd, dim3(grid), dim3(NWAVES * 64), LDS_BYTES, stream, a);
#else
    for (int p = 0; p < NPH; ++p) { a.ph_lo = p; a.ph_hi = p + 1; hipLaunchKernelGGL(fwd, dim3(grid), dim3(NWAVES * 64), LDS_BYTES, stream, a); }
#endif
}
```

```cpp
#include <hip/hip_runtime.h>
#include <cstdio>
#include <cstdint>
#define ONE_LAUNCH 1
#define FAST_GEMM 1
#define FAST_MIX 1
#define EPI_FENCE 0
namespace pg8 {
#define PG8_LAS __attribute__((address_space(3)))
typedef unsigned short bf16_t;
typedef short bf16x8 __attribute__((ext_vector_type(8)));
typedef float f32x4 __attribute__((ext_vector_type(4)));
typedef unsigned u32x4 __attribute__((ext_vector_type(4)));
constexpr int BM = 256, BK = 64, HALF = 128, HTB = HALF * BK * 2  , STAGE_BYTES = 8 * HTB, NXCD = 8, WGM = 4;

__host__ __device__ __forceinline__ int lds_byte(int r, int c) { const int st = (r >> 4) * 2 + (c >> 5), rr = r & 15, cc = c & 31, ob = rr * 64 + cc * 2; return st * 1024 + (ob ^ (((ob >> 9) & 1) << 5)); }
__host__ __device__ __forceinline__ void stage_rc(int b, int& R, int& C) { const int st = b / 1024, sb = b % 1024, swz = sb ^ (((sb >> 9) & 1) << 5); R = (st >> 1) * 16 + swz / 64; C = (st & 1) * 32 + (swz % 64) / 2; }
__host__ __device__ __forceinline__ int perm32(int rho) { const int n = rho >> 4, i = rho & 15; return 8 * (i >> 2) + 4 * n + (i & 3); }

struct Unit { int pm, pn; };
struct Gemm { const bf16_t* A; const bf16_t* Bt; int M, N, K; int wid; };
__device__ __forceinline__ int fresh_lane() { int l; asm volatile("v_mbcnt_lo_u32_b32 %0, -1, 0\n\tv_mbcnt_hi_u32_b32 %0, -1, %0" : "=v"(l)); return l; }

struct StaticOrder {
    int nM, nN, nwg, G, c;
    __host__ __device__ void init(int M, int N, int G_, int c_) { nM = M / BM; nN = N / BM; nwg = nM * nN; G = G_; c = c_; }
    __host__ __device__ bool next(int i, Unit& u) const {
        const long L = (long)i * G + c; if (L >= nwg) return false;
        int wgid = (int)L; { const int q = nwg / NXCD, r = nwg % NXCD, xcd = wgid % NXCD, off = wgid / NXCD; wgid = (xcd < r ? xcd * (q + 1) : r * (q + 1) + (xcd - r) * q) + off; }
        const int nig = WGM * nN, gid = wgid / nig, fm = gid * WGM, gsz = (nM - fm) < WGM ? (nM - fm) : WGM;
        u.pm = fm + ((wgid % nig) % gsz); u.pn = (wgid % nig) / gsz; return true;
    }
    __device__ __forceinline__ void a_ready(const Unit&) const {}
    __device__ __forceinline__ void done(const Unit&) const {}
};
__device__ __forceinline__ unsigned cvt_pk_bf16(float lo, float hi) { unsigned r; asm volatile("v_cvt_pk_bf16_f32 %0, %1, %2" : "=v"(r) : "v"(lo), "v"(hi)); return r; }
typedef int pg8_v8i __attribute__((ext_vector_type(8))); typedef int pg8_v4i __attribute__((ext_vector_type(4)));
__device__ __forceinline__ pg8_v8i pg8_cat(bf16x8 lo, bf16x8 hi) { return __builtin_shufflevector(__builtin_bit_cast(pg8_v4i, lo), __builtin_bit_cast(pg8_v4i, hi), 0, 1, 2, 3, 4, 5, 6, 7); }
template <class Epi, class Sched, bool ALIGN_EPI = false, bool SP2 = false, bool F8 = false, bool GATHER = false>
__device__ __forceinline__ void gemm_phase(PG8_LAS unsigned char* lds, const Gemm g, const Sched& S, const Epi& E) {
    const int lane = fresh_lane(), wid = g.wid, tid = wid * 64 + lane, wr = wid >> 2, wc = wid & 3, fr = lane & 15, fq = lane >> 4;
    const int K = g.K, nt = K / BK;
    unsigned voffA[2], voffB[2];
#pragma unroll
    for (int i = 0; i < 2; ++i) { int R, C; stage_rc(tid * 16 + i * 8192, R, C); const int Rb = Epi::PERM ? ((R & ~31) + perm32(R & 31)) : R;
        voffA[i] = (unsigned)(R * K + C) * 2u; voffB[i] = (unsigned)(Rb * K + C) * 2u; }
    unsigned vA[2], nvA[2], gC = 0u;
    const unsigned kstep = (unsigned)(BK * 2);
    const unsigned hstep = (unsigned)HALF * K * 2;
    const unsigned tstep = 2 * hstep;
    const __amdgpu_buffer_rsrc_t rsA = __builtin_amdgcn_make_buffer_rsrc((void*)g.A, (short)0, -1, 0x00020000), rsB = __builtin_amdgcn_make_buffer_rsrc((void*)g.Bt, (short)0, -1, 0x00020000);
    const unsigned ldsw = (unsigned)wid * 1024u;
    const int aoff = lds_byte(wr * 64 + fr, fq * 8), boff = lds_byte(wc * 32 + fr, fq * 8);
#define PG8_SA(b, h) (((b) * 2 + (h)) * HTB)
#define PG8_SB(b, h) ((4 + (b) * 2 + (h)) * HTB)
#define PG8_STAGE(bufoff, gbase, voff) do { _Pragma("unroll") for (int _i = 0; _i < 2; ++_i) \
        __builtin_amdgcn_raw_ptr_buffer_load_lds(PG8_RS_##voff, (PG8_LAS unsigned*)(lds + (bufoff) + ldsw + _i * 8192), 16, (int)(voff)[_i], (int)(gbase), 0, 0); } while (0)
#define PG8_RS_voffA rsA
#define PG8_RS_voffB rsB
#define PG8_STAGE_A(bufoff, h, off) do { if constexpr (GATHER) { const unsigned _pk = ((off) >> 31) != 0u ? nvA[h] : vA[h]; _Pragma("unroll") for (int _i = 0; _i < 2; ++_i) \
        __builtin_amdgcn_raw_ptr_buffer_load_lds(rsA, (PG8_LAS unsigned*)(lds + (bufoff) + ldsw + _i * 8192), 16, (int)(((_pk >> (16 * _i)) & 0xffffu) * (unsigned)(K * 2) + gC), (int)((off) & 0x7fffffffu), 0, 0); } \
        else { PG8_STAGE(bufoff, (off) + (h) * hstep, voffA); } } while (0)
#define PG8_LOADROWS(dst, u) do { const int _ln = fresh_lane(); int _R, _C; stage_rc((wid * 64 + _ln) * 16, _R, _C); gC = (unsigned)_C * 2u; \
        _Pragma("unroll") for (int _h = 0; _h < 2; ++_h) dst[_h] = S.row_id(u, _R + 128 * _h) | (S.row_id(u, _R + 64 + 128 * _h) << 16); } while (0)
#define PG8_LDA(dst, b, h) do { _Pragma("unroll") for (int m = 0; m < 4; ++m) _Pragma("unroll") for (int k = 0; k < 2; ++k) dst[m][k] = *(const PG8_LAS bf16x8*)(lds + PG8_SA(b, h) + aoff + m * 2048 + k * 1024); } while (0)
#define PG8_LDB(dst, b, h) do { _Pragma("unroll") for (int n = 0; n < 2; ++n) _Pragma("unroll") for (int k = 0; k < 2; ++k) dst[n][k] = *(const PG8_LAS bf16x8*)(lds + PG8_SB(b, h) + boff + n * 2048 + k * 1024); } while (0)
#define PG8_MMA(ai, bj, At, Bt) do { __builtin_amdgcn_s_setprio(1); if constexpr (F8) { _Pragma("unroll") for (int m = 0; m < 4; ++m) _Pragma("unroll") for (int n = 0; n < 2; ++n) \
        acc[ai][bj][m][n] = __builtin_amdgcn_mfma_scale_f32_16x16x128_f8f6f4(pg8_cat(Bt[n][0], Bt[n][1]), pg8_cat(At[m][0], At[m][1]), acc[ai][bj][m][n], 0, 0, 0, 0, 0, 0); } else { \
        _Pragma("unroll") for (int m = 0; m < 4; ++m) _Pragma("unroll") for (int n = 0; n < 2; ++n) _Pragma("unroll") for (int k = 0; k < 2; ++k) \
        acc[ai][bj][m][n] = __builtin_amdgcn_mfma_f32_16x16x32_bf16(Bt[n][k], At[m][k], acc[ai][bj][m][n], 0, 0, 0); } __builtin_amdgcn_s_setprio(0); } while (0)
#define PG8_WAIT_V(n) asm volatile("s_waitcnt vmcnt(" #n ")" ::: "memory")
#define PG8_WAIT_L(n) asm volatile("s_waitcnt lgkmcnt(" #n ")" ::: "memory")
#define PG8_BAR __builtin_amdgcn_s_barrier()
#define PG8_SCHED __builtin_amdgcn_sched_barrier(0)
    Unit cur, nxt; int ui = 0;
    if (!S.next(0, cur)) return;
    f32x4 acc[2][2][4][2];
#pragma unroll
    for (int a = 0; a < 2; ++a)
#pragma unroll
        for (int b = 0; b < 2; ++b)
#pragma unroll
            for (int m = 0; m < 4; ++m)
#pragma unroll
                for (int n = 0; n < 2; ++n) acc[a][b][m][n] = (f32x4){0.f, 0.f, 0.f, 0.f};
    bf16x8 At[4][2], B0[2][2], B1[2][2];
    unsigned cA = GATHER ? 0u : (unsigned)cur.pm * tstep, cB = (unsigned)cur.pn * tstep;
    if constexpr (GATHER) { PG8_LOADROWS(vA, cur); PG8_LOADROWS(nvA, cur); }
    S.a_ready(cur);
    if constexpr (SP2) {
        PG8_STAGE(PG8_SB(0, 0), cB, voffB); PG8_STAGE(PG8_SB(0, 1), cB + hstep, voffB); PG8_STAGE_A(PG8_SA(0, 0), 0, cA); PG8_STAGE_A(PG8_SA(0, 1), 1, cA);
        if (wr == 1) PG8_BAR;
        PG8_WAIT_V(2); PG8_BAR;
        PG8_STAGE(PG8_SB(1, 0), cB + kstep, voffB); PG8_STAGE_A(PG8_SA(1, 0), 0, cA + kstep); PG8_STAGE(PG8_SB(1, 1), cB + hstep + kstep, voffB);
        PG8_WAIT_V(6); PG8_BAR;
    } else {
        PG8_STAGE(PG8_SB(0, 0), cB, voffB); PG8_STAGE_A(PG8_SA(0, 0), 0, cA); PG8_STAGE(PG8_SB(0, 1), cB + hstep, voffB); PG8_STAGE_A(PG8_SA(0, 1), 1, cA);
        if (wr == 1) PG8_BAR;
        PG8_WAIT_V(4); PG8_BAR;
        PG8_STAGE(PG8_SB(1, 0), cB + kstep, voffB); PG8_STAGE_A(PG8_SA(1, 0), 0, cA + kstep); PG8_STAGE(PG8_SB(1, 1), cB + hstep + kstep, voffB);
        PG8_WAIT_V(6); PG8_BAR;
    }
    for (;;) {
        const bool has_next = S.next(ui + 1, nxt);
        const unsigned nA = GATHER ? (has_next ? 0x80000000u : 0u) : (has_next ? (unsigned)nxt.pm * tstep : cA), nB = has_next ? (unsigned)nxt.pn * tstep : cB;
        if constexpr (GATHER) { if (has_next) PG8_LOADROWS(nvA, nxt); }
#pragma unroll 1
        for (int t = 0; t < nt; t += 2) {
            const bool last = (t == nt - 2);
            const unsigned a1 = cA + (unsigned)(t + 1) * kstep;
            const unsigned a2 = last ? nA : cA + (unsigned)(t + 2) * kstep, b2 = last ? nB : cB + (unsigned)(t + 2) * kstep;
            const unsigned a3 = a2 + kstep, b3 = b2 + kstep;
            if (last && has_next) S.a_ready(nxt);
            if constexpr (SP2) {
            PG8_LDB(B0, 0, 0); PG8_LDB(B1, 0, 1); PG8_SCHED; PG8_LDA(At, 0, 0); PG8_STAGE_A(PG8_SA(1, 1), 1, a1);
            PG8_WAIT_V(8); PG8_WAIT_L(0); PG8_BAR; PG8_MMA(0, 0, At, B0); PG8_MMA(0, 1, At, B1); PG8_BAR; PG8_SCHED;
            PG8_LDA(At, 0, 1); PG8_STAGE(PG8_SB(0, 0), b2, voffB); PG8_STAGE(PG8_SB(0, 1), b2 + hstep, voffB); PG8_STAGE_A(PG8_SA(0, 0), 0, a2);
            PG8_WAIT_V(8); PG8_WAIT_L(0); PG8_BAR; PG8_MMA(1, 0, At, B0); PG8_MMA(1, 1, At, B1); PG8_BAR; PG8_SCHED;
            PG8_LDB(B0, 1, 0); PG8_LDB(B1, 1, 1); PG8_SCHED; PG8_LDA(At, 1, 0); PG8_STAGE_A(PG8_SA(0, 1), 1, a2);
            PG8_WAIT_V(8); PG8_WAIT_L(0); PG8_BAR; PG8_MMA(0, 0, At, B0); PG8_MMA(0, 1, At, B1); PG8_BAR; PG8_SCHED;
            PG8_LDA(At, 1, 1); PG8_STAGE(PG8_SB(1, 0), b3, voffB); PG8_STAGE(PG8_SB(1, 1), b3 + hstep, voffB); PG8_STAGE_A(PG8_SA(1, 0), 0, a3);
            PG8_WAIT_V(8); PG8_WAIT_L(0); PG8_BAR; PG8_MMA(1, 0, At, B0); PG8_MMA(1, 1, At, B1); PG8_BAR; PG8_SCHED;
            } else {
            PG8_LDB(B0, 0, 0); PG8_SCHED; PG8_LDA(At, 0, 0); PG8_STAGE_A(PG8_SA(1, 1), 1, a1);
            PG8_WAIT_L(8); PG8_BAR; PG8_WAIT_L(0); PG8_MMA(0, 0, At, B0); PG8_BAR; PG8_SCHED;
            PG8_LDB(B1, 0, 1); PG8_STAGE(PG8_SB(0, 0), b2, voffB);
            PG8_BAR; PG8_WAIT_L(0); PG8_MMA(0, 1, At, B1); PG8_BAR;
            PG8_LDA(At, 0, 1); PG8_STAGE_A(PG8_SA(0, 0), 0, a2);
            PG8_BAR; PG8_WAIT_L(0); PG8_MMA(1, 0, At, B0); PG8_BAR; PG8_SCHED;
            PG8_STAGE(PG8_SB(0, 1), b2 + hstep, voffB);
            PG8_WAIT_V(6); PG8_BAR; PG8_MMA(1, 1, At, B1); PG8_BAR;
            PG8_LDB(B0, 1, 0); PG8_SCHED; PG8_LDA(At, 1, 0); PG8_STAGE_A(PG8_SA(0, 1), 1, a2);
            PG8_WAIT_L(8); PG8_BAR; PG8_WAIT_L(0); PG8_MMA(0, 0, At, B0); PG8_BAR; PG8_SCHED;
            PG8_LDB(B1, 1, 1); PG8_STAGE(PG8_SB(1, 0), b3, voffB);
            PG8_BAR; PG8_WAIT_L(0); PG8_MMA(0, 1, At, B1); PG8_BAR;
            PG8_LDA(At, 1, 1); PG8_STAGE_A(PG8_SA(1, 0), 0, a3);
            PG8_BAR; PG8_WAIT_L(0); PG8_MMA(1, 0, At, B0); PG8_BAR; PG8_SCHED;
            PG8_STAGE(PG8_SB(1, 1), b3 + hstep, voffB);
            PG8_WAIT_V(6); PG8_BAR; PG8_MMA(1, 1, At, B1); PG8_BAR;
            }
        }
        if constexpr (ALIGN_EPI) { if (wr == 0) PG8_BAR; }
        bool keep = false;
        if constexpr (Epi::HAS_MID) keep = E.first_half(cur);
        if constexpr (!Epi::AFTER_DRAIN) { if (keep) E.mid(acc, cur, wr, wc, fr, fq); else E(acc, cur, wr, wc, fr, fq); S.done(cur); }
        if (!has_next) break;
        if (!keep) {
#pragma unroll
        for (int a = 0; a < 2; ++a)
#pragma unroll
            for (int b = 0; b < 2; ++b)
#pragma unroll
                for (int m = 0; m < 4; ++m)
#pragma unroll
                    for (int n = 0; n < 2; ++n) acc[a][b][m][n] = (f32x4){0.f, 0.f, 0.f, 0.f};
        }
        cur = nxt; cA = GATHER ? 0u : nA; cB = nB; ++ui;
        if constexpr (GATHER) { vA[0] = nvA[0]; vA[1] = nvA[1]; }
        if constexpr (ALIGN_EPI) { if (wr == 1) PG8_BAR; }
    }
    PG8_WAIT_V(0);
    if constexpr (!ALIGN_EPI) { if (wr == 0) PG8_BAR; }
    PG8_BAR;
    if constexpr (Epi::AFTER_DRAIN) { E.fused(acc, cur, wr, wc, fr, fq, lds, wid, lane); S.done(cur); }
#undef PG8_SA
#undef PG8_SB
#undef PG8_STAGE
#undef PG8_RS_voffA
#undef PG8_STAGE_A
#undef PG8_LOADROWS
#undef PG8_RS_voffB
#undef PG8_LDA
#undef PG8_LDB
#undef PG8_MMA
#undef PG8_WAIT_V
#undef PG8_WAIT_L
#undef PG8_BAR
#undef PG8_SCHED
}
}

#define GAS __attribute__((address_space(1)))
#define LAS __attribute__((address_space(3)))
typedef unsigned short bf16;
typedef float f32x4 __attribute__((ext_vector_type(4)));
typedef short bf16x8 __attribute__((ext_vector_type(8)));
typedef unsigned u32x4 __attribute__((ext_vector_type(4)));
typedef unsigned u32x2 __attribute__((ext_vector_type(2)));
typedef GAS unsigned gu32;

constexpr int NWAVES = 8;
constexpr int D = 1024, SEQ = 8192, NBATCH = 2, NMETA = 16, LTOT = SEQ + NMETA;
constexpr int M = NBATCH * SEQ;
constexpr int MP = M + 256;
constexpr int INW = 4352;
constexpr int NCH = LTOT / 16;
constexpr int NE = 32, TOPK = 4;
constexpr int MAXT = M * TOPK / 256 + NE;
constexpr int NSLOT = MAXT * 256;
constexpr int VP = 8320;
constexpr float RMS_EPS = 1e-5f;

constexpr size_t MiB = 1ull << 20;
constexpr size_t WS_CTL = 0, CTL_ZERO_BYTES = 65536;
constexpr size_t WS_ROT = 1 * MiB;
constexpr size_t WS_TOK = 2 * MiB;
constexpr size_t WS_SSMP = 4 * MiB;
constexpr size_t WS_TOKOF = 24 * MiB;
constexpr size_t WS_GATEOF = 26 * MiB;
constexpr size_t WS_RSOF = 28 * MiB;
constexpr size_t WS_WIN = 32 * MiB;
constexpr size_t WS_WGLU = 41 * MiB;
constexpr size_t WS_WBR = 43 * MiB;
constexpr size_t WS_WOUT = 47 * MiB;
constexpr size_t WS_WGU = 49 * MiB;
constexpr size_t WS_WDN = 177 * MiB;
constexpr size_t WS_XN = 241 * MiB;
constexpr size_t WS_U = 274 * MiB;
constexpr size_t WS_Q = 307 * MiB;
constexpr size_t WS_K = 339 * MiB;
constexpr size_t WS_VT = 344 * MiB;
constexpr size_t WS_GS = 349 * MiB;
constexpr size_t WS_GA = 381 * MiB;
constexpr size_t WS_Z = 413 * MiB;
constexpr size_t WS_BRA = 445 * MiB;
constexpr size_t WS_MIX = 509 * MiB;
constexpr size_t WS_H1 = 541 * MiB;
constexpr size_t WS_HN2 = 605 * MiB;
constexpr size_t WS_S16 = 637 * MiB;
constexpr size_t WS_XC = 671 * MiB;
constexpr size_t WS_XS = 241 * MiB;
constexpr size_t WS_HID = 385 * MiB;
constexpr size_t WS_YS = 688 * MiB;
constexpr size_t WS_END = 832 * MiB;
static_assert((size_t)NSLOT * 2048 <= 144 * MiB, "slot buffers");
constexpr int CW_TMO = 0, CW_CNT = 1024, CW_BAR = 4096;

constexpr int RING_BYTES = 131072;
constexpr int LDSCTL_OFF = RING_BYTES;
constexpr int LDS_BYTES = 163840;

#define LDS_WAIT() asm volatile("s_waitcnt lgkmcnt(0)" ::: "memory")
#define VM_WAIT() asm volatile("s_waitcnt vmcnt(0)" ::: "memory")
#define RLX_AGENT __ATOMIC_RELAXED, __HIP_MEMORY_SCOPE_AGENT

__device__ __forceinline__ unsigned f2bf(float f) { unsigned u = __builtin_bit_cast(unsigned, f); return (u + 0x7fffu + ((u >> 16) & 1u)) >> 16; }
typedef float f32x2_t __attribute__((ext_vector_type(2))); typedef __bf16 bf16x2_t __attribute__((ext_vector_type(2)));
__device__ __forceinline__ unsigned pk2(float lo, float hi) { f32x2_t v = {lo, hi}; bf16x2_t b = __builtin_convertvector(v, bf16x2_t); return __builtin_bit_cast(unsigned, b); }
__device__ __forceinline__ float bflo(unsigned w) { return __uint_as_float(w << 16); }
__device__ __forceinline__ float bfhi(unsigned w) { return __uint_as_float(w & 0xffff0000u); }
__device__ __forceinline__ float bf2f(bf16 b) { return __uint_as_float((unsigned)b << 16); }
__device__ __forceinline__ float wave_sum(float v) {
#pragma unroll
    for (int o = 1; o < 64; o <<= 1) v += __shfl_xor(v, o);
    return v;
}
__device__ __forceinline__ float wave_max(float v) {
#pragma unroll
    for (int o = 1; o < 64; o <<= 1) v = fmaxf(v, __shfl_xor(v, o));
    return v;
}
__device__ __forceinline__ float sigmoidf_(float x) { return __builtin_amdgcn_rcpf(1.0f + __builtin_amdgcn_exp2f(-1.4426950408889634f * x)); }
__device__ __forceinline__ float gelu_tanh(float x) { const float e = __builtin_amdgcn_exp2f(x * (-2.3022082f + -0.1029432f * (x * x))); return x * __builtin_amdgcn_rcpf(1.0f + e); }
__device__ __forceinline__ void unpack8(u32x4 w, float (&v)[8]) { v[0] = bflo(w.x); v[1] = bfhi(w.x); v[2] = bflo(w.y); v[3] = bfhi(w.y); v[4] = bflo(w.z); v[5] = bfhi(w.z); v[6] = bflo(w.w); v[7] = bfhi(w.w); }
__device__ __forceinline__ u32x4 pack8(const float (&v)[8]) { u32x4 w; w.x = pk2(v[0], v[1]); w.y = pk2(v[2], v[3]); w.z = pk2(v[4], v[5]); w.w = pk2(v[6], v[7]); return w; }

__device__ __forceinline__ unsigned pk4_fp8(float a, float b, float c, float d) { unsigned w = 0u; w = __builtin_amdgcn_cvt_pk_fp8_f32(a, b, w, false); w = __builtin_amdgcn_cvt_pk_fp8_f32(c, d, w, true); return w; }
struct Args { const float* in[26]; float* out; unsigned char* ws; int ph_lo, ph_hi; };
struct Ctx { LAS unsigned char* lds; unsigned char* ws; int tid, lane, wave, G, bid, gw, ngw; };
using pg8::Unit;

template <class E>
__device__ __forceinline__ void naive_gemm_unit(const bf16* __restrict__ A, int lda, const bf16* __restrict__ Bt, int ldb, int K, int pm, int pn, const E& e, int wave, int lane) {
    const int fr = lane & 15, fq = lane >> 4;
    const int row0 = pm * 256 + wave * 32;
#pragma unroll 1
    for (int cg = 0; cg < 4; ++cg) {
        f32x4 acc[2][2][2];
#pragma unroll
        for (int i = 0; i < 2; ++i)
#pragma unroll
            for (int j = 0; j < 2; ++j)
#pragma unroll
                for (int n = 0; n < 2; ++n) acc[i][j][n] = (f32x4){0.f, 0.f, 0.f, 0.f};
#pragma unroll 1
        for (int half = 0; half < (E::HAS_MID ? 2 : 1); ++half) {
            const bf16* ap[2]; const bf16* bp[2][2];
#pragma unroll
            for (int mi = 0; mi < 2; ++mi) ap[mi] = A + (size_t)(half * M + row0 + 16 * mi + fr) * lda + 8 * fq;
#pragma unroll
            for (int bj = 0; bj < 2; ++bj)
#pragma unroll
                for (int n = 0; n < 2; ++n) bp[bj][n] = Bt + (size_t)(half * 1024 + pn * 256 + 128 * bj + 32 * cg + pg8::perm32(16 * n + fr)) * ldb + 8 * fq;
#pragma unroll 1
            for (int k0 = 0; k0 < K; k0 += 32) {
                bf16x8 av[2], bv[2][2];
#pragma unroll
                for (int mi = 0; mi < 2; ++mi) av[mi] = *(const bf16x8*)(ap[mi] + k0);
#pragma unroll
                for (int bj = 0; bj < 2; ++bj)
#pragma unroll
                    for (int n = 0; n < 2; ++n) bv[bj][n] = *(const bf16x8*)(bp[bj][n] + k0);
#pragma unroll
                for (int mi = 0; mi < 2; ++mi)
#pragma unroll
                    for (int bj = 0; bj < 2; ++bj)
#pragma unroll
                        for (int n = 0; n < 2; ++n) acc[mi][bj][n] = __builtin_amdgcn_mfma_f32_16x16x32_bf16(bv[bj][n], av[mi], acc[mi][bj][n], 0, 0, 0);
            }
            if constexpr (E::HAS_MID) {
                if (half == 0) {
#pragma unroll
                    for (int mi = 0; mi < 2; ++mi) e.mid(row0 + 16 * mi + fr, pn * 256 + 32 * cg + 8 * fq, acc[mi][0][0], acc[mi][0][1], acc[mi][1][0], acc[mi][1][1]);
                }
            }
        }
#pragma unroll
        for (int mi = 0; mi < 2; ++mi) e.row8(row0 + 16 * mi + fr, pn * 256 + 32 * cg + 8 * fq, acc[mi][0][0], acc[mi][0][1], acc[mi][1][0], acc[mi][1][1], pm, pn);
    }
}
#ifndef EPI_FENCE
#define EPI_FENCE 0
#endif
template <class E> struct FastEpi {
    static constexpr bool PERM = true, AFTER_DRAIN = false, HAS_MID = E::HAS_MID;
    E e;
    __device__ __forceinline__ void operator()(const f32x4 (&acc)[2][2][4][2], const Unit& u, int wr, int wc, int fr, int fq) const {
#pragma unroll
        for (int ai = 0; ai < 2; ++ai)
#pragma unroll
            for (int m = 0; m < 4; ++m) {
                e.row8(u.pm * 256 + ai * 128 + wr * 64 + m * 16 + fr, u.pn * 256 + wc * 32 + 8 * fq, acc[ai][0][m][0], acc[ai][0][m][1], acc[ai][1][m][0], acc[ai][1][m][1], u.pm, u.pn);
                if constexpr (EPI_FENCE > 0) { if ((m % EPI_FENCE) == EPI_FENCE - 1) asm volatile("" ::: "memory"); } }
    }
    __device__ __forceinline__ bool first_half(const Unit& u) const { if constexpr (E::HAS_MID) return u.pm < M / 256; else return false; }
    __device__ __forceinline__ void mid(f32x4 (&acc)[2][2][4][2], const Unit& u, int wr, int wc, int fr, int fq) const {
        if constexpr (E::HAS_MID) {
#pragma unroll
            for (int ai = 0; ai < 2; ++ai)
#pragma unroll
                for (int m = 0; m < 4; ++m)
                    e.mid(u.pm * 256 + ai * 128 + wr * 64 + m * 16 + fr, u.pn * 256 + wc * 32 + 8 * fq, acc[ai][0][m][0], acc[ai][0][m][1], acc[ai][1][m][0], acc[ai][1][m][1]);
        }
    }
};
struct PairOrder {
    pg8::StaticOrder so;
    __device__ __forceinline__ bool next(int i, Unit& u) const { Unit t; if (!so.next(i >> 1, t)) return false; const int h = i & 1; u.pm = t.pm + h * (M / 256); u.pn = t.pn + h * 4; return true; }
    __device__ __forceinline__ void a_ready(const Unit&) const {}
    __device__ __forceinline__ void done(const Unit&) const {}
};
struct RowMajorOrder {
    int nN, nwg, G, c;
    __device__ __forceinline__ bool next(int i, Unit& u) const { const long L = (long)i * G + c; if (L >= nwg) return false; u.pm = (int)L / nN; u.pn = (int)L % nN; return true; }
    __device__ __forceinline__ void a_ready(const Unit&) const {}
    __device__ __forceinline__ void done(const Unit&) const {}
};
#ifndef NCV
#define NCV 72
#endif
#ifndef NCV_ITEMS
#define NCV_ITEMS 2592
#endif
__device__ __forceinline__ bool inproj_unit(int L, Unit& u) {
    if (L < 576) { pg8::StaticOrder a; a.init(M, 9 * 256, 1, 0); return a.next(L, u); }
    if (L < 581) { const int k = L - 576; u.pm = M / 256; u.pn = k < 4 ? k : 8; return true; }
    if (L < 584) { u.pm = L - 581; u.pn = 16; return true; }
    if (L < 1032) { pg8::StaticOrder b; b.init(M, 7 * 256, 1, 0); if (!b.next(L - 584, u)) return false; u.pn += 9; return true; }
    if (L < 1093) { u.pm = 3 + (L - 1032); u.pn = 16; return true; }
    return false;
}
#ifndef P1R
#define P1R 6
#endif
struct InProjOrder {
    int Gg, c;
    static constexpr bool HAS_HALF = false;
    __device__ __forceinline__ bool next(int i, Unit& u) const { if (i >= P1R) return false; return inproj_unit(i * Gg + c, u); }
    __device__ __forceinline__ void a_ready(const Unit&) const {}
    __device__ __forceinline__ void done(const Unit&) const {}
};
struct DeferredOrder {
    int j0, stride, Gg;
    static constexpr bool HAS_HALF = false;
    __device__ __forceinline__ bool next(int i, Unit& u) const { if (i > 1 || j0 < 0) return false; return inproj_unit(P1R * Gg + j0 + i * stride, u); }
    __device__ __forceinline__ void a_ready(const Unit&) const {}
    __device__ __forceinline__ void done(const Unit&) const {}
};
struct MoeTabs { const LAS int* tile_e; const LAS int* tb; const LAS int* cnt; const int* tok_of; const float* gate_of; const float* rs_of; };
__device__ __forceinline__ int moe_slot_pos(const MoeTabs& T, int e, int slot_row, bool& ok) { const int p = slot_row - T.tb[e] * 256; ok = p < T.cnt[e]; return p; }
struct MoeOrder {
    static constexpr bool HAS_HALF = false;
    MoeTabs T; int ntiles, nct, G, c;
    __device__ __forceinline__ bool next(int i, Unit& u) const {
        if ((G & 7) != 0) { const long L = (long)i * G + c; if (L >= (long)ntiles * nct) return false; u.pm = (int)L / nct; u.pn = __builtin_amdgcn_readfirstlane(T.tile_e[u.pm]) * nct + (int)L % nct; return true; }
        const int per = G >> 3, x = c & 7, j = c >> 3, rpb = 32 / nct;
        const long slot = (long)i * per + j;
        const long blk = (slot >> 5) * 8 + x; const int w = (int)(slot & 31);
        const long rt = blk * rpb + w / nct;
        if (rt >= ntiles) return false;
        u.pm = (int)rt; u.pn = __builtin_amdgcn_readfirstlane(T.tile_e[rt]) * nct + w % nct; return true; }
    __device__ __forceinline__ unsigned row_id(const Unit& u, int r) const { const int e = u.pn / nct; bool ok; const int p = moe_slot_pos(T, e, u.pm * 256 + r, ok); return ok ? (unsigned)T.tok_of[e * M + p] : 0u; }
    __device__ __forceinline__ void a_ready(const Unit&) const {}
    __device__ __forceinline__ void done(const Unit&) const {}
};

__device__ __forceinline__ void f4to8(f32x4 a0, f32x4 a1, float (&v)[8]) { v[0] = a0[0]; v[1] = a0[1]; v[2] = a0[2]; v[3] = a0[3]; v[4] = a1[0]; v[5] = a1[1]; v[6] = a1[2]; v[7] = a1[3]; }

struct EpiInProj {
    static constexpr bool HAS_MID = false;
    bf16 *U, *Q, *Kb, *Vt, *GSp, *GAp; const float* rot;
    __device__ __forceinline__ void one(int row, int col, f32x4 v0, f32x4 v1) const {
        const bool meta = row >= M;
        if (meta) { if (row >= M + NMETA) return; if (!(col < 1024 || (col >= 2048 && col < 2304))) return; }
        const int pos = meta ? row - M : NMETA + (row & (SEQ - 1));
        const int b0 = meta ? 0 : (row >> 13), nb = meta ? 2 : 1;
        float v[8]; f4to8(v0, v1, v);
        if (col < 1024) {
            const int g = col >> 4, h0 = col & 15; const u32x4 w = pack8(v);
            for (int bi = 0; bi < nb; ++bi) { const int b = b0 + bi; *(u32x4*)(U + ((size_t)((g * 2 + b) * NCH + (pos >> 4)) * 256 + (pos & 15) * 16 + h0)) = w; }
        } else if (col < 2176) {
            if ((col & 63) < 16) {
                const int i0 = (col & 8) ? 4 : 0; const float* cs = rot + pos * 16;
#pragma unroll
                for (int j = 0; j < 4; ++j) { const float c = cs[i0 + j], s = cs[8 + i0 + j], x1 = v[j], x2 = v[4 + j]; v[j] = x1 * c - x2 * s; v[4 + j] = x2 * c + x1 * s; }
            }
            if (col < 2048) {
#pragma unroll
                for (int j = 0; j < 8; ++j) v[j] *= 0.18033688011112042f;
                *(u32x4*)(Q + (size_t)row * 1024 + (col - 1024)) = pack8(v);
            } else {
                const u32x4 w = pack8(v);
                for (int bi = 0; bi < nb; ++bi) { const int b = b0 + bi; *(u32x4*)(Kb + ((size_t)(b * LTOT + pos)) * 128 + (col - 2048)) = w; }
            }
        } else if (col < 2304) {
            const u32x4 w = pack8(v);
            for (int bi = 0; bi < nb; ++bi) { const int b = b0 + bi; *(u32x4*)(Vt + ((size_t)(b * LTOT + pos)) * 128 + (col - 2176)) = w; }
        } else {
#pragma unroll
            for (int j = 0; j < 8; ++j) v[j] = sigmoidf_(v[j]);
            if (col < 3328) *(u32x4*)(GSp + (size_t)row * 1024 + (col - 2304)) = pack8(v);
            else *(u32x4*)(GAp + (size_t)row * 1024 + (col - 3328)) = pack8(v);
        }
    }
    __device__ __forceinline__ void row8(int row, int col, f32x4 a0, f32x4 a1, f32x4 b0, f32x4 b1, int, int) const { one(row, col, a0, a1); one(row, col + 128, b0, b1); }
};
struct EpiGlu {
    static constexpr bool HAS_MID = false;
    const bf16* Z; const float* bias; bf16* O;
    __device__ __forceinline__ void one(int row, int col, f32x4 v0, f32x4 v1) const {
        float v[8], z[8]; f4to8(v0, v1, v); unpack8(*(const u32x4*)(Z + (size_t)row * 1024 + col), z);
        const f32x4 c0 = *(const f32x4*)(bias + col), c1 = *(const f32x4*)(bias + col + 4); float bb[8]; f4to8(c0, c1, bb);
#pragma unroll
        for (int j = 0; j < 8; ++j) v[j] = z[j] * sigmoidf_(v[j] + bb[j]);
        *(u32x4*)(O + (size_t)row * 1024 + col) = pack8(v);
    }
    __device__ __forceinline__ void row8(int row, int col, f32x4 a0, f32x4 a1, f32x4 b0, f32x4 b1, int, int) const { one(row, col, a0, a1); one(row, col + 128, b0, b1); }
};
struct EpiBr {
    static constexpr bool HAS_MID = true;
    const bf16* GSp; const bf16* GAp; bf16* MIX;
    __device__ __forceinline__ void mid1(int row, int col, f32x4& v0, f32x4& v1) const {
        float gs[8], ga[8]; unpack8(*(const u32x4*)(GSp + (size_t)row * 1024 + col), gs); unpack8(*(const u32x4*)(GAp + (size_t)row * 1024 + col), ga);
#pragma unroll
        for (int j = 0; j < 4; ++j) { v0[j] *= gs[j] * __builtin_amdgcn_rcpf(fmaxf(ga[j], 1e-20f)); v1[j] *= gs[4 + j] * __builtin_amdgcn_rcpf(fmaxf(ga[4 + j], 1e-20f)); }
    }
    __device__ __forceinline__ void mid(int row, int col, f32x4& a0, f32x4& a1, f32x4& b0, f32x4& b1) const { mid1(row, col, a0, a1); mid1(row, col + 128, b0, b1); }
    __device__ __forceinline__ void one(int row, int col, f32x4 v0, f32x4 v1) const {
        float v[8], ga[8]; f4to8(v0, v1, v); unpack8(*(const u32x4*)(GAp + (size_t)row * 1024 + col), ga);
#pragma unroll
        for (int j = 0; j < 8; ++j) v[j] *= ga[j];
        *(u32x4*)(MIX + (size_t)row * 1024 + col) = pack8(v);
    }
    __device__ __forceinline__ void row8(int row, int col, f32x4 a0, f32x4 a1, f32x4 b0, f32x4 b1, int, int) const {
        if (row >= M) { row -= M; col -= 1024; }
        one(row, col, a0, a1); one(row, col + 128, b0, b1); }
};
struct EpiOut {
    static constexpr bool HAS_MID = false;
    const float* X; float* H1;
    __device__ __forceinline__ void one(int row, int col, f32x4 v0, f32x4 v1) const {
        const size_t o = (size_t)row * 1024 + col;
        *(f32x4*)(H1 + o) = *(const f32x4*)(X + o) + v0; *(f32x4*)(H1 + o + 4) = *(const f32x4*)(X + o + 4) + v1;
    }
    __device__ __forceinline__ void row8(int row, int col, f32x4 a0, f32x4 a1, f32x4 b0, f32x4 b1, int, int) const { one(row, col, a0, a1); one(row, col + 128, b0, b1); }
};
struct EpiMoe1 {
    static constexpr bool HAS_MID = false;
    const float* bgu; unsigned char* HID; MoeTabs T;
    __device__ __forceinline__ void row8(int row, int col, f32x4 a0, f32x4 a1, f32x4 b0, f32x4 b1, int, int pn) const {
        const int e = pn >> 3, ct = pn & 7, j0 = 128 * ct + (col - pn * 256); bool ok; const int p = moe_slot_pos(T, e, row, ok);
        const float rs = (ok ? T.rs_of[e * M + p] : 0.f) * 0.0625f;
        float g[8], up[8], bg[8], bu[8]; f4to8(a0 * rs, a1 * rs, g); f4to8(b0 * rs, b1 * rs, up);
        const float* bp = bgu + (size_t)e * 2048 + j0;
        f4to8(*(const f32x4*)bp, *(const f32x4*)(bp + 4), bg); f4to8(*(const f32x4*)(bp + 1024), *(const f32x4*)(bp + 1028), bu);
#pragma unroll
        for (int j = 0; j < 8; ++j) { const float gg = fminf(g[j] + bg[j], 7.0f), uu = fminf(fmaxf(up[j] + bu[j], -7.0f), 7.0f); g[j] = gg * sigmoidf_(1.702f * gg) * (uu + 1.0f); }
        u32x2 w; w.x = pk4_fp8(g[0], g[1], g[2], g[3]); w.y = pk4_fp8(g[4], g[5], g[6], g[7]); *(u32x2*)(HID + (size_t)row * 1024 + j0) = w;
    }
};
struct EpiMoe2 {
    static constexpr bool HAS_MID = false;
    const float* bd; unsigned char* YS; MoeTabs T;
    __device__ __forceinline__ void one(int row, int e, int c0, f32x4 v0, f32x4 v1, float gt) const {
        float v[8], bb[8]; f4to8(v0, v1, v); const float* bp = bd + (size_t)e * 1024 + c0; f4to8(*(const f32x4*)bp, *(const f32x4*)(bp + 4), bb);
#pragma unroll
        for (int j = 0; j < 8; ++j) v[j] = (v[j] + bb[j] * 16.0f) * gt;
        u32x2 w; w.x = pk4_fp8(v[0], v[1], v[2], v[3]); w.y = pk4_fp8(v[4], v[5], v[6], v[7]); *(u32x2*)(YS + (size_t)row * 1024 + c0) = w;
    }
    __device__ __forceinline__ void row8(int row, int col, f32x4 a0, f32x4 a1, f32x4 b0, f32x4 b1, int, int pn) const {
        const int e = pn >> 2, ct = pn & 3, c0 = 256 * ct + (col - pn * 256); bool ok; const int p = moe_slot_pos(T, e, row, ok); const float gt = ok ? T.gate_of[e * M + p] : 0.f;
        one(row, e, c0, a0, a1, gt); one(row, e, c0 + 128, b0, b1, gt);
    }
};
#define XB_TMO      128
#define XB_XCNT(j)  (256  + 64 * (j))
#define XB_XSUB(j)  (1280 + 64 * (j))
#define XB_XGEN(j)  (2304 + 64 * (j))
#define XB_TOP      3328
#define XB_TOPGEN   3392
#define XCD_BAR_WORDS 3456
#define XB_SPIN_CAP (1u << 18)

__device__ __forceinline__ unsigned xb_ld(unsigned* p)              { return __hip_atomic_load(p, __ATOMIC_RELAXED, __HIP_MEMORY_SCOPE_AGENT); }
__device__ __forceinline__ unsigned xb_add(unsigned* p, unsigned v) { return __hip_atomic_fetch_add(p, v, __ATOMIC_RELAXED, __HIP_MEMORY_SCOPE_AGENT); }
__device__ __forceinline__ unsigned xb_xcc_id() { return (unsigned)__builtin_amdgcn_s_getreg((3 << 11) | 20) & 0xFu; }
#define XB_SPIN(cond, bar) do { unsigned _sp = 0; while (cond) { __builtin_amdgcn_s_sleep(1); \
    if ((++_sp & 255u) == 0u) { if (xb_ld(&(bar)[XB_TMO])) break; if (_sp > XB_SPIN_CAP) { atomicAdd(&(bar)[XB_TMO], 1u); break; } } } } while (0)

struct XcdBarrier {
    unsigned* bar; unsigned x;
    volatile LAS unsigned* st;
};

__device__ __forceinline__ XcdBarrier xcd_barrier_post(unsigned* bar, volatile LAS unsigned* st) {
    XcdBarrier b; b.bar = bar; b.x = xb_xcc_id(); b.st = st;
    if (threadIdx.x == 0) (void)xb_add(&bar[XB_XCNT(b.x)], 1u);
    return b;
}
__device__ __forceinline__ void xcd_barrier_complete(unsigned* bar, unsigned x, unsigned& nloc, unsigned& nx) {
    const unsigned G = gridDim.x * gridDim.y * gridDim.z;
    unsigned sum, cnt, mine, sp = 0u;
    for (;;) {
        sum = 0u; cnt = 0u; mine = 0u;
#pragma unroll
        for (unsigned j = 0; j < 16; ++j) { const unsigned c = xb_ld(&bar[XB_XCNT(j)]); sum += c; cnt += (c > 0u) ? 1u : 0u; mine = (j == x) ? c : mine; }
        if (sum == G) break;
        __builtin_amdgcn_s_sleep(1);
        if ((++sp & 255u) == 0u) { if (xb_ld(&bar[XB_TMO])) break; if (sp > XB_SPIN_CAP) { atomicAdd(&bar[XB_TMO], 1u); break; } }
    }
    nloc = mine > 0u ? mine : 1u; nx = cnt > 0u ? cnt : 1u;
}

__device__ __forceinline__ void xcd_barrier(const XcdBarrier& b, const bool thread0) {
    asm volatile("s_waitcnt vmcnt(0)" ::: "memory");
    __syncthreads();
    if (thread0) {
        unsigned* bar = b.bar;
        __builtin_amdgcn_s_waitcnt(0);
        unsigned nloc = b.st[0], nx = b.st[1];
        if (nloc == 0u) { xcd_barrier_complete(bar, b.x, nloc, nx); b.st[0] = nloc; b.st[1] = nx; }
        const unsigned old = xb_add(&bar[XB_XSUB(b.x)], 1u);
        const unsigned gen = old / nloc;
        if (old + 1u == (gen + 1u) * nloc) {
            __builtin_amdgcn_fence(__ATOMIC_RELEASE, "agent");
            asm volatile("s_waitcnt vmcnt(0)" ::: "memory");
            const unsigned og = xb_add(&bar[XB_TOP], 1u);
            const unsigned tg = og / nx;
            if (og + 1u == (tg + 1u) * nx) xb_add(&bar[XB_TOPGEN], 1u);
            else XB_SPIN(xb_ld(&bar[XB_TOPGEN]) == tg, bar);
            __builtin_amdgcn_fence(__ATOMIC_ACQUIRE, "agent");
            xb_add(&bar[XB_XGEN(b.x)], 1u);
            asm volatile("s_waitcnt vmcnt(0)" ::: "memory");
        } else {
            XB_SPIN(xb_ld(&bar[XB_XGEN(b.x)]) == gen, bar);
            __builtin_amdgcn_fence(__ATOMIC_ACQUIRE, "agent");
            asm volatile("s_waitcnt vmcnt(0)" ::: "memory");
        }
    }
    __syncthreads();
}

constexpr size_t SSM_A16 = 1 * MiB, SSM_TF = 2 * MiB, SSM_VF = 4 * MiB, SSM_WF = 8 * MiB;
constexpr int NCI = 2 * NCH;
constexpr int NCB = (NCI + 15) / 16;
constexpr int CW_Q = 2048;

__device__ __forceinline__ void p0_ssm_prep(const Args& a, const Ctx& c, int g) {
    LAS float* AP = (LAS float*)(c.lds);
    LAS float* BBl = AP + 64 * 17 * 2;
    LAS float* Cc = BBl + 64 * 16 * 2;
    LAS float* Kt = Cc + 16 * 64 * 2;
    unsigned char* sp = c.ws + WS_SSMP;
    const int tid = c.tid;
    if (tid < 64) { const int p = tid, i = g * 64 + p;
        const float lr = a.in[4][i], li = a.in[5][i], dt = expf(a.in[6][g]);
        for (int tau = 0; tau <= 16; ++tau) { const float mag = expf((float)tau * dt * lr), ang = (float)tau * dt * li; AP[(p * 17 + tau) * 2] = mag * cosf(ang); AP[(p * 17 + tau) * 2 + 1] = mag * sinf(ang); }
        const float mag = expf(dt * lr), ar = mag * cosf(dt * li), ai = mag * sinf(dt * li);
        const float den = lr * lr + li * li, nr = ar - 1.0f, ni = ai, fr_ = (nr * lr + ni * li) / den, fi_ = (ni * lr - nr * li) / den;
        for (int h = 0; h < 16; ++h) { const float br = a.in[7][i * 16 + h], bi = a.in[8][i * 16 + h]; BBl[(p * 16 + h) * 2] = fr_ * br - fi_ * bi; BBl[(p * 16 + h) * 2 + 1] = fr_ * bi + fi_ * br; }
        float* A16 = (float*)(sp + SSM_A16); const float m16 = expf(16.0f * dt * lr), a16 = 16.0f * dt * li; A16[i * 2] = m16 * cosf(a16); A16[i * 2 + 1] = m16 * sinf(a16);
    }
    for (int idx = tid; idx < 1024; idx += NWAVES * 64) { const int h = idx >> 6, p = idx & 63; Cc[idx * 2] = a.in[9][(g * 16 + h) * 64 + p]; Cc[idx * 2 + 1] = a.in[10][(g * 16 + h) * 64 + p]; }
    __syncthreads();
    for (int idx = tid; idx < 4096; idx += NWAVES * 64) { const int tau = idx >> 8, h = (idx >> 4) & 15, hp = idx & 15; float s = 0.f;
        for (int p = 0; p < 64; ++p) { const float ar = AP[(p * 17 + tau) * 2], ai = AP[(p * 17 + tau) * 2 + 1], br = BBl[(p * 16 + hp) * 2], bi = BBl[(p * 16 + hp) * 2 + 1];
            const float gr = ar * br - ai * bi, gi = ar * bi + ai * br; s += Cc[(h * 64 + p) * 2] * gr - Cc[(h * 64 + p) * 2 + 1] * gi; }
        if (tau == 0 && h == hp) s += a.in[11][g * 16 + h];
        Kt[idx] = s; }
    __syncthreads();
    bf16* TF = (bf16*)(sp + SSM_TF); bf16* VF = (bf16*)(sp + SSM_VF); bf16* WF = (bf16*)(sp + SSM_WF);
    for (int idx = tid; idx < 1024; idx += NWAVES * 64) { const int dl = idx >> 6, ln = idx & 63, fr = ln & 15, fq = ln >> 4; float v[8];
#pragma unroll
        for (int e = 0; e < 8; ++e) { const int j = 8 * fq + e, tau = dl - (j >> 4), hp = j & 15; v[e] = tau >= 0 ? Kt[(tau * 16 + fr) * 16 + hp] : 0.f; }
        *(u32x4*)(TF + ((size_t)(g * 16 + dl) * 64 + ln) * 8) = pack8(v); }
    for (int idx = tid; idx < 4096; idx += NWAVES * 64) { const int t = idx >> 8, kx = (idx >> 6) & 3, ln = idx & 63, fr = ln & 15, fq = ln >> 4; float v[8];
#pragma unroll
        for (int e = 0; e < 8; ++e) { const int pp = 32 * kx + 8 * fq + e, p = pp & 63; const float cr = Cc[(fr * 64 + p) * 2], ci = Cc[(fr * 64 + p) * 2 + 1], ar = AP[(p * 17 + t + 1) * 2], ai = AP[(p * 17 + t + 1) * 2 + 1];
            v[e] = pp < 64 ? (cr * ar - ci * ai) : -(cr * ai + ci * ar); }
        *(u32x4*)(VF + ((size_t)((g * 16 + t) * 4 + kx) * 64 + ln) * 8) = pack8(v); }
    for (int idx = tid; idx < 4096; idx += NWAVES * 64) { const int pb = idx >> 9, ks = (idx >> 6) & 7, ln = idx & 63, fr = ln & 15, fq = ln >> 4, pp = 16 * pb + fr, p = pp & 63; float v[8];
#pragma unroll
        for (int e = 0; e < 8; ++e) { const int k = 32 * ks + 8 * fq + e, s = k >> 4, h = k & 15; const float ar = AP[(p * 17 + 15 - s) * 2], ai = AP[(p * 17 + 15 - s) * 2 + 1], br = BBl[(p * 16 + h) * 2], bi = BBl[(p * 16 + h) * 2 + 1];
            v[e] = pp < 64 ? (ar * br - ai * bi) : (ar * bi + ai * br); }
        *(u32x4*)(WF + ((size_t)((g * 8 + pb) * 8 + ks) * 64 + ln) * 8) = pack8(v); }
    __syncthreads();
}
__device__ __forceinline__ void ssm_phase_a(const Ctx& c) {
    const bf16* U = (const bf16*)(c.ws + WS_U); const bf16* WF = (const bf16*)(c.ws + WS_SSMP + SSM_WF); float* S16 = (float*)(c.ws + WS_S16);
    const int fr = c.lane & 15, fq = c.lane >> 4;
    for (int it = c.gw; it < 64 * NCB; it += c.ngw) {
        const int g = it / NCB, cb = it % NCB, cidx = 16 * cb + fr, cl = cidx < NCI ? cidx : NCI - 1;
        bf16x8 uf[8];
#pragma unroll
        for (int ks = 0; ks < 8; ++ks) uf[ks] = *(const bf16x8*)(U + ((size_t)(g * NCI + cl)) * 256 + 32 * ks + 8 * fq);
#pragma unroll 2
        for (int pb = 0; pb < 8; ++pb) { f32x4 acc = {0.f, 0.f, 0.f, 0.f};
#pragma unroll
            for (int ks = 0; ks < 8; ++ks) { const bf16x8 wf = *(const bf16x8*)(WF + ((size_t)((g * 8 + pb) * 8 + ks) * 64 + c.lane) * 8); acc = __builtin_amdgcn_mfma_f32_16x16x32_bf16(wf, uf[ks], acc, 0, 0, 0); }
            if (cidx < NCI) *(f32x4*)(S16 + ((size_t)(g * NCI + cidx)) * 128 + 16 * pb + 4 * fq) = acc; }
    }
}
__device__ __forceinline__ void ssm_carry(const Ctx& c) {
    LAS float* E = (LAS float*)(c.lds + LDSCTL_OFF + 4096);
    for (int it = c.bid; it < 128; it += c.G) {
        const int g = it >> 1, b = it & 1, p = c.lane, seg = c.wave, c0 = 64 * seg;
        const float* A16 = (const float*)(c.ws + WS_SSMP + SSM_A16); const float ar = A16[(g * 64 + p) * 2], ai = A16[(g * 64 + p) * 2 + 1];
        const float* sp = (const float*)(c.ws + WS_S16) + ((size_t)(g * NCI + b * NCH + c0)) * 128; bf16* xp = (bf16*)(c.ws + WS_XC) + ((size_t)(g * NCI + b * NCH + c0)) * 128;
        float lr[64], li[64];
#pragma unroll
        for (int j = 0; j < 64; ++j) { lr[j] = sp[j * 128 + p]; li[j] = sp[j * 128 + 64 + p]; }
        float xr = 0.f, xi = 0.f;
#pragma unroll
        for (int j = 0; j < 64; ++j) { const float tr = ar * xr - ai * xi + lr[j], ti = ar * xi + ai * xr + li[j]; xr = tr; xi = ti; lr[j] = xr; li[j] = xi; }
        __syncthreads();
        E[(seg * 64 + p) * 2] = xr; E[(seg * 64 + p) * 2 + 1] = xi;
        float a64r = ar, a64i = ai;
#pragma unroll
        for (int k = 0; k < 6; ++k) { const float tr = a64r * a64r - a64i * a64i, ti = 2.0f * a64r * a64i; a64r = tr; a64i = ti; }
        __syncthreads();
        float cr = 0.f, ci = 0.f;
        for (int s2 = 0; s2 < seg; ++s2) { const float er = E[(s2 * 64 + p) * 2], ei = E[(s2 * 64 + p) * 2 + 1]; const float tr = a64r * cr - a64i * ci + er, ti = a64r * ci + a64i * cr + ei; cr = tr; ci = ti; }
        float pr = ar, pi = ai; bf16* xq = xp + 128 + p;
#pragma unroll
        for (int j = 0; j < 64; ++j) { const float vr = lr[j] + pr * cr - pi * ci, vi = li[j] + pr * ci + pi * cr;
            xq[0] = (bf16)f2bf(vr); xq[64] = (bf16)f2bf(vi); xq += 128; asm volatile("" : "+v"(xq));
            const float tr = pr * ar - pi * ai, ti = pr * ai + pi * ar; pr = tr; pi = ti; }
    }
}
__device__ __forceinline__ void ssm_phase_c(const Ctx& c) {
    const bf16* U = (const bf16*)(c.ws + WS_U); const bf16* XC = (const bf16*)(c.ws + WS_XC); bf16* Z = (bf16*)(c.ws + WS_Z);
    const bf16* TF = (const bf16*)(c.ws + WS_SSMP + SSM_TF); const bf16* VF = (const bf16*)(c.ws + WS_SSMP + SSM_VF);
    const int fr = c.lane & 15, fq = c.lane >> 4;
    for (int it = c.bid; it < 256; it += c.G) {
        const int g = it >> 2, q = it & 3;
        __syncthreads();
        for (int idx = c.tid; idx < 4096; idx += NWAVES * 64) *(LAS u32x4*)(c.lds + idx * 16) = *(const u32x4*)(VF + (size_t)g * 32768 + idx * 8);
        bf16x8 tf[16];
#pragma unroll
        for (int dl = 0; dl < 16; ++dl) tf[dl] = *(const bf16x8*)(TF + ((size_t)(g * 16 + dl) * 64 + c.lane) * 8);
        __syncthreads();
        for (int cb = q + 4 * c.wave; cb < NCB; cb += 32) {
            const int cidx = 16 * cb + fr, cl = cidx < NCI ? cidx : NCI - 1;
            bf16x8 uf[8], xf[4];
#pragma unroll
            for (int ks = 0; ks < 8; ++ks) uf[ks] = *(const bf16x8*)(U + ((size_t)(g * NCI + cl)) * 256 + 32 * ks + 8 * fq);
#pragma unroll
            for (int kx = 0; kx < 4; ++kx) xf[kx] = *(const bf16x8*)(XC + ((size_t)(g * NCI + cl)) * 128 + 32 * kx + 8 * fq);
            const int b = cidx >= NCH ? 1 : 0, cc = cidx - b * NCH; const bool ok = cidx < NCI && cc >= 1;
            bf16* zp = Z + (size_t)(b * SEQ + 16 * (cc - 1)) * 1024 + g * 16 + 4 * fq;
#pragma unroll
            for (int t = 0; t < 16; ++t) { f32x4 acc = {0.f, 0.f, 0.f, 0.f};
#pragma unroll
                for (int ks = 0; ks <= t / 2; ++ks) acc = __builtin_amdgcn_mfma_f32_16x16x32_bf16(tf[t - 2 * ks], uf[ks], acc, 0, 0, 0);
#pragma unroll
                for (int kx = 0; kx < 4; ++kx) { const bf16x8 vf = *(const LAS bf16x8*)(c.lds + ((t * 4 + kx) * 64 + c.lane) * 16); acc = __builtin_amdgcn_mfma_f32_16x16x32_bf16(vf, xf[kx], acc, 0, 0, 0); }
                if (ok) { u32x2 w; w.x = pk2(gelu_tanh(acc[0]), gelu_tanh(acc[1])); w.y = pk2(gelu_tanh(acc[2]), gelu_tanh(acc[3])); *(u32x2*)(zp + (size_t)t * 1024) = w; }
                asm volatile("" ::: "memory"); }
        }
    }
}

__device__ __forceinline__ float ld_sc1_f32(const float* p) { return __uint_as_float(__hip_atomic_load((const unsigned*)p, RLX_AGENT)); }
__device__ __forceinline__ void ssm_chain(const Ctx& c, int g, int b) {
    const int fr = c.lane & 15, fq = c.lane >> 4, w = c.wave, p = c.lane;
    const bf16* Ub = (const bf16*)(c.ws + WS_U) + ((size_t)(g * NCI + b * NCH)) * 256;
    float* Sb = (float*)(c.ws + WS_S16) + ((size_t)(g * NCI + b * NCH)) * 128;
    bf16* Xb = (bf16*)(c.ws + WS_XC) + ((size_t)(g * NCI + b * NCH)) * 128;
    bf16* Z = (bf16*)(c.ws + WS_Z);
    const bf16* TF = (const bf16*)(c.ws + WS_SSMP + SSM_TF); const bf16* VF = (const bf16*)(c.ws + WS_SSMP + SSM_VF); const bf16* WF = (const bf16*)(c.ws + WS_SSMP + SSM_WF);
    LAS float* E = (LAS float*)(c.lds + LDSCTL_OFF + 4096);
    __syncthreads();
    for (int idx = c.tid; idx < 4096; idx += NWAVES * 64) { *(LAS u32x4*)(c.lds + idx * 16) = *(const u32x4*)(VF + (size_t)g * 32768 + idx * 8); *(LAS u32x4*)(c.lds + 65536 + idx * 16) = *(const u32x4*)(WF + (size_t)g * 32768 + idx * 8); }
    {
        __syncthreads();
#pragma unroll 1
        for (int h2 = 0; h2 < 2; ++h2) {
            bf16x8 uf[2][8];
#pragma unroll
            for (int i = 0; i < 2; ++i)
#pragma unroll
                for (int ks = 0; ks < 8; ++ks) uf[i][ks] = *(const bf16x8*)(Ub + (size_t)(16 * (w + 8 * (2 * h2 + i)) + fr) * 256 + 32 * ks + 8 * fq);
#pragma unroll
            for (int i = 0; i < 2; ++i) {
#pragma unroll 2
                for (int pb = 0; pb < 8; ++pb) { f32x4 acc = {0.f, 0.f, 0.f, 0.f};
#pragma unroll
                    for (int ks = 0; ks < 8; ++ks) acc = __builtin_amdgcn_mfma_f32_16x16x32_bf16(*(const LAS bf16x8*)(c.lds + 65536 + ((pb * 8 + ks) * 64 + c.lane) * 16), uf[i][ks], acc, 0, 0, 0);
                    *(f32x4*)(Sb + (size_t)(16 * (w + 8 * (2 * h2 + i)) + fr) * 128 + 16 * pb + 4 * fq) = acc; }
            }
        }
    }
    VM_WAIT(); __syncthreads();
    {
        const float* A16 = (const float*)(c.ws + WS_SSMP + SSM_A16); const float ar = A16[(g * 64 + p) * 2], ai = A16[(g * 64 + p) * 2 + 1];
        const float* sp = Sb + (size_t)(64 * w) * 128;
        float xr = 0.f, xi = 0.f;
#pragma unroll 1
        for (int h2 = 0; h2 < 2; ++h2) { float lr[32], li[32];
#pragma unroll
            for (int j = 0; j < 32; ++j) { lr[j] = ld_sc1_f32(sp + (32 * h2 + j) * 128 + p); li[j] = ld_sc1_f32(sp + (32 * h2 + j) * 128 + 64 + p); }
#pragma unroll
            for (int j = 0; j < 32; ++j) { const float tr = ar * xr - ai * xi + lr[j], ti = ar * xi + ai * xr + li[j]; xr = tr; xi = ti; } }
        E[(w * 64 + p) * 2] = xr; E[(w * 64 + p) * 2 + 1] = xi;
        float a64r = ar, a64i = ai;
#pragma unroll
        for (int k = 0; k < 6; ++k) { const float tr = a64r * a64r - a64i * a64i, ti = 2.0f * a64r * a64i; a64r = tr; a64i = ti; }
        __syncthreads();
        xr = 0.f; xi = 0.f;
        for (int s2 = 0; s2 < w; ++s2) { const float er = E[(s2 * 64 + p) * 2], ei = E[(s2 * 64 + p) * 2 + 1]; const float tr = a64r * xr - a64i * xi + er, ti = a64r * xi + a64i * xr + ei; xr = tr; xi = ti; }
        bf16* xq = Xb + (size_t)(64 * w + 1) * 128 + p;
#pragma unroll 1
        for (int h2 = 0; h2 < 2; ++h2) { float lr[32], li[32];
#pragma unroll
            for (int j = 0; j < 32; ++j) { lr[j] = ld_sc1_f32(sp + (32 * h2 + j) * 128 + p); li[j] = ld_sc1_f32(sp + (32 * h2 + j) * 128 + 64 + p); }
#pragma unroll
            for (int j = 0; j < 32; ++j) { const float tr = ar * xr - ai * xi + lr[j], ti = ar * xi + ai * xr + li[j]; xr = tr; xi = ti;
                xq[0] = (bf16)f2bf(xr); xq[64] = (bf16)f2bf(xi); xq += 128; asm volatile("" : "+v"(xq)); } }
    }
    VM_WAIT(); __syncthreads();
    {
        bf16x8 tf[16];
#pragma unroll
        for (int dl = 0; dl < 16; ++dl) tf[dl] = *(const bf16x8*)(TF + ((size_t)(g * 16 + dl) * 64 + c.lane) * 8);
        bf16x8 uf[8], xf[4], un[8], xn[4];
        { const int cl = 16 * w + fr;
#pragma unroll
            for (int ks = 0; ks < 8; ++ks) uf[ks] = *(const bf16x8*)(Ub + (size_t)cl * 256 + 32 * ks + 8 * fq);
#pragma unroll
            for (int kx = 0; kx < 4; ++kx) xf[kx] = *(const bf16x8*)(Xb + (size_t)cl * 128 + 32 * kx + 8 * fq); }
#pragma unroll 1
        for (int cb = w; cb < 33; cb += 8) {
            const int ci_ = 16 * cb + fr;
            if (cb + 8 < 33) { const int cn = 16 * (cb + 8) + fr, cl = cn < NCH ? cn : NCH - 1;
#pragma unroll
                for (int ks = 0; ks < 8; ++ks) un[ks] = *(const bf16x8*)(Ub + (size_t)cl * 256 + 32 * ks + 8 * fq);
#pragma unroll
                for (int kx = 0; kx < 4; ++kx) xn[kx] = *(const bf16x8*)(Xb + (size_t)cl * 128 + 32 * kx + 8 * fq); }
            const bool ok = ci_ >= 1 && ci_ < NCH;
            bf16* zp = Z + (size_t)(b * SEQ + 16 * (ci_ - 1)) * 1024 + g * 16 + 4 * fq;
#pragma unroll
            for (int t = 0; t < 16; ++t) { f32x4 acc = {0.f, 0.f, 0.f, 0.f};
#pragma unroll
                for (int ks = 0; ks <= t / 2; ++ks) acc = __builtin_amdgcn_mfma_f32_16x16x32_bf16(tf[t - 2 * ks], uf[ks], acc, 0, 0, 0);
#pragma unroll
                for (int kx = 0; kx < 4; ++kx) { const bf16x8 vf = *(const LAS bf16x8*)(c.lds + ((t * 4 + kx) * 64 + c.lane) * 16); acc = __builtin_amdgcn_mfma_f32_16x16x32_bf16(vf, xf[kx], acc, 0, 0, 0); }
                if (ok) { u32x2 wv; wv.x = pk2(gelu_tanh(acc[0]), gelu_tanh(acc[1])); wv.y = pk2(gelu_tanh(acc[2]), gelu_tanh(acc[3])); *(u32x2*)(zp + (size_t)t * 1024) = wv; }
                asm volatile("" ::: "memory"); }
#pragma unroll
            for (int ks = 0; ks < 8; ++ks) uf[ks] = un[ks];
#pragma unroll
            for (int kx = 0; kx < 4; ++kx) xf[kx] = xn[kx];
        }
    }
}

template <bool FIRST>
__device__ __forceinline__ void attn_qblocks(LAS unsigned char* Ks, LAS unsigned char* Vs, const bf16* qp, bf16x8 (&qc)[2], bf16* ao, int t0, float sink, int fr, int fq) {
    constexpr int KST = 144, VST = 432;
#pragma unroll 2
    for (int qa = 0; qa < 4; ++qa) {
        bf16x8 qf[2]; qf[0] = qc[0]; qf[1] = qc[1];
        if (qa < 3) { qc[0] = *(const bf16x8*)(qp + (size_t)(16 * (qa + 1)) * 1024); qc[1] = *(const bf16x8*)(qp + (size_t)(16 * (qa + 1)) * 1024 + 32); }
        f32x4 s[10];
#pragma unroll
        for (int jb = 0; jb < 10; ++jb) { const int j = jb < 9 ? qa + jb : 12; f32x4 acc = {0.f, 0.f, 0.f, 0.f};
#pragma unroll
            for (int ks = 0; ks < 2; ++ks) { const bf16x8 kf = *(const LAS bf16x8*)(Ks + (16 * j + fr) * KST + (32 * ks + 8 * fq) * 2); acc = __builtin_amdgcn_mfma_f32_16x16x32_bf16(kf, qf[ks], acc, 0, 0, 0); }
            s[jb] = acc; }
#pragma unroll
        for (int i = 0; i < 4; ++i) { if (4 * fq + i - fr < 1) s[0][i] = -1e30f; if (4 * fq + i - fr > 0) s[8][i] = -1e30f; }
        if constexpr (FIRST) {
#pragma unroll
            for (int jb = 0; jb < 9; ++jb)
#pragma unroll
                for (int i = 0; i < 4; ++i) if (t0 - 128 + 16 * (qa + jb) + 4 * fq + i < 0) s[jb][i] = -1e30f; }
        float mx = sink;
#pragma unroll
        for (int jb = 0; jb < 10; ++jb) mx = fmaxf(fmaxf(mx, fmaxf(s[jb][0], s[jb][1])), fmaxf(s[jb][2], s[jb][3]));
        mx = fmaxf(mx, __shfl_xor(mx, 16)); mx = fmaxf(mx, __shfl_xor(mx, 32));
        float l = 0.f;
#pragma unroll
        for (int jb = 0; jb < 10; ++jb)
#pragma unroll
            for (int i = 0; i < 4; ++i) { s[jb][i] = __builtin_amdgcn_exp2f(s[jb][i] - mx); l += s[jb][i]; }
        l += __shfl_xor(l, 16); l += __shfl_xor(l, 32); l += __builtin_amdgcn_exp2f(sink - mx);
        f32x4 o[4];
#pragma unroll
        for (int db = 0; db < 4; ++db) o[db] = (f32x4){0.f, 0.f, 0.f, 0.f};
#pragma unroll
        for (int pr = 0; pr < 5; ++pr) { const int ja = qa + 2 * pr, jbk = pr < 4 ? qa + 2 * pr + 1 : 12;
            u32x4 pw; pw.x = pk2(s[2 * pr][0], s[2 * pr][1]); pw.y = pk2(s[2 * pr][2], s[2 * pr][3]); pw.z = pk2(s[2 * pr + 1][0], s[2 * pr + 1][1]); pw.w = pk2(s[2 * pr + 1][2], s[2 * pr + 1][3]);
            const bf16x8 pf = __builtin_bit_cast(bf16x8, pw);
#pragma unroll
            for (int db = 0; db < 4; ++db) { const u32x2 lo = *(const LAS u32x2*)(Vs + (16 * db + fr) * VST + (16 * ja + 4 * fq) * 2), hi = *(const LAS u32x2*)(Vs + (16 * db + fr) * VST + (16 * jbk + 4 * fq) * 2);
                u32x4 vw; vw.x = lo.x; vw.y = lo.y; vw.z = hi.x; vw.w = hi.y; o[db] = __builtin_amdgcn_mfma_f32_16x16x32_bf16(__builtin_bit_cast(bf16x8, vw), pf, o[db], 0, 0, 0); } }
        const float inv = __builtin_amdgcn_rcpf(l);
#pragma unroll
        for (int db = 0; db < 4; ++db) { u32x2 w; w.x = pk2(o[db][0] * inv, o[db][1] * inv); w.y = pk2(o[db][2] * inv, o[db][3] * inv); *(u32x2*)(ao + (size_t)(16 * qa) * 1024 + 16 * db) = w; }
    }
}
__device__ __forceinline__ void attn_fast(const Args& a, const Ctx& c) {
    const bf16* Q = (const bf16*)(c.ws + WS_Q); const bf16* Kb = (const bf16*)(c.ws + WS_K); const bf16* Vt = (const bf16*)(c.ws + WS_VT); bf16* AO = (bf16*)(c.ws + WS_BRA) + (size_t)M * 1024;
    unsigned* qctr = (unsigned*)(c.ws + WS_CTL) + CW_Q;
    LAS unsigned char* Ks = c.lds; LAS unsigned char* Vs = c.lds + 30720; volatile LAS int* uslot = (volatile LAS int*)(c.lds + LDSCTL_OFF + 64);
    constexpr int KST = 144, VST = 432;
    const int fr = c.lane & 15, fq = c.lane >> 4;
    volatile LAS int* ncall = (volatile LAS int*)(c.lds + LDSCTL_OFF + 68);
    __syncthreads(); if (c.tid == 0) *ncall = *ncall + 1; __syncthreads();
    const int qbase = (*ncall - 1) * (512 + c.G);
    int nxt = 0; if (c.tid == 0) nxt = (int)__hip_atomic_fetch_add(qctr, 1u, RLX_AGENT) - qbase;
    for (;;) {
        __syncthreads();
        if (c.tid == 0) *uslot = nxt;
        __syncthreads();
        const int unit = *uslot; if (unit >= 512) break;
        if (c.tid == 0) nxt = (int)__hip_atomic_fetch_add(qctr, 1u, RLX_AGENT) - qbase;
        const int b = unit >> 8, kvh = (unit >> 7) & 1, t0 = 64 * (unit & 127);
        const int head = kvh * 8 + c.wave;
        const bf16* qp = Q + (size_t)(b * SEQ + t0 + fr) * 1024 + head * 64 + 8 * fq;
        bf16x8 qc[2]; qc[0] = *(const bf16x8*)qp; qc[1] = *(const bf16x8*)(qp + 32);
        for (int idx = c.tid; idx < 1664; idx += NWAVES * 64) { const int row = idx >> 3, pc = idx & 7; int pos; bool ok = true;
            if (row < 192) { const int tok = t0 - 128 + row; ok = tok >= 0; pos = NMETA + tok; } else pos = row - 192;
            u32x4 v = {0u, 0u, 0u, 0u}; if (ok) v = *(const u32x4*)(Kb + ((size_t)(b * LTOT + pos)) * 128 + kvh * 64 + pc * 8);
            *(LAS u32x4*)(Ks + row * KST + pc * 16) = v; }
        for (int idx = c.tid; idx < 1664; idx += NWAVES * 64) { const int row = idx >> 3, pc = idx & 7; int pos; bool ok = true;
            if (row < 192) { const int tok = t0 - 128 + row; ok = tok >= 0; pos = NMETA + tok; } else pos = row - 192;
            u32x4 v = {0u, 0u, 0u, 0u}; if (ok) v = *(const u32x4*)(Vt + ((size_t)(b * LTOT + pos)) * 128 + kvh * 64 + pc * 8);
            LAS bf16* vd = (LAS bf16*)(Vs + (8 * pc) * VST + row * 2);
            vd[0 * (VST / 2)] = (bf16)(v.x & 0xffffu); vd[1 * (VST / 2)] = (bf16)(v.x >> 16); vd[2 * (VST / 2)] = (bf16)(v.y & 0xffffu); vd[3 * (VST / 2)] = (bf16)(v.y >> 16);
            vd[4 * (VST / 2)] = (bf16)(v.z & 0xffffu); vd[5 * (VST / 2)] = (bf16)(v.z >> 16); vd[6 * (VST / 2)] = (bf16)(v.w & 0xffffu); vd[7 * (VST / 2)] = (bf16)(v.w >> 16); }
        __syncthreads();
        const float sink = a.in[14][head] * 1.4426950408889634f;
        if (t0 < 128) attn_qblocks<true>(Ks, Vs, qp, qc, AO + (size_t)(b * SEQ + t0 + fr) * 1024 + head * 64 + 4 * fq, t0, sink, fr, fq);
        else attn_qblocks<false>(Ks, Vs, qp, qc, AO + (size_t)(b * SEQ + t0 + fr) * 1024 + head * 64 + 4 * fq, t0, sink, fr, fq);
    }
}

constexpr size_t SSM_WRF = 16 * MiB;
__device__ __forceinline__ void p0_router_frags(const Args& a, const Ctx& c) {
    bf16* WRF = (bf16*)(c.ws + WS_SSMP + SSM_WRF); const float* wr = a.in[19];
    const int gt = c.bid * (NWAVES * 64) + c.tid, ngt = c.G * NWAVES * 64;
    for (int idx = gt; idx < 4096; idx += ngt) { const int ks = idx >> 7, eb = (idx >> 6) & 1, ln = idx & 63, fr = ln & 15, fq = ln >> 4; float hi[8], lo[8];
#pragma unroll
        for (int e = 0; e < 8; ++e) { const float w = wr[(size_t)(32 * ks + 8 * fq + e) * 32 + 16 * eb + fr]; const float h = bf2f((bf16)f2bf(w)); hi[e] = h; lo[e] = w - h; }
        *(u32x4*)(WRF + (size_t)idx * 8) = pack8(hi); *(u32x4*)(WRF + 32768 + (size_t)idx * 8) = pack8(lo); }
}

__device__ __forceinline__ int swap23(int p) { return (p & 3) | ((p & 4) << 1) | ((p & 8) >> 1); }
__device__ __forceinline__ void tr_item(const float* __restrict__ W, int ldw, int k0, int n0src, bool perm, bf16* WT, int ldt, int rowdst0, int kdst, LAS float* scr, int lane) {
    float tv[32];
#pragma unroll
    for (int i = 0; i < 32; ++i) tv[i] = W[(size_t)(k0 + 2 * i + (lane >> 5)) * ldw + n0src + (lane & 31)];
#pragma unroll
    for (int i = 0; i < 32; ++i) scr[(2 * i + (lane >> 5)) * 33 + (lane & 31)] = tv[i];
    LDS_WAIT(); asm volatile("" ::: "memory");
    const int c = lane & 7;
#pragma unroll
    for (int j = 0; j < 4; ++j) { const int n = (lane >> 3) + 8 * j; const int ns = (perm && n < 16) ? swap23(n) : n; const LAS float* s = scr + (8 * c) * 33 + ns;
        u32x4 o; o.x = pk2(s[0 * 33], s[1 * 33]); o.y = pk2(s[2 * 33], s[3 * 33]); o.z = pk2(s[4 * 33], s[5 * 33]); o.w = pk2(s[6 * 33], s[7 * 33]);
        *(u32x4*)(WT + (size_t)(rowdst0 + n) * ldt + kdst + k0 + 8 * c) = o; }
    LDS_WAIT(); asm volatile("" ::: "memory");
}
struct Tr8Item { const float* src; unsigned char* dst; int ldw; };
__device__ __forceinline__ Tr8Item tr8_item_of(const Args& a, unsigned char* Wgu8, unsigned char* Wdn8, int id, int wave, int lane) {
    Tr8Item t;
    if (id < 2048) { const int e = id >> 6, kb = (id >> 3) & 7, jt = id & 7; const int col = lane < 32 ? 128 * jt + 4 * lane : 1024 + 128 * jt + 4 * (lane - 32);
        t.src = a.in[21] + (size_t)e * 1024 * 2048 + (size_t)(128 * kb + 16 * wave) * 2048 + col; t.ldw = 2048; t.dst = Wgu8 + (size_t)e * 2048 * 1024 + (size_t)(256 * jt) * 1024 + 128 * kb; }
    else { const int r = id - 2048, e = r >> 5, kb = (r >> 2) & 7, nb = r & 3;
        t.src = a.in[23] + (size_t)e * 1024 * 1024 + (size_t)(128 * kb + 16 * wave) * 1024 + 256 * nb + 4 * lane; t.ldw = 1024; t.dst = Wdn8 + (size_t)e * 1024 * 1024 + (size_t)(256 * nb) * 1024 + 128 * kb; }
    return t;
}
__device__ __forceinline__ void tr8_load(const Tr8Item& t, f32x4 (&v)[16]) {
#pragma unroll
    for (int j = 0; j < 16; ++j) v[j] = *(const f32x4*)(t.src + (size_t)j * t.ldw);
}
__device__ __forceinline__ void tr8_finish(const Tr8Item& t, const f32x4 (&v)[16], LAS unsigned char* tile, int tid, int wave, int lane) {
    __syncthreads();
#pragma unroll
    for (int cc = 0; cc < 4; ++cc) { u32x4 o;
        o.x = pk4_fp8(v[0][cc] * 16.0f, v[1][cc] * 16.0f, v[2][cc] * 16.0f, v[3][cc] * 16.0f);    o.y = pk4_fp8(v[4][cc] * 16.0f, v[5][cc] * 16.0f, v[6][cc] * 16.0f, v[7][cc] * 16.0f);
        o.z = pk4_fp8(v[8][cc] * 16.0f, v[9][cc] * 16.0f, v[10][cc] * 16.0f, v[11][cc] * 16.0f); o.w = pk4_fp8(v[12][cc] * 16.0f, v[13][cc] * 16.0f, v[14][cc] * 16.0f, v[15][cc] * 16.0f);
        *(LAS u32x4*)(tile + (4 * lane + cc) * 144 + 16 * wave) = o; }
    __syncthreads();
#pragma unroll
    for (int i = 0; i < 4; ++i) { const int p = tid + 512 * i, n = p >> 3, q = p & 7;
        *(u32x4*)(t.dst + (size_t)n * 1024 + 16 * q) = *(const LAS u32x4*)(tile + n * 144 + 16 * q); }
}
__device__ __forceinline__ void tr8_run(const Args& a, const Ctx& c, int first, int stride, int lo, int hi) {
    unsigned char* Wgu8 = c.ws + WS_WGU; unsigned char* Wdn8 = c.ws + WS_WDN;
    f32x4 va[16], vb[16];
    int id = lo + first;
    Tr8Item ta = tr8_item_of(a, Wgu8, Wdn8, id < hi ? id : lo, c.wave, c.lane), tb = ta;
    if (id < hi) tr8_load(ta, va);
    while (id < hi) {
        const int id1 = id + stride;
        if (id1 < hi) { tb = tr8_item_of(a, Wgu8, Wdn8, id1, c.wave, c.lane); tr8_load(tb, vb); }
        tr8_finish(ta, va, c.lds, c.tid, c.wave, c.lane);
        if (id1 >= hi) break;
        const int id2 = id1 + stride;
        if (id2 < hi) { ta = tr8_item_of(a, Wgu8, Wdn8, id2, c.wave, c.lane); tr8_load(ta, va); }
        tr8_finish(tb, vb, c.lds, c.tid, c.wave, c.lane);
        id = id2;
    }
    __syncthreads();
}
__device__ __forceinline__ void rms_row_to_bf16(const float* xrow, const float* gain, bf16* orow, int lane) {
    f32x4 v[4]; float s = 0.f;
#pragma unroll
    for (int j = 0; j < 4; ++j) { v[j] = *(const f32x4*)(xrow + 4 * lane + 256 * j); s += (v[j].x * v[j].x + v[j].y * v[j].y) + (v[j].z * v[j].z + v[j].w * v[j].w); }
    const float rstd = 1.0f / sqrtf(wave_sum(s) * (1.0f / D) + RMS_EPS);
#pragma unroll
    for (int j = 0; j < 4; ++j) { const f32x4 g = *(const f32x4*)(gain + 4 * lane + 256 * j); u32x2 w; w.x = pk2(v[j].x * rstd * g.x, v[j].y * rstd * g.y); w.y = pk2(v[j].z * rstd * g.z, v[j].w * rstd * g.w);
        *(u32x2*)(orow + 4 * lane + 256 * j) = w; }
}
#ifndef P0REP
#define P0REP 0
#endif
#ifdef FAST_MIX
constexpr bool FAST_MIX_P0 = FAST_MIX != 0;
#else
constexpr bool FAST_MIX_P0 = false;
#endif
__device__ __forceinline__ void p0_prologue(const Args& a, const Ctx& c) {
    for (int rp = 0; rp < 1 + (P0REP & 1); ++rp)
    for (int g = c.bid; g < 64; g += c.G) p0_ssm_prep(a, c, g);
    LAS float* scr = (LAS float*)(c.lds + c.wave * 16384);
    bf16* WinT = (bf16*)(c.ws + WS_WIN); bf16* WgluT = (bf16*)(c.ws + WS_WGLU); bf16* WbrT = (bf16*)(c.ws + WS_WBR); bf16* WoutT = (bf16*)(c.ws + WS_WOUT);
    constexpr int NI_IN = 16 * 136, NI_SQ = 512, NI_ALL = NI_IN + 4 * NI_SQ;
    for (int rp = 0; rp < 1 + ((P0REP >> 1) & 1); ++rp)
    for (int it = c.gw; it < NI_ALL; it += c.ngw) {
        int r = it;
        if (r < NI_IN) { const int kb = r / 136, nb = r % 136, n0 = 32 * nb; const bool perm = (n0 >= 1024 && n0 < 2176 && (n0 & 63) == 0);
            tr_item(a.in[3], INW, 64 * kb, n0, perm, WinT, 1024, n0, 0, scr, c.lane); continue; } r -= NI_IN;
        if (r < NI_SQ) { tr_item(a.in[12], 1024, 64 * (r >> 5), 32 * (r & 31), false, WgluT, 1024, 32 * (r & 31), 0, scr, c.lane); continue; } r -= NI_SQ;
        if (r < NI_SQ) { tr_item(a.in[15], 1024, 64 * (r >> 5), 32 * (r & 31), false, WbrT, 1024, 32 * (r & 31), 0, scr, c.lane); continue; } r -= NI_SQ;
        if (r < NI_SQ) { tr_item(a.in[16], 1024, 64 * (r >> 5), 32 * (r & 31), false, WbrT, 1024, 1024 + 32 * (r & 31), 0, scr, c.lane); continue; } r -= NI_SQ;
        tr_item(a.in[17], 1024, 64 * (r >> 5), 32 * (r & 31), false, WoutT, 1024, 32 * (r & 31), 0, scr, c.lane);
    }
    for (int rp = 0; rp < 1 + ((P0REP >> 2) & 1); ++rp) tr8_run(a, c, c.bid, c.G, 0, 3072 - NCV_ITEMS);
    bf16* XN = (bf16*)(c.ws + WS_XN);
    for (int rp = 0; rp < 1 + ((P0REP >> 3) & 1); ++rp)
    for (int m0 = 2 * c.gw; m0 < MP; m0 += 2 * c.ngw) {
        f32x4 v[2][4]; float ss[2];
#pragma unroll
        for (int r = 0; r < 2; ++r) { const int m = m0 + r; const float* xrow = m < M ? a.in[0] + (size_t)m * D : a.in[1] + (size_t)((m < M + NMETA ? m : M) - M) * D;
#pragma unroll
            for (int j = 0; j < 4; ++j) v[r][j] = *(const f32x4*)(xrow + 4 * c.lane + 256 * j); }
#pragma unroll
        for (int r = 0; r < 2; ++r) { float s = 0.f;
#pragma unroll
            for (int j = 0; j < 4; ++j) s += (v[r][j].x * v[r][j].x + v[r][j].y * v[r][j].y) + (v[r][j].z * v[r][j].z + v[r][j].w * v[r][j].w);
            ss[r] = wave_sum(s); }
#pragma unroll
        for (int r = 0; r < 2; ++r) { const int m = m0 + r; const float rstd = (m < M + NMETA) ? 1.0f / sqrtf(ss[r] * (1.0f / D) + RMS_EPS) : 0.f;
#pragma unroll
            for (int j = 0; j < 4; ++j) { const f32x4 g = *(const f32x4*)(a.in[2] + 4 * c.lane + 256 * j); u32x2 w; w.x = pk2(v[r][j].x * rstd * g.x, v[r][j].y * rstd * g.y); w.y = pk2(v[r][j].z * rstd * g.z, v[r][j].w * rstd * g.w);
                *(u32x2*)(XN + (size_t)m * D + 4 * c.lane + 256 * j) = w; } }
    }
    p0_router_frags(a, c);
    const int gt = c.bid * (NWAVES * 64) + c.tid, ngt = c.G * NWAVES * 64;
    float* rot = (float*)(c.ws + WS_ROT);
    for (int i = gt; i < LTOT * 8; i += ngt) { const int pos = i >> 3, j = i & 7;
        const float invs[8] = {1.0f, 0.1939227432012558f, 0.03760603070259094f, 0.007292664609849453f, 0.0014142135623842478f, 0.00027424818836152554f, 5.318296098266728e-05f, 1.0313386155758053e-05f};
        float inv = invs[0];
#pragma unroll
        for (int q = 1; q < 8; ++q) inv = (j == q) ? invs[q] : inv;
        const float ang = (float)pos * inv; const double rev = (double)ang * 0.15915494309189535; const float fr_ = (float)(rev - floor(rev));
        rot[pos * 16 + j] = __builtin_amdgcn_cosf(fr_); rot[pos * 16 + 8 + j] = __builtin_amdgcn_sinf(fr_); }
    if constexpr (!FAST_MIX_P0) {
    float* Ab = (float*)(c.ws + WS_SSMP); float* BB = Ab + 16384;
    for (int i = gt; i < 4096; i += ngt) { const int g = i >> 6;
        const float lr = a.in[4][i], li = a.in[5][i], dt = expf(a.in[6][g]), mag = expf(dt * lr), ar = mag * cosf(dt * li), ai = mag * sinf(dt * li);
        const float den = lr * lr + li * li, nr = ar - 1.0f, ni = ai, fr = (nr * lr + ni * li) / den, fi = (ni * lr - nr * li) / den;
        Ab[2 * i] = ar; Ab[2 * i + 1] = ai;
        for (int h = 0; h < 16; ++h) { const float br = a.in[7][i * 16 + h], bi = a.in[8][i * 16 + h]; BB[(i * 16 + h) * 2] = fr * br - fi * bi; BB[(i * 16 + h) * 2 + 1] = fr * bi + fi * br; }
    }
    }
}

__device__ __forceinline__ void p2_ssm_naive(const Args& a, const Ctx& c) {
    const float* Ab = (const float*)(c.ws + WS_SSMP); const float* BB = Ab + 16384;
    const bf16* U = (const bf16*)(c.ws + WS_U); bf16* Z = (bf16*)(c.ws + WS_Z);
    for (int it = c.gw; it < 128; it += c.ngw) {
        const int g = it >> 1, b = it & 1, p = c.lane, gp = g * 64 + p;
        const float ar = Ab[2 * gp], ai = Ab[2 * gp + 1];
        float bbr[16], bbi[16], cr[16], ci[16], dd[16];
#pragma unroll
        for (int h = 0; h < 16; ++h) { bbr[h] = BB[(gp * 16 + h) * 2]; bbi[h] = BB[(gp * 16 + h) * 2 + 1]; cr[h] = a.in[9][(g * 16 + h) * 64 + p]; ci[h] = a.in[10][(g * 16 + h) * 64 + p]; dd[h] = a.in[11][g * 16 + h]; }
        float xr = 0.f, xi = 0.f;
        const bf16* up = U + (size_t)((g * 2 + b) * NCH) * 256;
        for (int t = 0; t < LTOT; ++t) {
            float u[16]; { float t0[8], t1[8]; unpack8(*(const u32x4*)(up + t * 16), t0); unpack8(*(const u32x4*)(up + t * 16 + 8), t1);
#pragma unroll
                for (int h = 0; h < 8; ++h) { u[h] = t0[h]; u[8 + h] = t1[h]; } }
            float br_ = 0.f, bi_ = 0.f;
#pragma unroll
            for (int h = 0; h < 16; ++h) { br_ += bbr[h] * u[h]; bi_ += bbi[h] * u[h]; }
            const float nxr = ar * xr - ai * xi + br_, nxi = ar * xi + ai * xr + bi_; xr = nxr; xi = nxi;
            if (t >= NMETA) {
                float mine = 0.f;
#pragma unroll
                for (int h = 0; h < 16; ++h) { float v = wave_sum(cr[h] * xr - ci[h] * xi); if (c.lane == h) mine = v + dd[h] * u[h]; }
                if (c.lane < 16) Z[(size_t)(b * SEQ + t - NMETA) * 1024 + g * 16 + c.lane] = (bf16)f2bf(gelu_tanh(mine));
            }
        }
    }
}
__device__ __forceinline__ float dot8(u32x4 q, u32x4 k) {
    return (bflo(q.x) * bflo(k.x) + bfhi(q.x) * bfhi(k.x)) + (bflo(q.y) * bflo(k.y) + bfhi(q.y) * bfhi(k.y)) + (bflo(q.z) * bflo(k.z) + bfhi(q.z) * bfhi(k.z)) + (bflo(q.w) * bflo(k.w) + bfhi(q.w) * bfhi(k.w));
}
__device__ __forceinline__ void p2_attn_naive(const Args& a, const Ctx& c) {
    const bf16* Q = (const bf16*)(c.ws + WS_Q); const bf16* Kb = (const bf16*)(c.ws + WS_K); const bf16* Vt = (const bf16*)(c.ws + WS_VT); bf16* BRA = (bf16*)(c.ws + WS_BRA);
    const int lane = c.lane;
    for (int it = c.gw; it < M * 16; it += c.ngw) {
        const int r = it >> 4, h = it & 15, kvh = h >> 3, b = r >> 13, t = r & (SEQ - 1);
        u32x4 qv[8];
#pragma unroll
        for (int i = 0; i < 8; ++i) qv[i] = *(const u32x4*)(Q + (size_t)r * 1024 + h * 64 + 8 * i);
        float s[3];
#pragma unroll
        for (int sl = 0; sl < 3; ++sl) {
            int pos; bool ok;
            if (sl < 2) { const int tok = t - 127 + lane + 64 * sl; ok = tok >= 0; pos = NMETA + (ok ? tok : 0); } else { ok = lane < NMETA; pos = ok ? lane : 0; }
            const bf16* kp = Kb + ((size_t)(b * LTOT + pos)) * 128 + kvh * 64; float acc = 0.f;
#pragma unroll
            for (int i = 0; i < 8; ++i) acc += dot8(qv[i], *(const u32x4*)(kp + 8 * i));
            s[sl] = ok ? acc : -1e30f;
        }
        const float sink = a.in[14][h] * 1.4426950408889634f;
        const float mx = wave_max(fmaxf(fmaxf(s[0], s[1]), fmaxf(s[2], sink)));
        const float p0 = exp2f(s[0] - mx), p1 = exp2f(s[1] - mx), p2 = exp2f(s[2] - mx);
        const float l = wave_sum(p0 + p1 + p2) + exp2f(sink - mx);
        const bf16* vrow = Vt + (size_t)(b * LTOT) * 128 + kvh * 64 + lane;
        float o = 0.f;
        for (int j = 0; j < 128; ++j) { const int tok = t - 127 + j; const float pj = __shfl(j < 64 ? p0 : p1, j & 63); if (tok >= 0) o += pj * bf2f(vrow[(size_t)(NMETA + tok) * 128]); }
        for (int j = 0; j < NMETA; ++j) { const float pj = __shfl(p2, j); o += pj * bf2f(vrow[(size_t)j * 128]); }
        BRA[(size_t)(M + r) * 1024 + h * 64 + lane] = (bf16)f2bf(o / l);
    }
}

__device__ __forceinline__ void p6_router(const Args& a, const Ctx& c) {
    const float* H1 = (const float*)(c.ws + WS_H1); unsigned char* XG = c.ws + WS_HN2;
    int* TE = (int*)(c.ws + WS_TOK); int* TP = TE + M * 4; float* RS = (float*)(c.ws + WS_TOK) + M * 16 + NSLOT * 2;
    int* TOKOF = (int*)(c.ws + WS_TOKOF); float* GATEOF = (float*)(c.ws + WS_GATEOF); float* RSOF = (float*)(c.ws + WS_RSOF);
    unsigned* cnt = (unsigned*)(c.ws + WS_CTL) + CW_CNT;
    const float* brt = a.in[20];
    LAS float* gl = (LAS float*)(c.lds + LDSCTL_OFF + 8192);
    LAS unsigned* hist = (LAS unsigned*)(c.lds + LDSCTL_OFF + 12288); LAS unsigned* ebase = hist + 32;
    const int lane = c.lane, fr = lane & 15, fq = lane >> 4;
    __syncthreads();
    for (int idx = c.tid; idx < 8192; idx += NWAVES * 64) *(LAS u32x4*)(c.lds + idx * 16) = *(const u32x4*)(c.ws + WS_SSMP + SSM_WRF + (size_t)idx * 16);
    for (int idx = c.tid; idx < 1024; idx += NWAVES * 64) gl[idx] = a.in[18][idx];
    for (int t0 = 0; t0 < M / 16; t0 += 4 * c.G) {
        if (c.tid < 32) hist[c.tid] = 0u;
        __syncthreads();
        const int kh = c.wave >> 2;
        const int tile = t0 + (c.wave & 3) * c.G + c.bid; const bool work = tile < M / 16;
        LAS float* part = (LAS float*)(c.lds + LDSCTL_OFF + 16384) + ((c.wave & 3) * 64 + lane) * 9;
        int te[4]; unsigned rk[4]; float gts[4] = {0.f, 0.f, 0.f, 0.f}, rstd_keep = 0.f; const int row = 16 * tile + fr;
        f32x4 racc0 = {0.f, 0.f, 0.f, 0.f}, racc1 = {0.f, 0.f, 0.f, 0.f}; float rss = 0.f;
        if (work) {
            const float* xr = H1 + (size_t)row * D + 8 * fq;
            f32x4 acc0 = {0.f, 0.f, 0.f, 0.f}, acc1 = {0.f, 0.f, 0.f, 0.f}; float ss = 0.f;
#pragma unroll 4
            for (int ks = 16 * kh; ks < 16 * kh + 16; ++ks) {
                const f32x4 x0 = *(const f32x4*)(xr + 32 * ks), x1 = *(const f32x4*)(xr + 32 * ks + 4);
                const f32x4 g0 = *(const LAS f32x4*)(gl + 32 * ks + 8 * fq), g1 = *(const LAS f32x4*)(gl + 32 * ks + 8 * fq + 4);
                ss += (x0.x * x0.x + x0.y * x0.y) + (x0.z * x0.z + x0.w * x0.w) + (x1.x * x1.x + x1.y * x1.y) + (x1.z * x1.z + x1.w * x1.w);
                const f32x4 v0 = x0 * g0, v1 = x1 * g1;
                u32x4 hw; hw.x = pk2(v0.x, v0.y); hw.y = pk2(v0.z, v0.w); hw.z = pk2(v1.x, v1.y); hw.w = pk2(v1.z, v1.w);
                { u32x2 w8; w8.x = pk4_fp8(v0.x, v0.y, v0.z, v0.w); w8.y = pk4_fp8(v1.x, v1.y, v1.z, v1.w); *(u32x2*)(XG + (size_t)row * D + 32 * ks + 8 * fq) = w8; }
                u32x4 lw; lw.x = pk2(v0.x - bflo(hw.x), v0.y - bfhi(hw.x)); lw.y = pk2(v0.z - bflo(hw.y), v0.w - bfhi(hw.y)); lw.z = pk2(v1.x - bflo(hw.z), v1.y - bfhi(hw.z)); lw.w = pk2(v1.z - bflo(hw.w), v1.w - bfhi(hw.w));
                const bf16x8 hi = __builtin_bit_cast(bf16x8, hw), lo = __builtin_bit_cast(bf16x8, lw);
                const bf16x8 wh0 = *(const LAS bf16x8*)(c.lds + ((ks * 2 + 0) * 64 + lane) * 16), wh1 = *(const LAS bf16x8*)(c.lds + ((ks * 2 + 1) * 64 + lane) * 16);
                const bf16x8 wl0 = *(const LAS bf16x8*)(c.lds + 65536 + ((ks * 2 + 0) * 64 + lane) * 16), wl1 = *(const LAS bf16x8*)(c.lds + 65536 + ((ks * 2 + 1) * 64 + lane) * 16);
                acc0 = __builtin_amdgcn_mfma_f32_16x16x32_bf16(wh0, hi, acc0, 0, 0, 0); acc1 = __builtin_amdgcn_mfma_f32_16x16x32_bf16(wh1, hi, acc1, 0, 0, 0);
                acc0 = __builtin_amdgcn_mfma_f32_16x16x32_bf16(wl0, hi, acc0, 0, 0, 0); acc1 = __builtin_amdgcn_mfma_f32_16x16x32_bf16(wl1, hi, acc1, 0, 0, 0);
                acc0 = __builtin_amdgcn_mfma_f32_16x16x32_bf16(wh0, lo, acc0, 0, 0, 0); acc1 = __builtin_amdgcn_mfma_f32_16x16x32_bf16(wh1, lo, acc1, 0, 0, 0);
            }
            racc0 = acc0; racc1 = acc1; rss = ss;
            if (kh == 1) { part[0] = acc0[0]; part[1] = acc0[1]; part[2] = acc0[2]; part[3] = acc0[3]; part[4] = acc1[0]; part[5] = acc1[1]; part[6] = acc1[2]; part[7] = acc1[3]; part[8] = ss; }
        }
        __syncthreads();
        if (work && kh == 0) {
            f32x4 acc0, acc1; float ss;
            acc0 = racc0; acc1 = racc1; ss = rss;
            acc0[0] += part[0]; acc0[1] += part[1]; acc0[2] += part[2]; acc0[3] += part[3]; acc1[0] += part[4]; acc1[1] += part[5]; acc1[2] += part[6]; acc1[3] += part[7]; ss += part[8];
            ss += __shfl_xor(ss, 16); ss += __shfl_xor(ss, 32);
            const float rstd = 1.0f / sqrtf(ss * (1.0f / D) + RMS_EPS);
            float lg[32];
#pragma unroll
            for (int q = 0; q < 4; ++q)
#pragma unroll
                for (int r = 0; r < 4; ++r) { lg[4 * q + r] = __shfl(acc0[r], fr + 16 * q) * rstd + brt[4 * q + r]; lg[16 + 4 * q + r] = __shfl(acc1[r], fr + 16 * q) * rstd + brt[16 + 4 * q + r]; }
            float tv[4];
#pragma unroll
            for (int k = 0; k < 4; ++k) { float best = -3.0e38f; int bi = 0;
#pragma unroll
                for (int e = 0; e < 32; ++e) if (lg[e] > best) { best = lg[e]; bi = e; }
                te[k] = bi; tv[k] = best;
#pragma unroll
                for (int e = 0; e < 32; ++e) if (e == bi) lg[e] = -3.0e38f; }
            if (fq == 0) {
                const float e1 = __expf(tv[1] - tv[0]), e2 = __expf(tv[2] - tv[0]), e3 = __expf(tv[3] - tv[0]), inv = 1.0f / (1.0f + e1 + e2 + e3);
                gts[0] = inv; gts[1] = e1 * inv; gts[2] = e2 * inv; gts[3] = e3 * inv;
                *(u32x4*)(TE + row * 4) = (u32x4){(unsigned)te[0], (unsigned)te[1], (unsigned)te[2], (unsigned)te[3]};
                rstd_keep = rstd;
#pragma unroll
                for (int k = 0; k < 4; ++k) rk[k] = __hip_atomic_fetch_add(hist + te[k], 1u, __ATOMIC_RELAXED, __HIP_MEMORY_SCOPE_WORKGROUP);
            }
        }
        __syncthreads();
        if (c.tid < 32) ebase[c.tid] = __hip_atomic_fetch_add(cnt + c.tid, hist[c.tid], RLX_AGENT);
        __syncthreads();
        if (work && kh == 0 && fq == 0) { const u32x4 pp = {ebase[te[0]] + rk[0], ebase[te[1]] + rk[1], ebase[te[2]] + rk[2], ebase[te[3]] + rk[3]}; *(u32x4*)(TP + row * 4) = pp;
#pragma unroll
            for (int k = 0; k < 4; ++k) { TOKOF[te[k] * M + (int)pp[k]] = row; GATEOF[te[k] * M + (int)pp[k]] = gts[k]; RSOF[te[k] * M + (int)pp[k]] = rstd_keep; } }
        __syncthreads();
    }
}
__device__ __forceinline__ int moe_tables(const Ctx& c, LAS int* tb, LAS int* tile_e, LAS int* cntl) {
    __syncthreads();
    if (c.wave == 0) {
        const gu32* cnt = (const gu32*)(c.ws + WS_CTL) + CW_CNT; const int lane = c.lane;
        const int cn = lane < NE ? (int)__hip_atomic_load(cnt + (lane & 31), RLX_AGENT) : 0; if (lane < NE) cntl[lane] = cn;
        const int n = (cn + 255) >> 8;
        int incl = n;
#pragma unroll
        for (int o = 1; o < 32; o <<= 1) { const int t = __shfl_up(incl, o); if (lane >= o) incl += t; }
        int excl = incl - n; if (excl > MAXT) excl = MAXT;
        if (lane < NE) tb[lane] = excl;
        if (lane == NE - 1) tb[NE] = incl > MAXT ? MAXT : incl;
        if (lane < NE) for (int i = 0; i < n && excl + i < MAXT; ++i) tile_e[excl + i] = lane;
    }
    __syncthreads();
    return __builtin_amdgcn_readfirstlane(tb[NE]);
}
__device__ __forceinline__ void p10_final(const Args& a, const Ctx& c, const LAS int* tb) {
    const float* H1 = (const float*)(c.ws + WS_H1); const unsigned char* YS = c.ws + WS_YS;
    const int* TE = (const int*)(c.ws + WS_TOK); const int* TP = TE + M * 4; const float* gain = a.in[25];
    for (int row = c.gw; row < M; row += c.ngw) {
        f32x4 v[4];
#pragma unroll
        for (int j = 0; j < 4; ++j) v[j] = *(const f32x4*)(H1 + (size_t)row * D + 4 * c.lane + 256 * j);
        const u32x4 te4 = *(const u32x4*)(TE + row * 4), tp4 = *(const u32x4*)(TP + row * 4); u32x4 ts;
#pragma unroll
        for (int k = 0; k < 4; ++k) ts[k] = (unsigned)tb[te4[k]] * 256u + tp4[k];
        unsigned yw[4][4];
#pragma unroll
        for (int k = 0; k < 4; ++k) { const unsigned char* ys = YS + (size_t)ts[k] * D;
#pragma unroll
            for (int j = 0; j < 4; ++j) yw[k][j] = *(const unsigned*)(ys + 4 * c.lane + 256 * j); }
#pragma unroll
        for (int k = 0; k < 4; ++k)
#pragma unroll
            for (int j = 0; j < 4; ++j) { typedef float f32x2v __attribute__((ext_vector_type(2)));
                const f32x2v lo = __builtin_amdgcn_cvt_pk_f32_fp8(yw[k][j], false), hi = __builtin_amdgcn_cvt_pk_f32_fp8(yw[k][j], true);
                v[j].x += lo.x * 0.0625f; v[j].y += lo.y * 0.0625f; v[j].z += hi.x * 0.0625f; v[j].w += hi.y * 0.0625f; }
        float s = 0.f;
#pragma unroll
        for (int j = 0; j < 4; ++j) s += (v[j].x * v[j].x + v[j].y * v[j].y) + (v[j].z * v[j].z + v[j].w * v[j].w);
        const float rstd = 1.0f / sqrtf(wave_sum(s) * (1.0f / D) + RMS_EPS);
#pragma unroll
        for (int j = 0; j < 4; ++j) { const f32x4 g = *(const f32x4*)(gain + 4 * c.lane + 256 * j); *(f32x4*)(a.out + (size_t)row * D + 4 * c.lane + 256 * j) = v[j] * rstd * g; }
    }
}

#ifndef ONE_LAUNCH
#define ONE_LAUNCH 0
#endif
#ifndef FAST_GEMM
#define FAST_GEMM 0
#endif
#ifndef FAST_MIX
#define FAST_MIX 0
#endif
constexpr int NPH = 10;

template <bool FAST, class E, class S, bool F8 = false, bool GATHER = false>
__device__ __forceinline__ void run_gemm(const Ctx& c, const bf16* A, const bf16* Bt, int K, const S& s, const E& e) {
    if constexpr (FAST) { pg8::Gemm g{A, Bt, 0, 0, K, c.wave}; FastEpi<E> fe{e}; pg8::gemm_phase<FastEpi<E>, S, true, true, F8, GATHER>(c.lds, g, s, fe); }
    else { Unit u; for (int i = 0; s.next(i, u); ++i) naive_gemm_unit(A, K, Bt, K, K, u.pm, u.pn, e, c.wave, c.lane); }
}

__global__ void __launch_bounds__(NWAVES * 64, 2) fwd(Args args) {
    extern __shared__ __attribute__((aligned(16))) unsigned char lds_raw[];
    Ctx c0; c0.lds = (LAS unsigned char*)lds_raw; c0.ws = args.ws; c0.tid = threadIdx.x; c0.lane = c0.tid & 63; c0.wave = __builtin_amdgcn_readfirstlane(c0.tid >> 6);
    c0.G = gridDim.x; c0.bid = blockIdx.x; c0.gw = c0.bid * NWAVES + c0.wave; c0.ngw = c0.G * NWAVES;
    const Ctx& c = c0;
    volatile LAS unsigned* MISC = (volatile LAS unsigned*)(c.lds + LDSCTL_OFF);
    LAS int* tb = (LAS int*)(c.lds + LDSCTL_OFF + 512); LAS int* tile_e = (LAS int*)(c.lds + LDSCTL_OFF + 1024); LAS int* cntl = (LAS int*)(c.lds + LDSCTL_OFF + 256);
    for (int u = c.tid; u < (LDS_BYTES - LDSCTL_OFF) / 4; u += NWAVES * 64) ((LAS unsigned*)(c.lds + LDSCTL_OFF))[u] = 0u;
    __syncthreads();
    volatile LAS unsigned long long* ptab = (volatile LAS unsigned long long*)(c0.lds + LDSCTL_OFF + 2560);
    if (c0.tid < 26) ptab[c0.tid] = (unsigned long long)args.in[c0.tid];
    if (c0.tid == 26) ptab[26] = (unsigned long long)args.out;
    __syncthreads();
    const int lo = args.ph_lo, hi = args.ph_hi;
    XcdBarrier bar; bar.bar = (unsigned*)(c.ws + WS_CTL) + CW_BAR; bar.x = 0; bar.st = nullptr;
    if (hi - lo > 1) bar = xcd_barrier_post((unsigned*)(c.ws + WS_CTL) + CW_BAR, MISC + 8);
#ifndef DISMASK
#define DISMASK 0
#endif
#define IN(k) (lo <= (k) && (k) < hi && !((DISMASK >> (k)) & 1))
#define GRID_BAR() xcd_barrier(bar, c0.wave == 0 && pg8::fresh_lane() == 0)
#define SEAM(k) do { if (IN(k) && IN((k) + 1)) GRID_BAR(); } while (0)
#define WSB (c0.ws)
#define XN ((bf16*)(WSB + WS_XN))
#define U ((bf16*)(WSB + WS_U))
#define Q ((bf16*)(WSB + WS_Q))
#define Kb ((bf16*)(WSB + WS_K))
#define Vt ((bf16*)(WSB + WS_VT))
#define GSp ((bf16*)(WSB + WS_GS))
#define GAp ((bf16*)(WSB + WS_GA))
#define Z ((bf16*)(WSB + WS_Z))
#define BRA ((bf16*)(WSB + WS_BRA))
#define MIX ((bf16*)(WSB + WS_MIX))
#define H1 ((float*)(WSB + WS_H1))
#define HID ((bf16*)(WSB + WS_HID))
#define YS ((bf16*)(WSB + WS_YS))

#ifndef REPMASK
#define REPMASK 0
#endif
    int mixpass = 0, glupass = 0;
#ifndef GLU_NOSTORE
#define GLU_NOSTORE 0
#endif
#define PHASE(k, ...) if (IN(k)) { Ctx c = c0; c.lane = pg8::fresh_lane(); c.tid = c.wave * 64 + c.lane; Args pa; \
        _Pragma("unroll") for (int _k = 0; _k < 26; ++_k) { const unsigned long long _v = ptab[_k]; pa.in[_k] = (const float*)(((unsigned long long)(unsigned)__builtin_amdgcn_readfirstlane((int)(_v >> 32)) << 32) | (unsigned)__builtin_amdgcn_readfirstlane((int)_v)); } \
        { const unsigned long long _v = ptab[26]; pa.out = (float*)(((unsigned long long)(unsigned)__builtin_amdgcn_readfirstlane((int)(_v >> 32)) << 32) | (unsigned)__builtin_amdgcn_readfirstlane((int)_v)); } pa.ws = c0.ws; pa.ph_lo = 0; pa.ph_hi = 0; __VA_ARGS__ if constexpr ((REPMASK >> (k)) & 1) { GRID_BAR(); __VA_ARGS__ } } SEAM(k);
    PHASE(0, p0_prologue(pa, c);)
    PHASE(1, {
        EpiInProj E{U, Q, Kb, Vt, GSp, GAp, (const float*)(WSB + WS_ROT)};
        if constexpr (FAST_GEMM && FAST_MIX) {
            if (c.bid < c.G - NCV) { InProjOrder S{c.G - NCV, c.bid}; run_gemm<true>(c, XN, (const bf16*)(WSB + WS_WIN), 1024, S, E); }
            else tr8_run(pa, c, c.bid - (c.G - NCV), NCV, 3072 - NCV_ITEMS, 3072); }
        else { pg8::StaticOrder S; S.init(MP, INW, c.G, c.bid); run_gemm<FAST_GEMM>(c, XN, (const bf16*)(WSB + WS_WIN), 1024, S, E); } })
    PHASE(2, if constexpr (FAST_MIX) {
#ifndef DEFER_REP
#define DEFER_REP 0
#endif
#ifndef MIXSKIP
#define MIXSKIP 0
#endif
 if (!(MIXSKIP & 1) || mixpass == 0) { for (int it = c.bid; it < 128; it += c.G) ssm_chain(c, it >> 1, it & 1); }
 if constexpr (FAST_GEMM) { if (mixpass == 0 || DEFER_REP) { EpiInProj E{U, Q, Kb, Vt, GSp, GAp, (const float*)(WSB + WS_ROT)};
     const int half = c.G >> 1;
     DeferredOrder S{c.bid >= half ? c.bid - half : -1, half, c.G - NCV};
     run_gemm<true>(c, XN, (const bf16*)(WSB + WS_WIN), 1024, S, E); __syncthreads(); } }
 if (!(MIXSKIP & 2) || mixpass == 0) attn_fast(pa, c);
 ++mixpass;
 } else { p2_ssm_naive(pa, c); p2_attn_naive(pa, c); })
    PHASE(3, {
        pg8::StaticOrder S; S.init(M, 1024, c.G, c.bid);
        EpiGlu E{Z, pa.in[13], BRA};
        run_gemm<FAST_GEMM>(c, Z, (const bf16*)(WSB + WS_WGLU), 1024, S, E); })
    PHASE(4, {
        EpiBr E{GSp, GAp, MIX};
        if constexpr (FAST_GEMM) { PairOrder S; S.so.init(M, 1024, c.G, c.bid); run_gemm<true>(c, BRA, (const bf16*)(WSB + WS_WBR), 1024, S, E); }
        else { pg8::StaticOrder S; S.init(M, 1024, c.G, c.bid); run_gemm<false>(c, BRA, (const bf16*)(WSB + WS_WBR), 1024, S, E); } })
    PHASE(5, {
        pg8::StaticOrder S; S.init(M, 1024, c.G, c.bid);
        EpiOut E{pa.in[0], H1};
        run_gemm<FAST_GEMM>(c, MIX, (const bf16*)(WSB + WS_WOUT), 1024, S, E); })
    PHASE(6, p6_router(pa, c);)
    PHASE(7, {
        const int nt = moe_tables(c, tb, tile_e, cntl);
        const MoeTabs T{tile_e, tb, cntl, (const int*)(WSB + WS_TOKOF), (const float*)(WSB + WS_GATEOF), (const float*)(WSB + WS_RSOF)};
        MoeOrder S{T, nt, 8, c.G, c.bid};
        EpiMoe1 E{pa.in[22], (unsigned char*)HID, T};
        run_gemm<true, EpiMoe1, MoeOrder, true, true>(c, (const bf16*)(WSB + WS_HN2), (const bf16*)(WSB + WS_WGU), 512, S, E); })
    PHASE(8, {
        const int nt = moe_tables(c, tb, tile_e, cntl);
        const MoeTabs T{tile_e, tb, cntl, (const int*)(WSB + WS_TOKOF), (const float*)(WSB + WS_GATEOF), (const float*)(WSB + WS_RSOF)};
        MoeOrder S{T, nt, 4, c.G, c.bid};
        EpiMoe2 E{pa.in[24], (unsigned char*)YS, T};
        run_gemm<true, EpiMoe2, MoeOrder, true>(c, HID, (const bf16*)(WSB + WS_WDN), 512, S, E); })
    PHASE(9, { moe_tables(c, tb, tile_e, cntl); p10_final(pa, c, tb); })
#undef PHASE
#undef WSB
#undef XN
#undef U
#undef Q
#undef Kb
#undef Vt
#undef GSp
#undef GAp
#undef Z
#undef BRA
#undef MIX
#undef H1
#undef HID
#undef YS
#undef IN
#undef SEAM
}

extern "C" void kernel_launch(void* const* d_in, const int* in_sizes, int n_in, void* d_out, int out_size, void* d_ws, size_t ws_size, hipStream_t stream) {
    static int grid = 0;
    if (grid == 0) {
        if (n_in != 26 || in_sizes[0] != M * D || out_size != M * D || ws_size < WS_END) { fprintf(stderr, "kernel_launch: unexpected shapes (n_in %d, in0 %d, out %d, ws %zu)\n", n_in, n_in > 0 ? in_sizes[0] : -1, out_size, ws_size); grid = -1; return; }
        int dev = 0, cus = 0, per_cu = 0;
        if (hipGetDevice(&dev) != hipSuccess || hipDeviceGetAttribute(&cus, hipDeviceAttributeMultiprocessorCount, dev) != hipSuccess) { grid = -1; return; }
        if (hipFuncSetAttribute((const void*)fwd, hipFuncAttributeMaxDynamicSharedMemorySize, LDS_BYTES) != hipSuccess) { fprintf(stderr, "kernel_launch: hipFuncSetAttribute failed\n"); grid = -1; return; }
        if (hipOccupancyMaxActiveBlocksPerMultiprocessor(&per_cu, (const void*)fwd, NWAVES * 64, LDS_BYTES) != hipSuccess || per_cu < 1) fprintf(stderr, "kernel_launch: occupancy query says %d\n", per_cu);
        (void)hipGetLastError();
        grid = cus;
    }
    if (grid < 0) return;
    if (hipMemsetAsync((char*)d_ws + WS_CTL, 0, CTL_ZERO_BYTES, stream) != hipSuccess) return;
    Args a{};
    for (int i = 0; i < 26; ++i) a.in[i] = (const float*)d_in[i];
    a.out = (float*)d_out; a.ws = (unsigned char*)d_ws;
#if ONE_LAUNCH
    a.ph_lo = 0; a.ph_hi = NPH;
    hipLaunchKernelGGL(fwd, dim3(grid), dim3(NWAVES * 64), LDS_BYTES, stream, a);
#else
    for (int p = 0; p < NPH; ++p) { a.ph_lo = p; a.ph_hi = p + 1; hipLaunchKernelGGL(fwd, dim3(grid), dim3(NWAVES * 64), LDS_BYTES, stream, a); }
#endif
}
```

```cpp
#include <hip/hip_runtime.h>
#include <cstdio>
#include <cstdint>
#define ONE_LAUNCH 1
#define FAST_GEMM 1
#define FAST_MIX 1
#define EPI_FENCE 0
#ifndef WARM_A_N
#define WARM_A_N 2
#endif
#ifndef KDUP_NOSKIP
#define KDUP_NOSKIP 0
#endif
namespace pg8 {
#define PG8_LAS __attribute__((address_space(3)))
typedef unsigned short bf16_t;
typedef short bf16x8 __attribute__((ext_vector_type(8)));
typedef float f32x4 __attribute__((ext_vector_type(4)));
typedef unsigned u32x4 __attribute__((ext_vector_type(4)));
constexpr int BM = 256, BK = 64, HALF = 128, HTB = HALF * BK * 2  , STAGE_BYTES = 8 * HTB, NXCD = 8, WGM = 4;

__host__ __device__ __forceinline__ int lds_byte(int r, int c) { const int st = (r >> 4) * 2 + (c >> 5), rr = r & 15, cc = c & 31, ob = rr * 64 + cc * 2; return st * 1024 + (ob ^ (((ob >> 9) & 1) << 5)); }
__host__ __device__ __forceinline__ void stage_rc(int b, int& R, int& C) { const int st = b / 1024, sb = b % 1024, swz = sb ^ (((sb >> 9) & 1) << 5); R = (st >> 1) * 16 + swz / 64; C = (st & 1) * 32 + (swz % 64) / 2; }
__host__ __device__ __forceinline__ int perm32(int rho) { const int n = rho >> 4, i = rho & 15; return 8 * (i >> 2) + 4 * n + (i & 3); }

struct Unit { int pm, pn; };
struct Gemm { const bf16_t* A; const bf16_t* Bt; int M, N, K; int wid; };
__device__ __forceinline__ int fresh_lane() { int l; asm volatile("v_mbcnt_lo_u32_b32 %0, -1, 0\n\tv_mbcnt_hi_u32_b32 %0, -1, %0" : "=v"(l)); return l; }

struct StaticOrder {
    int nM, nN, nwg, G, c;
    __host__ __device__ void init(int M, int N, int G_, int c_) { nM = M / BM; nN = N / BM; nwg = nM * nN; G = G_; c = c_; }
    __host__ __device__ bool next(int i, Unit& u) const {
        const long L = (long)i * G + c; if (L >= nwg) return false;
        int wgid = (int)L; { const int q = nwg / NXCD, r = nwg % NXCD, xcd = wgid % NXCD, off = wgid / NXCD; wgid = (xcd < r ? xcd * (q + 1) : r * (q + 1) + (xcd - r) * q) + off; }
        const int nig = WGM * nN, gid = wgid / nig, fm = gid * WGM, gsz = (nM - fm) < WGM ? (nM - fm) : WGM;
        u.pm = fm + ((wgid % nig) % gsz); u.pn = (wgid % nig) / gsz; return true;
    }
    __device__ __forceinline__ void a_ready(const Unit&) const {}
    __device__ __forceinline__ void done(const Unit&) const {}
};
__device__ __forceinline__ unsigned cvt_pk_bf16(float lo, float hi) { unsigned r; asm volatile("v_cvt_pk_bf16_f32 %0, %1, %2" : "=v"(r) : "v"(lo), "v"(hi)); return r; }
typedef int pg8_v8i __attribute__((ext_vector_type(8))); typedef int pg8_v4i __attribute__((ext_vector_type(4)));
__device__ __forceinline__ pg8_v8i pg8_cat(bf16x8 lo, bf16x8 hi) { return __builtin_shufflevector(__builtin_bit_cast(pg8_v4i, lo), __builtin_bit_cast(pg8_v4i, hi), 0, 1, 2, 3, 4, 5, 6, 7); }
template <class Epi, class Sched, bool ALIGN_EPI = false, bool SP2 = false, bool F8 = false, bool GATHER = false>
__device__ __forceinline__ void gemm_phase(PG8_LAS unsigned char* lds, const Gemm g, const Sched& S, const Epi& E) {
    const int lane = fresh_lane(), wid = g.wid, tid = wid * 64 + lane, wr = wid >> 2, wc = wid & 3, fr = lane & 15, fq = lane >> 4;
    const int K = g.K, nt = K / BK;
    unsigned voffA[2], voffB[2];
#pragma unroll
    for (int i = 0; i < 2; ++i) { int R, C; stage_rc(tid * 16 + i * 8192, R, C); const int Rb = Epi::PERM ? ((R & ~31) + perm32(R & 31)) : R;
        voffA[i] = (unsigned)(R * K + C) * 2u; voffB[i] = (unsigned)(Rb * K + C) * 2u; }
    unsigned vA[2], nvA[2], gC = 0u;
    const unsigned kstep = (unsigned)(BK * 2);
    const unsigned hstep = (unsigned)HALF * K * 2;
    const unsigned tstep = 2 * hstep;
    const __amdgpu_buffer_rsrc_t rsA = __builtin_amdgcn_make_buffer_rsrc((void*)g.A, (short)0, -1, 0x00020000), rsB = __builtin_amdgcn_make_buffer_rsrc((void*)g.Bt, (short)0, -1, 0x00020000);
    const unsigned ldsw = (unsigned)wid * 1024u;
    const int aoff = lds_byte(wr * 64 + fr, fq * 8), boff = lds_byte(wc * 32 + fr, fq * 8);
#define PG8_SA(b, h) (((b) * 2 + (h)) * HTB)
#define PG8_SB(b, h) ((4 + (b) * 2 + (h)) * HTB)
#define PG8_STAGE(bufoff, gbase, voff) do { _Pragma("unroll") for (int _i = 0; _i < 2; ++_i) \
        __builtin_amdgcn_raw_ptr_buffer_load_lds(PG8_RS_##voff, (PG8_LAS unsigned*)(lds + (bufoff) + ldsw + _i * 8192), 16, (int)(voff)[_i], (int)(gbase), 0, 0); } while (0)
#define PG8_RS_voffA rsA
#define PG8_RS_voffB rsB
#define PG8_STAGE_A(bufoff, h, off) do { if constexpr (GATHER) { const unsigned _pk = ((off) >> 31) != 0u ? nvA[h] : vA[h]; _Pragma("unroll") for (int _i = 0; _i < 2; ++_i) \
        __builtin_amdgcn_raw_ptr_buffer_load_lds(rsA, (PG8_LAS unsigned*)(lds + (bufoff) + ldsw + _i * 8192), 16, (int)(((_pk >> (16 * _i)) & 0xffffu) * (unsigned)(K * 2) + gC), (int)((off) & 0x7fffffffu), 0, 0); } \
        else { PG8_STAGE(bufoff, (off) + (h) * hstep, voffA); } } while (0)
#define PG8_LOADROWS(dst, u) do { const int _ln = fresh_lane(); int _R, _C; stage_rc((wid * 64 + _ln) * 16, _R, _C); gC = (unsigned)_C * 2u; \
        _Pragma("unroll") for (int _h = 0; _h < 2; ++_h) dst[_h] = S.row_id(u, _R + 128 * _h) | (S.row_id(u, _R + 64 + 128 * _h) << 16); } while (0)
#define PG8_LDA(dst, b, h) do { _Pragma("unroll") for (int m = 0; m < 4; ++m) _Pragma("unroll") for (int k = 0; k < 2; ++k) dst[m][k] = *(const PG8_LAS bf16x8*)(lds + PG8_SA(b, h) + aoff + m * 2048 + k * 1024); } while (0)
#define PG8_LDB(dst, b, h) do { _Pragma("unroll") for (int n = 0; n < 2; ++n) _Pragma("unroll") for (int k = 0; k < 2; ++k) dst[n][k] = *(const PG8_LAS bf16x8*)(lds + PG8_SB(b, h) + boff + n * 2048 + k * 1024); } while (0)
#define PG8_MMA(ai, bj, At, Bt) do { __builtin_amdgcn_s_setprio(1); if constexpr (F8) { _Pragma("unroll") for (int m = 0; m < 4; ++m) _Pragma("unroll") for (int n = 0; n < 2; ++n) \
        acc[ai][bj][m][n] = __builtin_amdgcn_mfma_scale_f32_16x16x128_f8f6f4(pg8_cat(Bt[n][0], Bt[n][1]), pg8_cat(At[m][0], At[m][1]), acc[ai][bj][m][n], 0, 0, 0, 0, 0, 0); } else { \
        _Pragma("unroll") for (int m = 0; m < 4; ++m) _Pragma("unroll") for (int n = 0; n < 2; ++n) _Pragma("unroll") for (int k = 0; k < 2; ++k) \
        acc[ai][bj][m][n] = __builtin_amdgcn_mfma_f32_16x16x32_bf16(Bt[n][k], At[m][k], acc[ai][bj][m][n], 0, 0, 0); } __builtin_amdgcn_s_setprio(0); } while (0)
#define PG8_WAIT_V(n) asm volatile("s_waitcnt vmcnt(" #n ")" ::: "memory")
#define PG8_WAIT_L(n) asm volatile("s_waitcnt lgkmcnt(" #n ")" ::: "memory")
#define PG8_BAR __builtin_amdgcn_s_barrier()
#define PG8_SCHED __builtin_amdgcn_sched_barrier(0)
    Unit cur, nxt; int ui = 0;
    if (!S.next(0, cur)) return;
    f32x4 acc[2][2][4][2];
#pragma unroll
    for (int a = 0; a < 2; ++a)
#pragma unroll
        for (int b = 0; b < 2; ++b)
#pragma unroll
            for (int m = 0; m < 4; ++m)
#pragma unroll
                for (int n = 0; n < 2; ++n) acc[a][b][m][n] = (f32x4){0.f, 0.f, 0.f, 0.f};
    bf16x8 At[4][2], B0[2][2], B1[2][2];
    unsigned cA = GATHER ? 0u : (unsigned)cur.pm * tstep, cB = (unsigned)cur.pn * tstep;
    if constexpr (GATHER) { PG8_LOADROWS(vA, cur); PG8_LOADROWS(nvA, cur); }
    S.a_ready(cur);
    if constexpr (Epi::WARM_A > 0) {
        const int _ln = fresh_lane(); const unsigned q = (unsigned)cur.pn & 3u;
#pragma unroll
        for (int _i = 0; _i < (WARM_A_N); ++_i) { const unsigned line = q * (4096u / 4u) + (unsigned)(_i * 512 + wid * 64 + _ln);
            if (_i * 512 < 1024) __builtin_amdgcn_raw_ptr_buffer_load_lds(rsA, (PG8_LAS unsigned*)(lds + 131072 + 8192 + wid * 256), 4, (int)(line * ((unsigned)K * 2u * 256u / 4096u)), (int)cA, 0, 0); }
    }
    if constexpr (SP2) {
        PG8_STAGE(PG8_SB(0, 0), cB, voffB); PG8_STAGE(PG8_SB(0, 1), cB + hstep, voffB); PG8_STAGE_A(PG8_SA(0, 0), 0, cA); PG8_STAGE_A(PG8_SA(0, 1), 1, cA);
        if (wr == 1) PG8_BAR;
        PG8_WAIT_V(2); PG8_BAR;
        PG8_STAGE(PG8_SB(1, 0), cB + kstep, voffB); PG8_STAGE_A(PG8_SA(1, 0), 0, cA + kstep); PG8_STAGE(PG8_SB(1, 1), cB + hstep + kstep, voffB);
        PG8_WAIT_V(6); PG8_BAR;
    } else {
        PG8_STAGE(PG8_SB(0, 0), cB, voffB); PG8_STAGE_A(PG8_SA(0, 0), 0, cA); PG8_STAGE(PG8_SB(0, 1), cB + hstep, voffB); PG8_STAGE_A(PG8_SA(0, 1), 1, cA);
        if (wr == 1) PG8_BAR;
        PG8_WAIT_V(4); PG8_BAR;
        PG8_STAGE(PG8_SB(1, 0), cB + kstep, voffB); PG8_STAGE_A(PG8_SA(1, 0), 0, cA + kstep); PG8_STAGE(PG8_SB(1, 1), cB + hstep + kstep, voffB);
        PG8_WAIT_V(6); PG8_BAR;
    }
    for (;;) {
        const bool has_next = S.next(ui + 1, nxt);
        const unsigned nA = GATHER ? (has_next ? 0x80000000u : 0u) : (has_next ? (unsigned)nxt.pm * tstep : cA), nB = has_next ? (unsigned)nxt.pn * tstep : cB;
        if constexpr (GATHER) { if (has_next) PG8_LOADROWS(nvA, nxt); }
        if constexpr (Epi::UNIT_PRE) E.unit_pre(cur, wid, fresh_lane(), ui & 1);
#pragma unroll 1
        for (int t = 0; t < nt; t += 2) {
            const bool last = (t == nt - 2);
            const unsigned a1 = cA + (unsigned)(t + 1) * kstep;
            const unsigned a2 = last ? nA : cA + (unsigned)(t + 2) * kstep, b2 = last ? nB : cB + (unsigned)(t + 2) * kstep;
            const unsigned a3 = a2 + kstep, b3 = b2 + kstep;
            if (last && has_next) S.a_ready(nxt);
            if constexpr (SP2) {
            PG8_LDB(B0, 0, 0); PG8_LDB(B1, 0, 1); PG8_SCHED; PG8_LDA(At, 0, 0); PG8_STAGE_A(PG8_SA(1, 1), 1, a1);
            PG8_WAIT_V(8); PG8_WAIT_L(0); PG8_BAR; PG8_MMA(0, 0, At, B0); PG8_MMA(0, 1, At, B1); PG8_BAR; PG8_SCHED;
            PG8_LDA(At, 0, 1); PG8_STAGE(PG8_SB(0, 0), b2, voffB); PG8_STAGE(PG8_SB(0, 1), b2 + hstep, voffB); PG8_STAGE_A(PG8_SA(0, 0), 0, a2);
            PG8_WAIT_V(8); PG8_WAIT_L(0); PG8_BAR; PG8_MMA(1, 0, At, B0); PG8_MMA(1, 1, At, B1); PG8_BAR; PG8_SCHED;
            PG8_LDB(B0, 1, 0); PG8_LDB(B1, 1, 1); PG8_SCHED; PG8_LDA(At, 1, 0); PG8_STAGE_A(PG8_SA(0, 1), 1, a2);
            PG8_WAIT_V(8); PG8_WAIT_L(0); PG8_BAR; PG8_MMA(0, 0, At, B0); PG8_MMA(0, 1, At, B1); PG8_BAR; PG8_SCHED;
            PG8_LDA(At, 1, 1); PG8_STAGE(PG8_SB(1, 0), b3, voffB); PG8_STAGE(PG8_SB(1, 1), b3 + hstep, voffB); PG8_STAGE_A(PG8_SA(1, 0), 0, a3);
            PG8_WAIT_V(8); PG8_WAIT_L(0); PG8_BAR; PG8_MMA(1, 0, At, B0); PG8_MMA(1, 1, At, B1); PG8_BAR; PG8_SCHED;
            } else {
            PG8_LDB(B0, 0, 0); PG8_SCHED; PG8_LDA(At, 0, 0); PG8_STAGE_A(PG8_SA(1, 1), 1, a1);
            PG8_WAIT_L(8); PG8_BAR; PG8_WAIT_L(0); PG8_MMA(0, 0, At, B0); PG8_BAR; PG8_SCHED;
            PG8_LDB(B1, 0, 1); PG8_STAGE(PG8_SB(0, 0), b2, voffB);
            PG8_BAR; PG8_WAIT_L(0); PG8_MMA(0, 1, At, B1); PG8_BAR;
            PG8_LDA(At, 0, 1); PG8_STAGE_A(PG8_SA(0, 0), 0, a2);
            PG8_BAR; PG8_WAIT_L(0); PG8_MMA(1, 0, At, B0); PG8_BAR; PG8_SCHED;
            PG8_STAGE(PG8_SB(0, 1), b2 + hstep, voffB);
            PG8_WAIT_V(6); PG8_BAR; PG8_MMA(1, 1, At, B1); PG8_BAR;
            PG8_LDB(B0, 1, 0); PG8_SCHED; PG8_LDA(At, 1, 0); PG8_STAGE_A(PG8_SA(0, 1), 1, a2);
            PG8_WAIT_L(8); PG8_BAR; PG8_WAIT_L(0); PG8_MMA(0, 0, At, B0); PG8_BAR; PG8_SCHED;
            PG8_LDB(B1, 1, 1); PG8_STAGE(PG8_SB(1, 0), b3, voffB);
            PG8_BAR; PG8_WAIT_L(0); PG8_MMA(0, 1, At, B1); PG8_BAR;
            PG8_LDA(At, 1, 1); PG8_STAGE_A(PG8_SA(1, 0), 0, a3);
            PG8_BAR; PG8_WAIT_L(0); PG8_MMA(1, 0, At, B0); PG8_BAR; PG8_SCHED;
            PG8_STAGE(PG8_SB(1, 1), b3 + hstep, voffB);
            PG8_WAIT_V(6); PG8_BAR; PG8_MMA(1, 1, At, B1); PG8_BAR;
            }
        }
        if constexpr (ALIGN_EPI) { if (wr == 0) PG8_BAR; }
        bool keep = false;
        if constexpr (Epi::HAS_MID) keep = E.first_half(cur);
        bool kskip = false; if constexpr (Epi::KDUP && !KDUP_NOSKIP) kskip = !(ui & 1);
        if constexpr (!Epi::AFTER_DRAIN) { if (!kskip) { if (keep) E.mid(acc, cur, wr, wc, fr, fq); else E(acc, cur, wr, wc, fr, fq, ui & 1); } S.done(cur); }
        if (!has_next) break;
        if (!keep) {
#pragma unroll
        for (int a = 0; a < 2; ++a)
#pragma unroll
            for (int b = 0; b < 2; ++b)
#pragma unroll
                for (int m = 0; m < 4; ++m)
#pragma unroll
                    for (int n = 0; n < 2; ++n) acc[a][b][m][n] = (f32x4){0.f, 0.f, 0.f, 0.f};
        }
        cur = nxt; cA = GATHER ? 0u : nA; cB = nB; ++ui;
        if constexpr (GATHER) { vA[0] = nvA[0]; vA[1] = nvA[1]; }
        if constexpr (ALIGN_EPI) { if (wr == 1) PG8_BAR; }
    }
    PG8_WAIT_V(0);
    if constexpr (!ALIGN_EPI) { if (wr == 0) PG8_BAR; }
    PG8_BAR;
    if constexpr (Epi::AFTER_DRAIN) { E.fused(acc, cur, wr, wc, fr, fq, lds, wid, lane); S.done(cur); }
#undef PG8_SA
#undef PG8_SB
#undef PG8_STAGE
#undef PG8_RS_voffA
#undef PG8_STAGE_A
#undef PG8_LOADROWS
#undef PG8_RS_voffB
#undef PG8_LDA
#undef PG8_LDB
#undef PG8_MMA
#undef PG8_WAIT_V
#undef PG8_WAIT_L
#undef PG8_BAR
#undef PG8_SCHED
}
}

#define GAS __attribute__((address_space(1)))
#define LAS __attribute__((address_space(3)))
typedef unsigned short bf16;
typedef float f32x4 __attribute__((ext_vector_type(4)));
typedef short bf16x8 __attribute__((ext_vector_type(8)));
typedef unsigned u32x4 __attribute__((ext_vector_type(4)));
typedef unsigned u32x2 __attribute__((ext_vector_type(2)));
typedef GAS unsigned gu32;

constexpr int NWAVES = 8;
constexpr int D = 1024, SEQ = 8192, NBATCH = 2, NMETA = 16, LTOT = SEQ + NMETA;
constexpr int M = NBATCH * SEQ;
constexpr int MP = M + 256;
constexpr int INW = 4352;
constexpr int NCH = LTOT / 16;
constexpr int NE = 32, TOPK = 4;
constexpr int MAXT = M * TOPK / 256 + NE;
constexpr int NSLOT = MAXT * 256;
constexpr int VP = 8320;
constexpr float RMS_EPS = 1e-5f;

constexpr size_t MiB = 1ull << 20;
constexpr size_t WS_CTL = 0, CTL_ZERO_BYTES = 65536;
constexpr size_t WS_ROT = 1 * MiB;
constexpr size_t WS_TOK = 2 * MiB;
constexpr size_t WS_SSMP = 4 * MiB;
constexpr size_t WS_TOKOF = 24 * MiB;
constexpr size_t WS_GATEOF = 26 * MiB;
constexpr size_t WS_RSOF = 28 * MiB;
constexpr size_t WS_WIN = 32 * MiB;
constexpr size_t WS_WGLU = 41 * MiB;
constexpr size_t WS_WBR = 43 * MiB;
constexpr size_t WS_WOUT = 47 * MiB;
constexpr size_t WS_WGU = 49 * MiB;
constexpr size_t WS_WDN = 177 * MiB;
constexpr size_t WS_XN = 241 * MiB;
constexpr size_t WS_U = 274 * MiB;
constexpr size_t WS_Q = 307 * MiB;
constexpr size_t WS_K = 339 * MiB;
constexpr size_t WS_VT = 344 * MiB;
constexpr size_t WS_GS = 349 * MiB;
constexpr size_t WS_GA = 381 * MiB;
constexpr size_t WS_Z = 413 * MiB;
constexpr size_t WS_BRA = 445 * MiB;
constexpr size_t WS_MIX = 509 * MiB;
constexpr size_t WS_H1 = 541 * MiB;
constexpr size_t WS_HN2 = 605 * MiB;
constexpr size_t WS_S16 = 637 * MiB;
constexpr size_t WS_XC = 671 * MiB;
constexpr size_t WS_XS = 241 * MiB;
constexpr size_t WS_HID = 385 * MiB;
constexpr size_t WS_YS = 688 * MiB;
constexpr size_t WS_END = 832 * MiB;
static_assert((size_t)NSLOT * 2048 <= 144 * MiB, "slot buffers");
constexpr int CW_TMO = 0, CW_CNT = 1024, CW_BAR = 4096, CW_TEAM = 8192, CW_XID = 12288, CW_DEP = 13312;

constexpr int RING_BYTES = 131072;
constexpr int LDSCTL_OFF = RING_BYTES;
constexpr int LDS_BYTES = 163840;

#define LDS_WAIT() asm volatile("s_waitcnt lgkmcnt(0)" ::: "memory")
#define VM_WAIT() asm volatile("s_waitcnt vmcnt(0)" ::: "memory")
#define RLX_AGENT __ATOMIC_RELAXED, __HIP_MEMORY_SCOPE_AGENT

__device__ __forceinline__ unsigned f2bf(float f) { unsigned u = __builtin_bit_cast(unsigned, f); return (u + 0x7fffu + ((u >> 16) & 1u)) >> 16; }
typedef float f32x2_t __attribute__((ext_vector_type(2))); typedef __bf16 bf16x2_t __attribute__((ext_vector_type(2)));
__device__ __forceinline__ unsigned pk2(float lo, float hi) { f32x2_t v = {lo, hi}; bf16x2_t b = __builtin_convertvector(v, bf16x2_t); return __builtin_bit_cast(unsigned, b); }
__device__ __forceinline__ float bflo(unsigned w) { return __uint_as_float(w << 16); }
__device__ __forceinline__ float bfhi(unsigned w) { return __uint_as_float(w & 0xffff0000u); }
__device__ __forceinline__ float bf2f(bf16 b) { return __uint_as_float((unsigned)b << 16); }
__device__ __forceinline__ float wave_sum(float v) {
#pragma unroll
    for (int o = 1; o < 64; o <<= 1) v += __shfl_xor(v, o);
    return v;
}
__device__ __forceinline__ float wave_max(float v) {
#pragma unroll
    for (int o = 1; o < 64; o <<= 1) v = fmaxf(v, __shfl_xor(v, o));
    return v;
}
__device__ __forceinline__ float sigmoidf_(float x) { return __builtin_amdgcn_rcpf(1.0f + __builtin_amdgcn_exp2f(-1.4426950408889634f * x)); }
__device__ __forceinline__ float gelu_tanh(float x) { const float e = __builtin_amdgcn_exp2f(x * (-2.3022082f + -0.1029432f * (x * x))); return x * __builtin_amdgcn_rcpf(1.0f + e); }
__device__ __forceinline__ void unpack8(u32x4 w, float (&v)[8]) { v[0] = bflo(w.x); v[1] = bfhi(w.x); v[2] = bflo(w.y); v[3] = bfhi(w.y); v[4] = bflo(w.z); v[5] = bfhi(w.z); v[6] = bflo(w.w); v[7] = bfhi(w.w); }
__device__ __forceinline__ u32x4 pack8(const float (&v)[8]) { u32x4 w; w.x = pk2(v[0], v[1]); w.y = pk2(v[2], v[3]); w.z = pk2(v[4], v[5]); w.w = pk2(v[6], v[7]); return w; }

__device__ __forceinline__ unsigned pk4_fp8(float a, float b, float c, float d) { unsigned w = 0u; w = __builtin_amdgcn_cvt_pk_fp8_f32(a, b, w, false); w = __builtin_amdgcn_cvt_pk_fp8_f32(c, d, w, true); return w; }
struct Args { const float* in[26]; float* out; unsigned char* ws; int ph_lo, ph_hi; };
struct Ctx { LAS unsigned char* lds; unsigned char* ws; int tid, lane, wave, G, bid, gw, ngw; };
using pg8::Unit;

template <class E>
__device__ __forceinline__ void naive_gemm_unit(const bf16* __restrict__ A, int lda, const bf16* __restrict__ Bt, int ldb, int K, int pm, int pn, const E& e, int wave, int lane) {
    const int fr = lane & 15, fq = lane >> 4;
    const int row0 = pm * 256 + wave * 32;
#pragma unroll 1
    for (int cg = 0; cg < 4; ++cg) {
        f32x4 acc[2][2][2];
#pragma unroll
        for (int i = 0; i < 2; ++i)
#pragma unroll
            for (int j = 0; j < 2; ++j)
#pragma unroll
                for (int n = 0; n < 2; ++n) acc[i][j][n] = (f32x4){0.f, 0.f, 0.f, 0.f};
#pragma unroll 1
        for (int half = 0; half < (E::HAS_MID ? 2 : 1); ++half) {
            const bf16* ap[2]; const bf16* bp[2][2];
#pragma unroll
            for (int mi = 0; mi < 2; ++mi) ap[mi] = A + (size_t)(half * M + row0 + 16 * mi + fr) * lda + 8 * fq;
#pragma unroll
            for (int bj = 0; bj < 2; ++bj)
#pragma unroll
                for (int n = 0; n < 2; ++n) bp[bj][n] = Bt + (size_t)(half * 1024 + pn * 256 + 128 * bj + 32 * cg + pg8::perm32(16 * n + fr)) * ldb + 8 * fq;
#pragma unroll 1
            for (int k0 = 0; k0 < K; k0 += 32) {
                bf16x8 av[2], bv[2][2];
#pragma unroll
                for (int mi = 0; mi < 2; ++mi) av[mi] = *(const bf16x8*)(ap[mi] + k0);
#pragma unroll
                for (int bj = 0; bj < 2; ++bj)
#pragma unroll
                    for (int n = 0; n < 2; ++n) bv[bj][n] = *(const bf16x8*)(bp[bj][n] + k0);
#pragma unroll
                for (int mi = 0; mi < 2; ++mi)
#pragma unroll
                    for (int bj = 0; bj < 2; ++bj)
#pragma unroll
                        for (int n = 0; n < 2; ++n) acc[mi][bj][n] = __builtin_amdgcn_mfma_f32_16x16x32_bf16(bv[bj][n], av[mi], acc[mi][bj][n], 0, 0, 0);
            }
            if constexpr (E::HAS_MID) {
                if (half == 0) {
#pragma unroll
                    for (int mi = 0; mi < 2; ++mi) e.mid(row0 + 16 * mi + fr, pn * 256 + 32 * cg + 8 * fq, acc[mi][0][0], acc[mi][0][1], acc[mi][1][0], acc[mi][1][1]);
                }
            }
        }
#pragma unroll
        for (int mi = 0; mi < 2; ++mi) e.row8(row0 + 16 * mi + fr, pn * 256 + 32 * cg + 8 * fq, acc[mi][0][0], acc[mi][0][1], acc[mi][1][0], acc[mi][1][1], pm, pn);
    }
}
#ifndef EPI_FENCE
#define EPI_FENCE 0
#endif
#ifndef WARMMASK
#define WARMMASK 0
#endif
#ifndef NTMASK
#define NTMASK 0
#endif
template <int BIT, class T> __device__ __forceinline__ void st_nt(T* p, T v) { if constexpr ((NTMASK >> BIT) & 1) __builtin_nontemporal_store(v, p); else *p = v; }
#ifndef GATE_RATIO
#define GATE_RATIO (FAST_GEMM && FAST_MIX)
#endif
#ifndef UPRE
#define UPRE 3
#endif
#ifndef GPB_INP
#define GPB_INP (-1)
#endif
#ifndef GPB_OUT
#define GPB_OUT 4
#endif
#ifndef GPB_M1
#define GPB_M1 2
#endif
#ifndef GPB_GLU
#define GPB_GLU 4
#endif
#ifndef GPB_BR
#define GPB_BR 4
#endif
#ifndef GPB_M2
#define GPB_M2 2
#endif
#ifndef KDUPID
#define KDUPID (-1)
#endif
#ifndef EPI2X
#define EPI2X 0
#endif
#ifndef EPI_FRESH
#define EPI_FRESH 1
#endif
template <class E, class = void> struct pairst_t { static constexpr bool value = false; };
template <class E> struct pairst_t<E, decltype((void)E::PAIRST)> { static constexpr bool value = E::PAIRST; };
template <class E> constexpr bool pairst_v = pairst_t<E>::value;
template <class E> struct FastEpi {
    static constexpr bool PERM = true, AFTER_DRAIN = false, HAS_MID = E::HAS_MID, KDUP = (KDUPID == E::ID);
    static constexpr bool UNIT_PRE = E::UNIT_PRE; static constexpr int WARM_A = (WARMMASK >> E::ID) & 1;
    __device__ __forceinline__ void unit_pre(const Unit& u, int wid, int lane, int par) const { if constexpr (E::UNIT_PRE) e.unit_pre(u, wid, lane, par); }
    E e;
    __device__ __forceinline__ void operator()(const f32x4 (&acc)[2][2][4][2], const Unit& u, int wr, int wc, int fr, int fq, int par = 0) const {
        if constexpr (EPI_FRESH) { const int _l = pg8::fresh_lane(); fr = _l & 15; fq = _l >> 4; }
#if EPI2X
#pragma unroll 1
        for (int rep = 0; rep < 1 + ((EPI2X >> E::ID) & 1); ++rep)
#endif
        {
#if EPI2X
        asm volatile("" : "+v"(fr));
#endif
        if constexpr (E::GPB < 0) {
            if (u.pm < M / 256) { e.unit(acc, u.pm, u.pn, wr, wc, fr, fq); }
            else {
#pragma unroll
                for (int ai = 0; ai < 2; ++ai)
#pragma unroll
                    for (int m = 0; m < 4; ++m) e.row8(u.pm * 256 + ai * 128 + wr * 64 + m * 16 + fr, u.pn * 256 + wc * 32 + 8 * fq, acc[ai][0][m][0], acc[ai][0][m][1], acc[ai][1][m][0], acc[ai][1][m][1], u.pm, u.pn);
            }
        } else
        if constexpr (E::GPB > 0) {
            const int row0 = u.pm * 256 + wr * 64 + fr, col = u.pn * 256 + wc * 32 + 8 * fq;
#pragma unroll
            for (int b = 0; b < 8 / E::GPB; ++b) {
                typename E::Pre P; if constexpr (E::UNIT_PRE) e.pre(P, b, row0, col, u.pm, u.pn, par); else e.pre(P, b, row0, col, u.pm, u.pn);
                if constexpr (pairst_v<E>) {
                    static_assert(E::GPB == 2, "pair stores need two row groups per batch");
                    const int ai = (2 * b) >> 2, m = (2 * b) & 3;
                    e.pair(P, row0 + ai * 128 + m * 16, col, u.pm, u.pn, acc[ai][0][m][0], acc[ai][0][m][1], acc[ai][1][m][0], acc[ai][1][m][1],
                           acc[ai][0][m + 1][0], acc[ai][0][m + 1][1], acc[ai][1][m + 1][0], acc[ai][1][m + 1][1]);
                } else
#pragma unroll
                for (int i = 0; i < E::GPB; ++i) { const int idx = b * E::GPB + i, ai = idx >> 2, m = idx & 3;
                    e.row8p(P, i, row0 + ai * 128 + m * 16, col, acc[ai][0][m][0], acc[ai][0][m][1], acc[ai][1][m][0], acc[ai][1][m][1], u.pm, u.pn); }
            }
        } else
#pragma unroll
        for (int ai = 0; ai < 2; ++ai)
#pragma unroll
            for (int m = 0; m < 4; ++m) {
                e.row8(u.pm * 256 + ai * 128 + wr * 64 + m * 16 + fr, u.pn * 256 + wc * 32 + 8 * fq, acc[ai][0][m][0], acc[ai][0][m][1], acc[ai][1][m][0], acc[ai][1][m][1], u.pm, u.pn);
                if constexpr (EPI_FENCE > 0) { if ((m % EPI_FENCE) == EPI_FENCE - 1) asm volatile("" ::: "memory"); } }
        }
    }
    __device__ __forceinline__ bool first_half(const Unit& u) const { if constexpr (E::HAS_MID) return u.pm < M / 256; else return false; }
    __device__ __forceinline__ void mid(f32x4 (&acc)[2][2][4][2], const Unit& u, int wr, int wc, int fr, int fq) const {
        if constexpr (E::HAS_MID) {
#pragma unroll
            for (int ai = 0; ai < 2; ++ai)
#pragma unroll
                for (int m = 0; m < 4; ++m)
                    e.mid(u.pm * 256 + ai * 128 + wr * 64 + m * 16 + fr, u.pn * 256 + wc * 32 + 8 * fq, acc[ai][0][m][0], acc[ai][0][m][1], acc[ai][1][m][0], acc[ai][1][m][1]);
        }
    }
};
struct PairOrder {
    pg8::StaticOrder so;
    __device__ __forceinline__ bool next(int i, Unit& u) const { Unit t; if (!so.next(i >> 1, t)) return false; const int h = i & 1; u.pm = t.pm + h * (M / 256); u.pn = t.pn + h * 4; return true; }
    __device__ __forceinline__ void a_ready(const Unit&) const {}
    __device__ __forceinline__ void done(const Unit&) const {}
};
struct RowMajorOrder {
    int nN, nwg, G, c;
    __device__ __forceinline__ bool next(int i, Unit& u) const { const long L = (long)i * G + c; if (L >= nwg) return false; u.pm = (int)L / nN; u.pn = (int)L % nN; return true; }
    __device__ __forceinline__ void a_ready(const Unit&) const {}
    __device__ __forceinline__ void done(const Unit&) const {}
};
#ifndef NCV
#define NCV 80
#endif
#ifndef NCV_ITEMS
#define NCV_ITEMS 3072
#endif
__device__ __forceinline__ bool inproj_unit(int L, Unit& u) {
    if (L < 576) { pg8::StaticOrder a; a.init(M, 9 * 256, 1, 0); return a.next(L, u); }
    if (L < 581) { const int k = L - 576; u.pm = M / 256; u.pn = k < 4 ? k : 8; return true; }
    if (L < 584) { u.pm = L - 581; u.pn = 16; return true; }
    if (L < 1032) { pg8::StaticOrder b; b.init(M, 7 * 256, 1, 0); if (!b.next(L - 584, u)) return false; u.pn += 9; return true; }
    if (L < 1093) { u.pm = 3 + (L - 1032); u.pn = 16; return true; }
    return false;
}
#ifndef P1R
#define P1R 6
#endif
struct InProjOrder {
    int Gg, c;
    static constexpr bool HAS_HALF = false;
    __device__ __forceinline__ bool next(int i, Unit& u) const { if (i >= P1R) return false; return inproj_unit(i * Gg + c, u); }
    __device__ __forceinline__ void a_ready(const Unit&) const {}
    __device__ __forceinline__ void done(const Unit&) const {}
};
struct DeferredOrder {
    int j0, stride, Gg;
    static constexpr bool HAS_HALF = false;
    __device__ __forceinline__ bool next(int i, Unit& u) const { if (i > 1 || j0 < 0) return false; return inproj_unit(P1R * Gg + j0 + i * stride, u); }
    __device__ __forceinline__ void a_ready(const Unit&) const {}
    __device__ __forceinline__ void done(const Unit&) const {}
};
struct MoeTabs { const LAS int* tile_e; const LAS int* tb; const LAS int* cnt; const int* tok_of; const float* gate_of; const float* rs_of; };
__device__ __forceinline__ int moe_slot_pos(const MoeTabs& T, int e, int slot_row, bool& ok) { const int p = slot_row - T.tb[e] * 256; ok = p < T.cnt[e]; return p; }
struct MoeOrder {
    static constexpr bool HAS_HALF = false;
    MoeTabs T; int ntiles, nct, G, c;
    __device__ __forceinline__ bool next(int i, Unit& u) const {
        if ((G & 7) != 0) { const long L = (long)i * G + c; if (L >= (long)ntiles * nct) return false; u.pm = (int)L / nct; u.pn = __builtin_amdgcn_readfirstlane(T.tile_e[u.pm]) * nct + (int)L % nct; return true; }
        const int per = G >> 3, x = c & 7, j = c >> 3, rpb = 32 / nct;
        const long slot = (long)i * per + j;
        const long blk = (slot >> 5) * 8 + x; const int w = (int)(slot & 31);
        const long rt = blk * rpb + w / nct;
        if (rt >= ntiles) return false;
        u.pm = (int)rt; u.pn = __builtin_amdgcn_readfirstlane(T.tile_e[rt]) * nct + w % nct; return true; }
    __device__ __forceinline__ unsigned row_id(const Unit& u, int r) const { const int e = u.pn / nct; bool ok; const int p = moe_slot_pos(T, e, u.pm * 256 + r, ok); return ok ? (unsigned)T.tok_of[e * M + p] : 0u; }
    __device__ __forceinline__ void a_ready(const Unit&) const {}
    __device__ __forceinline__ void done(const Unit&) const {}
};

__device__ __forceinline__ void f4to8(f32x4 a0, f32x4 a1, float (&v)[8]) { v[0] = a0[0]; v[1] = a0[1]; v[2] = a0[2]; v[3] = a0[3]; v[4] = a1[0]; v[5] = a1[1]; v[6] = a1[2]; v[7] = a1[3]; }

struct EpiInProj {
    static constexpr bool UNIT_PRE = false; static constexpr int GPB = GPB_INP; static constexpr int ID = 0; static constexpr bool HAS_MID = false;
    bf16 *U, *Q, *Kb, *Vt, *GSp, *GAp; const float* rot;
    __device__ __forceinline__ void one(int row, int col, f32x4 v0, f32x4 v1) const {
        const bool meta = row >= M;
        if (meta) { if (row >= M + NMETA) return; if (!(col < 1024 || (col >= 2048 && col < 2304))) return; }
        const int pos = meta ? row - M : NMETA + (row & (SEQ - 1));
        const int b0 = meta ? 0 : (row >> 13), nb = meta ? 2 : 1;
        float v[8]; f4to8(v0, v1, v);
        if (col < 1024) {
            const int g = col >> 4, h0 = col & 15; const u32x4 w = pack8(v);
            for (int bi = 0; bi < nb; ++bi) { const int b = b0 + bi; *(u32x4*)(U + ((size_t)((g * 2 + b) * NCH + (pos >> 4)) * 256 + (pos & 15) * 16 + h0)) = w; }
        } else if (col < 2176) {
            if ((col & 63) < 16) {
                const int i0 = (col & 8) ? 4 : 0; const float* cs = rot + pos * 16;
#pragma unroll
                for (int j = 0; j < 4; ++j) { const float c = cs[i0 + j], s = cs[8 + i0 + j], x1 = v[j], x2 = v[4 + j]; v[j] = x1 * c - x2 * s; v[4 + j] = x2 * c + x1 * s; }
            }
            if (col < 2048) {
#pragma unroll
                for (int j = 0; j < 8; ++j) v[j] *= 0.18033688011112042f;
                *(u32x4*)(Q + (size_t)row * 1024 + (col - 1024)) = pack8(v);
            } else {
                const u32x4 w = pack8(v);
                for (int bi = 0; bi < nb; ++bi) { const int b = b0 + bi; *(u32x4*)(Kb + ((size_t)(b * LTOT + pos)) * 128 + (col - 2048)) = w; }
            }
        } else if (col < 2304) {
            const u32x4 w = pack8(v);
            for (int bi = 0; bi < nb; ++bi) { const int b = b0 + bi; *(u32x4*)(Vt + ((size_t)(b * LTOT + pos)) * 128 + (col - 2176)) = w; }
        } else {
#pragma unroll
            for (int j = 0; j < 8; ++j) v[j] = sigmoidf_(v[j]);
            if (col < 3328) *(u32x4*)(GSp + (size_t)row * 1024 + (col - 2304)) = pack8(v);
            else *(u32x4*)(GAp + (size_t)row * 1024 + (col - 3328)) = pack8(v);
        }
    }
    static constexpr bool HAS_UNIT = true;
    __device__ __forceinline__ void rotate(float (&v)[8], f32x4 c, f32x4 s_) const {
#pragma unroll
        for (int j = 0; j < 4; ++j) { const float x1 = v[j], x2 = v[4 + j]; v[j] = x1 * c[j] - x2 * s_[j]; v[4 + j] = x2 * c[j] + x1 * s_[j]; } }
    __device__ __forceinline__ void unit(const f32x4 (&acc)[2][2][4][2], int pm, int pn, int wr, int wc, int fr, int fq) const {
        const int row0 = pm * 256 + wr * 64 + fr, colt = wc * 32 + 8 * fq;
        const int b = pm >> 5;
        if (pn < 4) {
#pragma unroll
            for (int idx = 0; idx < 8; ++idx) { const int ai = idx >> 2, m = idx & 3, row = row0 + ai * 128 + m * 16, pos = NMETA + (row & (SEQ - 1));
#pragma unroll
                for (int hf = 0; hf < 2; ++hf) { const int col = pn * 256 + colt + 128 * hf, g = col >> 4, h0 = col & 15; float v[8]; f4to8(acc[ai][hf][m][0], acc[ai][hf][m][1], v);
                    st_nt<2>((u32x4*)(U + ((size_t)((g * 2 + b) * NCH + (pos >> 4)) * 256 + (pos & 15) * 16 + h0)), pack8(v)); } }
        } else if (pn < 9) {
            const bool rl = (colt & 63) < 16; const int i0 = (colt & 8) ? 4 : 0;
#pragma unroll
            for (int bt = 0; bt < 2; ++bt) {
                f32x4 cc[4], ss[4];
#pragma unroll
                for (int i = 0; i < 4; ++i) { const int idx = 4 * bt + i, row = row0 + (idx >> 2) * 128 + (idx & 3) * 16, pos = NMETA + (row & (SEQ - 1)); const float* cs = rot + pos * 16 + i0;
                    if (rl) { cc[i] = *(const f32x4*)cs; ss[i] = *(const f32x4*)(cs + 8); } else { cc[i] = (f32x4){1.f, 1.f, 1.f, 1.f}; ss[i] = (f32x4){0.f, 0.f, 0.f, 0.f}; } }
#pragma unroll
                for (int i = 0; i < 4; ++i) { const int idx = 4 * bt + i, ai = idx >> 2, m = idx & 3, row = row0 + ai * 128 + m * 16, pos = NMETA + (row & (SEQ - 1));
                    float v[8], w[8]; f4to8(acc[ai][0][m][0], acc[ai][0][m][1], v); f4to8(acc[ai][1][m][0], acc[ai][1][m][1], w);
                    if (rl) rotate(v, cc[i], ss[i]);
                    if (pn < 8) {
                        if (rl) rotate(w, cc[i], ss[i]);
#pragma unroll
                        for (int j = 0; j < 8; ++j) { v[j] *= 0.18033688011112042f; w[j] *= 0.18033688011112042f; }
                        bf16* qp = Q + (size_t)row * 1024 + ((pn - 4) * 256 + colt); st_nt<2>((u32x4*)qp, pack8(v)); st_nt<2>((u32x4*)(qp + 128), pack8(w));
                    } else {
                        st_nt<2>((u32x4*)(Kb + ((size_t)(b * LTOT + pos)) * 128 + colt), pack8(v)); st_nt<2>((u32x4*)(Vt + ((size_t)(b * LTOT + pos)) * 128 + colt), pack8(w));
                    } }
            }
        } else {
            if constexpr (GATE_RATIO) {
                bf16* Rp = GSp + ((pn - 9) * 128 + colt); bf16* Ap = GAp + ((pn - 9) * 128 + colt);
#ifdef ST2X_IN
                { bf16* r2 = Rp; bf16* a2 = Ap; asm volatile("" : "+v"(r2), "+v"(a2) :: "memory");
#pragma unroll
                for (int idx = 0; idx < 8; ++idx) { const int ai = idx >> 2, m = idx & 3, row = row0 + ai * 128 + m * 16; float v[8], w[8]; f4to8(acc[ai][0][m][0], acc[ai][0][m][1], v); f4to8(acc[ai][1][m][0], acc[ai][1][m][1], w);
                    __builtin_nontemporal_store(pack8(v), (u32x4*)(r2 + (size_t)row * 1024)); __builtin_nontemporal_store(pack8(w), (u32x4*)(a2 + (size_t)row * 1024)); } }
#endif
#pragma unroll
                for (int idx = 0; idx < 8; ++idx) { const int ai = idx >> 2, m = idx & 3, row = row0 + ai * 128 + m * 16;
                    float v[8], w[8]; f4to8(acc[ai][0][m][0], acc[ai][0][m][1], v); f4to8(acc[ai][1][m][0], acc[ai][1][m][1], w);
#pragma unroll
                    for (int j = 0; j < 8; ++j) { const float es = __builtin_amdgcn_exp2f(fminf(-1.4426950408889634f * v[j], 80.0f)), ea = __builtin_amdgcn_exp2f(fminf(-1.4426950408889634f * w[j], 80.0f));
                        v[j] = (1.0f + ea) * __builtin_amdgcn_rcpf(1.0f + es); w[j] = __builtin_amdgcn_rcpf(1.0f + ea); }
                    __builtin_nontemporal_store(pack8(v), (u32x4*)(Rp + (size_t)row * 1024)); __builtin_nontemporal_store(pack8(w), (u32x4*)(Ap + (size_t)row * 1024)); }
            } else {
            bf16* G = pn < 13 ? GSp + ((pn - 9) * 256 + colt) : GAp + ((pn - 13) * 256 + colt);
#pragma unroll
            for (int idx = 0; idx < 8; ++idx) { const int ai = idx >> 2, m = idx & 3, row = row0 + ai * 128 + m * 16;
                float v[8], w[8]; f4to8(acc[ai][0][m][0], acc[ai][0][m][1], v); f4to8(acc[ai][1][m][0], acc[ai][1][m][1], w);
#pragma unroll
                for (int j = 0; j < 8; ++j) { v[j] = sigmoidf_(v[j]); w[j] = sigmoidf_(w[j]); }
                bf16* gp = G + (size_t)row * 1024; __builtin_nontemporal_store(pack8(v), (u32x4*)gp); __builtin_nontemporal_store(pack8(w), (u32x4*)(gp + 128)); }
            }
        }
    }
    __device__ __forceinline__ void row8(int row, int col, f32x4 a0, f32x4 a1, f32x4 b0, f32x4 b1, int, int) const { one(row, col, a0, a1); one(row, col + 128, b0, b1); }
};
struct EpiGlu {
    static constexpr bool UNIT_PRE = false; static constexpr int GPB = GPB_GLU; static constexpr int ID = 1; static constexpr bool HAS_MID = false;
    const bf16* Z; const float* bias; bf16* O;
    __device__ __forceinline__ void one(int row, int col, f32x4 v0, f32x4 v1) const {
        float v[8], z[8]; f4to8(v0, v1, v); unpack8(*(const u32x4*)(Z + (size_t)row * 1024 + col), z);
        const f32x4 c0 = *(const f32x4*)(bias + col), c1 = *(const f32x4*)(bias + col + 4); float bb[8]; f4to8(c0, c1, bb);
#pragma unroll
        for (int j = 0; j < 8; ++j) v[j] = z[j] * sigmoidf_(v[j] + bb[j]);
        *(u32x4*)(O + (size_t)row * 1024 + col) = pack8(v);
    }
    struct Pre { u32x4 z[GPB > 0 ? GPB : 1][2]; f32x4 c[4]; };
    __device__ __forceinline__ void pre(Pre& P, int b, int row0, int col, int, int) const {
#pragma unroll
        for (int i = 0; i < GPB; ++i) { const int idx = GPB * b + i; const bf16* zp = Z + (size_t)(row0 + (idx >> 2) * 128 + (idx & 3) * 16) * 1024 + col; P.z[i][0] = *(const u32x4*)zp; P.z[i][1] = *(const u32x4*)(zp + 128); }
        P.c[0] = *(const f32x4*)(bias + col); P.c[1] = *(const f32x4*)(bias + col + 4); P.c[2] = *(const f32x4*)(bias + col + 128); P.c[3] = *(const f32x4*)(bias + col + 132);
    }
    __device__ __forceinline__ void half(u32x4 zz, f32x4 c0, f32x4 c1, f32x4 v0, f32x4 v1, bf16* op) const {
        float v[8], z[8], bb[8]; f4to8(v0, v1, v); unpack8(zz, z); f4to8(c0, c1, bb);
#pragma unroll
        for (int j = 0; j < 8; ++j) v[j] = z[j] * sigmoidf_(v[j] + bb[j]);
        st_nt<1>((u32x4*)op, pack8(v));
    }
    __device__ __forceinline__ void row8p(const Pre& P, int i, int row, int col, f32x4 a0, f32x4 a1, f32x4 b0, f32x4 b1, int, int) const {
        bf16* op = O + (size_t)row * 1024 + col; half(P.z[i][0], P.c[0], P.c[1], a0, a1, op); half(P.z[i][1], P.c[2], P.c[3], b0, b1, op + 128);
    }
    __device__ __forceinline__ void row8(int row, int col, f32x4 a0, f32x4 a1, f32x4 b0, f32x4 b1, int, int) const { one(row, col, a0, a1); one(row, col + 128, b0, b1); }
};
struct EpiBr {
    static constexpr bool UNIT_PRE = false; static constexpr int GPB = GPB_BR; static constexpr int ID = 2; static constexpr bool HAS_MID = true;
    const bf16* GSp; const bf16* GAp; bf16* MIX;
    __device__ __forceinline__ void mid1(int row, int col, f32x4& v0, f32x4& v1) const {
        if constexpr (GATE_RATIO) { float r[8]; unpack8(*(const u32x4*)(GSp + (size_t)row * 1024 + col), r);
#pragma unroll
            for (int j = 0; j < 4; ++j) { v0[j] *= r[j]; v1[j] *= r[4 + j]; } return; }
        float gs[8], ga[8]; unpack8(*(const u32x4*)(GSp + (size_t)row * 1024 + col), gs); unpack8(*(const u32x4*)(GAp + (size_t)row * 1024 + col), ga);
#pragma unroll
        for (int j = 0; j < 4; ++j) { v0[j] *= gs[j] * __builtin_amdgcn_rcpf(fmaxf(ga[j], 1e-20f)); v1[j] *= gs[4 + j] * __builtin_amdgcn_rcpf(fmaxf(ga[4 + j], 1e-20f)); }
    }
    __device__ __forceinline__ void mid(int row, int col, f32x4& a0, f32x4& a1, f32x4& b0, f32x4& b1) const { mid1(row, col, a0, a1); mid1(row, col + 128, b0, b1); }
    __device__ __forceinline__ void one(int row, int col, f32x4 v0, f32x4 v1) const {
        float v[8], ga[8]; f4to8(v0, v1, v); unpack8(*(const u32x4*)(GAp + (size_t)row * 1024 + col), ga);
#pragma unroll
        for (int j = 0; j < 8; ++j) v[j] *= ga[j];
        *(u32x4*)(MIX + (size_t)row * 1024 + col) = pack8(v);
    }
    struct Pre { u32x4 ga[GPB > 0 ? GPB : 1][2]; };
    __device__ __forceinline__ void pre(Pre& P, int b, int row0, int col, int, int) const {
#pragma unroll
        for (int i = 0; i < GPB; ++i) { const int idx = GPB * b + i; const bf16* gp = GAp + (size_t)(row0 - M + (idx >> 2) * 128 + (idx & 3) * 16) * 1024 + (col - 1024); P.ga[i][0] = *(const u32x4*)gp; P.ga[i][1] = *(const u32x4*)(gp + 128); }
    }
    __device__ __forceinline__ void half(u32x4 gg, f32x4 v0, f32x4 v1, bf16* op) const {
        float v[8], ga[8]; f4to8(v0, v1, v); unpack8(gg, ga);
#pragma unroll
        for (int j = 0; j < 8; ++j) v[j] *= ga[j];
        st_nt<1>((u32x4*)op, pack8(v));
    }
    __device__ __forceinline__ void row8p(const Pre& P, int i, int row, int col, f32x4 a0, f32x4 a1, f32x4 b0, f32x4 b1, int, int) const {
        bf16* op = MIX + (size_t)(row - M) * 1024 + (col - 1024); half(P.ga[i][0], a0, a1, op); half(P.ga[i][1], b0, b1, op + 128);
    }
    __device__ __forceinline__ void row8(int row, int col, f32x4 a0, f32x4 a1, f32x4 b0, f32x4 b1, int, int) const {
        if (row >= M) { row -= M; col -= 1024; }
        one(row, col, a0, a1); one(row, col + 128, b0, b1); }
};
struct EpiOut {
    static constexpr bool UNIT_PRE = false; static constexpr int GPB = GPB_OUT; static constexpr int ID = 3; static constexpr bool HAS_MID = false;
    const float* X; float* H1;
    struct Pre { f32x4 x[4][4]; };
    __device__ __forceinline__ void pre(Pre& P, int b, int row0, int col, int, int) const {
#pragma unroll
        for (int i = 0; i < GPB; ++i) { const int idx = GPB * b + i; const float* xp = X + (size_t)(row0 + (idx >> 2) * 128 + (idx & 3) * 16) * 1024 + col;
            P.x[i][0] = __builtin_nontemporal_load((const f32x4*)xp); P.x[i][1] = __builtin_nontemporal_load((const f32x4*)(xp + 4)); P.x[i][2] = __builtin_nontemporal_load((const f32x4*)(xp + 128)); P.x[i][3] = __builtin_nontemporal_load((const f32x4*)(xp + 132)); }
    }
    __device__ __forceinline__ void row8p(const Pre& P, int i, int row, int col, f32x4 a0, f32x4 a1, f32x4 b0, f32x4 b1, int, int) const {
        float* hp = H1 + (size_t)row * 1024 + col;
        st_nt<1>((f32x4*)hp, P.x[i][0] + a0); st_nt<1>((f32x4*)(hp + 4), P.x[i][1] + a1); st_nt<1>((f32x4*)(hp + 128), P.x[i][2] + b0); st_nt<1>((f32x4*)(hp + 132), P.x[i][3] + b1);
    }
    __device__ __forceinline__ void one(int row, int col, f32x4 v0, f32x4 v1) const {
        const size_t o = (size_t)row * 1024 + col;
        *(f32x4*)(H1 + o) = *(const f32x4*)(X + o) + v0; *(f32x4*)(H1 + o + 4) = *(const f32x4*)(X + o + 4) + v1;
    }
    __device__ __forceinline__ void row8(int row, int col, f32x4 a0, f32x4 a1, f32x4 b0, f32x4 b1, int, int) const { one(row, col, a0, a1); one(row, col + 128, b0, b1); }
};
#ifndef PAIRMASK
#define PAIRMASK 2
#endif
#ifndef STG
#define STG 0
#endif
#ifndef PKMATH
#define PKMATH 1
#endif
__device__ __forceinline__ f32x2_t swiglu2(f32x2_t ag, f32x2_t au, f32x2_t bg, f32x2_t bu, f32x2_t rs2) {
    f32x2_t gg = ag * rs2 + bg, uu = au * rs2 + bu;
    gg.x = fminf(gg.x, 7.0f); gg.y = fminf(gg.y, 7.0f); uu.x = __builtin_amdgcn_fmed3f(uu.x, -7.0f, 7.0f); uu.y = __builtin_amdgcn_fmed3f(uu.y, -7.0f, 7.0f);
    const f32x2_t t = gg * (f32x2_t){-2.4554669595930156f, -2.4554669595930156f};
    f32x2_t d = {__builtin_amdgcn_exp2f(t.x), __builtin_amdgcn_exp2f(t.y)}; d = d + (f32x2_t){1.0f, 1.0f};
    const f32x2_t r = {__builtin_amdgcn_rcpf(d.x), __builtin_amdgcn_rcpf(d.y)};
    return (gg * uu + gg) * r;
}
struct EpiMoe1 {
    static constexpr bool UNIT_PRE = ((UPRE & 1) != 0); static constexpr int GPB = GPB_M1; static constexpr int ID = 4; static constexpr bool HAS_MID = false;
    const float* bgu; unsigned char* HID; MoeTabs T; LAS float* sc;
    struct Pre { float rs[8]; f32x4 bg0, bg1, bu0, bu1; const LAS float* sp; int rso; };
    __device__ __forceinline__ void unit_pre(const Unit& u, int wid, int lane, int par) const {
        const int e = u.pn >> 3, ct = u.pn & 7; LAS float* dst = sc + par * 512 + wid * 64;
        if (wid < 4) { bool ok; const int p = moe_slot_pos(T, e, u.pm * 256 + wid * 64 + lane, ok);
            __builtin_amdgcn_raw_ptr_buffer_load_lds(__builtin_amdgcn_make_buffer_rsrc((void*)T.rs_of, (short)0, -1, 0x00020000), (LAS unsigned*)dst, 4, (e * M + (ok ? p : 0)) * 4, 0, 0, 0); }
        else { const int cidx = (wid - 4) * 64 + lane;
            __builtin_amdgcn_raw_ptr_buffer_load_lds(__builtin_amdgcn_make_buffer_rsrc((void*)bgu, (short)0, -1, 0x00020000), (LAS unsigned*)dst, 4, (e * 2048 + 128 * ct + (cidx & 127) + (cidx >> 7) * 1024) * 4, 0, 0, 0); }
    }
    __device__ __forceinline__ void pre(Pre& P, int b, int row0, int col, int pm, int pn, int par = 0) const {
        const int e = pn >> 3, ct = pn & 7, j0 = 128 * ct + (col - pn * 256);
        if constexpr (UNIT_PRE) { const int lr = row0 - pm * 256, lc = col - pn * 256; const LAS float* sp = sc + par * 512;
            if constexpr (PAIRST) { P.sp = sp + 256 + lc; P.rso = lr + ((GPB * b) >> 2) * 128 + ((GPB * b) & 3) * 16 - 256 - lc; return; }
#pragma unroll
            for (int i = 0; i < GPB; ++i) { const int idx = GPB * b + i; P.rs[i] = sp[lr + (idx >> 2) * 128 + (idx & 3) * 16] * 0.0625f; }
            if constexpr ((STG & 1) != 0 || PAIRST) P.sp = sp + 256 + lc;
            else { P.bg0 = *(const LAS f32x4*)(sp + 256 + lc); P.bg1 = *(const LAS f32x4*)(sp + 260 + lc); P.bu0 = *(const LAS f32x4*)(sp + 384 + lc); P.bu1 = *(const LAS f32x4*)(sp + 388 + lc); }
        } else {
#pragma unroll
        for (int i = 0; i < GPB; ++i) { const int idx = GPB * b + i; bool ok; const int p = moe_slot_pos(T, e, row0 + (idx >> 2) * 128 + (idx & 3) * 16, ok); P.rs[i] = (ok ? T.rs_of[e * M + p] : 0.f) * 0.0625f; }
        const float* bp = bgu + (size_t)e * 2048 + j0; P.bg0 = *(const f32x4*)bp; P.bg1 = *(const f32x4*)(bp + 4); P.bu0 = *(const f32x4*)(bp + 1024); P.bu1 = *(const f32x4*)(bp + 1028);
        }
    }
    static constexpr bool PAIRST = (PAIRMASK & 1) != 0;
    __device__ __forceinline__ void store_pair(u32x2 w0, u32x2 w1, int row_a, int col, int pm, int pn, int fq) const {
        const int ct = pn & 7, lc = col - pn * 256; fq = (lc >> 3) & 3;
        const auto rx = __builtin_amdgcn_permlane16_swap(w0.x, w1.x, false, false), ry = __builtin_amdgcn_permlane16_swap(w0.y, w1.y, false, false);
        const u32x4 o = {rx[0], ry[0], rx[1], ry[1]};
        *(u32x4*)(HID + (size_t)(row_a + 16 * (fq & 1)) * 1024 + 128 * ct + (lc & ~31) + 16 * (fq >> 1)) = o;
    }
    __device__ __forceinline__ void pair(const Pre& P, int row_a, int col, int pm, int pn, f32x4 a0, f32x4 a1, f32x4 b0, f32x4 b1, f32x4 c0, f32x4 c1, f32x4 d0, f32x4 d1) const {
        const u32x2 w0 = row8v(P, 0, a0, a1, b0, b1); __builtin_amdgcn_sched_barrier(0); const u32x2 w1 = row8v(P, 1, c0, c1, d0, d1); __builtin_amdgcn_sched_barrier(0); store_pair(w0, w1, row_a, col, pm, pn, 0); __builtin_amdgcn_sched_barrier(0); }
    __device__ __forceinline__ u32x2 row8v(const Pre& P, int i, f32x4 a0, f32x4 a1, f32x4 b0, f32x4 b1) const {
        const float rs = UNIT_PRE ? P.sp[P.rso + 16 * i] * 0.0625f : P.rs[i]; const f32x2_t rs2 = {rs, rs}; float g[8];
#pragma unroll
        for (int q = 0; q < 4; ++q) { const f32x4 av = q < 2 ? a0 : a1, bv = q < 2 ? b0 : b1; const int o = 2 * (q & 1);
            f32x2_t gb2, ub2;
            if constexpr (UNIT_PRE) { gb2 = *(const LAS f32x2_t*)(P.sp + 2 * q); ub2 = *(const LAS f32x2_t*)(P.sp + 128 + 2 * q); }
            else { const f32x4 gb = q < 2 ? P.bg0 : P.bg1, ub = q < 2 ? P.bu0 : P.bu1; gb2 = (f32x2_t){gb[o], gb[o + 1]}; ub2 = (f32x2_t){ub[o], ub[o + 1]}; }
            const f32x2_t r = swiglu2((f32x2_t){av[o], av[o + 1]}, (f32x2_t){bv[o], bv[o + 1]}, gb2, ub2, rs2); g[2 * q] = r.x; g[2 * q + 1] = r.y; }
        u32x2 w; w.x = pk4_fp8(g[0], g[1], g[2], g[3]); w.y = pk4_fp8(g[4], g[5], g[6], g[7]); return w;
    }
    __device__ __forceinline__ void row8p(const Pre& P, int i, int row, int col, f32x4 a0, f32x4 a1, f32x4 b0, f32x4 b1, int pm, int pn) const {
        const int ct = pn & 7, j0 = 128 * ct + (col - pn * 256); const float rs = P.rs[i];
        float g[8];
        if constexpr (PKMATH) {
            const f32x2_t rs2 = {rs, rs};
#pragma unroll
            for (int q = 0; q < 4; ++q) { const f32x4 av = q < 2 ? a0 : a1, bv = q < 2 ? b0 : b1; const int o = 2 * (q & 1); f32x2_t gb2, ub2;
                if constexpr ((STG & 1) != 0 && UNIT_PRE) { gb2 = *(const LAS f32x2_t*)(P.sp + 2 * q); ub2 = *(const LAS f32x2_t*)(P.sp + 128 + 2 * q); }
                else { const f32x4 gb = q < 2 ? P.bg0 : P.bg1, ub = q < 2 ? P.bu0 : P.bu1; gb2 = (f32x2_t){gb[o], gb[o + 1]}; ub2 = (f32x2_t){ub[o], ub[o + 1]}; }
                const f32x2_t r = swiglu2((f32x2_t){av[o], av[o + 1]}, (f32x2_t){bv[o], bv[o + 1]}, gb2, ub2, rs2); g[2 * q] = r.x; g[2 * q + 1] = r.y; }
        } else {
        float up[8], bg[8], bu[8]; f4to8(a0 * rs, a1 * rs, g); f4to8(b0 * rs, b1 * rs, up); f4to8(P.bg0, P.bg1, bg); f4to8(P.bu0, P.bu1, bu);
#pragma unroll
        for (int j = 0; j < 8; ++j) { const float gg = fminf(g[j] + bg[j], 7.0f), uu = fminf(fmaxf(up[j] + bu[j], -7.0f), 7.0f); g[j] = gg * sigmoidf_(1.702f * gg) * (uu + 1.0f); }
        }
        u32x2 w; w.x = pk4_fp8(g[0], g[1], g[2], g[3]); w.y = pk4_fp8(g[4], g[5], g[6], g[7]);
        if constexpr ((STG & 1) != 0) {
            int lr = row - pm * 256; asm volatile("" : "+v"(lr));
            const int lc = col - pn * 256, wr_ = (lr >> 6) & 1, m = (lr >> 4) & 3, fr_ = lr & 15;
            LAS unsigned char* buf = (LAS unsigned char*)sc + 4096 + (m & 1) * 4608;
            *(LAS u32x2*)(buf + (wr_ * 16 + fr_) * 144 + lc) = w;
            asm volatile("s_waitcnt lgkmcnt(0)" ::: "memory"); __builtin_amdgcn_s_barrier(); asm volatile("" ::: "memory");
            const int t = (wr_ * 4 + (lc >> 5)) * 64 + ((lc >> 3) & 3) * 16 + fr_, r = t >> 3, ch = t & 7;
            if (t < 256) { const u32x4 o = *(const LAS u32x4*)(buf + r * 144 + ch * 16);
                *(u32x4*)(HID + (size_t)(pm * 256 + (lr & 128) + (r >> 4) * 64 + m * 16 + (r & 15)) * 1024 + 128 * ct + ch * 16) = o; }
            return; }
        st_nt<0>((u32x2*)(HID + (size_t)row * 1024 + j0), w);
    }
    __device__ __forceinline__ void row8(int row, int col, f32x4 a0, f32x4 a1, f32x4 b0, f32x4 b1, int, int pn) const {
        const int e = pn >> 3, ct = pn & 7, j0 = 128 * ct + (col - pn * 256); bool ok; const int p = moe_slot_pos(T, e, row, ok);
        const float rs = (ok ? T.rs_of[e * M + p] : 0.f) * 0.0625f;
        float g[8], up[8], bg[8], bu[8]; f4to8(a0 * rs, a1 * rs, g); f4to8(b0 * rs, b1 * rs, up);
        const float* bp = bgu + (size_t)e * 2048 + j0;
        f4to8(*(const f32x4*)bp, *(const f32x4*)(bp + 4), bg); f4to8(*(const f32x4*)(bp + 1024), *(const f32x4*)(bp + 1028), bu);
#pragma unroll
        for (int j = 0; j < 8; ++j) { const float gg = fminf(g[j] + bg[j], 7.0f), uu = fminf(fmaxf(up[j] + bu[j], -7.0f), 7.0f); g[j] = gg * sigmoidf_(1.702f * gg) * (uu + 1.0f); }
        u32x2 w; w.x = pk4_fp8(g[0], g[1], g[2], g[3]); w.y = pk4_fp8(g[4], g[5], g[6], g[7]); *(u32x2*)(HID + (size_t)row * 1024 + j0) = w;
    }
};
struct EpiMoe2 {
    static constexpr bool UNIT_PRE = ((UPRE & 2) != 0); static constexpr int GPB = GPB_M2; static constexpr int ID = 5; static constexpr bool HAS_MID = false;
    const float* bd; unsigned char* YS; MoeTabs T; LAS float* sc;
    __device__ __forceinline__ void one(int row, int e, int c0, f32x4 v0, f32x4 v1, float gt) const {
        float v[8], bb[8]; f4to8(v0, v1, v); const float* bp = bd + (size_t)e * 1024 + c0; f4to8(*(const f32x4*)bp, *(const f32x4*)(bp + 4), bb);
#pragma unroll
        for (int j = 0; j < 8; ++j) v[j] = (v[j] + bb[j] * 16.0f) * gt;
        u32x2 w; w.x = pk4_fp8(v[0], v[1], v[2], v[3]); w.y = pk4_fp8(v[4], v[5], v[6], v[7]); *(u32x2*)(YS + (size_t)row * 1024 + c0) = w;
    }
    struct Pre { float gt[8]; f32x4 b0, b1, b2, b3; };
    __device__ __forceinline__ void unit_pre(const Unit& u, int wid, int lane, int par) const {
        const int e = u.pn >> 2, ct = u.pn & 3; LAS float* dst = sc + par * 512 + wid * 64;
        if (wid < 4) { bool ok; const int p = moe_slot_pos(T, e, u.pm * 256 + wid * 64 + lane, ok);
            __builtin_amdgcn_raw_ptr_buffer_load_lds(__builtin_amdgcn_make_buffer_rsrc((void*)T.gate_of, (short)0, -1, 0x00020000), (LAS unsigned*)dst, 4, (e * M + (ok ? p : 0)) * 4, 0, 0, 0); }
        else { const int cidx = (wid - 4) * 64 + lane;
            __builtin_amdgcn_raw_ptr_buffer_load_lds(__builtin_amdgcn_make_buffer_rsrc((void*)bd, (short)0, -1, 0x00020000), (LAS unsigned*)dst, 4, (e * 1024 + 256 * ct + cidx) * 4, 0, 0, 0); }
    }
    __device__ __forceinline__ void pre(Pre& P, int b, int row0, int col, int pm, int pn, int par = 0) const {
        const int e = pn >> 2, ct = pn & 3, c0 = 256 * ct + (col - pn * 256);
        if constexpr (UNIT_PRE) { const int lr = row0 - pm * 256, lc = col - pn * 256; const LAS float* sp = sc + par * 512;
#pragma unroll
            for (int i = 0; i < GPB; ++i) { const int idx = GPB * b + i; P.gt[i] = sp[lr + (idx >> 2) * 128 + (idx & 3) * 16]; }
            P.b0 = *(const LAS f32x4*)(sp + 256 + lc) * 16.0f; P.b1 = *(const LAS f32x4*)(sp + 260 + lc) * 16.0f; P.b2 = *(const LAS f32x4*)(sp + 384 + lc) * 16.0f; P.b3 = *(const LAS f32x4*)(sp + 388 + lc) * 16.0f;
        } else {
#pragma unroll
        for (int i = 0; i < GPB; ++i) { const int idx = GPB * b + i; bool ok; const int p = moe_slot_pos(T, e, row0 + (idx >> 2) * 128 + (idx & 3) * 16, ok); P.gt[i] = ok ? T.gate_of[e * M + p] : 0.f; }
        const float* bp = bd + (size_t)e * 1024 + c0; P.b0 = *(const f32x4*)bp * 16.0f; P.b1 = *(const f32x4*)(bp + 4) * 16.0f; P.b2 = *(const f32x4*)(bp + 128) * 16.0f; P.b3 = *(const f32x4*)(bp + 132) * 16.0f;
        }
    }
    static constexpr bool PAIRST = (PAIRMASK & 2) != 0;
    __device__ __forceinline__ void pair(const Pre& P, int row_a, int col, int pm, int pn, f32x4 a0, f32x4 a1, f32x4 b0, f32x4 b1, f32x4 c0, f32x4 c1, f32x4 d0, f32x4 d1) const {
        const int ct = pn & 3, lc = col - pn * 256, fq = (lc >> 3) & 3; const float g0 = P.gt[0], g1 = P.gt[1];
        float v[8], w8[8], y[8], z8[8]; f4to8((a0 + P.b0) * g0, (a1 + P.b1) * g0, v); f4to8((b0 + P.b2) * g0, (b1 + P.b3) * g0, w8); f4to8((c0 + P.b0) * g1, (c1 + P.b1) * g1, y); f4to8((d0 + P.b2) * g1, (d1 + P.b3) * g1, z8);
        u32x2 wa0, wb0, wa1, wb1; wa0.x = pk4_fp8(v[0], v[1], v[2], v[3]); wa0.y = pk4_fp8(v[4], v[5], v[6], v[7]); wb0.x = pk4_fp8(w8[0], w8[1], w8[2], w8[3]); wb0.y = pk4_fp8(w8[4], w8[5], w8[6], w8[7]);
        wa1.x = pk4_fp8(y[0], y[1], y[2], y[3]); wa1.y = pk4_fp8(y[4], y[5], y[6], y[7]); wb1.x = pk4_fp8(z8[0], z8[1], z8[2], z8[3]); wb1.y = pk4_fp8(z8[4], z8[5], z8[6], z8[7]);
        const auto ax = __builtin_amdgcn_permlane16_swap(wa0.x, wa1.x, false, false), ay = __builtin_amdgcn_permlane16_swap(wa0.y, wa1.y, false, false);
        const auto bx = __builtin_amdgcn_permlane16_swap(wb0.x, wb1.x, false, false), by = __builtin_amdgcn_permlane16_swap(wb0.y, wb1.y, false, false);
        unsigned char* dst = YS + (size_t)(row_a + 16 * (fq & 1)) * 1024 + 256 * ct + (lc & ~31) + 16 * (fq >> 1);
        *(u32x4*)dst = (u32x4){ax[0], ay[0], ax[1], ay[1]}; *(u32x4*)(dst + 128) = (u32x4){bx[0], by[0], bx[1], by[1]};
    }
    __device__ __forceinline__ void row8p(const Pre& P, int i, int row, int col, f32x4 a0, f32x4 a1, f32x4 b0, f32x4 b1, int pm, int pn) const {
        const int ct = pn & 3, c0 = 256 * ct + (col - pn * 256); const float gt = P.gt[i];
        float v[8], w8[8]; f4to8((a0 + P.b0) * gt, (a1 + P.b1) * gt, v); f4to8((b0 + P.b2) * gt, (b1 + P.b3) * gt, w8);
        u32x2 w; w.x = pk4_fp8(v[0], v[1], v[2], v[3]); w.y = pk4_fp8(v[4], v[5], v[6], v[7]);
        u32x2 x; x.x = pk4_fp8(w8[0], w8[1], w8[2], w8[3]); x.y = pk4_fp8(w8[4], w8[5], w8[6], w8[7]);
        if constexpr ((STG & 2) != 0) {
            int lr = row - pm * 256; asm volatile("" : "+v"(lr));
            const int lc = col - pn * 256, wr_ = (lr >> 6) & 1, m = (lr >> 4) & 3, fr_ = lr & 15;
            LAS unsigned char* buf = (LAS unsigned char*)sc + 4096 + (m & 1) * 8704;
            *(LAS u32x2*)(buf + (wr_ * 16 + fr_) * 272 + lc) = w; *(LAS u32x2*)(buf + (wr_ * 16 + fr_) * 272 + lc + 128) = x;
            asm volatile("s_waitcnt lgkmcnt(0)" ::: "memory"); __builtin_amdgcn_s_barrier(); asm volatile("" ::: "memory");
            const int t = (wr_ * 4 + (lc >> 5)) * 64 + ((lc >> 3) & 3) * 16 + fr_, r = t >> 4, ch = t & 15;
            const u32x4 o = *(const LAS u32x4*)(buf + r * 272 + ch * 16);
            *(u32x4*)(YS + (size_t)(pm * 256 + (lr & 128) + (r >> 4) * 64 + m * 16 + (r & 15)) * 1024 + 256 * ct + ch * 16) = o;
            return; }
        st_nt<0>((u32x2*)(YS + (size_t)row * 1024 + c0), w); st_nt<0>((u32x2*)(YS + (size_t)row * 1024 + c0 + 128), x);
#ifdef ST2X
        { u32x2* p2 = (u32x2*)(YS + (size_t)row * 1024 + c0); asm volatile("" : "+v"(p2) :: "memory"); *p2 = w; p2[16] = x; }
#endif
    }
    __device__ __forceinline__ void row8(int row, int col, f32x4 a0, f32x4 a1, f32x4 b0, f32x4 b1, int, int pn) const {
        const int e = pn >> 2, ct = pn & 3, c0 = 256 * ct + (col - pn * 256); bool ok; const int p = moe_slot_pos(T, e, row, ok); const float gt = ok ? T.gate_of[e * M + p] : 0.f;
        one(row, e, c0, a0, a1, gt); one(row, e, c0 + 128, b0, b1, gt);
    }
};
#define XB_TMO      128
#define XB_XCNT(j)  (256  + 64 * (j))
#define XB_XSUB(j)  (1280 + 64 * (j))
#define XB_XGEN(j)  (2304 + 64 * (j))
#define XB_TOP      3328
#define XB_TOPGEN   3392
#define XCD_BAR_WORDS 3456
#define XB_SPIN_CAP (1u << 18)

__device__ __forceinline__ unsigned xb_ld(unsigned* p)              { return __hip_atomic_load(p, __ATOMIC_RELAXED, __HIP_MEMORY_SCOPE_AGENT); }
__device__ __forceinline__ unsigned xb_add(unsigned* p, unsigned v) { return __hip_atomic_fetch_add(p, v, __ATOMIC_RELAXED, __HIP_MEMORY_SCOPE_AGENT); }
__device__ __forceinline__ unsigned xb_xcc_id() { return (unsigned)__builtin_amdgcn_s_getreg((3 << 11) | 20) & 0xFu; }
#define XB_SPIN(cond, bar) do { unsigned _sp = 0; while (cond) { __builtin_amdgcn_s_sleep(1); \
    if ((++_sp & 255u) == 0u) { if (xb_ld(&(bar)[XB_TMO])) break; if (_sp > XB_SPIN_CAP) { atomicAdd(&(bar)[XB_TMO], 1u); break; } } } } while (0)

struct XcdBarrier {
    unsigned* bar; unsigned x;
    volatile LAS unsigned* st;
};

__device__ __forceinline__ XcdBarrier xcd_barrier_post(unsigned* bar, volatile LAS unsigned* st) {
    XcdBarrier b; b.bar = bar; b.x = xb_xcc_id(); b.st = st;
    if (threadIdx.x == 0) (void)xb_add(&bar[XB_XCNT(b.x)], 1u);
    return b;
}
__device__ __forceinline__ void xcd_barrier_complete(unsigned* bar, unsigned x, unsigned& nloc, unsigned& nx) {
    const unsigned G = gridDim.x * gridDim.y * gridDim.z;
    unsigned sum, cnt, mine, sp = 0u;
    for (;;) {
        sum = 0u; cnt = 0u; mine = 0u;
#pragma unroll
        for (unsigned j = 0; j < 16; ++j) { const unsigned c = xb_ld(&bar[XB_XCNT(j)]); sum += c; cnt += (c > 0u) ? 1u : 0u; mine = (j == x) ? c : mine; }
        if (sum == G) break;
        __builtin_amdgcn_s_sleep(1);
        if ((++sp & 255u) == 0u) { if (xb_ld(&bar[XB_TMO])) break; if (sp > XB_SPIN_CAP) { atomicAdd(&bar[XB_TMO], 1u); break; } }
    }
    nloc = mine > 0u ? mine : 1u; nx = cnt > 0u ? cnt : 1u;
}

__device__ __forceinline__ void xcd_barrier(const XcdBarrier& b, const bool thread0) {
    asm volatile("s_waitcnt vmcnt(0)" ::: "memory");
    __syncthreads();
    if (thread0) {
        unsigned* bar = b.bar;
        __builtin_amdgcn_s_waitcnt(0);
        unsigned nloc = b.st[0], nx = b.st[1];
        if (nloc == 0u) { xcd_barrier_complete(bar, b.x, nloc, nx); b.st[0] = nloc; b.st[1] = nx; }
        const unsigned old = xb_add(&bar[XB_XSUB(b.x)], 1u);
        const unsigned gen = old / nloc;
        if (old + 1u == (gen + 1u) * nloc) {
            __builtin_amdgcn_fence(__ATOMIC_RELEASE, "agent");
            asm volatile("s_waitcnt vmcnt(0)" ::: "memory");
            const unsigned og = xb_add(&bar[XB_TOP], 1u);
            const unsigned tg = og / nx;
            if (og + 1u == (tg + 1u) * nx) xb_add(&bar[XB_TOPGEN], 1u);
            else XB_SPIN(xb_ld(&bar[XB_TOPGEN]) == tg, bar);
            __builtin_amdgcn_fence(__ATOMIC_ACQUIRE, "agent");
            xb_add(&bar[XB_XGEN(b.x)], 1u);
            asm volatile("s_waitcnt vmcnt(0)" ::: "memory");
        } else {
            XB_SPIN(xb_ld(&bar[XB_XGEN(b.x)]) == gen, bar);
            __builtin_amdgcn_fence(__ATOMIC_ACQUIRE, "agent");
            asm volatile("s_waitcnt vmcnt(0)" ::: "memory");
        }
    }
    __syncthreads();
}
#ifndef Z_PAIR
#define Z_PAIR 0
#endif

constexpr size_t SSM_A16 = 1 * MiB, SSM_TF = 2 * MiB, SSM_VF = 4 * MiB, SSM_WF = 8 * MiB;
constexpr int NCI = 2 * NCH;
constexpr int NCB = (NCI + 15) / 16;
constexpr int CW_Q = 2048;

__device__ __forceinline__ void p0_ssm_prep(const Args& a, const Ctx& c, int g) {
    LAS float* AP = (LAS float*)(c.lds);
    constexpr int APS = 18;
    LAS float* BBl = AP + 64 * APS * 2;
    LAS float* Cc = BBl + 64 * 16 * 2;
    LAS float* Kt = Cc + 16 * 64 * 2;
    LAS float* Fz = Kt + 4096;
    unsigned char* sp = c.ws + WS_SSMP;
    const int tid = c.tid;
    if (tid < 64) { const int p = tid, i = g * 64 + p;
        const float lr = a.in[4][i], li = a.in[5][i], dt = expf(a.in[6][g]);
        const float mag = expf(dt * lr), ar = mag * cosf(dt * li), ai = mag * sinf(dt * li);
        float pr = 1.0f, pi = 0.0f;
#pragma unroll
        for (int tau = 0; tau <= 16; ++tau) { AP[(p * APS + tau) * 2] = pr; AP[(p * APS + tau) * 2 + 1] = pi; const float tr = pr * ar - pi * ai, ti = pr * ai + pi * ar; pr = tr; pi = ti; }
        const float den = lr * lr + li * li, nr = ar - 1.0f, ni = ai; Fz[p * 2] = (nr * lr + ni * li) / den; Fz[p * 2 + 1] = (ni * lr - nr * li) / den;
        float* A16 = (float*)(sp + SSM_A16); const float m16 = expf(16.0f * dt * lr), a16 = 16.0f * dt * li; A16[i * 2] = m16 * cosf(a16); A16[i * 2 + 1] = m16 * sinf(a16);
    }
    for (int idx = tid; idx < 1024; idx += NWAVES * 64) { const int h = idx >> 6, p = idx & 63; Cc[idx * 2] = a.in[9][(g * 16 + h) * 64 + p]; Cc[idx * 2 + 1] = a.in[10][(g * 16 + h) * 64 + p]; }
    float bre[2], bim[2];
#pragma unroll
    for (int k = 0; k < 2; ++k) { bre[k] = a.in[7][g * 1024 + tid + 512 * k]; bim[k] = a.in[8][g * 1024 + tid + 512 * k]; }
    __syncthreads();
#pragma unroll
    for (int k = 0; k < 2; ++k) { const int idx = tid + 512 * k, p = idx >> 4; const float fr_ = Fz[p * 2], fi_ = Fz[p * 2 + 1]; BBl[idx * 2] = fr_ * bre[k] - fi_ * bim[k]; BBl[idx * 2 + 1] = fr_ * bim[k] + fi_ * bre[k]; }
    __syncthreads();
    {
        const int hp = tid & 15, h = (tid >> 4) & 15, t0 = 8 * (tid >> 8); float s[8];
#pragma unroll
        for (int k = 0; k < 8; ++k) s[k] = 0.f;
#pragma unroll 4
        for (int p = 0; p < 64; ++p) { const f32x2_t cc = *(const LAS f32x2_t*)(Cc + (h * 64 + p) * 2), bb = *(const LAS f32x2_t*)(BBl + (p * 16 + hp) * 2);
            const float cbr = cc.x * bb.x - cc.y * bb.y, cbi = cc.x * bb.y + cc.y * bb.x;
#pragma unroll
            for (int k2 = 0; k2 < 4; ++k2) { const f32x4 aa = *(const LAS f32x4*)(AP + (p * APS + t0 + 2 * k2) * 2); s[2 * k2] += cbr * aa.x - cbi * aa.y; s[2 * k2 + 1] += cbr * aa.z - cbi * aa.w; } }
        if (t0 == 0 && h == hp) s[0] += a.in[11][g * 16 + h];
#pragma unroll
        for (int k = 0; k < 8; ++k) Kt[((t0 + k) * 16 + h) * 16 + hp] = s[k];
    }
    __syncthreads();
    bf16* TF = (bf16*)(sp + SSM_TF); bf16* VF = (bf16*)(sp + SSM_VF); bf16* WF = (bf16*)(sp + SSM_WF);
    for (int idx = tid; idx < 1024; idx += NWAVES * 64) { const int dl = idx >> 6, ln = idx & 63, fr = ln & 15, fq = ln >> 4; float v[8];
#pragma unroll
        for (int e = 0; e < 8; ++e) { const int j = 8 * fq + e, tau = dl - (j >> 4), hp = j & 15; v[e] = tau >= 0 ? Kt[(tau * 16 + fr) * 16 + hp] : 0.f; }
        *(u32x4*)(TF + ((size_t)(g * 16 + dl) * 64 + ln) * 8) = pack8(v); }
    for (int idx = tid; idx < 4096; idx += NWAVES * 64) { const int t = idx >> 8, kx = (idx >> 6) & 3, ln = idx & 63, fr = ln & 15, fq = ln >> 4; float v[8];
#pragma unroll
        for (int e = 0; e < 8; ++e) { const int pp = 32 * kx + 8 * fq + e, p = pp & 63; const float cr = Cc[(fr * 64 + p) * 2], ci = Cc[(fr * 64 + p) * 2 + 1], ar = AP[(p * APS + t + 1) * 2], ai = AP[(p * APS + t + 1) * 2 + 1];
            v[e] = pp < 64 ? (cr * ar - ci * ai) : -(cr * ai + ci * ar); }
        *(u32x4*)(VF + ((size_t)((g * 16 + t) * 4 + kx) * 64 + ln) * 8) = pack8(v); }
    for (int idx = tid; idx < 4096; idx += NWAVES * 64) { const int pb = idx >> 9, ks = (idx >> 6) & 7, ln = idx & 63, fr = ln & 15, fq = ln >> 4, pp = 16 * pb + fr, p = pp & 63; float v[8];
#pragma unroll
        for (int e = 0; e < 8; ++e) { const int k = 32 * ks + 8 * fq + e, s = k >> 4, h = k & 15; const float ar = AP[(p * APS + 15 - s) * 2], ai = AP[(p * APS + 15 - s) * 2 + 1], br = BBl[(p * 16 + h) * 2], bi = BBl[(p * 16 + h) * 2 + 1];
            v[e] = pp < 64 ? (ar * br - ai * bi) : (ar * bi + ai * br); }
        *(u32x4*)(WF + ((size_t)((g * 8 + pb) * 8 + ks) * 64 + ln) * 8) = pack8(v); }
    __syncthreads();
}
__device__ __forceinline__ void ssm_phase_a(const Ctx& c) {
    const bf16* U = (const bf16*)(c.ws + WS_U); const bf16* WF = (const bf16*)(c.ws + WS_SSMP + SSM_WF); float* S16 = (float*)(c.ws + WS_S16);
    const int fr = c.lane & 15, fq = c.lane >> 4;
    for (int it = c.gw; it < 64 * NCB; it += c.ngw) {
        const int g = it / NCB, cb = it % NCB, cidx = 16 * cb + fr, cl = cidx < NCI ? cidx : NCI - 1;
        bf16x8 uf[8];
#pragma unroll
        for (int ks = 0; ks < 8; ++ks) uf[ks] = *(const bf16x8*)(U + ((size_t)(g * NCI + cl)) * 256 + 32 * ks + 8 * fq);
#pragma unroll 2
        for (int pb = 0; pb < 8; ++pb) { f32x4 acc = {0.f, 0.f, 0.f, 0.f};
#pragma unroll
            for (int ks = 0; ks < 8; ++ks) { const bf16x8 wf = *(const bf16x8*)(WF + ((size_t)((g * 8 + pb) * 8 + ks) * 64 + c.lane) * 8); acc = __builtin_amdgcn_mfma_f32_16x16x32_bf16(wf, uf[ks], acc, 0, 0, 0); }
            if (cidx < NCI) *(f32x4*)(S16 + ((size_t)(g * NCI + cidx)) * 128 + 16 * pb + 4 * fq) = acc; }
    }
}
__device__ __forceinline__ void ssm_carry(const Ctx& c) {
    LAS float* E = (LAS float*)(c.lds + LDSCTL_OFF + 4096);
    for (int it = c.bid; it < 128; it += c.G) {
        const int g = it >> 1, b = it & 1, p = c.lane, seg = c.wave, c0 = 64 * seg;
        const float* A16 = (const float*)(c.ws + WS_SSMP + SSM_A16); const float ar = A16[(g * 64 + p) * 2], ai = A16[(g * 64 + p) * 2 + 1];
        const float* sp = (const float*)(c.ws + WS_S16) + ((size_t)(g * NCI + b * NCH + c0)) * 128; bf16* xp = (bf16*)(c.ws + WS_XC) + ((size_t)(g * NCI + b * NCH + c0)) * 128;
        float lr[64], li[64];
#pragma unroll
        for (int j = 0; j < 64; ++j) { lr[j] = sp[j * 128 + p]; li[j] = sp[j * 128 + 64 + p]; }
        float xr = 0.f, xi = 0.f;
#pragma unroll
        for (int j = 0; j < 64; ++j) { const float tr = ar * xr - ai * xi + lr[j], ti = ar * xi + ai * xr + li[j]; xr = tr; xi = ti; lr[j] = xr; li[j] = xi; }
        __syncthreads();
        E[(seg * 64 + p) * 2] = xr; E[(seg * 64 + p) * 2 + 1] = xi;
        float a64r = ar, a64i = ai;
#pragma unroll
        for (int k = 0; k < 6; ++k) { const float tr = a64r * a64r - a64i * a64i, ti = 2.0f * a64r * a64i; a64r = tr; a64i = ti; }
        __syncthreads();
        float cr = 0.f, ci = 0.f;
        for (int s2 = 0; s2 < seg; ++s2) { const float er = E[(s2 * 64 + p) * 2], ei = E[(s2 * 64 + p) * 2 + 1]; const float tr = a64r * cr - a64i * ci + er, ti = a64r * ci + a64i * cr + ei; cr = tr; ci = ti; }
        float pr = ar, pi = ai; bf16* xq = xp + 128 + p;
#pragma unroll
        for (int j = 0; j < 64; ++j) { const float vr = lr[j] + pr * cr - pi * ci, vi = li[j] + pr * ci + pi * cr;
            xq[0] = (bf16)f2bf(vr); xq[64] = (bf16)f2bf(vi); xq += 128; asm volatile("" : "+v"(xq));
            const float tr = pr * ar - pi * ai, ti = pr * ai + pi * ar; pr = tr; pi = ti; }
    }
}
__device__ __forceinline__ void ssm_phase_c(const Ctx& c) {
    const bf16* U = (const bf16*)(c.ws + WS_U); const bf16* XC = (const bf16*)(c.ws + WS_XC); bf16* Z = (bf16*)(c.ws + WS_Z);
    const bf16* TF = (const bf16*)(c.ws + WS_SSMP + SSM_TF); const bf16* VF = (const bf16*)(c.ws + WS_SSMP + SSM_VF);
    const int fr = c.lane & 15, fq = c.lane >> 4;
    for (int it = c.bid; it < 256; it += c.G) {
        const int g = it >> 2, q = it & 3;
        __syncthreads();
        for (int idx = c.tid; idx < 4096; idx += NWAVES * 64) *(LAS u32x4*)(c.lds + idx * 16) = *(const u32x4*)(VF + (size_t)g * 32768 + idx * 8);
        bf16x8 tf[16];
#pragma unroll
        for (int dl = 0; dl < 16; ++dl) tf[dl] = *(const bf16x8*)(TF + ((size_t)(g * 16 + dl) * 64 + c.lane) * 8);
        __syncthreads();
        for (int cb = q + 4 * c.wave; cb < NCB; cb += 32) {
            const int cidx = 16 * cb + fr, cl = cidx < NCI ? cidx : NCI - 1;
            bf16x8 uf[8], xf[4];
#pragma unroll
            for (int ks = 0; ks < 8; ++ks) uf[ks] = *(const bf16x8*)(U + ((size_t)(g * NCI + cl)) * 256 + 32 * ks + 8 * fq);
#pragma unroll
            for (int kx = 0; kx < 4; ++kx) xf[kx] = *(const bf16x8*)(XC + ((size_t)(g * NCI + cl)) * 128 + 32 * kx + 8 * fq);
            const int b = cidx >= NCH ? 1 : 0, cc = cidx - b * NCH; const bool ok = cidx < NCI && cc >= 1;
            bf16* zp = Z + (size_t)(b * SEQ + 16 * (cc - 1)) * 1024 + g * 16 + 4 * fq;
#pragma unroll
            for (int t = 0; t < 16; ++t) { f32x4 acc = {0.f, 0.f, 0.f, 0.f};
#pragma unroll
                for (int ks = 0; ks <= t / 2; ++ks) acc = __builtin_amdgcn_mfma_f32_16x16x32_bf16(tf[t - 2 * ks], uf[ks], acc, 0, 0, 0);
#pragma unroll
                for (int kx = 0; kx < 4; ++kx) { const bf16x8 vf = *(const LAS bf16x8*)(c.lds + ((t * 4 + kx) * 64 + c.lane) * 16); acc = __builtin_amdgcn_mfma_f32_16x16x32_bf16(vf, xf[kx], acc, 0, 0, 0); }
                if (ok) { u32x2 w; w.x = pk2(gelu_tanh(acc[0]), gelu_tanh(acc[1])); w.y = pk2(gelu_tanh(acc[2]), gelu_tanh(acc[3])); *(u32x2*)(zp + (size_t)t * 1024) = w; }
                asm volatile("" ::: "memory"); }
        }
    }
}

__device__ __forceinline__ float ld_sc1_f32(const float* p) { return __uint_as_float(__hip_atomic_load((const unsigned*)p, RLX_AGENT)); }
__device__ __forceinline__ void ssm_chain(const Ctx& c, int g, int b) {
    const int fr = c.lane & 15, fq = c.lane >> 4, w = c.wave, p = c.lane;
    const bf16* Ub = (const bf16*)(c.ws + WS_U) + ((size_t)(g * NCI + b * NCH)) * 256;
    float* Sb = (float*)(c.ws + WS_S16) + ((size_t)(g * NCI + b * NCH)) * 128;
    bf16* Xb = (bf16*)(c.ws + WS_XC) + ((size_t)(g * NCI + b * NCH)) * 128;
    bf16* Z = (bf16*)(c.ws + WS_Z);
    const bf16* TF = (const bf16*)(c.ws + WS_SSMP + SSM_TF); const bf16* VF = (const bf16*)(c.ws + WS_SSMP + SSM_VF); const bf16* WF = (const bf16*)(c.ws + WS_SSMP + SSM_WF);
    LAS float* E = (LAS float*)(c.lds + LDSCTL_OFF + 4096);
    __syncthreads();
    { u32x4 fv[8], fw[8];
#pragma unroll
      for (int i = 0; i < 8; ++i) { const int idx = c.tid + i * NWAVES * 64; fv[i] = *(const u32x4*)(VF + (size_t)g * 32768 + idx * 8); fw[i] = *(const u32x4*)(WF + (size_t)g * 32768 + idx * 8); }
#pragma unroll
      for (int i = 0; i < 8; ++i) { const int idx = c.tid + i * NWAVES * 64; *(LAS u32x4*)(c.lds + idx * 16) = fv[i]; *(LAS u32x4*)(c.lds + 65536 + idx * 16) = fw[i]; } }
    {
        __syncthreads();
#pragma unroll 1
        for (int h2 = 0; h2 < 2; ++h2) {
            bf16x8 uf[2][8];
#pragma unroll
            for (int i = 0; i < 2; ++i)
#pragma unroll
                for (int ks = 0; ks < 8; ++ks) uf[i][ks] = *(const bf16x8*)(Ub + (size_t)(16 * (w + 8 * (2 * h2 + i)) + fr) * 256 + 32 * ks + 8 * fq);
#pragma unroll
            for (int i = 0; i < 2; ++i) {
#pragma unroll 2
                for (int pb = 0; pb < 8; ++pb) { f32x4 acc = {0.f, 0.f, 0.f, 0.f};
#pragma unroll
                    for (int ks = 0; ks < 8; ++ks) acc = __builtin_amdgcn_mfma_f32_16x16x32_bf16(*(const LAS bf16x8*)(c.lds + 65536 + ((pb * 8 + ks) * 64 + c.lane) * 16), uf[i][ks], acc, 0, 0, 0);
                    *(f32x4*)(Sb + (size_t)(16 * (w + 8 * (2 * h2 + i)) + fr) * 128 + 16 * pb + 4 * fq) = acc; }
            }
        }
    }
    VM_WAIT(); __syncthreads();
    {
        const float* A16 = (const float*)(c.ws + WS_SSMP + SSM_A16); const float ar = A16[(g * 64 + p) * 2], ai = A16[(g * 64 + p) * 2 + 1];
        const float* sp = Sb + (size_t)(64 * w) * 128;
        float xr = 0.f, xi = 0.f;
#pragma unroll 1
        for (int h2 = 0; h2 < 2; ++h2) { float lr[32], li[32];
#pragma unroll
            for (int j = 0; j < 32; ++j) { lr[j] = ld_sc1_f32(sp + (32 * h2 + j) * 128 + p); li[j] = ld_sc1_f32(sp + (32 * h2 + j) * 128 + 64 + p); }
#pragma unroll
            for (int j = 0; j < 32; ++j) { const float tr = ar * xr - ai * xi + lr[j], ti = ar * xi + ai * xr + li[j]; xr = tr; xi = ti; } }
        E[(w * 64 + p) * 2] = xr; E[(w * 64 + p) * 2 + 1] = xi;
        float a64r = ar, a64i = ai;
#pragma unroll
        for (int k = 0; k < 6; ++k) { const float tr = a64r * a64r - a64i * a64i, ti = 2.0f * a64r * a64i; a64r = tr; a64i = ti; }
        __syncthreads();
        xr = 0.f; xi = 0.f;
        for (int s2 = 0; s2 < w; ++s2) { const float er = E[(s2 * 64 + p) * 2], ei = E[(s2 * 64 + p) * 2 + 1]; const float tr = a64r * xr - a64i * xi + er, ti = a64r * xi + a64i * xr + ei; xr = tr; xi = ti; }
        GAS bf16* xq = (GAS bf16*)(Xb + (size_t)(64 * w + 1) * 128 + p);
#pragma unroll 1
        for (int h2 = 0; h2 < 2; ++h2) { float lr[32], li[32];
#pragma unroll
            for (int j = 0; j < 32; ++j) { lr[j] = ld_sc1_f32(sp + (32 * h2 + j) * 128 + p); li[j] = ld_sc1_f32(sp + (32 * h2 + j) * 128 + 64 + p); }
#pragma unroll
            for (int j = 0; j < 32; ++j) { const float tr = ar * xr - ai * xi + lr[j], ti = ar * xi + ai * xr + li[j]; xr = tr; xi = ti;
                xq[0] = (bf16)f2bf(xr); xq[64] = (bf16)f2bf(xi); xq += 128; asm volatile("" : "+v"(xq)); } }
    }
    VM_WAIT(); __syncthreads();
    {
        bf16x8 tf[16];
#pragma unroll
        for (int dl = 0; dl < 16; ++dl) tf[dl] = *(const bf16x8*)(TF + ((size_t)(g * 16 + dl) * 64 + c.lane) * 8);
        bf16x8 uf[8], xf[4], un[8], xn[4];
        { const int cl = 16 * w + fr;
#pragma unroll
            for (int ks = 0; ks < 8; ++ks) uf[ks] = *(const bf16x8*)(Ub + (size_t)cl * 256 + 32 * ks + 8 * fq);
#pragma unroll
            for (int kx = 0; kx < 4; ++kx) xf[kx] = *(const bf16x8*)(Xb + (size_t)cl * 128 + 32 * kx + 8 * fq); }
#pragma unroll 1
        for (int cb = w; cb < 33; cb += 8) {
            const int ci_ = 16 * cb + fr;
            if (cb + 8 < 33) { const int cn = 16 * (cb + 8) + fr, cl = cn < NCH ? cn : NCH - 1;
#pragma unroll
                for (int ks = 0; ks < 8; ++ks) un[ks] = *(const bf16x8*)(Ub + (size_t)cl * 256 + 32 * ks + 8 * fq);
#pragma unroll
                for (int kx = 0; kx < 4; ++kx) xn[kx] = *(const bf16x8*)(Xb + (size_t)cl * 128 + 32 * kx + 8 * fq); }
            const bool ok = ci_ >= 1 && ci_ < NCH;
            bf16* zp = Z + (size_t)(b * SEQ + 16 * (ci_ - 1)) * 1024 + g * 16 + 4 * fq;
            u32x2 wprev = {0u, 0u};
#pragma unroll
            for (int t = 0; t < 16; ++t) { f32x4 acc = {0.f, 0.f, 0.f, 0.f};
#pragma unroll
                for (int ks = 0; ks <= t / 2; ++ks) acc = __builtin_amdgcn_mfma_f32_16x16x32_bf16(tf[t - 2 * ks], uf[ks], acc, 0, 0, 0);
#pragma unroll
                for (int kx = 0; kx < 4; ++kx) { const bf16x8 vf = *(const LAS bf16x8*)(c.lds + ((t * 4 + kx) * 64 + c.lane) * 16); acc = __builtin_amdgcn_mfma_f32_16x16x32_bf16(vf, xf[kx], acc, 0, 0, 0); }
                u32x2 wv; wv.x = pk2(gelu_tanh(acc[0]), gelu_tanh(acc[1])); wv.y = pk2(gelu_tanh(acc[2]), gelu_tanh(acc[3]));
                if constexpr (Z_PAIR) {
                    if (t & 1) { const auto rx = __builtin_amdgcn_permlane16_swap(wprev.x, wv.x, false, false), ry = __builtin_amdgcn_permlane16_swap(wprev.y, wv.y, false, false);
                        if (ok) *(u32x4*)(zp + (size_t)(t - 1 + (fq & 1)) * 1024 - 4 * (fq & 1)) = (u32x4){rx[0], ry[0], rx[1], ry[1]}; }
                    else wprev = wv;
                } else { if (ok) *(u32x2*)(zp + (size_t)t * 1024) = wv; }
                asm volatile("" ::: "memory"); }
#pragma unroll
            for (int ks = 0; ks < 8; ++ks) uf[ks] = un[ks];
#pragma unroll
            for (int kx = 0; kx < 4; ++kx) xf[kx] = xn[kx];
        }
    }
}

template <bool FIRST>
__device__ __forceinline__ void attn_qblocks(LAS unsigned char* Ks, LAS unsigned char* Vs, const bf16* qp, bf16x8 (&qc)[2], bf16* ao, int t0, float sink, int fr, int fq) {
    constexpr int KST = 144, VST = 432;
#pragma unroll 2
    for (int qa = 0; qa < 4; ++qa) {
        bf16x8 qf[2]; qf[0] = qc[0]; qf[1] = qc[1];
        if (qa < 3) { qc[0] = *(const bf16x8*)(qp + (size_t)(16 * (qa + 1)) * 1024); qc[1] = *(const bf16x8*)(qp + (size_t)(16 * (qa + 1)) * 1024 + 32); }
        f32x4 s[10];
#pragma unroll
        for (int jb = 0; jb < 10; ++jb) { const int j = jb < 9 ? qa + jb : 12; f32x4 acc = {0.f, 0.f, 0.f, 0.f};
#pragma unroll
            for (int ks = 0; ks < 2; ++ks) { const bf16x8 kf = *(const LAS bf16x8*)(Ks + (16 * j + fr) * KST + (32 * ks + 8 * fq) * 2); acc = __builtin_amdgcn_mfma_f32_16x16x32_bf16(kf, qf[ks], acc, 0, 0, 0); }
            s[jb] = acc; }
#pragma unroll
        for (int i = 0; i < 4; ++i) { if (4 * fq + i - fr < 1) s[0][i] = -1e30f; if (4 * fq + i - fr > 0) s[8][i] = -1e30f; }
        if constexpr (FIRST) {
#pragma unroll
            for (int jb = 0; jb < 9; ++jb)
#pragma unroll
                for (int i = 0; i < 4; ++i) if (t0 - 128 + 16 * (qa + jb) + 4 * fq + i < 0) s[jb][i] = -1e30f; }
        float mx = sink;
#pragma unroll
        for (int jb = 0; jb < 10; ++jb) mx = fmaxf(fmaxf(mx, fmaxf(s[jb][0], s[jb][1])), fmaxf(s[jb][2], s[jb][3]));
        mx = fmaxf(mx, __shfl_xor(mx, 16)); mx = fmaxf(mx, __shfl_xor(mx, 32));
        float l = 0.f;
#pragma unroll
        for (int jb = 0; jb < 10; ++jb)
#pragma unroll
            for (int i = 0; i < 4; ++i) { s[jb][i] = __builtin_amdgcn_exp2f(s[jb][i] - mx); l += s[jb][i]; }
        l += __shfl_xor(l, 16); l += __shfl_xor(l, 32); l += __builtin_amdgcn_exp2f(sink - mx);
        f32x4 o[4];
#pragma unroll
        for (int db = 0; db < 4; ++db) o[db] = (f32x4){0.f, 0.f, 0.f, 0.f};
#pragma unroll
        for (int pr = 0; pr < 5; ++pr) { const int ja = qa + 2 * pr, jbk = pr < 4 ? qa + 2 * pr + 1 : 12;
            u32x4 pw; pw.x = pk2(s[2 * pr][0], s[2 * pr][1]); pw.y = pk2(s[2 * pr][2], s[2 * pr][3]); pw.z = pk2(s[2 * pr + 1][0], s[2 * pr + 1][1]); pw.w = pk2(s[2 * pr + 1][2], s[2 * pr + 1][3]);
            const bf16x8 pf = __builtin_bit_cast(bf16x8, pw);
#pragma unroll
            for (int db = 0; db < 4; ++db) { const u32x2 lo = *(const LAS u32x2*)(Vs + (16 * db + fr) * VST + (16 * ja + 4 * fq) * 2), hi = *(const LAS u32x2*)(Vs + (16 * db + fr) * VST + (16 * jbk + 4 * fq) * 2);
                u32x4 vw; vw.x = lo.x; vw.y = lo.y; vw.z = hi.x; vw.w = hi.y; o[db] = __builtin_amdgcn_mfma_f32_16x16x32_bf16(__builtin_bit_cast(bf16x8, vw), pf, o[db], 0, 0, 0); } }
        const float inv = __builtin_amdgcn_rcpf(l);
#pragma unroll
        for (int db = 0; db < 4; ++db) { u32x2 w; w.x = pk2(o[db][0] * inv, o[db][1] * inv); w.y = pk2(o[db][2] * inv, o[db][3] * inv); *(u32x2*)(ao + (size_t)(16 * qa) * 1024 + 16 * db) = w; }
    }
}
__device__ __forceinline__ void attn_fast(const Args& a, const Ctx& c) {
    const bf16* Q = (const bf16*)(c.ws + WS_Q); const bf16* Kb = (const bf16*)(c.ws + WS_K); const bf16* Vt = (const bf16*)(c.ws + WS_VT); bf16* AO = (bf16*)(c.ws + WS_BRA) + (size_t)M * 1024;
    unsigned* qctr = (unsigned*)(c.ws + WS_CTL) + CW_Q;
    LAS unsigned char* Ks = c.lds; LAS unsigned char* Vs = c.lds + 30720; volatile LAS int* uslot = (volatile LAS int*)(c.lds + LDSCTL_OFF + 64);
    constexpr int KST = 144, VST = 432;
    const int fr = c.lane & 15, fq = c.lane >> 4;
    volatile LAS int* ncall = (volatile LAS int*)(c.lds + LDSCTL_OFF + 68);
    __syncthreads(); if (c.tid == 0) *ncall = *ncall + 1; __syncthreads();
    const int qbase = (*ncall - 1) * (512 + c.G);
    int nxt = 0; if (c.tid == 0) nxt = (int)__hip_atomic_fetch_add(qctr, 1u, RLX_AGENT) - qbase;
    for (;;) {
        __syncthreads();
        if (c.tid == 0) *uslot = nxt;
        __syncthreads();
        const int unit = *uslot; if (unit >= 512) break;
        if (c.tid == 0) nxt = (int)__hip_atomic_fetch_add(qctr, 1u, RLX_AGENT) - qbase;
        const int b = unit >> 8, kvh = (unit >> 7) & 1, t0 = 64 * (unit & 127);
        const int head = kvh * 8 + c.wave;
        const bf16* qp = Q + (size_t)(b * SEQ + t0 + fr) * 1024 + head * 64 + 8 * fq;
        bf16x8 qc[2]; qc[0] = *(const bf16x8*)qp; qc[1] = *(const bf16x8*)(qp + 32);
        for (int idx = c.tid; idx < 1664; idx += NWAVES * 64) { const int row = idx >> 3, pc = idx & 7; int pos; bool ok = true;
            if (row < 192) { const int tok = t0 - 128 + row; ok = tok >= 0; pos = NMETA + tok; } else pos = row - 192;
            u32x4 v = {0u, 0u, 0u, 0u}; if (ok) v = *(const u32x4*)(Kb + ((size_t)(b * LTOT + pos)) * 128 + kvh * 64 + pc * 8);
            *(LAS u32x4*)(Ks + row * KST + pc * 16) = v; }
        for (int idx = c.tid; idx < 1664; idx += NWAVES * 64) { const int row = idx >> 3, pc = idx & 7; int pos; bool ok = true;
            if (row < 192) { const int tok = t0 - 128 + row; ok = tok >= 0; pos = NMETA + tok; } else pos = row - 192;
            u32x4 v = {0u, 0u, 0u, 0u}; if (ok) v = *(const u32x4*)(Vt + ((size_t)(b * LTOT + pos)) * 128 + kvh * 64 + pc * 8);
            LAS bf16* vd = (LAS bf16*)(Vs + (8 * pc) * VST + row * 2);
            vd[0 * (VST / 2)] = (bf16)(v.x & 0xffffu); vd[1 * (VST / 2)] = (bf16)(v.x >> 16); vd[2 * (VST / 2)] = (bf16)(v.y & 0xffffu); vd[3 * (VST / 2)] = (bf16)(v.y >> 16);
            vd[4 * (VST / 2)] = (bf16)(v.z & 0xffffu); vd[5 * (VST / 2)] = (bf16)(v.z >> 16); vd[6 * (VST / 2)] = (bf16)(v.w & 0xffffu); vd[7 * (VST / 2)] = (bf16)(v.w >> 16); }
        __syncthreads();
        const float sink = a.in[14][head] * 1.4426950408889634f;
        if (t0 < 128) attn_qblocks<true>(Ks, Vs, qp, qc, AO + (size_t)(b * SEQ + t0 + fr) * 1024 + head * 64 + 4 * fq, t0, sink, fr, fq);
        else attn_qblocks<false>(Ks, Vs, qp, qc, AO + (size_t)(b * SEQ + t0 + fr) * 1024 + head * 64 + 4 * fq, t0, sink, fr, fq);
    }
}

constexpr size_t SSM_WRF = 16 * MiB;
__device__ __forceinline__ void p0_router_frags(const Args& a, const Ctx& c) {
    bf16* WRF = (bf16*)(c.ws + WS_SSMP + SSM_WRF); const float* wr = a.in[19];
    const int gt = c.bid * (NWAVES * 64) + c.tid, ngt = c.G * NWAVES * 64;
    for (int idx = gt; idx < 4096; idx += ngt) { const int ks = idx >> 7, eb = (idx >> 6) & 1, ln = idx & 63, fr = ln & 15, fq = ln >> 4; float hi[8], lo[8];
#pragma unroll
        for (int e = 0; e < 8; ++e) { const float w = wr[(size_t)(32 * ks + 8 * fq + e) * 32 + 16 * eb + fr]; const float h = bf2f((bf16)f2bf(w)); hi[e] = h; lo[e] = w - h; }
        *(u32x4*)(WRF + (size_t)idx * 8) = pack8(hi); *(u32x4*)(WRF + 32768 + (size_t)idx * 8) = pack8(lo); }
}

__device__ __forceinline__ int swap23(int p) { return (p & 3) | ((p & 4) << 1) | ((p & 8) >> 1); }
__device__ __forceinline__ void tr_item(const float* __restrict__ W, int ldw, int k0, int n0src, bool perm, bf16* WT, int ldt, int rowdst0, int kdst, LAS float* scr, int lane) {
    float tv[32];
#pragma unroll
    for (int i = 0; i < 32; ++i) tv[i] = __builtin_nontemporal_load(W + (size_t)(k0 + 2 * i + (lane >> 5)) * ldw + n0src + (lane & 31));
#pragma unroll
    for (int i = 0; i < 32; ++i) scr[(2 * i + (lane >> 5)) * 33 + (lane & 31)] = tv[i];
    LDS_WAIT(); asm volatile("" ::: "memory");
    const int c = lane & 7;
#pragma unroll
    for (int j = 0; j < 4; ++j) { const int n = (lane >> 3) + 8 * j; const int ns = (perm && n < 16) ? swap23(n) : n; const LAS float* s = scr + (8 * c) * 33 + ns;
        u32x4 o; o.x = pk2(s[0 * 33], s[1 * 33]); o.y = pk2(s[2 * 33], s[3 * 33]); o.z = pk2(s[4 * 33], s[5 * 33]); o.w = pk2(s[6 * 33], s[7 * 33]);
        *(u32x4*)(WT + (size_t)(rowdst0 + n) * ldt + kdst + k0 + 8 * c) = o; }
    LDS_WAIT(); asm volatile("" ::: "memory");
}
struct Tr8Item { const float* src; unsigned char* dst; int ldw; };
__device__ __forceinline__ Tr8Item tr8_item_of(const Args& a, unsigned char* Wgu8, unsigned char* Wdn8, int id, int wave, int lane) {
    Tr8Item t;
    if (id < 2048) { const int e = id >> 6, kb = (id >> 3) & 7, jt = id & 7; const int col = lane < 32 ? 128 * jt + 4 * lane : 1024 + 128 * jt + 4 * (lane - 32);
        t.src = a.in[21] + (size_t)e * 1024 * 2048 + (size_t)(128 * kb + 16 * wave) * 2048 + col; t.ldw = 2048; t.dst = Wgu8 + (size_t)e * 2048 * 1024 + (size_t)(256 * jt) * 1024 + 128 * kb; }
    else { const int r = id - 2048, e = r >> 5, kb = (r >> 2) & 7, nb = r & 3;
        t.src = a.in[23] + (size_t)e * 1024 * 1024 + (size_t)(128 * kb + 16 * wave) * 1024 + 256 * nb + 4 * lane; t.ldw = 1024; t.dst = Wdn8 + (size_t)e * 1024 * 1024 + (size_t)(256 * nb) * 1024 + 128 * kb; }
    return t;
}
__device__ __forceinline__ void tr8_load(const Tr8Item& t, f32x4 (&v)[16]) {
#pragma unroll
    for (int j = 0; j < 16; ++j) v[j] = __builtin_nontemporal_load((const f32x4*)(t.src + (size_t)j * t.ldw));
}
__device__ __forceinline__ void tr8_finish(const Tr8Item& t, const f32x4 (&v)[16], LAS unsigned char* tile, int tid, int wave, int lane) {
    __syncthreads();
#pragma unroll
    for (int cc = 0; cc < 4; ++cc) { u32x4 o;
        o.x = pk4_fp8(v[0][cc] * 16.0f, v[1][cc] * 16.0f, v[2][cc] * 16.0f, v[3][cc] * 16.0f);    o.y = pk4_fp8(v[4][cc] * 16.0f, v[5][cc] * 16.0f, v[6][cc] * 16.0f, v[7][cc] * 16.0f);
        o.z = pk4_fp8(v[8][cc] * 16.0f, v[9][cc] * 16.0f, v[10][cc] * 16.0f, v[11][cc] * 16.0f); o.w = pk4_fp8(v[12][cc] * 16.0f, v[13][cc] * 16.0f, v[14][cc] * 16.0f, v[15][cc] * 16.0f);
        *(LAS u32x4*)(tile + (4 * lane + cc) * 144 + 16 * wave) = o; }
    __syncthreads();
#pragma unroll
    for (int i = 0; i < 4; ++i) { const int p = tid + 512 * i, n = p >> 3, q = p & 7;
        __builtin_nontemporal_store(*(const LAS u32x4*)(tile + n * 144 + 16 * q), (u32x4*)(t.dst + (size_t)n * 1024 + 16 * q)); }
}
__device__ __forceinline__ void tr8_run(const Args& a, const Ctx& c, int first, int stride, int lo, int hi) {
    unsigned char* Wgu8 = c.ws + WS_WGU; unsigned char* Wdn8 = c.ws + WS_WDN;
    f32x4 va[16], vb[16];
    int id = lo + first;
    Tr8Item ta = tr8_item_of(a, Wgu8, Wdn8, id < hi ? id : lo, c.wave, c.lane), tb = ta;
    if (id < hi) tr8_load(ta, va);
    while (id < hi) {
        const int id1 = id + stride;
        if (id1 < hi) { tb = tr8_item_of(a, Wgu8, Wdn8, id1, c.wave, c.lane); tr8_load(tb, vb); }
        tr8_finish(ta, va, c.lds, c.tid, c.wave, c.lane);
        if (id1 >= hi) break;
        const int id2 = id1 + stride;
        if (id2 < hi) { ta = tr8_item_of(a, Wgu8, Wdn8, id2, c.wave, c.lane); tr8_load(ta, va); }
        tr8_finish(tb, vb, c.lds, c.tid, c.wave, c.lane);
        id = id2;
    }
    __syncthreads();
}
__device__ __forceinline__ void rms_row_to_bf16(const float* xrow, const float* gain, bf16* orow, int lane) {
    f32x4 v[4]; float s = 0.f;
#pragma unroll
    for (int j = 0; j < 4; ++j) { v[j] = *(const f32x4*)(xrow + 4 * lane + 256 * j); s += (v[j].x * v[j].x + v[j].y * v[j].y) + (v[j].z * v[j].z + v[j].w * v[j].w); }
    const float rstd = 1.0f / sqrtf(wave_sum(s) * (1.0f / D) + RMS_EPS);
#pragma unroll
    for (int j = 0; j < 4; ++j) { const f32x4 g = *(const f32x4*)(gain + 4 * lane + 256 * j); u32x2 w; w.x = pk2(v[j].x * rstd * g.x, v[j].y * rstd * g.y); w.y = pk2(v[j].z * rstd * g.z, v[j].w * rstd * g.w);
        *(u32x2*)(orow + 4 * lane + 256 * j) = w; }
}
#ifndef XN_ROWS
#define XN_ROWS 4
#endif
#ifndef P0REP
#define P0REP 0
#endif
#ifdef FAST_MIX
constexpr bool FAST_MIX_P0 = FAST_MIX != 0;
#else
constexpr bool FAST_MIX_P0 = false;
#endif
__device__ __forceinline__ void p0_prologue(const Args& a, const Ctx& c) {
    for (int rp = 0; rp < 1 + (P0REP & 1); ++rp)
    for (int g = c.bid; g < 64; g += c.G) p0_ssm_prep(a, c, g);
    LAS float* scr = (LAS float*)(c.lds + c.wave * 16384);
    bf16* WinT = (bf16*)(c.ws + WS_WIN); bf16* WgluT = (bf16*)(c.ws + WS_WGLU); bf16* WbrT = (bf16*)(c.ws + WS_WBR); bf16* WoutT = (bf16*)(c.ws + WS_WOUT);
    constexpr int NI_IN = 16 * 136, NI_SQ = 512, NI_ALL = NI_IN + 4 * NI_SQ;
    for (int rp = 0; rp < 1 + ((P0REP >> 1) & 1); ++rp)
    for (int it = c.gw; it < NI_ALL; it += c.ngw) {
        int r = it;
        if (r < NI_IN) { const int kb = r / 136, nb = r % 136, n0 = 32 * nb; const bool perm = (n0 >= 1024 && n0 < 2176 && (n0 & 63) == 0);
            const int nd = n0 < 2304 ? n0 : (n0 < 3328 ? 2304 + ((n0 - 2304) >> 7) * 256 + ((n0 - 2304) & 127) : 2304 + ((n0 - 3328) >> 7) * 256 + 128 + ((n0 - 3328) & 127));
            tr_item(a.in[3], INW, 64 * kb, n0, perm, WinT, 1024, GATE_RATIO ? nd : n0, 0, scr, c.lane); continue; } r -= NI_IN;
        if (r < NI_SQ) { tr_item(a.in[12], 1024, 64 * (r >> 5), 32 * (r & 31), false, WgluT, 1024, 32 * (r & 31), 0, scr, c.lane); continue; } r -= NI_SQ;
        if (r < NI_SQ) { tr_item(a.in[15], 1024, 64 * (r >> 5), 32 * (r & 31), false, WbrT, 1024, 32 * (r & 31), 0, scr, c.lane); continue; } r -= NI_SQ;
        if (r < NI_SQ) { tr_item(a.in[16], 1024, 64 * (r >> 5), 32 * (r & 31), false, WbrT, 1024, 1024 + 32 * (r & 31), 0, scr, c.lane); continue; } r -= NI_SQ;
        tr_item(a.in[17], 1024, 64 * (r >> 5), 32 * (r & 31), false, WoutT, 1024, 32 * (r & 31), 0, scr, c.lane);
    }
    for (int rp = 0; rp < 1 + ((P0REP >> 2) & 1); ++rp) tr8_run(a, c, c.bid, c.G, 0, 3072 - NCV_ITEMS);
    bf16* XN = (bf16*)(c.ws + WS_XN); constexpr int XR = XN_ROWS;
    for (int rp = 0; rp < 1 + ((P0REP >> 3) & 1); ++rp)
    for (int m0 = XR * c.gw; m0 < MP; m0 += XR * c.ngw) {
        f32x4 v[XR][4]; float ss[XR];
#pragma unroll
        for (int r = 0; r < XR; ++r) { const int m = m0 + r; const float* xrow = m < M ? a.in[0] + (size_t)m * D : a.in[1] + (size_t)((m < M + NMETA ? m : M) - M) * D;
#pragma unroll
            for (int j = 0; j < 4; ++j) v[r][j] = __builtin_nontemporal_load((const f32x4*)(xrow + 4 * c.lane + 256 * j)); }
#pragma unroll
        for (int r = 0; r < XR; ++r) { float s = 0.f;
#pragma unroll
            for (int j = 0; j < 4; ++j) s += (v[r][j].x * v[r][j].x + v[r][j].y * v[r][j].y) + (v[r][j].z * v[r][j].z + v[r][j].w * v[r][j].w);
            ss[r] = wave_sum(s); }
#pragma unroll
        for (int r = 0; r < XR; ++r) { const int m = m0 + r; const float rstd = (m < M + NMETA) ? 1.0f / sqrtf(ss[r] * (1.0f / D) + RMS_EPS) : 0.f;
#pragma unroll
            for (int j = 0; j < 4; ++j) { const f32x4 g = *(const f32x4*)(a.in[2] + 4 * c.lane + 256 * j); u32x2 w; w.x = pk2(v[r][j].x * rstd * g.x, v[r][j].y * rstd * g.y); w.y = pk2(v[r][j].z * rstd * g.z, v[r][j].w * rstd * g.w);
                *(u32x2*)(XN + (size_t)m * D + 4 * c.lane + 256 * j) = w; } }
    }
    p0_router_frags(a, c);
    const int gt = c.bid * (NWAVES * 64) + c.tid, ngt = c.G * NWAVES * 64;
    float* rot = (float*)(c.ws + WS_ROT);
    for (int i = gt; i < LTOT * 8; i += ngt) { const int pos = i >> 3, j = i & 7;
        const float invs[8] = {1.0f, 0.1939227432012558f, 0.03760603070259094f, 0.007292664609849453f, 0.0014142135623842478f, 0.00027424818836152554f, 5.318296098266728e-05f, 1.0313386155758053e-05f};
        float inv = invs[0];
#pragma unroll
        for (int q = 1; q < 8; ++q) inv = (j == q) ? invs[q] : inv;
        const float ang = (float)pos * inv; const double rev = (double)ang * 0.15915494309189535; const float fr_ = (float)(rev - floor(rev));
        rot[pos * 16 + j] = __builtin_amdgcn_cosf(fr_); rot[pos * 16 + 8 + j] = __builtin_amdgcn_sinf(fr_); }
    if constexpr (!FAST_MIX_P0) {
    float* Ab = (float*)(c.ws + WS_SSMP); float* BB = Ab + 16384;
    for (int i = gt; i < 4096; i += ngt) { const int g = i >> 6;
        const float lr = a.in[4][i], li = a.in[5][i], dt = expf(a.in[6][g]), mag = expf(dt * lr), ar = mag * cosf(dt * li), ai = mag * sinf(dt * li);
        const float den = lr * lr + li * li, nr = ar - 1.0f, ni = ai, fr = (nr * lr + ni * li) / den, fi = (ni * lr - nr * li) / den;
        Ab[2 * i] = ar; Ab[2 * i + 1] = ai;
        for (int h = 0; h < 16; ++h) { const float br = a.in[7][i * 16 + h], bi = a.in[8][i * 16 + h]; BB[(i * 16 + h) * 2] = fr * br - fi * bi; BB[(i * 16 + h) * 2 + 1] = fr * bi + fi * br; }
    }
    }
}

__device__ __forceinline__ void p2_ssm_naive(const Args& a, const Ctx& c) {
    const float* Ab = (const float*)(c.ws + WS_SSMP); const float* BB = Ab + 16384;
    const bf16* U = (const bf16*)(c.ws + WS_U); bf16* Z = (bf16*)(c.ws + WS_Z);
    for (int it = c.gw; it < 128; it += c.ngw) {
        const int g = it >> 1, b = it & 1, p = c.lane, gp = g * 64 + p;
        const float ar = Ab[2 * gp], ai = Ab[2 * gp + 1];
        float bbr[16], bbi[16], cr[16], ci[16], dd[16];
#pragma unroll
        for (int h = 0; h < 16; ++h) { bbr[h] = BB[(gp * 16 + h) * 2]; bbi[h] = BB[(gp * 16 + h) * 2 + 1]; cr[h] = a.in[9][(g * 16 + h) * 64 + p]; ci[h] = a.in[10][(g * 16 + h) * 64 + p]; dd[h] = a.in[11][g * 16 + h]; }
        float xr = 0.f, xi = 0.f;
        const bf16* up = U + (size_t)((g * 2 + b) * NCH) * 256;
        for (int t = 0; t < LTOT; ++t) {
            float u[16]; { float t0[8], t1[8]; unpack8(*(const u32x4*)(up + t * 16), t0); unpack8(*(const u32x4*)(up + t * 16 + 8), t1);
#pragma unroll
                for (int h = 0; h < 8; ++h) { u[h] = t0[h]; u[8 + h] = t1[h]; } }
            float br_ = 0.f, bi_ = 0.f;
#pragma unroll
            for (int h = 0; h < 16; ++h) { br_ += bbr[h] * u[h]; bi_ += bbi[h] * u[h]; }
            const float nxr = ar * xr - ai * xi + br_, nxi = ar * xi + ai * xr + bi_; xr = nxr; xi = nxi;
            if (t >= NMETA) {
                float mine = 0.f;
#pragma unroll
                for (int h = 0; h < 16; ++h) { float v = wave_sum(cr[h] * xr - ci[h] * xi); if (c.lane == h) mine = v + dd[h] * u[h]; }
                if (c.lane < 16) Z[(size_t)(b * SEQ + t - NMETA) * 1024 + g * 16 + c.lane] = (bf16)f2bf(gelu_tanh(mine));
            }
        }
    }
}
__device__ __forceinline__ float dot8(u32x4 q, u32x4 k) {
    return (bflo(q.x) * bflo(k.x) + bfhi(q.x) * bfhi(k.x)) + (bflo(q.y) * bflo(k.y) + bfhi(q.y) * bfhi(k.y)) + (bflo(q.z) * bflo(k.z) + bfhi(q.z) * bfhi(k.z)) + (bflo(q.w) * bflo(k.w) + bfhi(q.w) * bfhi(k.w));
}
__device__ __forceinline__ void p2_attn_naive(const Args& a, const Ctx& c) {
    const bf16* Q = (const bf16*)(c.ws + WS_Q); const bf16* Kb = (const bf16*)(c.ws + WS_K); const bf16* Vt = (const bf16*)(c.ws + WS_VT); bf16* BRA = (bf16*)(c.ws + WS_BRA);
    const int lane = c.lane;
    for (int it = c.gw; it < M * 16; it += c.ngw) {
        const int r = it >> 4, h = it & 15, kvh = h >> 3, b = r >> 13, t = r & (SEQ - 1);
        u32x4 qv[8];
#pragma unroll
        for (int i = 0; i < 8; ++i) qv[i] = *(const u32x4*)(Q + (size_t)r * 1024 + h * 64 + 8 * i);
        float s[3];
#pragma unroll
        for (int sl = 0; sl < 3; ++sl) {
            int pos; bool ok;
            if (sl < 2) { const int tok = t - 127 + lane + 64 * sl; ok = tok >= 0; pos = NMETA + (ok ? tok : 0); } else { ok = lane < NMETA; pos = ok ? lane : 0; }
            const bf16* kp = Kb + ((size_t)(b * LTOT + pos)) * 128 + kvh * 64; float acc = 0.f;
#pragma unroll
            for (int i = 0; i < 8; ++i) acc += dot8(qv[i], *(const u32x4*)(kp + 8 * i));
            s[sl] = ok ? acc : -1e30f;
        }
        const float sink = a.in[14][h] * 1.4426950408889634f;
        const float mx = wave_max(fmaxf(fmaxf(s[0], s[1]), fmaxf(s[2], sink)));
        const float p0 = exp2f(s[0] - mx), p1 = exp2f(s[1] - mx), p2 = exp2f(s[2] - mx);
        const float l = wave_sum(p0 + p1 + p2) + exp2f(sink - mx);
        const bf16* vrow = Vt + (size_t)(b * LTOT) * 128 + kvh * 64 + lane;
        float o = 0.f;
        for (int j = 0; j < 128; ++j) { const int tok = t - 127 + j; const float pj = __shfl(j < 64 ? p0 : p1, j & 63); if (tok >= 0) o += pj * bf2f(vrow[(size_t)(NMETA + tok) * 128]); }
        for (int j = 0; j < NMETA; ++j) { const float pj = __shfl(p2, j); o += pj * bf2f(vrow[(size_t)j * 128]); }
        BRA[(size_t)(M + r) * 1024 + h * 64 + lane] = (bf16)f2bf(o / l);
    }
}

__device__ __forceinline__ void router_stage(const Args& a, const Ctx& c) {
    LAS float* gl = (LAS float*)(c.lds + LDSCTL_OFF + 8192);
    __syncthreads();
    { u32x4 wv[16];
#pragma unroll
      for (int i = 0; i < 16; ++i) wv[i] = *(const u32x4*)(c.ws + WS_SSMP + SSM_WRF + (size_t)(c.tid + i * NWAVES * 64) * 16);
#pragma unroll
      for (int i = 0; i < 16; ++i) *(LAS u32x4*)(c.lds + (c.tid + i * NWAVES * 64) * 16) = wv[i]; }
    for (int idx = c.tid; idx < 1024; idx += NWAVES * 64) gl[idx] = a.in[18][idx];
}
__device__ __forceinline__ void p6_router(const Args& a, const Ctx& c, int tile0, bool staged = false) {
    const float* H1 = (const float*)(c.ws + WS_H1); unsigned char* XG = c.ws + WS_HN2;
    int* TE = (int*)(c.ws + WS_TOK); int* TP = TE + M * 4; float* RS = (float*)(c.ws + WS_TOK) + M * 16 + NSLOT * 2;
    int* TOKOF = (int*)(c.ws + WS_TOKOF); float* GATEOF = (float*)(c.ws + WS_GATEOF); float* RSOF = (float*)(c.ws + WS_RSOF);
    unsigned* cnt = (unsigned*)(c.ws + WS_CTL) + CW_CNT;
    const float* brt = a.in[20];
    LAS float* gl = (LAS float*)(c.lds + LDSCTL_OFF + 8192);
    LAS unsigned* hist = (LAS unsigned*)(c.lds + LDSCTL_OFF + 12288); LAS unsigned* ebase = hist + 32;
    const int lane = c.lane, fr = lane & 15, fq = lane >> 4;
    if (!staged) router_stage(a, c);
    for (int t0 = 0; t0 < (tile0 >= 0 ? 1 : M / 16); t0 += 4 * c.G) {
        if (c.tid < 32) hist[c.tid] = 0u;
        __syncthreads();
        const int kh = c.wave >> 2;
        const int tile = tile0 >= 0 ? tile0 + (c.wave & 3) : t0 + (c.wave & 3) * c.G + c.bid; const bool work = tile < M / 16;
        LAS float* part = (LAS float*)(c.lds + LDSCTL_OFF + 16384) + ((c.wave & 3) * 64 + lane) * 9;
        int te[4]; unsigned rk[4]; float gts[4] = {0.f, 0.f, 0.f, 0.f}, rstd_keep = 0.f; const int row = 16 * tile + fr;
        f32x4 racc0 = {0.f, 0.f, 0.f, 0.f}, racc1 = {0.f, 0.f, 0.f, 0.f}; float rss = 0.f;
        if (work) {
            const float* xr = H1 + (size_t)row * D + 8 * fq;
            f32x4 acc0 = {0.f, 0.f, 0.f, 0.f}, acc1 = {0.f, 0.f, 0.f, 0.f}; float ss = 0.f;
#pragma unroll 4
            for (int ks = 16 * kh; ks < 16 * kh + 16; ++ks) {
                const f32x4 x0 = *(const f32x4*)(xr + 32 * ks), x1 = *(const f32x4*)(xr + 32 * ks + 4);
                const f32x4 g0 = *(const LAS f32x4*)(gl + 32 * ks + 8 * fq), g1 = *(const LAS f32x4*)(gl + 32 * ks + 8 * fq + 4);
                ss += (x0.x * x0.x + x0.y * x0.y) + (x0.z * x0.z + x0.w * x0.w) + (x1.x * x1.x + x1.y * x1.y) + (x1.z * x1.z + x1.w * x1.w);
                const f32x4 v0 = x0 * g0, v1 = x1 * g1;
                u32x4 hw; hw.x = pk2(v0.x, v0.y); hw.y = pk2(v0.z, v0.w); hw.z = pk2(v1.x, v1.y); hw.w = pk2(v1.z, v1.w);
                { u32x2 w8; w8.x = pk4_fp8(v0.x, v0.y, v0.z, v0.w); w8.y = pk4_fp8(v1.x, v1.y, v1.z, v1.w); *(u32x2*)(XG + (size_t)row * D + 32 * ks + 8 * fq) = w8; }
                u32x4 lw; lw.x = pk2(v0.x - bflo(hw.x), v0.y - bfhi(hw.x)); lw.y = pk2(v0.z - bflo(hw.y), v0.w - bfhi(hw.y)); lw.z = pk2(v1.x - bflo(hw.z), v1.y - bfhi(hw.z)); lw.w = pk2(v1.z - bflo(hw.w), v1.w - bfhi(hw.w));
                const bf16x8 hi = __builtin_bit_cast(bf16x8, hw), lo = __builtin_bit_cast(bf16x8, lw);
                const bf16x8 wh0 = *(const LAS bf16x8*)(c.lds + ((ks * 2 + 0) * 64 + lane) * 16), wh1 = *(const LAS bf16x8*)(c.lds + ((ks * 2 + 1) * 64 + lane) * 16);
                const bf16x8 wl0 = *(const LAS bf16x8*)(c.lds + 65536 + ((ks * 2 + 0) * 64 + lane) * 16), wl1 = *(const LAS bf16x8*)(c.lds + 65536 + ((ks * 2 + 1) * 64 + lane) * 16);
                acc0 = __builtin_amdgcn_mfma_f32_16x16x32_bf16(wh0, hi, acc0, 0, 0, 0); acc1 = __builtin_amdgcn_mfma_f32_16x16x32_bf16(wh1, hi, acc1, 0, 0, 0);
                acc0 = __builtin_amdgcn_mfma_f32_16x16x32_bf16(wl0, hi, acc0, 0, 0, 0); acc1 = __builtin_amdgcn_mfma_f32_16x16x32_bf16(wl1, hi, acc1, 0, 0, 0);
                acc0 = __builtin_amdgcn_mfma_f32_16x16x32_bf16(wh0, lo, acc0, 0, 0, 0); acc1 = __builtin_amdgcn_mfma_f32_16x16x32_bf16(wh1, lo, acc1, 0, 0, 0);
            }
            racc0 = acc0; racc1 = acc1; rss = ss;
            if (kh == 1) { part[0] = acc0[0]; part[1] = acc0[1]; part[2] = acc0[2]; part[3] = acc0[3]; part[4] = acc1[0]; part[5] = acc1[1]; part[6] = acc1[2]; part[7] = acc1[3]; part[8] = ss; }
        }
        __syncthreads();
        if (work && kh == 0) {
            f32x4 acc0, acc1; float ss;
            acc0 = racc0; acc1 = racc1; ss = rss;
            acc0[0] += part[0]; acc0[1] += part[1]; acc0[2] += part[2]; acc0[3] += part[3]; acc1[0] += part[4]; acc1[1] += part[5]; acc1[2] += part[6]; acc1[3] += part[7]; ss += part[8];
            ss += __shfl_xor(ss, 16); ss += __shfl_xor(ss, 32);
            const float rstd = 1.0f / sqrtf(ss * (1.0f / D) + RMS_EPS);
            float lg[32];
#pragma unroll
            for (int q = 0; q < 4; ++q)
#pragma unroll
                for (int r = 0; r < 4; ++r) { lg[4 * q + r] = __shfl(acc0[r], fr + 16 * q) * rstd + brt[4 * q + r]; lg[16 + 4 * q + r] = __shfl(acc1[r], fr + 16 * q) * rstd + brt[16 + 4 * q + r]; }
            float tv[4];
#pragma unroll
            for (int k = 0; k < 4; ++k) { float best = -3.0e38f; int bi = 0;
#pragma unroll
                for (int e = 0; e < 32; ++e) if (lg[e] > best) { best = lg[e]; bi = e; }
                te[k] = bi; tv[k] = best;
#pragma unroll
                for (int e = 0; e < 32; ++e) if (e == bi) lg[e] = -3.0e38f; }
            if (fq == 0) {
                const float e1 = __expf(tv[1] - tv[0]), e2 = __expf(tv[2] - tv[0]), e3 = __expf(tv[3] - tv[0]), inv = 1.0f / (1.0f + e1 + e2 + e3);
                gts[0] = inv; gts[1] = e1 * inv; gts[2] = e2 * inv; gts[3] = e3 * inv;
                *(u32x4*)(TE + row * 4) = (u32x4){(unsigned)te[0], (unsigned)te[1], (unsigned)te[2], (unsigned)te[3]};
                rstd_keep = rstd;
#pragma unroll
                for (int k = 0; k < 4; ++k) rk[k] = __hip_atomic_fetch_add(hist + te[k], 1u, __ATOMIC_RELAXED, __HIP_MEMORY_SCOPE_WORKGROUP);
            }
        }
        __syncthreads();
        if (c.tid < 32) ebase[c.tid] = __hip_atomic_fetch_add(cnt + c.tid, hist[c.tid], RLX_AGENT);
        __syncthreads();
        if (work && kh == 0 && fq == 0) { const u32x4 pp = {ebase[te[0]] + rk[0], ebase[te[1]] + rk[1], ebase[te[2]] + rk[2], ebase[te[3]] + rk[3]}; *(u32x4*)(TP + row * 4) = pp;
#pragma unroll
            for (int k = 0; k < 4; ++k) { TOKOF[te[k] * M + (int)pp[k]] = row; GATEOF[te[k] * M + (int)pp[k]] = gts[k]; RSOF[te[k] * M + (int)pp[k]] = rstd_keep; } }
        __syncthreads();
    }
}
__device__ __forceinline__ int moe_tables(const Ctx& c, LAS int* tb, LAS int* tile_e, LAS int* cntl) {
    __syncthreads();
    if (c.wave == 0) {
        const gu32* cnt = (const gu32*)(c.ws + WS_CTL) + CW_CNT; const int lane = c.lane;
        const int cn = lane < NE ? (int)__hip_atomic_load(cnt + (lane & 31), RLX_AGENT) : 0; if (lane < NE) cntl[lane] = cn;
        const int n = (cn + 255) >> 8;
        int incl = n;
#pragma unroll
        for (int o = 1; o < 32; o <<= 1) { const int t = __shfl_up(incl, o); if (lane >= o) incl += t; }
        int excl = incl - n; if (excl > MAXT) excl = MAXT;
        if (lane < NE) tb[lane] = excl;
        if (lane == NE - 1) tb[NE] = incl > MAXT ? MAXT : incl;
        if (lane < NE) for (int i = 0; i < n && excl + i < MAXT; ++i) tile_e[excl + i] = lane;
    }
    __syncthreads();
    return __builtin_amdgcn_readfirstlane(tb[NE]);
}
__device__ __forceinline__ void p10_final(const Args& a, const Ctx& c, const LAS int* tb) {
    const float* H1 = (const float*)(c.ws + WS_H1); const unsigned char* YS = c.ws + WS_YS;
    const int* TE = (const int*)(c.ws + WS_TOK); const int* TP = TE + M * 4; const float* gain = a.in[25];
    for (int row = c.gw; row < M; row += c.ngw) {
        f32x4 v[4];
#pragma unroll
        for (int j = 0; j < 4; ++j) v[j] = *(const f32x4*)(H1 + (size_t)row * D + 4 * c.lane + 256 * j);
        const u32x4 te4 = *(const u32x4*)(TE + row * 4), tp4 = *(const u32x4*)(TP + row * 4); u32x4 ts;
#pragma unroll
        for (int k = 0; k < 4; ++k) ts[k] = (unsigned)tb[te4[k]] * 256u + tp4[k];
        unsigned yw[4][4];
#pragma unroll
        for (int k = 0; k < 4; ++k) { const unsigned char* ys = YS + (size_t)ts[k] * D;
#pragma unroll
            for (int j = 0; j < 4; ++j) yw[k][j] = *(const unsigned*)(ys + 4 * c.lane + 256 * j); }
#pragma unroll
        for (int k = 0; k < 4; ++k)
#pragma unroll
            for (int j = 0; j < 4; ++j) { typedef float f32x2v __attribute__((ext_vector_type(2)));
                const f32x2v lo = __builtin_amdgcn_cvt_pk_f32_fp8(yw[k][j], false), hi = __builtin_amdgcn_cvt_pk_f32_fp8(yw[k][j], true);
                v[j].x += lo.x * 0.0625f; v[j].y += lo.y * 0.0625f; v[j].z += hi.x * 0.0625f; v[j].w += hi.y * 0.0625f; }
        float s = 0.f;
#pragma unroll
        for (int j = 0; j < 4; ++j) s += (v[j].x * v[j].x + v[j].y * v[j].y) + (v[j].z * v[j].z + v[j].w * v[j].w);
        const float rstd = 1.0f / sqrtf(wave_sum(s) * (1.0f / D) + RMS_EPS);
#pragma unroll
        for (int j = 0; j < 4; ++j) { const f32x4 g = *(const f32x4*)(gain + 4 * c.lane + 256 * j); *(f32x4*)(a.out + (size_t)row * D + 4 * c.lane + 256 * j) = v[j] * rstd * g; }
    }
}

#ifndef ATT_SPLIT
#define ATT_SPLIT 0
#endif
#ifndef MOE_CV
#define MOE_CV 32
#endif
#ifndef RT_SB
#define RT_SB 2
#endif
#ifndef ONE_LAUNCH
#define ONE_LAUNCH 0
#endif
#ifndef FAST_GEMM
#define FAST_GEMM 0
#endif
#ifndef FAST_MIX
#define FAST_MIX 0
#endif
constexpr int NPH = 10;

template <int STAGE> struct MoeFusedOrder {
    static constexpr bool HAS_HALF = false;
    MoeTabs T; int nt, x, j, nx; unsigned* dep; unsigned* tmo; bool same;
    __device__ __forceinline__ bool next(int i, Unit& u) const {
        constexpr int U1 = 8 * RT_SB, U2 = 4 * RT_SB;
        if constexpr (STAGE == 1) { const int s = j + 32 * i; if (s >= U1 * nx) return false; const int sb = (s / U1) * 8 + x, w = s % U1, rt = RT_SB * sb + (w >> 3); if (rt >= nt) return false;
            u.pm = rt; u.pn = __builtin_amdgcn_readfirstlane(T.tile_e[rt]) * 8 + (w & 7); return true; }
        else { const int t = ((j - U1 * nx) & 31) + 32 * i; if (t >= U2 * nx) return false; const int sb = (t / U2) * 8 + x, w = t % U2, rt = RT_SB * sb + (w >> 2); if (rt >= nt) return false;
            u.pm = rt; u.pn = __builtin_amdgcn_readfirstlane(T.tile_e[rt]) * 4 + (w & 3); return true; }
    }
    __device__ __forceinline__ unsigned row_id(const Unit& u, int r) const { const int e = u.pn >> 3; bool ok; const int p = moe_slot_pos(T, e, u.pm * 256 + r, ok); return ok ? (unsigned)T.tok_of[e * M + p] : 0u; }
    __device__ __forceinline__ void a_ready(const Unit& u) const {
        if constexpr (STAGE == 2) { unsigned* d = dep + u.pm * 8; XB_SPIN(xb_ld(d) < 64u, tmo); if (!same) __builtin_amdgcn_fence(__ATOMIC_ACQUIRE, "agent"); } }
    __device__ __forceinline__ void done(const Unit& u) const {
        if constexpr (STAGE == 1) { asm volatile("s_waitcnt vmcnt(0)" ::: "memory");
            if (!same) { __builtin_amdgcn_fence(__ATOMIC_RELEASE, "agent"); asm volatile("s_waitcnt vmcnt(0)" ::: "memory"); }
            if (pg8::fresh_lane() == 0) (void)xb_add(dep + u.pm * 8, 1u); } }
};
__device__ __forceinline__ int team_wgid(int bid) { return (bid & 7) * 32 + (bid >> 3); }
template <class S> struct DupOrder {
    S s;
    __device__ __forceinline__ bool next(int i, Unit& u) const { return s.next(i >> 1, u); }
    __device__ __forceinline__ void a_ready(const Unit& u) const { s.a_ready(u); }
    __device__ __forceinline__ void done(const Unit& u) const { s.done(u); }
    __device__ __forceinline__ unsigned row_id(const Unit& u, int r) const { return s.row_id(u, r); }
};
template <bool FAST, class E, class S, bool F8 = false, bool GATHER = false>
__device__ __forceinline__ void run_gemm(const Ctx& c, const bf16* A, const bf16* Bt, int K, const S& s, const E& e) {
    if constexpr (FAST) { pg8::Gemm g{A, Bt, 0, 0, K, c.wave}; FastEpi<E> fe{e};
        if constexpr (KDUPID == E::ID) { DupOrder<S> d{s}; pg8::gemm_phase<FastEpi<E>, DupOrder<S>, true, true, F8, GATHER>(c.lds, g, d, fe); }
        else pg8::gemm_phase<FastEpi<E>, S, true, true, F8, GATHER>(c.lds, g, s, fe); }
    else { Unit u; for (int i = 0; s.next(i, u); ++i) naive_gemm_unit(A, K, Bt, K, K, u.pm, u.pn, e, c.wave, c.lane); }
}

__global__ void __launch_bounds__(NWAVES * 64, 2) fwd(Args args) {
    extern __shared__ __attribute__((aligned(16))) unsigned char lds_raw[];
    Ctx c0; c0.lds = (LAS unsigned char*)lds_raw; c0.ws = args.ws; c0.tid = threadIdx.x; c0.lane = c0.tid & 63; c0.wave = __builtin_amdgcn_readfirstlane(c0.tid >> 6);
    c0.G = gridDim.x; c0.bid = blockIdx.x; c0.gw = c0.bid * NWAVES + c0.wave; c0.ngw = c0.G * NWAVES;
    const Ctx& c = c0;
    volatile LAS unsigned* MISC = (volatile LAS unsigned*)(c.lds + LDSCTL_OFF);
    LAS int* tb = (LAS int*)(c.lds + LDSCTL_OFF + 512); LAS int* tile_e = (LAS int*)(c.lds + LDSCTL_OFF + 1024); LAS int* cntl = (LAS int*)(c.lds + LDSCTL_OFF + 256);
    for (int u = c.tid; u < (LDS_BYTES - LDSCTL_OFF) / 4; u += NWAVES * 64) ((LAS unsigned*)(c.lds + LDSCTL_OFF))[u] = 0u;
    __syncthreads();
    volatile LAS unsigned long long* ptab = (volatile LAS unsigned long long*)(c0.lds + LDSCTL_OFF + 2560);
    if (c0.tid < 26) ptab[c0.tid] = (unsigned long long)args.in[c0.tid];
    if (c0.tid == 26) ptab[26] = (unsigned long long)args.out;
    __syncthreads();
    const int lo = args.ph_lo, hi = args.ph_hi;
    XcdBarrier bar; bar.bar = (unsigned*)(c.ws + WS_CTL) + CW_BAR; bar.x = 0; bar.st = nullptr;
    if (hi - lo > 1) bar = xcd_barrier_post((unsigned*)(c.ws + WS_CTL) + CW_BAR, MISC + 8);
    if (c0.tid == 0) __hip_atomic_store((unsigned*)(c.ws + WS_CTL) + CW_XID + c0.bid, xb_xcc_id() + 1u, __ATOMIC_RELAXED, __HIP_MEMORY_SCOPE_AGENT);
#ifndef DISMASK
#define DISMASK 0
#endif
#define IN(k) (lo <= (k) && (k) < hi && !((DISMASK >> (k)) & 1))
#define GRID_BAR() xcd_barrier(bar, c0.wave == 0 && pg8::fresh_lane() == 0)
#ifndef REPMASK
#define REPMASK 0
#endif
#ifndef FUSE_MOE
#define FUSE_MOE 0
#endif
#ifndef FUSE_TEAM
#define FUSE_TEAM 1
#endif
#define fuse (FUSE_TEAM && ONE_LAUNCH && !REPMASK && c0.G == 256 && hi - lo == NPH)
#define TEAM_BAR(pm, stage) do { asm volatile("s_waitcnt vmcnt(0)" ::: "memory"); __syncthreads(); \
        if (c0.wave == 0 && pg8::fresh_lane() == 0) { unsigned* tw = (unsigned*)(c0.ws + WS_CTL) + CW_TEAM + ((pm) * 4 + (stage)) * 16; \
            unsigned* xid = (unsigned*)(c0.ws + WS_CTL) + CW_XID; const unsigned me = xb_xcc_id() + 1u; bool same; const int _w0 = team_wgid(c0.bid) & ~12; \
            if ((stage) == 0) { unsigned _id[4];        \
                _Pragma("unroll") for (int _j = 0; _j < 4; ++_j) { const int _w = _w0 | (_j << 2); _id[_j] = xb_ld(xid + ((_w & 31) * 8 + (_w >> 5))); } \
                same = (_id[0] == me) & (_id[1] == me) & (_id[2] == me) & (_id[3] == me); MISC[14] = same ? 1u : 0u; } \
            else same = MISC[14] != 0u; \
            if (!same) { __builtin_amdgcn_fence(__ATOMIC_RELEASE, "agent"); asm volatile("s_waitcnt vmcnt(0)" ::: "memory"); }     \
            (void)xb_add(tw, 1u); \
            XB_SPIN(xb_ld(tw) < 4u, (unsigned*)(c0.ws + WS_CTL) + CW_BAR); \
            __builtin_amdgcn_fence(__ATOMIC_ACQUIRE, "agent"); asm volatile("s_waitcnt vmcnt(0)" ::: "memory"); } \
        __syncthreads(); } while (0)
#define TEAM_ARRIVE(pm, stage) do { asm volatile("s_waitcnt vmcnt(0)" ::: "memory"); __syncthreads(); \
        if (c0.wave == 0 && pg8::fresh_lane() == 0) { unsigned* tw = (unsigned*)(c0.ws + WS_CTL) + CW_TEAM + ((pm) * 4 + (stage)) * 16; \
            if (MISC[14] == 0u) { __builtin_amdgcn_fence(__ATOMIC_RELEASE, "agent"); asm volatile("s_waitcnt vmcnt(0)" ::: "memory"); } \
            (void)xb_add(tw, 1u); } } while (0)
#define TEAM_WAIT(pm, stage) do { if (c0.wave == 0 && pg8::fresh_lane() == 0) { unsigned* tw = (unsigned*)(c0.ws + WS_CTL) + CW_TEAM + ((pm) * 4 + (stage)) * 16; \
            XB_SPIN(xb_ld(tw) < 4u, (unsigned*)(c0.ws + WS_CTL) + CW_BAR); \
            __builtin_amdgcn_fence(__ATOMIC_ACQUIRE, "agent"); asm volatile("s_waitcnt vmcnt(0)" ::: "memory"); } \
        __syncthreads(); } while (0)
#define SEAM(k) do { if (IN(k) && IN((k) + 1) && !(fuse && (k) >= 3 && (k) <= 5) && !(fuse && FUSE_MOE && (k) == 7)) GRID_BAR(); } while (0)
#define WSB (c0.ws)
#define XN ((bf16*)(WSB + WS_XN))
#define U ((bf16*)(WSB + WS_U))
#define Q ((bf16*)(WSB + WS_Q))
#define Kb ((bf16*)(WSB + WS_K))
#define Vt ((bf16*)(WSB + WS_VT))
#define GSp ((bf16*)(WSB + WS_GS))
#define GAp ((bf16*)(WSB + WS_GA))
#define Z ((bf16*)(WSB + WS_Z))
#define BRA ((bf16*)(WSB + WS_BRA))
#define MIX ((bf16*)(WSB + WS_MIX))
#define H1 ((float*)(WSB + WS_H1))
#define HID ((bf16*)(WSB + WS_HID))
#define YS ((bf16*)(WSB + WS_YS))

    int mixpass = 0, glupass = 0;
#ifndef GLU_NOSTORE
#define GLU_NOSTORE 0
#endif
#define PHASE(k, ...) if (IN(k)) { Ctx c = c0; c.lane = pg8::fresh_lane(); c.tid = c.wave * 64 + c.lane; Args pa; \
        _Pragma("unroll") for (int _k = 0; _k < 26; ++_k) { const unsigned long long _v = ptab[_k]; pa.in[_k] = (const float*)(const GAS float*)(((unsigned long long)(unsigned)__builtin_amdgcn_readfirstlane((int)(_v >> 32)) << 32) | (unsigned)__builtin_amdgcn_readfirstlane((int)_v)); } \
        { const unsigned long long _v = ptab[26]; pa.out = (float*)(GAS float*)(((unsigned long long)(unsigned)__builtin_amdgcn_readfirstlane((int)(_v >> 32)) << 32) | (unsigned)__builtin_amdgcn_readfirstlane((int)_v)); }     pa.ws = c0.ws; pa.ph_lo = 0; pa.ph_hi = 0; __VA_ARGS__ if constexpr ((REPMASK >> (k)) & 1) { GRID_BAR(); __VA_ARGS__ } } SEAM(k);
    PHASE(0, p0_prologue(pa, c);)
    PHASE(1, {
        EpiInProj E{U, Q, Kb, Vt, GSp, GAp, (const float*)(WSB + WS_ROT)};
        if constexpr (FAST_GEMM && FAST_MIX) {
            if (c.bid < c.G - NCV) { InProjOrder S{c.G - NCV, c.bid}; run_gemm<true>(c, XN, (const bf16*)(WSB + WS_WIN), 1024, S, E); }
            else tr8_run(pa, c, c.bid - (c.G - NCV), NCV, 3072 - NCV_ITEMS, (MOE_CV && c.G == 256) ? 2048 : 3072); }
        else { pg8::StaticOrder S; S.init(MP, INW, c.G, c.bid); run_gemm<FAST_GEMM>(c, XN, (const bf16*)(WSB + WS_WIN), 1024, S, E); } })
    PHASE(2, if constexpr (FAST_MIX) {
#ifndef DEFER_REP
#define DEFER_REP 0
#endif
#ifndef MIXSKIP
#define MIXSKIP 0
#endif
 if (!(MIXSKIP & 1) || mixpass == 0) { for (int it = c.bid; it < 128; it += c.G) ssm_chain(c, it >> 1, it & 1); }
 if constexpr (FAST_GEMM) { if (mixpass == 0 || DEFER_REP) { EpiInProj E{U, Q, Kb, Vt, GSp, GAp, (const float*)(WSB + WS_ROT)};
     const int half = c.G >> 1;
     DeferredOrder S{c.bid >= half ? c.bid - half : -1, half, c.G - NCV};
     run_gemm<true>(c, XN, (const bf16*)(WSB + WS_WIN), 1024, S, E); __syncthreads(); } }
 if ((!(MIXSKIP & 2) || mixpass == 0) && (!ATT_SPLIT || c.bid >= ATT_SPLIT || c.G <= ATT_SPLIT)) attn_fast(pa, c);
 ++mixpass;
 } else { p2_ssm_naive(pa, c); p2_attn_naive(pa, c); })
#define TEAM_PM(var) pg8::Unit var; { const int _w = team_wgid(c0.bid); var.pm = (_w >> 4) * 4 + (_w & 3); var.pn = (_w & 15) >> 2; }
    PHASE(3, {
        { pg8::StaticOrder S; S.init(M, 1024, c.G, c.bid); EpiGlu E{Z, pa.in[13], BRA};
          run_gemm<FAST_GEMM>(c, Z, (const bf16*)(WSB + WS_WGLU), 1024, S, E); }
        if constexpr (FAST_GEMM) { if (fuse) {
            { TEAM_PM(tu) TEAM_BAR(tu.pm, 0); }
            { EpiBr E{GSp, GAp, MIX}; PairOrder S2; S2.so.init(M, 1024, c.G, c.bid); run_gemm<true>(c, BRA, (const bf16*)(WSB + WS_WBR), 1024, S2, E); }
            { TEAM_PM(tu) TEAM_BAR(tu.pm, 1); }
            { pg8::StaticOrder S; S.init(M, 1024, c.G, c.bid); EpiOut E{pa.in[0], H1}; run_gemm<true>(c, MIX, (const bf16*)(WSB + WS_WOUT), 1024, S, E); }
            { TEAM_PM(tu) TEAM_ARRIVE(tu.pm, 2); }
            router_stage(pa, c);
            { TEAM_PM(tu) TEAM_WAIT(tu.pm, 2); }
            { TEAM_PM(tu) p6_router(pa, c, tu.pm * 16 + tu.pn * 4, true); }
        } } })
    PHASE(4, if (!fuse) {
        EpiBr E{GSp, GAp, MIX};
        if constexpr (FAST_GEMM) { PairOrder S; S.so.init(M, 1024, c.G, c.bid); run_gemm<true>(c, BRA, (const bf16*)(WSB + WS_WBR), 1024, S, E); }
        else { pg8::StaticOrder S; S.init(M, 1024, c.G, c.bid); run_gemm<false>(c, BRA, (const bf16*)(WSB + WS_WBR), 1024, S, E); } })
    PHASE(5, if (!fuse) {
        pg8::StaticOrder S; S.init(M, 1024, c.G, c.bid);
        EpiOut E{pa.in[0], H1};
        run_gemm<FAST_GEMM>(c, MIX, (const bf16*)(WSB + WS_WOUT), 1024, S, E); })
    PHASE(6, if (!fuse) p6_router(pa, c, -1);)
    PHASE(7, {
        const int nt = moe_tables(c, tb, tile_e, cntl);
        const MoeTabs T{tile_e, tb, cntl, (const int*)(WSB + WS_TOKOF), (const float*)(WSB + WS_GATEOF), (const float*)(WSB + WS_RSOF)};
        if (fuse && FUSE_MOE) {
            if (c.tid == 0) { unsigned* xid = (unsigned*)(WSB + WS_CTL) + CW_XID; const unsigned me = xb_xcc_id() + 1u; bool same = true;
                for (int k = 0; k < 32; ++k) same = same && (xb_ld(xid + (c.bid & 7) + 8 * k) == me);
                MISC[12] = same ? 1u : 0u; }
            __syncthreads();
            const bool same = __builtin_amdgcn_readfirstlane((int)MISC[12]) != 0;
            const int nsb = (nt + RT_SB - 1) / RT_SB, gx = c.bid & 7, nx = (nsb - gx + 7) >> 3;
            unsigned* dep = (unsigned*)(WSB + WS_CTL) + CW_DEP; unsigned* tmo = (unsigned*)(WSB + WS_CTL) + CW_BAR;
            { MoeFusedOrder<1> S{T, nt, gx, c.bid >> 3, nx, dep, tmo, same};
              EpiMoe1 E{pa.in[22], (unsigned char*)HID, T, (LAS float*)(c.lds + LDSCTL_OFF + 8192)};
              run_gemm<true, EpiMoe1, MoeFusedOrder<1>, true, true>(c, (const bf16*)(WSB + WS_HN2), (const bf16*)(WSB + WS_WGU), 512, S, E); }
            { MoeFusedOrder<2> S{T, nt, gx, c.bid >> 3, nx, dep, tmo, same};
              EpiMoe2 E{pa.in[24], (unsigned char*)YS, T, (LAS float*)(c.lds + LDSCTL_OFF + 8192)};
              run_gemm<true, EpiMoe2, MoeFusedOrder<2>, true>(c, HID, (const bf16*)(WSB + WS_WDN), 512, S, E); }
        } else {
        if (MOE_CV && c.G == 256 && c.bid >= c.G - MOE_CV) tr8_run(pa, c, c.bid - (c.G - MOE_CV), MOE_CV, 2048, 3072);
        else {
        MoeOrder S{T, nt, 8, (MOE_CV && c.G == 256) ? c.G - MOE_CV : c.G, c.bid};
        EpiMoe1 E{pa.in[22], (unsigned char*)HID, T, (LAS float*)(c.lds + LDSCTL_OFF + 8192)};
        run_gemm<true, EpiMoe1, MoeOrder, true, true>(c, (const bf16*)(WSB + WS_HN2), (const bf16*)(WSB + WS_WGU), 512, S, E); } } })
    PHASE(8, if (!(fuse && FUSE_MOE)) {
        const int nt = (ONE_LAUNCH && !REPMASK) ? __builtin_amdgcn_readfirstlane(tb[NE]) : moe_tables(c, tb, tile_e, cntl);
        const MoeTabs T{tile_e, tb, cntl, (const int*)(WSB + WS_TOKOF), (const float*)(WSB + WS_GATEOF), (const float*)(WSB + WS_RSOF)};
        MoeOrder S{T, nt, 4, c.G, c.bid};
        EpiMoe2 E{pa.in[24], (unsigned char*)YS, T, (LAS float*)(c.lds + LDSCTL_OFF + 8192)};
        run_gemm<true, EpiMoe2, MoeOrder, true>(c, HID, (const bf16*)(WSB + WS_WDN), 512, S, E); })
    PHASE(9, { if (!(ONE_LAUNCH && !REPMASK)) moe_tables(c, tb, tile_e, cntl); p10_final(pa, c, tb); })
#undef PHASE
#undef WSB
#undef XN
#undef U
#undef Q
#undef Kb
#undef Vt
#undef GSp
#undef GAp
#undef Z
#undef BRA
#undef MIX
#undef H1
#undef HID
#undef YS
#undef IN
#undef SEAM
#undef fuse
}

extern "C" void kernel_launch(void* const* d_in, const int* in_sizes, int n_in, void* d_out, int out_size, void* d_ws, size_t ws_size, hipStream_t stream) {
    static int grid = 0;
    if (grid == 0) {
        if (n_in != 26 || in_sizes[0] != M * D || out_size != M * D || ws_size < WS_END) { fprintf(stderr, "kernel_launch: unexpected shapes (n_in %d, in0 %d, out %d, ws %zu)\n", n_in, n_in > 0 ? in_sizes[0] : -1, out_size, ws_size); grid = -1; return; }
        int dev = 0, cus = 0, per_cu = 0;
        if (hipGetDevice(&dev) != hipSuccess || hipDeviceGetAttribute(&cus, hipDeviceAttributeMultiprocessorCount, dev) != hipSuccess) { grid = -1; return; }
        if (hipFuncSetAttribute((const void*)fwd, hipFuncAttributeMaxDynamicSharedMemorySize, LDS_BYTES) != hipSuccess) { fprintf(stderr, "kernel_launch: hipFuncSetAttribute failed\n"); grid = -1; return; }
        if (hipOccupancyMaxActiveBlocksPerMultiprocessor(&per_cu, (const void*)fwd, NWAVES * 64, LDS_BYTES) != hipSuccess || per_cu < 1) fprintf(stderr, "kernel_launch: occupancy query says %d\n", per_cu);
        (void)hipGetLastError();
        grid = cus;
    }
    if (grid < 0) return;
    if (hipMemsetAsync((char*)d_ws + WS_CTL, 0, CTL_ZERO_BYTES, stream) != hipSuccess) return;
    Args a{};
    for (int i = 0; i < 26; ++i) a.in[i] = (const float*)d_in[i];
    a.out = (float*)d_out; a.ws = (unsigned char*)d_ws;
#if ONE_LAUNCH
    a.ph_lo = 0; a.ph_hi = NPH;
    hipLaunchKernelGGL(fwd, dim3(grid), dim3(NWAVES * 64), LDS_BYTES, stream, a);
#else
    for (int p = 0; p < NPH; ++p) { a.ph_lo = p; a.ph_hi = p + 1; hipLaunchKernelGGL(fwd, dim3(grid), dim3(NWAVES * 64), LDS_BYTES, stream, a); }
#endif
}
```
